# Optimizing an MI355X kernel written in HIP

```python
import numpy as np
import jax
import jax.numpy as jnp
from jax import lax

D_MODEL = 1024
BATCH = 4
SEQ = 4096
DEPTH = 2

GRID_W = 64
CTX_LEN = 256
N_EVEN = (DEPTH + 1) // 2
N_ODD = DEPTH // 2
CHUNK = 64
CONV_K = 4
CONV_PAD_L = 2
CONV_PAD_R = 1
EPS = 1e-6
M_HEADS = 4
M_DK = D_MODEL // (2 * M_HEADS)
M_DV = D_MODEL // M_HEADS
M_QK = 2 * M_HEADS * M_DK
M_V = M_HEADS * M_DV
LRU_W = D_MODEL
LRU_BLOCKS = 8
LRU_BW = LRU_W // LRU_BLOCKS
LRU_C = 8.0
G_HEADS = 4
G_DK = D_MODEL // (2 * G_HEADS)
G_DV = D_MODEL // G_HEADS
G_QK = 2 * G_HEADS * G_DK
G_V = G_HEADS * G_DV
G_RANK = 16
G_TAU = 16.0
S_HEADS = 16
S_P = D_MODEL // S_HEADS
S_INNER = S_HEADS * S_P
S_N = 128
S_GROUPS = 2
S_HPG = S_HEADS // S_GROUPS
S_XBC = S_INNER + 2 * S_GROUPS * S_N
FF_DENSE = 2816
N_EXPERTS = 8
TOP_K = 2
FF_EXPERT = 3584
MOE_BLOCK = 256
AB_SIZES = [M_QK, M_V, M_V, 4 * M_HEADS, LRU_W, LRU_W]
AB_IN = sum(AB_SIZES)
CD_SIZES = [G_QK, G_V, G_V, 2 * G_RANK, S_INNER, S_XBC, 2 * S_HEADS]
CD_IN = sum(CD_SIZES)

kernel_name = 'hybrid_mlstm_rglru_gla_ssd_moe_trunk'


def split_cols(a, sizes):
    return jnp.split(a, np.cumsum(sizes)[:-1].tolist(), axis=-1)


def rmsnorm(u, g):
    uf = u.astype(jnp.float32)
    uf = uf * lax.rsqrt(jnp.mean(uf * uf, axis=-1, keepdims=True) + EPS)
    return (uf * g.astype(jnp.float32)).astype(u.dtype)


def headnorm(u, g, n_heads):
    shp = u.shape
    uh = u.astype(jnp.float32).reshape(*shp[:-1], n_heads, shp[-1] // n_heads)
    uh = uh * lax.rsqrt(jnp.mean(uh * uh, axis=-1, keepdims=True) + EPS)
    return uh.reshape(shp) * g.astype(jnp.float32)


def adaln(u, g, shift, scale):
    return rmsnorm(u, g) * (1 + scale) + shift


def dwconv(u, w, b):
    y = lax.conv_general_dilated(u, w[:, None, :].astype(u.dtype), window_strides=(1,),
                                 padding=[(CONV_PAD_L, CONV_PAD_R)],
                                 dimension_numbers=('NWC', 'WIO', 'NWC'),
                                 feature_group_count=u.shape[-1])
    return y + b.astype(u.dtype)


def stream_conv(u, w, b, n_ctx, rows):
    uc, ul = u[:, :n_ctx], u[:, n_ctx:]
    bsz, s, ch = ul.shape
    yl = dwconv(ul.reshape(bsz * rows, GRID_W, ch), w, b).reshape(bsz, s, ch)
    return jnp.concatenate([dwconv(uc, w, b), yl], axis=1)


def flip_streams(a, n_ctx):
    return jnp.concatenate([jnp.flip(a[:, :n_ctx], axis=1), jnp.flip(a[:, n_ctx:], axis=1)], axis=1)


def to_chunks(a):
    bsz, t = a.shape[:2]
    return jnp.moveaxis(a.reshape(bsz, t // CHUNK, CHUNK, *a.shape[2:]), 1, 0)


def from_chunks(a):
    a = jnp.moveaxis(a, 0, 1)
    return a.reshape(a.shape[0], a.shape[1] * a.shape[2], *a.shape[3:])


def chunk_mask(n_trailing):
    m = jnp.tril(jnp.ones((CHUNK, CHUNK), dtype=bool))
    return m.reshape((1, CHUNK, CHUNK) + (1,) * n_trailing)


def mlstm_scan(q, k, v, ig, lf):
    bsz, _, nh, dk = q.shape
    dv = v.shape[-1]
    mask = chunk_mask(1)

    def step(carry, inp):
        cmat, nvec, m = carry
        qc, kc, vc, ic, fc = inp
        b = jnp.cumsum(fc, axis=1)
        g = b + m[:, None]
        dlog = jnp.where(mask, b[:, :, None] - b[:, None] + ic[:, None], -jnp.inf)
        m_t = jnp.maximum(g, dlog.max(axis=2))
        w_inter = jnp.exp(g - m_t)
        sc = jnp.einsum('bthd,bshd->btsh', qc, kc) * jnp.exp(dlog - m_t[:, :, None])
        num = w_inter[..., None] * jnp.einsum('bhvd,bthd->bthv', cmat, qc) + jnp.einsum('btsh,bshv->bthv', sc, vc)
        den = w_inter * jnp.einsum('bhd,bthd->bth', nvec, qc) + sc.sum(axis=2)
        h = num / jnp.maximum(jnp.abs(den), jnp.exp(-m_t))[..., None]
        bl = b[:, -1]
        a_s = bl[:, None] - b + ic
        m_new = jnp.maximum(bl + m, a_s.max(axis=1))
        decay = jnp.exp(bl + m - m_new)
        ws = jnp.exp(a_s - m_new[:, None])
        cmat = decay[..., None, None] * cmat + jnp.einsum('bsh,bshv,bshd->bhvd', ws, vc, kc)
        nvec = decay[..., None] * nvec + jnp.einsum('bsh,bshd->bhd', ws, kc)
        return (cmat, nvec, m_new), h

    init = (jnp.zeros((bsz, nh, dv, dk), jnp.float32), jnp.zeros((bsz, nh, dk), jnp.float32),
            jnp.zeros((bsz, nh), jnp.float32))
    _, hs = lax.scan(step, init, (to_chunks(q), to_chunks(k), to_chunks(v), to_chunks(ig), to_chunks(lf)))
    return from_chunks(hs)


def _lin_combine(left, right):
    a1, b1 = left
    a2, b2 = right
    return a1 * a2, a2 * b1 + b2


def rglru(u, wa, ba, wx, bx, lam):
    bsz, t, wdt = u.shape
    ub = u.reshape(bsz, t, LRU_BLOCKS, LRU_BW)
    r = jax.nn.sigmoid(jnp.einsum('btnc,ncd->btnd', ub, wa.astype(jnp.float32)).reshape(bsz, t, wdt) + ba)
    i = jax.nn.sigmoid(jnp.einsum('btnc,ncd->btnd', ub, wx.astype(jnp.float32)).reshape(bsz, t, wdt) + bx)
    log_a = -LRU_C * r * jax.nn.softplus(-lam.astype(jnp.float32))
    a = jnp.exp(log_a)
    b = jnp.sqrt(-jnp.expm1(2.0 * log_a)) * (i * u)
    _, hs = lax.associative_scan(_lin_combine, (a, b), axis=1)
    return hs


def gla_scan(q, k, v, lg):
    bsz, _, nh, dk = q.shape
    dv = v.shape[-1]
    mask = chunk_mask(2)

    def step(state, inp):
        qc, kc, vc, gc = inp
        b = jnp.cumsum(gc, axis=1)
        inter = jnp.einsum('bthd,bhdv->bthv', qc * jnp.exp(b), state)
        decay = jnp.exp(jnp.where(mask, b[:, :, None] - b[:, None], -jnp.inf))
        att = jnp.einsum('bthd,bshd,btshd->btsh', qc, kc, decay)
        out = inter + jnp.einsum('btsh,bshv->bthv', att, vc)
        bl = b[:, -1]
        state = jnp.exp(bl)[..., None] * state + jnp.einsum('bshd,bshv->bhdv', kc * jnp.exp(bl[:, None] - b), vc)
        return state, out

    init = jnp.zeros((bsz, nh, dk, dv), jnp.float32)
    _, outs = lax.scan(step, init, (to_chunks(q), to_chunks(k), to_chunks(v), to_chunks(lg)))
    return from_chunks(outs)


def ssd_scan(x, dt, la, bm, cm):
    bsz = x.shape[0]
    mask = chunk_mask(2)

    def step(state, inp):
        xc, dtc, lac, bc, cc = inp
        b = jnp.cumsum(lac, axis=1)
        cb = jnp.einsum('btgn,bsgn->btsg', cc, bc)
        decay = jnp.exp(jnp.where(mask, b[:, :, None] - b[:, None], -jnp.inf))
        intra = jnp.einsum('btsg,btsge,bsgep->btgep', cb, decay, xc * dtc[..., None])
        inter = jnp.einsum('btgn,bgepn->btgep', cc, state) * jnp.exp(b)[..., None]
        bl = b[:, -1]
        w = jnp.exp(bl[:, None] - b) * dtc
        state = jnp.exp(bl)[..., None, None] * state + jnp.einsum('bsge,bsgep,bsgn->bgepn', w, xc, bc)
        return state, intra + inter

    init = jnp.zeros((bsz, S_GROUPS, S_HPG, S_P, S_N), jnp.float32)
    _, ys = lax.scan(step, init, (to_chunks(x), to_chunks(dt), to_chunks(la), to_chunks(bm), to_chunks(cm)))
    return from_chunks(ys)


def mix_ab(h, n_ctx, rows, in_w, m_conv_w, m_conv_b, m_gate_b, m_norm_w, l_conv_w, l_conv_b,
           l_wa, l_ba, l_wx, l_bx, l_lam, out_w):
    bsz, t, _ = h.shape
    fl = lambda a: flip_streams(a, n_ctx)
    qk, v, o, gt, lx, lg = split_cols(h @ in_w, AB_SIZES)
    qk = jax.nn.silu(stream_conv(qk, m_conv_w, m_conv_b, n_ctx, rows))
    q, k = jnp.split(qk, 2, axis=-1)
    q = q.reshape(bsz, t, M_HEADS, M_DK).astype(jnp.float32)
    k = k.reshape(bsz, t, M_HEADS, M_DK).astype(jnp.float32) * (M_DK ** -0.5)
    v = v.reshape(bsz, t, M_HEADS, M_DV).astype(jnp.float32)
    gt = gt.astype(jnp.float32).reshape(bsz, t, 4, M_HEADS) + m_gate_b.astype(jnp.float32)
    ig_f, ig_b = gt[:, :, 0], gt[:, :, 1]
    lf_f, lf_b = jax.nn.log_sigmoid(gt[:, :, 2]), jax.nn.log_sigmoid(gt[:, :, 3])
    hm = mlstm_scan(q, k, v, ig_f, lf_f) + fl(mlstm_scan(fl(q), fl(k), fl(v), fl(ig_b), fl(lf_b)))
    hm = headnorm(hm.reshape(bsz, t, M_V), m_norm_w, M_HEADS) * jax.nn.sigmoid(o.astype(jnp.float32))
    xl = stream_conv(lx, l_conv_w, l_conv_b, n_ctx, rows).astype(jnp.float32)
    hl = (rglru(xl, l_wa[0], l_ba[0], l_wx[0], l_bx[0], l_lam[0])
          + fl(rglru(fl(xl), l_wa[1], l_ba[1], l_wx[1], l_bx[1], l_lam[1])))
    hl = hl * jax.nn.gelu(lg.astype(jnp.float32))
    return jnp.concatenate([hm, hl], axis=-1).astype(h.dtype) @ out_w


def mix_cd(h, n_ctx, rows, in_w, g_alpha_w, g_alpha_b, g_norm_w, s_conv_w, s_conv_b,
           s_dt_bias, s_A_log, s_D, s_norm_w, out_w):
    bsz, t, _ = h.shape
    fl = lambda a: flip_streams(a, n_ctx)
    gqk, gv, gr, ga, z, xbc, dt = split_cols(h @ in_w, CD_SIZES)
    gq, gk = jnp.split(gqk, 2, axis=-1)
    gq = gq.reshape(bsz, t, G_HEADS, G_DK).astype(jnp.float32) * (G_DK ** -0.5)
    gk = gk.reshape(bsz, t, G_HEADS, G_DK).astype(jnp.float32)
    gv = gv.reshape(bsz, t, G_HEADS, G_DV).astype(jnp.float32)
    ga = ga.astype(jnp.float32).reshape(bsz, t, 2, G_RANK)

    def loggate(d):
        pre = ga[:, :, d] @ g_alpha_w[d].astype(jnp.float32) + g_alpha_b[d].astype(jnp.float32)
        return (jax.nn.log_sigmoid(pre) / G_TAU).reshape(bsz, t, G_HEADS, G_DK)

    og = gla_scan(gq, gk, gv, loggate(0)) + fl(gla_scan(fl(gq), fl(gk), fl(gv), fl(loggate(1))))
    og = headnorm(og.reshape(bsz, t, G_V), g_norm_w, G_HEADS) * jax.nn.silu(gr.astype(jnp.float32))
    xbc = jax.nn.silu(stream_conv(xbc, s_conv_w, s_conv_b, n_ctx, rows)).astype(jnp.float32)
    sx, sb, sc = split_cols(xbc, [S_INNER, S_GROUPS * S_N, S_GROUPS * S_N])
    sx = sx.reshape(bsz, t, S_GROUPS, S_HPG, S_P)
    sb = sb.reshape(bsz, t, S_GROUPS, S_N)
    sc = sc.reshape(bsz, t, S_GROUPS, S_N)
    dt = jax.nn.softplus(dt.astype(jnp.float32).reshape(bsz, t, 2, S_HEADS) + s_dt_bias.astype(jnp.float32))
    la = dt * (-jnp.exp(s_A_log.astype(jnp.float32)))
    grp = lambda a, d: a[:, :, d].reshape(bsz, t, S_GROUPS, S_HPG)
    ys = (ssd_scan(sx, grp(dt, 0), grp(la, 0), sb, sc)
          + fl(ssd_scan(fl(sx), fl(grp(dt, 1)), fl(grp(la, 1)), fl(sb), fl(sc))))
    ys = ys + s_D.astype(jnp.float32).reshape(S_GROUPS, S_HPG)[..., None] * sx
    ys = rmsnorm(ys.reshape(bsz, t, S_INNER) * jax.nn.silu(z.astype(jnp.float32)), s_norm_w)
    return jnp.concatenate([og, ys], axis=-1).astype(h.dtype) @ out_w


def swiglu(h, w1, w2):
    g, u = jnp.split(h @ w1, 2, axis=-1)
    return (jax.nn.silu(g) * u) @ w2


def moe_swiglu(h, router_w, router_b, w1, w2):
    bsz, t, dm = h.shape
    tok = h.reshape(-1, dm)
    n = tok.shape[0]
    logits = (tok @ router_w).astype(jnp.float32) + router_b.astype(jnp.float32)
    top_logit, top_idx = lax.top_k(logits, TOP_K)
    gates = jax.nn.softmax(top_logit, axis=-1).astype(h.dtype)
    flat_e = top_idx.reshape(-1)
    n_assign = n * TOP_K
    flat_tok = jnp.arange(n_assign, dtype=jnp.int32) // TOP_K
    order = jnp.argsort(flat_e)
    sorted_e = flat_e[order]
    counts = jnp.bincount(flat_e, length=N_EXPERTS)
    padded = (counts + MOE_BLOCK - 1) // MOE_BLOCK * MOE_BLOCK
    starts = jnp.cumsum(counts) - counts
    ends_p = jnp.cumsum(padded)
    pstarts = ends_p - padded
    slot_sorted = (pstarts[sorted_e] + jnp.arange(n_assign, dtype=jnp.int32) - starts[sorted_e]).astype(jnp.int32)
    slot = jnp.zeros((n_assign,), jnp.int32).at[order].set(slot_sorted)
    n_blocks = -(-n_assign // MOE_BLOCK) + N_EXPERTS
    slot_tok = jnp.full((n_blocks * MOE_BLOCK,), n, jnp.int32).at[slot].set(flat_tok)
    block_e = jnp.minimum(jnp.searchsorted(ends_p, jnp.arange(n_blocks, dtype=jnp.int32) * MOE_BLOCK, side='right'),
                          N_EXPERTS - 1)
    tok_pad = jnp.concatenate([tok, jnp.zeros((1, dm), tok.dtype)], axis=0)
    xs = tok_pad[slot_tok].reshape(n_blocks, MOE_BLOCK, dm)

    def expert_block(args):
        xb, e = args
        return swiglu(xb, w1[e], w2[e])

    ys = lax.map(expert_block, (xs, block_e)).reshape(-1, dm)
    y = (ys[slot].reshape(n, TOP_K, dm) * gates[..., None]).sum(axis=1)
    return y.reshape(bsz, t, dm)


def setup_inputs(seed: int = 0) -> dict:
    key = jax.random.key(seed)
    ks = iter(jax.random.split(key, 48))

    def nrm(shape, scale):
        return jax.random.normal(next(ks), shape, jnp.float32) * scale

    def unif(shape, lo, hi):
        return jax.random.uniform(next(ks), shape, jnp.float32, lo, hi)

    D = D_MODEL
    x = nrm((BATCH, SEQ, D), 1.0)
    c = nrm((BATCH, D), 1.0)
    ctx = nrm((BATCH, CTX_LEN, D), 1.0)
    c_ctx = nrm((D,), 1.0)
    mod_w = nrm((DEPTH, D, 6 * D), 0.5 * D ** -0.5)
    mod_b = nrm((DEPTH, 6 * D), 0.01)
    norm_g = 1.0 + nrm((DEPTH, 4, D), 0.02)
    ab_in_w = nrm((N_EVEN, D, AB_IN), D ** -0.5)
    m_conv_w = nrm((N_EVEN, CONV_K, M_QK), 0.5)
    m_conv_b = nrm((N_EVEN, M_QK), 0.01)
    m_gate_b = jnp.concatenate([nrm((N_EVEN, 2, M_HEADS), 0.1), unif((N_EVEN, 2, M_HEADS), 3.0, 6.0)], axis=1)
    m_norm_w = 1.0 + nrm((N_EVEN, M_V), 0.02)
    l_conv_w = nrm((N_EVEN, CONV_K, LRU_W), 0.5)
    l_conv_b = nrm((N_EVEN, LRU_W), 0.01)
    l_wa = nrm((N_EVEN, 2, LRU_BLOCKS, LRU_BW, LRU_BW), LRU_BW ** -0.5)
    l_ba = nrm((N_EVEN, 2, LRU_W), 0.01)
    l_wx = nrm((N_EVEN, 2, LRU_BLOCKS, LRU_BW, LRU_BW), LRU_BW ** -0.5)
    l_bx = nrm((N_EVEN, 2, LRU_W), 0.01)
    a_c = unif((N_EVEN, 2, LRU_W), 0.9, 0.999) ** (1.0 / LRU_C)
    l_lam = jnp.log(a_c) - jnp.log1p(-a_c)
    ab_out_w = nrm((N_EVEN, M_V + LRU_W, D), (M_V + LRU_W) ** -0.5)
    ffn_w1 = nrm((N_EVEN, D, 2 * FF_DENSE), D ** -0.5)
    ffn_w2 = nrm((N_EVEN, FF_DENSE, D), FF_DENSE ** -0.5)
    cd_in_w = nrm((N_ODD, D, CD_IN), D ** -0.5)
    g_alpha_w = nrm((N_ODD, 2, G_RANK, G_HEADS * G_DK), G_RANK ** -0.5)
    g_alpha_b = nrm((N_ODD, 2, G_HEADS * G_DK), 0.1)
    g_norm_w = 1.0 + nrm((N_ODD, G_V), 0.02)
    s_conv_w = nrm((N_ODD, CONV_K, S_XBC), 0.5)
    s_conv_b = nrm((N_ODD, S_XBC), 0.01)
    dt0 = jnp.exp(unif((N_ODD, 2, S_HEADS), float(np.log(1e-3)), float(np.log(1e-1))))
    s_dt_bias = dt0 + jnp.log(-jnp.expm1(-dt0))
    s_A_log = jnp.log(unif((N_ODD, 2, S_HEADS), 1.0, 16.0))
    s_D = 1.0 + nrm((N_ODD, S_HEADS), 0.1)
    s_norm_w = 1.0 + nrm((N_ODD, S_INNER), 0.02)
    cd_out_w = nrm((N_ODD, G_V + S_INNER, D), (G_V + S_INNER) ** -0.5)
    router_w = nrm((N_ODD, D, N_EXPERTS), D ** -0.5)
    router_b = nrm((N_ODD, N_EXPERTS), 0.01)
    moe_w1 = nrm((N_ODD, N_EXPERTS, D, 2 * FF_EXPERT), D ** -0.5)
    moe_w2 = nrm((N_ODD, N_EXPERTS, FF_EXPERT, D), FF_EXPERT ** -0.5)
    return {'x': x, 'c': c, 'ctx': ctx, 'c_ctx': c_ctx, 'mod_w': mod_w, 'mod_b': mod_b, 'norm_g': norm_g,
            'ab_in_w': ab_in_w, 'm_conv_w': m_conv_w, 'm_conv_b': m_conv_b, 'm_gate_b': m_gate_b,
            'm_norm_w': m_norm_w, 'l_conv_w': l_conv_w, 'l_conv_b': l_conv_b, 'l_wa': l_wa, 'l_ba': l_ba,
            'l_wx': l_wx, 'l_bx': l_bx, 'l_lam': l_lam, 'ab_out_w': ab_out_w, 'ffn_w1': ffn_w1, 'ffn_w2': ffn_w2,
            'cd_in_w': cd_in_w, 'g_alpha_w': g_alpha_w, 'g_alpha_b': g_alpha_b, 'g_norm_w': g_norm_w,
            's_conv_w': s_conv_w, 's_conv_b': s_conv_b, 's_dt_bias': s_dt_bias, 's_A_log': s_A_log, 's_D': s_D,
            's_norm_w': s_norm_w, 'cd_out_w': cd_out_w, 'router_w': router_w, 'router_b': router_b,
            'moe_w1': moe_w1, 'moe_w2': moe_w2}


def reference(x, c, ctx, c_ctx, mod_w, mod_b, norm_g,
              ab_in_w, m_conv_w, m_conv_b, m_gate_b, m_norm_w, l_conv_w, l_conv_b, l_wa, l_ba,
              l_wx, l_bx, l_lam, ab_out_w, ffn_w1, ffn_w2,
              cd_in_w, g_alpha_w, g_alpha_b, g_norm_w, s_conv_w, s_conv_b, s_dt_bias, s_A_log, s_D,
              s_norm_w, cd_out_w, router_w, router_b, moe_w1, moe_w2):
    bsz, seq, _ = x.shape
    n_ctx = ctx.shape[1]
    rows = seq // GRID_W
    xl, xc = x, ctx
    for layer in range(DEPTH):
        j = layer // 2
        last = layer == DEPTH - 1
        mlm = (jax.nn.silu(c) @ mod_w[layer] + mod_b[layer]).reshape(bsz, 6, 1, D_MODEL)
        ml = [mlm[:, i] for i in range(6)]
        mc = (jax.nn.silu(c_ctx) @ mod_w[layer] + mod_b[layer]).reshape(6, D_MODEL)
        g = norm_g[layer]
        h = jnp.concatenate([adaln(xc, g[0], mc[0], mc[1]), adaln(xl, g[0], ml[0], ml[1])], axis=1)
        if layer % 2 == 0:
            y = mix_ab(h, n_ctx, rows, ab_in_w[j], m_conv_w[j], m_conv_b[j], m_gate_b[j], m_norm_w[j],
                       l_conv_w[j], l_conv_b[j], l_wa[j], l_ba[j], l_wx[j], l_bx[j], l_lam[j], ab_out_w[j])
        else:
            y = mix_cd(h, n_ctx, rows, cd_in_w[j], g_alpha_w[j], g_alpha_b[j], g_norm_w[j], s_conv_w[j],
                       s_conv_b[j], s_dt_bias[j], s_A_log[j], s_D[j], s_norm_w[j], cd_out_w[j])
        y = rmsnorm(y, g[1])
        xl = xl + ml[2] * y[:, n_ctx:]
        hl = adaln(xl, g[2], ml[3], ml[4])
        if last:
            h2 = hl
        else:
            xc = xc + mc[2] * y[:, :n_ctx]
            h2 = jnp.concatenate([adaln(xc, g[2], mc[3], mc[4]), hl], axis=1)
        if layer % 2 == 0:
            f = swiglu(h2, ffn_w1[j], ffn_w2[j])
        else:
            f = moe_swiglu(h2, router_w[j], router_b[j], moe_w1[j], moe_w2[j])
        f = rmsnorm(f, g[3])
        xl = xl + ml[5] * f[:, f.shape[1] - seq:]
        if not last:
            xc = xc + mc[5] * f[:, :n_ctx]
    return xl
```

```cpp
#include <hip/hip_runtime.h>
#include <hip/hip_cooperative_groups.h>
#include <cstdio>
#include <cstdint>
namespace cg = cooperative_groups;

typedef unsigned short bf16;

constexpr int NB = 4, SEQ = 4096, NCTX = 256, TT = 4352, MROWS = NB * TT, DM = 1024;
constexpr int NTOK = NB * SEQ;
constexpr int FFD = 2816, FFE = 3584, NEXP = 8;
constexpr int AB_IN = 5136, CD_IN = 5696;
constexpr int MAXSLOT = 2 * NTOK + NEXP * 256;

constexpr size_t MiB = 1u << 20;
constexpr size_t OFF_CTL = 0, OFF_MOD = 1 * MiB, OFF_G = 2 * MiB, OFF_XC = 7 * MiB, OFF_TOPI = 11 * MiB, OFF_TOPG = 11 * MiB + 256 * 1024,
                 OFF_SLOT = 11 * MiB + 512 * 1024, OFF_STOK = 12 * MiB, OFF_RGS = 13 * MiB, OFF_H = 18 * MiB, OFF_ZS = 52 * MiB,
                 OFF_SO = 256 * MiB, OFF_HC = 392 * MiB, OFF_Y = 460 * MiB, OFF_W = 528 * MiB, WS_NEED = 528 * MiB;
constexpr size_t SEG = (size_t)MROWS * DM;
constexpr size_t OFF_ACT = OFF_ZS, OFF_XS = OFF_HC, OFF_ACTM = OFF_ZS, OFF_YS = OFF_HC;
constexpr int CW_CNT = 0, CW_BASE = 8, CW_TOT = 17;

struct Params { const float* in[37]; float* out; unsigned char* ws; };
enum { I_X = 0, I_C, I_CTX, I_CCTX, I_MODW, I_MODB, I_NORMG, I_ABIN, I_MCONVW, I_MCONVB, I_MGATEB, I_MNORMW, I_LCONVW, I_LCONVB, I_LWA, I_LBA, I_LWX, I_LBX,
       I_LLAM, I_ABOUT, I_FFN1, I_FFN2, I_CDIN, I_GALW, I_GALB, I_GNORMW, I_SCONVW, I_SCONVB, I_SDTB, I_SALOG, I_SD, I_SNORMW, I_CDOUT, I_RW, I_RB, I_MOE1, I_MOE2 };

__device__ __forceinline__ float bf2f(unsigned v) { return __uint_as_float(v << 16); }
__device__ __forceinline__ unsigned f2bf(float f) { unsigned u = __float_as_uint(f); return (u + 0x7fffu + ((u >> 16) & 1u)) >> 16; }
__device__ __forceinline__ float sigmoid_f(float x) { return 1.f / (1.f + expf(-x)); }
__device__ __forceinline__ float silu_f(float x) { return x / (1.f + expf(-x)); }
__device__ __forceinline__ float softplus_f(float x) { return fmaxf(x, 0.f) + log1pf(expf(-fabsf(x))); }
__device__ __forceinline__ float logsigmoid_f(float x) { return -softplus_f(-x); }
__device__ __forceinline__ float gelu_f(float x) { return 0.5f * x * (1.f + tanhf(0.7978845608028654f * (x + 0.044715f * x * x * x))); }
__device__ __forceinline__ float wave_sum(float v) {
#pragma unroll
    for (int o = 32; o >= 1; o >>= 1) v += __shfl_xor(v, o);
    return v;
}
__device__ __forceinline__ int tid_op() { int t = threadIdx.x; asm volatile("" : "+v"(t)); return t; }
__device__ __forceinline__ void ld_row_f32(const float* row, int lane, float (&v)[16]) {
#pragma unroll
    for (int j = 0; j < 4; ++j) { const float4 t = ((const float4*)row)[j * 64 + lane]; v[4 * j] = t.x; v[4 * j + 1] = t.y; v[4 * j + 2] = t.z; v[4 * j + 3] = t.w; }
}
__device__ __forceinline__ void st_row_f32(float* row, int lane, const float (&v)[16]) {
#pragma unroll
    for (int j = 0; j < 4; ++j) ((float4*)row)[j * 64 + lane] = make_float4(v[4 * j], v[4 * j + 1], v[4 * j + 2], v[4 * j + 3]);
}
__device__ __forceinline__ void ld_row_bf16(const bf16* row, int lane, float (&v)[16]) {
#pragma unroll
    for (int j = 0; j < 4; ++j) { const uint2 t = ((const uint2*)row)[j * 64 + lane]; v[4 * j] = bf2f(t.x & 0xffffu); v[4 * j + 1] = bf2f(t.x >> 16); v[4 * j + 2] = bf2f(t.y & 0xffffu); v[4 * j + 3] = bf2f(t.y >> 16); }
}
__device__ __forceinline__ void st_row_bf16(bf16* row, int lane, const float (&v)[16]) {
#pragma unroll
    for (int j = 0; j < 4; ++j) { uint2 t; t.x = f2bf(v[4 * j]) | (f2bf(v[4 * j + 1]) << 16); t.y = f2bf(v[4 * j + 2]) | (f2bf(v[4 * j + 3]) << 16); ((uint2*)row)[j * 64 + lane] = t; }
}
__device__ __forceinline__ float row_ss(const float (&v)[16]) { float s = 0.f;
#pragma unroll
    for (int i = 0; i < 16; ++i) s += v[i] * v[i];
    return wave_sum(s); }

__device__ __forceinline__ void seg_bounds(int t, int& lo, int& hi) { if (t < NCTX) { lo = 0; hi = NCTX; } else { lo = NCTX + ((t - NCTX) & ~63); hi = lo + 64; } }
__device__ __forceinline__ float conv4(const bf16* Z, int b, int t, int c, const float* w, int wstride, int wc, float bias) {
    int lo, hi; seg_bounds(t, lo, hi); float s = bias;
#pragma unroll
    for (int j = 0; j < 4; ++j) { const int tt = t + j - 2; if (tt >= lo && tt < hi) s += w[j * wstride + wc] * bf2f(Z[((size_t)(b * TT + tt)) * DM + c]); }
    return s;
}
__device__ __forceinline__ int tokmap(int dir, int tau) { return dir ? (tau < NCTX ? (NCTX - 1 - tau) : (TT + NCTX - 1 - tau)) : tau; }

__device__ __forceinline__ void phase_mod(const Params& p, float* sm) {
    float* sv = sm; float* red = sm + 5 * 1024; const int tid = tid_op();
    for (int i = tid; i < 5 * 1024; i += 512) { const int v = i >> 10, k = i & 1023; const float x = (v < 4) ? p.in[I_C][v * 1024 + k] : p.in[I_CCTX][k]; sv[i] = silu_f(x); }
    __syncthreads();
    float* MOD = (float*)(p.ws + OFF_MOD);
    for (int it = blockIdx.x; it < 192; it += gridDim.x) {
        const int l = it / 96, j0 = (it % 96) * 64, col = tid & 63, kg = tid >> 6;
        const float* w = p.in[I_MODW] + (size_t)l * 1024 * 6144 + j0 + col;
        float a[5] = {0.f, 0.f, 0.f, 0.f, 0.f};
        for (int k = kg * 128; k < kg * 128 + 128; ++k) { const float wv = w[(size_t)k * 6144];
#pragma unroll
            for (int v = 0; v < 5; ++v) a[v] += sv[v * 1024 + k] * wv; }
#pragma unroll
        for (int v = 0; v < 5; ++v) red[(kg * 5 + v) * 64 + col] = a[v];
        __syncthreads();
        if (tid < 320) { const int v = tid >> 6, cc = tid & 63; float s = 0.f;
            for (int g = 0; g < 8; ++g) s += red[(g * 5 + v) * 64 + cc];
            MOD[(size_t)(l * 5 + v) * 6144 + j0 + cc] = s + p.in[I_MODB][l * 6144 + j0 + cc]; }
        __syncthreads();
    }
    if (blockIdx.x == 0 && tid < 32) ((int*)(p.ws + OFF_CTL))[tid] = 0;
}

template <int MODE> __device__ __forceinline__ void phase_norm(const Params& p, int layer) {
    const int tid_ = tid_op(); const int lane = tid_ & 63, gw = blockIdx.x * 8 + (tid_ >> 6), NGW = gridDim.x * 8;
    const float* MOD = (const float*)(p.ws + OFF_MOD);
    const float* NG = p.in[I_NORMG] + (size_t)layer * 4 * 1024;
    float* XC = (float*)(p.ws + OFF_XC); bf16* H = (bf16*)(p.ws + OFF_H); const float* Y = (const float*)(p.ws + OFF_Y);
    const bool last = (layer == 1);
    for (int r = gw; r < MROWS; r += NGW) {
        const int b = r / TT, t = r % TT; const bool isctx = t < NCTX; const int v = isctx ? 4 : b;
        if ((MODE == 3 || (MODE == 1 && last)) && isctx) continue;
        const float* mv = MOD + (size_t)(layer * 5 + v) * 6144;
        const float* xin = isctx ? (p.in[I_CTX] + ((size_t)b * NCTX + t) * DM) : (p.in[I_X] + ((size_t)b * SEQ + (t - NCTX)) * DM);
        float* xst = isctx ? (XC + ((size_t)b * NCTX + t) * DM) : (p.out + ((size_t)b * SEQ + (t - NCTX)) * DM);
        float x[16], g[16], a[16], s[16];
        if (MODE == 0) {
            ld_row_f32(xin, lane, x);
            const float rstd = rsqrtf(row_ss(x) * (1.f / DM) + 1e-6f);
            ld_row_f32(NG, lane, g); ld_row_f32(mv + 1024, lane, a); ld_row_f32(mv, lane, s);
#pragma unroll
            for (int i = 0; i < 16; ++i) x[i] = x[i] * rstd * g[i] * (1.f + a[i]) + s[i];
            st_row_bf16(H + (size_t)r * DM, lane, x);
        } else if (MODE == 1 || MODE == 2) {
            float y[16];
            ld_row_f32(Y + (size_t)r * DM, lane, y);
            const float rstd = rsqrtf(row_ss(y) * (1.f / DM) + 1e-6f);
            ld_row_f32(NG + (MODE == 1 ? 1 : 3) * 1024, lane, g); ld_row_f32(mv + (MODE == 1 ? 2 : 5) * 1024, lane, a);
            if (MODE == 1 && layer == 0) ld_row_f32(xin, lane, x); else ld_row_f32(xst, lane, x);
#pragma unroll
            for (int i = 0; i < 16; ++i) x[i] = x[i] + a[i] * (y[i] * rstd * g[i]);
            st_row_f32(xst, lane, x);
            const float rstd2 = rsqrtf(row_ss(x) * (1.f / DM) + 1e-6f);
            const float* ng2 = (MODE == 1) ? (NG + 2 * 1024) : (p.in[I_NORMG] + (size_t)4 * 1024);
            const float* mv2 = (MODE == 1) ? mv : (MOD + (size_t)(5 + v) * 6144);
            ld_row_f32(ng2, lane, g); ld_row_f32(mv2 + (MODE == 1 ? 4 : 1) * 1024, lane, a); ld_row_f32(mv2 + (MODE == 1 ? 3 : 0) * 1024, lane, s);
#pragma unroll
            for (int i = 0; i < 16; ++i) x[i] = x[i] * rstd2 * g[i] * (1.f + a[i]) + s[i];
            st_row_bf16(H + (size_t)r * DM, lane, x);
            if (MODE == 1 && last) {
                float lg[8];
#pragma unroll
                for (int e = 0; e < 8; ++e) lg[e] = 0.f;
#pragma unroll
                for (int i = 0; i < 16; ++i) { const int col = (i >> 2) * 256 + lane * 4 + (i & 3); const float4 w0 = ((const float4*)(p.in[I_RW] + (size_t)col * 8))[0], w1 = ((const float4*)(p.in[I_RW] + (size_t)col * 8))[1];
                    lg[0] += x[i] * w0.x; lg[1] += x[i] * w0.y; lg[2] += x[i] * w0.z; lg[3] += x[i] * w0.w; lg[4] += x[i] * w1.x; lg[5] += x[i] * w1.y; lg[6] += x[i] * w1.z; lg[7] += x[i] * w1.w; }
#pragma unroll
                for (int e = 0; e < 8; ++e) lg[e] = wave_sum(lg[e]) + p.in[I_RB][e];
                if (lane == 0) {
                    int e0 = 0; float l0 = lg[0];
#pragma unroll
                    for (int e = 1; e < 8; ++e) if (lg[e] > l0) { l0 = lg[e]; e0 = e; }
                    int e1 = -1; float l1 = -3.0e38f;
#pragma unroll
                    for (int e = 0; e < 8; ++e) if (e != e0 && lg[e] > l1) { l1 = lg[e]; e1 = e; }
                    const float ex = expf(l1 - l0), g0 = 1.f / (1.f + ex), g1 = ex / (1.f + ex);
                    const int tok = b * SEQ + (t - NCTX);
                    ((int*)(p.ws + OFF_TOPI))[tok * 2] = e0; ((int*)(p.ws + OFF_TOPI))[tok * 2 + 1] = e1;
                    ((float*)(p.ws + OFF_TOPG))[tok * 2] = g0; ((float*)(p.ws + OFF_TOPG))[tok * 2 + 1] = g1;
                }
            }
        } else {
            const int tok = b * SEQ + (t - NCTX);
            const int s0 = ((const int*)(p.ws + OFF_SLOT))[tok * 2], s1 = ((const int*)(p.ws + OFF_SLOT))[tok * 2 + 1];
            const float g0 = ((const float*)(p.ws + OFF_TOPG))[tok * 2], g1 = ((const float*)(p.ws + OFF_TOPG))[tok * 2 + 1];
            const float* YS = (const float*)(p.ws + OFF_YS);
            float y[16];
            ld_row_f32(YS + (size_t)s0 * DM, lane, y); ld_row_f32(YS + (size_t)s1 * DM, lane, a);
#pragma unroll
            for (int i = 0; i < 16; ++i) y[i] = y[i] * g0 + a[i] * g1;
            const float rstd = rsqrtf(row_ss(y) * (1.f / DM) + 1e-6f);
            ld_row_f32(NG + 3 * 1024, lane, g); ld_row_f32(mv + 5 * 1024, lane, a); ld_row_f32(xst, lane, x);
#pragma unroll
            for (int i = 0; i < 16; ++i) x[i] = x[i] + a[i] * (y[i] * rstd * g[i]);
            st_row_f32(xst, lane, x);
        }
    }
}

template <bool DUAL, class Map, class Epi>
__device__ __forceinline__ void gemm_naive(const bf16* A, int lda, int ldb, int N, int K, int uoff, int ntiles, const Map& map, const Epi& epi, float* sm) {
    constexpr int NC = DUAL ? 4 : 8, TW = DUAL ? 64 : 128;
    float* As = sm;
    float* Bs = sm + 16 * 132;
    const int tid = tid_op(), ty = tid >> 4, tx = tid & 15;
    for (int tile = blockIdx.x; tile < ntiles; tile += gridDim.x) {
        int row0, col0; const float* B;
        if (!map(tile, TW, row0, col0, B)) continue;
        float acc[4][8];
#pragma unroll
        for (int i = 0; i < 4; ++i)
#pragma unroll
            for (int j = 0; j < 8; ++j) acc[i][j] = 0.f;
        for (int k0 = 0; k0 < K; k0 += 16) {
            { const int row = tid >> 2, kq = tid & 3; const uint2 t = *(const uint2*)(A + (size_t)(row0 + row) * lda + k0 + kq * 4);
              As[(kq * 4 + 0) * 132 + row] = bf2f(t.x & 0xffffu); As[(kq * 4 + 1) * 132 + row] = bf2f(t.x >> 16); As[(kq * 4 + 2) * 132 + row] = bf2f(t.y & 0xffffu); As[(kq * 4 + 3) * 132 + row] = bf2f(t.y >> 16); }
            { const int kk = tid >> 5, c4 = (tid & 31) * 4; int col = col0 + c4; bool ok = col + 3 < N;
              if (DUAL) { const int cc = c4 & 63; col = col0 + cc; ok = col + 3 < N; if (c4 >= 64) col += uoff; }
              float4 t = make_float4(0.f, 0.f, 0.f, 0.f); if (ok) t = *(const float4*)(B + (size_t)(k0 + kk) * ldb + col);
              *(float4*)(Bs + kk * 128 + c4) = t; }
            __syncthreads();
#pragma unroll
            for (int kk = 0; kk < 16; ++kk) {
                const float4 a4 = *(const float4*)(As + kk * 132 + ty * 4);
                const float av[4] = {a4.x, a4.y, a4.z, a4.w};
                float bv[8];
                if (DUAL) { const float4 b0 = *(const float4*)(Bs + kk * 128 + tx * 4), b1 = *(const float4*)(Bs + kk * 128 + 64 + tx * 4); bv[0] = b0.x; bv[1] = b0.y; bv[2] = b0.z; bv[3] = b0.w; bv[4] = b1.x; bv[5] = b1.y; bv[6] = b1.z; bv[7] = b1.w; }
                else { const float4 b0 = *(const float4*)(Bs + kk * 128 + tx * 8), b1 = *(const float4*)(Bs + kk * 128 + tx * 8 + 4); bv[0] = b0.x; bv[1] = b0.y; bv[2] = b0.z; bv[3] = b0.w; bv[4] = b1.x; bv[5] = b1.y; bv[6] = b1.z; bv[7] = b1.w; }
#pragma unroll
                for (int i = 0; i < 4; ++i)
#pragma unroll
                    for (int j = 0; j < 8; ++j) acc[i][j] += av[i] * bv[j];
            }
            __syncthreads();
        }
#pragma unroll
        for (int i = 0; i < 4; ++i)
#pragma unroll
            for (int j = 0; j < NC; ++j) { const int c = col0 + tx * NC + j; if (c < N) epi(row0 + ty * 4 + i, c, acc[i][j], DUAL ? acc[i][j + 4] : 0.f); }
    }
}
struct MapDense { int ntn; const float* B; __device__ __forceinline__ bool operator()(int tile, int tw, int& row0, int& col0, const float*& Bp) const { row0 = (tile / ntn) * 128; col0 = (tile % ntn) * tw; Bp = B; return true; } };
struct MapMoe { int ntn; const float* B; size_t estride; const int* ctl;
    __device__ __forceinline__ bool operator()(int tile, int tw, int& row0, int& col0, const float*& Bp) const {
        row0 = (tile / ntn) * 128; col0 = (tile % ntn) * tw; if (row0 >= ctl[CW_TOT]) return false;
        int e = 0;
#pragma unroll
        for (int i = 1; i < 8; ++i) if (row0 >= ctl[CW_BASE + i]) e = i;
        Bp = B + (size_t)e * estride; return true; } };
struct EpiInAB { bf16* ZS; float* G; __device__ __forceinline__ void operator()(int r, int c, float g, float) const {
        if (c < 3072) ZS[(size_t)(c >> 10) * SEG + (size_t)r * DM + (c & 1023)] = (bf16)f2bf(g);
        else if (c < 3088) G[(size_t)r * 64 + (c - 3072)] = g;
        else { const int cc = c - 3088; ZS[(size_t)(3 + (cc >> 10)) * SEG + (size_t)r * DM + (cc & 1023)] = (bf16)f2bf(g); } } };
struct EpiInCD { bf16* ZS; float* G; __device__ __forceinline__ void operator()(int r, int c, float g, float) const {
        if (c < 3072) ZS[(size_t)(c >> 10) * SEG + (size_t)r * DM + (c & 1023)] = (bf16)f2bf(g);
        else if (c < 3104) G[(size_t)r * 64 + (c - 3072)] = g;
        else if (c < 5664) { const int cc = c - 3104; ZS[(size_t)(3 + (cc >> 10)) * SEG + (size_t)r * DM + (cc & 1023)] = (bf16)f2bf(g); }
        else G[(size_t)r * 64 + 32 + (c - 5664)] = g; } };
struct EpiF32 { float* C; int ldc; __device__ __forceinline__ void operator()(int r, int c, float g, float) const { C[(size_t)r * ldc + c] = g; } };
struct EpiSwiglu { bf16* C; int ldc; __device__ __forceinline__ void operator()(int r, int c, float g, float u) const { C[(size_t)r * ldc + c] = (bf16)f2bf(silu_f(g) * u); } };

template <int MODE  > __device__ __forceinline__ void scan_naive_unit(const Params& p, int b, int h, int dir, int vh, float* sm) {
    constexpr int DV = (MODE == 2) ? 64 : 128, NP = 512 / DV, DPP = 128 / NP;
    float* qe = sm; float* kw = sm + 128; float* dec = sm + 256; float* vv = sm + 384; float* red = sm + 640; float* dred = sm + 640 + 2048;
    const int tid = tid_op(), v = tid % DV, part = tid / DV;
    const bf16* ZS = (const bf16*)(p.ws + OFF_ZS); const float* G = (const float*)(p.ws + OFF_G); bf16* SO = (bf16*)(p.ws + OFF_SO);
    float S[DPP];
#pragma unroll
    for (int i = 0; i < DPP; ++i) S[i] = 0.f;
    float nst = 0.f;
    __syncthreads();
    for (int tau = 0; tau < TT; ++tau) {
        const int t = tokmap(dir, tau); const size_t r = (size_t)b * TT + t;
        if (MODE == 0) {
            const float gi = G[r * 64 + dir * 4 + h] + p.in[I_MGATEB][dir * 4 + h], gf = G[r * 64 + (2 + dir) * 4 + h] + p.in[I_MGATEB][(2 + dir) * 4 + h];
            const float fdec = sigmoid_f(gf), iexp = expf(gi);
            if (tid < 256) { const int c = (tid < 128) ? (h * 128 + tid) : (512 + h * 128 + (tid - 128));
                const float qk = silu_f(conv4(ZS, b, t, c, p.in[I_MCONVW], 1024, c, p.in[I_MCONVB][c]));
                if (tid < 128) { qe[tid] = qk; dec[tid] = fdec; } else kw[tid - 128] = qk * 0.08838834764831845f * iexp; }
            else if (tid < 384) vv[tid - 256] = bf2f(ZS[SEG + r * DM + h * 256 + vh * 128 + (tid - 256)]);
        } else if (MODE == 1) {
            if (tid < 128) { const int d = tid;
                qe[d] = bf2f(ZS[r * DM + h * 128 + d]) * 0.08838834764831845f; kw[d] = bf2f(ZS[r * DM + 512 + h * 128 + d]);
                float pre = p.in[I_GALB][dir * 512 + h * 128 + d];
#pragma unroll
                for (int j = 0; j < 16; ++j) pre += G[r * 64 + dir * 16 + j] * p.in[I_GALW][(size_t)(dir * 16 + j) * 512 + h * 128 + d];
                dec[d] = expf(logsigmoid_f(pre) * (1.f / 16.f)); }
            else if (tid >= 256 && tid < 384) vv[tid - 256] = bf2f(ZS[SEG + r * DM + h * 256 + vh * 128 + (tid - 256)]);
        } else {
            const int g = h >> 3;
            const float dt = softplus_f(G[r * 64 + 32 + dir * 16 + h] + p.in[I_SDTB][dir * 16 + h]);
            const float la = -dt * expf(p.in[I_SALOG][dir * 16 + h]);
            if (tid < 64) { const int c = h * 64 + tid; vv[tid] = silu_f(conv4(ZS + 4 * SEG, b, t, c, p.in[I_SCONVW], 1536, c, p.in[I_SCONVB][c])); }
            else if (tid < 192) { const int n = tid - 64, c = g * 128 + n; kw[n] = dt * silu_f(conv4(ZS + 5 * SEG, b, t, c, p.in[I_SCONVW], 1536, 1024 + c, p.in[I_SCONVB][1024 + c])); dec[n] = expf(la); }
            else if (tid < 320) { const int n = tid - 192, c = 256 + g * 128 + n; qe[n] = silu_f(conv4(ZS + 5 * SEG, b, t, c, p.in[I_SCONVW], 1536, 1024 + c, p.in[I_SCONVB][1024 + c])); }
        }
        __syncthreads();
        const float xv = vv[v]; float po = 0.f;
#pragma unroll
        for (int i = 0; i < DPP; ++i) { const int d = part * DPP + i; S[i] = dec[d] * S[i] + kw[d] * xv; po += qe[d] * S[i]; }
        red[part * DV + v] = po;
        if (MODE == 0 && tid < 128) { nst = dec[tid] * nst + kw[tid]; dred[tid] = qe[tid] * nst; }
        __syncthreads();
        if (tid < DV) { float o = 0.f;
#pragma unroll
            for (int pp = 0; pp < NP; ++pp) o += red[pp * DV + tid];
            if (MODE == 0) { float den = 0.f; for (int d = 0; d < 128; ++d) den += dred[d]; o = o / fmaxf(fabsf(den), 1.f); }
            if (MODE == 2 && dir == 0) o += p.in[I_SD][h] * xv;
            if (MODE == 2) SO[(size_t)(2 + dir) * SEG + r * DM + h * 64 + tid] = (bf16)f2bf(o);
            else SO[(size_t)dir * SEG + r * DM + h * 256 + vh * 128 + tid] = (bf16)f2bf(o); }
    }
}
__device__ __forceinline__ void rglru_naive_unit(const Params& p, int b, int dir, int blk, float* sm) {
    float* xl = sm; float* ra = sm + 128; float* rx = sm + 128 + 512;
    const int tid = tid_op(), c = tid & 127, kp = tid >> 7, ch = blk * 128 + c;
    const bf16* ZS = (const bf16*)(p.ws + OFF_ZS); bf16* SO = (bf16*)(p.ws + OFF_SO);
    const float* wa = p.in[I_LWA] + (size_t)(dir * 8 + blk) * 128 * 128; const float* wx = p.in[I_LWX] + (size_t)(dir * 8 + blk) * 128 * 128;
    const float ba = p.in[I_LBA][dir * 1024 + ch], bx = p.in[I_LBX][dir * 1024 + ch], sp = softplus_f(-p.in[I_LLAM][dir * 1024 + ch]);
    float hst = 0.f;
    __syncthreads();
    for (int tau = 0; tau < TT; ++tau) {
        const int t = tokmap(dir, tau); const size_t r = (size_t)b * TT + t;
        if (tid < 128) xl[c] = conv4(ZS + 3 * SEG, b, t, ch, p.in[I_LCONVW], 1024, ch, p.in[I_LCONVB][ch]);
        __syncthreads();
        float pa = 0.f, px = 0.f;
        asm volatile("" : "+s"(wa), "+s"(wx));
        for (int k = kp * 32; k < kp * 32 + 32; ++k) { const float xk = xl[k]; pa += xk * wa[k * 128 + c]; px += xk * wx[k * 128 + c]; }
        ra[kp * 128 + c] = pa; rx[kp * 128 + c] = px;
        __syncthreads();
        if (tid < 128) {
            const float rr = sigmoid_f(ra[c] + ra[128 + c] + ra[256 + c] + ra[384 + c] + ba), ii = sigmoid_f(rx[c] + rx[128 + c] + rx[256 + c] + rx[384 + c] + bx);
            const float log_a = -8.f * rr * sp, a = expf(log_a), bb = sqrtf(-expm1f(2.f * log_a)) * (ii * xl[c]);
            hst = a * hst + bb;
            SO[(size_t)(2 + dir) * SEG + r * DM + ch] = (bf16)f2bf(hst);
        }
    }
}
__device__ __forceinline__ void phase_scan_naive(const Params& p, int layer, float* sm) {
    if (layer == 0) {
        for (int u = blockIdx.x; u < 128; u += gridDim.x) {
            if (u < 64) scan_naive_unit<0>(p, u >> 4, (u >> 2) & 3, (u >> 1) & 1, u & 1, sm);
            else { const int w = u - 64; rglru_naive_unit(p, w >> 4, (w >> 3) & 1, w & 7, sm); }
            __syncthreads();
        }
    } else {
        for (int u = blockIdx.x; u < 192; u += gridDim.x) {
            if (u < 64) scan_naive_unit<1>(p, u >> 4, (u >> 2) & 3, (u >> 1) & 1, u & 1, sm);
            else { const int w = u - 64; scan_naive_unit<2>(p, w >> 5, (w >> 1) & 15, w & 1, 0, sm); }
            __syncthreads();
        }
    }
}

__device__ __forceinline__ void phase_mix2(const Params& p, int layer) {
    const int tid_ = tid_op(); const int lane = tid_ & 63, gw = blockIdx.x * 8 + (tid_ >> 6), NGW = gridDim.x * 8;
    const bf16* ZS = (const bf16*)(p.ws + OFF_ZS); const bf16* SO = (const bf16*)(p.ws + OFF_SO); bf16* HC = (bf16*)(p.ws + OFF_HC);
    for (int r = gw; r < MROWS; r += NGW) {
        float a[16], c[16], w[16], g[16];
        ld_row_bf16(SO + (size_t)r * DM, lane, a); ld_row_bf16(SO + SEG + (size_t)r * DM, lane, c);
        ld_row_f32(layer == 0 ? p.in[I_MNORMW] : p.in[I_GNORMW], lane, w); ld_row_bf16(ZS + 2 * SEG + (size_t)r * DM, lane, g);
#pragma unroll
        for (int j = 0; j < 4; ++j) {
            float ss = 0.f;
#pragma unroll
            for (int i = 0; i < 4; ++i) { a[4 * j + i] += c[4 * j + i]; ss += a[4 * j + i] * a[4 * j + i]; }
            const float rstd = rsqrtf(wave_sum(ss) * (1.f / 256.f) + 1e-6f);
#pragma unroll
            for (int i = 0; i < 4; ++i) { const float gt = g[4 * j + i]; a[4 * j + i] = a[4 * j + i] * rstd * w[4 * j + i] * (layer == 0 ? sigmoid_f(gt) : silu_f(gt)); }
        }
        st_row_bf16(HC + (size_t)r * 2048, lane, a);
        ld_row_bf16(SO + 2 * SEG + (size_t)r * DM, lane, a); ld_row_bf16(SO + 3 * SEG + (size_t)r * DM, lane, c);
        if (layer == 0) {
            ld_row_bf16(ZS + 4 * SEG + (size_t)r * DM, lane, g);
#pragma unroll
            for (int i = 0; i < 16; ++i) a[i] = (a[i] + c[i]) * gelu_f(g[i]);
        } else {
            ld_row_bf16(ZS + 3 * SEG + (size_t)r * DM, lane, g); ld_row_f32(p.in[I_SNORMW], lane, w);
#pragma unroll
            for (int i = 0; i < 16; ++i) a[i] = (a[i] + c[i]) * silu_f(g[i]);
            const float rstd = rsqrtf(row_ss(a) * (1.f / DM) + 1e-6f);
#pragma unroll
            for (int i = 0; i < 16; ++i) a[i] = a[i] * rstd * w[i];
        }
        st_row_bf16(HC + (size_t)r * 2048 + 1024, lane, a);
    }
}

__device__ __forceinline__ void phase_route_naive(const Params& p, float* sm) {
    if (blockIdx.x != 0) return;
    int* cnt = (int*)sm; int* cur = cnt + 8; int* base = cnt + 16; const int tid = tid_op();
    const int* TOPI = (const int*)(p.ws + OFF_TOPI); int* SLOT = (int*)(p.ws + OFF_SLOT); int* STOK = (int*)(p.ws + OFF_STOK); int* ctl = (int*)(p.ws + OFF_CTL);
    if (tid < 16) cnt[tid] = 0;
    __syncthreads();
    for (int a = tid; a < 2 * NTOK; a += 512) atomicAdd(&cnt[TOPI[a]], 1);
    __syncthreads();
    if (tid == 0) { int acc = 0; for (int e = 0; e < 8; ++e) { base[e] = acc; ctl[CW_CNT + e] = cnt[e]; ctl[CW_BASE + e] = acc; acc += (cnt[e] + 255) / 256 * 256; } base[8] = acc; ctl[CW_BASE + 8] = acc; ctl[CW_TOT] = acc; }
    __syncthreads();
    for (int s = tid; s < MAXSLOT; s += 512) STOK[s] = -1;
    __syncthreads();
    for (int a = tid; a < 2 * NTOK; a += 512) { const int e = TOPI[a]; const int pos = atomicAdd(&cur[e], 1); const int s = base[e] + pos; SLOT[a] = s; STOK[s] = a >> 1; }
}
__device__ __forceinline__ void phase_gather(const Params& p) {
    const int tid_ = tid_op(); const int lane = tid_ & 63, gw = blockIdx.x * 8 + (tid_ >> 6), NGW = gridDim.x * 8;
    const int* STOK = (const int*)(p.ws + OFF_STOK); const int tot = ((const int*)(p.ws + OFF_CTL))[CW_TOT];
    const bf16* H = (const bf16*)(p.ws + OFF_H); bf16* XS = (bf16*)(p.ws + OFF_XS);
    for (int s = gw; s < tot; s += NGW) {
        const int tok = STOK[s]; uint2* dst = (uint2*)(XS + (size_t)s * DM);
        if (tok < 0) { for (int j = 0; j < 4; ++j) dst[j * 64 + lane] = make_uint2(0u, 0u); }
        else { const int b = tok >> 12, tl = tok & 4095; const uint2* src = (const uint2*)(H + ((size_t)b * TT + NCTX + tl) * DM); for (int j = 0; j < 4; ++j) dst[j * 64 + lane] = src[j * 64 + lane]; }
    }
}

__global__ void __launch_bounds__(512, 2) mega(Params p) {
    extern __shared__ __attribute__((aligned(16))) unsigned char lds[];
    cg::grid_group grid = cg::this_grid();
    float* sm = (float*)lds;
    unsigned char* ws = p.ws;
    bf16* H = (bf16*)(ws + OFF_H); bf16* ZS = (bf16*)(ws + OFF_ZS); float* G = (float*)(ws + OFF_G); bf16* HC = (bf16*)(ws + OFF_HC); float* Y = (float*)(ws + OFF_Y);
    const int* ctl = (const int*)(ws + OFF_CTL);

    phase_mod(p, sm);
    grid.sync();
    phase_norm<0>(p, 0);
    grid.sync();
    { MapDense m{(AB_IN + 127) / 128, p.in[I_ABIN]}; EpiInAB e{ZS, G}; gemm_naive<false>(H, DM, AB_IN, AB_IN, DM, 0, (MROWS / 128) * ((AB_IN + 127) / 128), m, e, sm); }
    grid.sync();
    phase_scan_naive(p, 0, sm);
    grid.sync();
    phase_mix2(p, 0);
    grid.sync();
    { MapDense m{8, p.in[I_ABOUT]}; EpiF32 e{Y, DM}; gemm_naive<false>(HC, 2048, DM, DM, 2048, 0, (MROWS / 128) * 8, m, e, sm); }
    grid.sync();
    phase_norm<1>(p, 0);
    grid.sync();
    { MapDense m{FFD / 64, p.in[I_FFN1]}; EpiSwiglu e{(bf16*)(ws + OFF_ACT), FFD}; gemm_naive<true>(H, DM, 2 * FFD, FFD, DM, FFD, (MROWS / 128) * (FFD / 64), m, e, sm); }
    grid.sync();
    { MapDense m{8, p.in[I_FFN2]}; EpiF32 e{Y, DM}; gemm_naive<false>((const bf16*)(ws + OFF_ACT), FFD, DM, DM, FFD, 0, (MROWS / 128) * 8, m, e, sm); }
    grid.sync();
    phase_norm<2>(p, 0);
    grid.sync();
    { MapDense m{(CD_IN + 127) / 128, p.in[I_CDIN]}; EpiInCD e{ZS, G}; gemm_naive<false>(H, DM, CD_IN, CD_IN, DM, 0, (MROWS / 128) * ((CD_IN + 127) / 128), m, e, sm); }
    grid.sync();
    phase_scan_naive(p, 1, sm);
    grid.sync();
    phase_mix2(p, 1);
    grid.sync();
    { MapDense m{8, p.in[I_CDOUT]}; EpiF32 e{Y, DM}; gemm_naive<false>(HC, 2048, DM, DM, 2048, 0, (MROWS / 128) * 8, m, e, sm); }
    grid.sync();
    phase_norm<1>(p, 1);
    grid.sync();
    phase_route_naive(p, sm);
    grid.sync();
    phase_gather(p);
    grid.sync();
    { MapMoe m{FFE / 64, p.in[I_MOE1], (size_t)DM * 2 * FFE, ctl}; EpiSwiglu e{(bf16*)(ws + OFF_ACTM), FFE}; gemm_naive<true>((const bf16*)(ws + OFF_XS), DM, 2 * FFE, FFE, DM, FFE, (MAXSLOT / 128) * (FFE / 64), m, e, sm); }
    grid.sync();
    { MapMoe m{8, p.in[I_MOE2], (size_t)FFE * DM, ctl}; EpiF32 e{(float*)(ws + OFF_YS), DM}; gemm_naive<false>((const bf16*)(ws + OFF_ACTM), FFE, DM, DM, FFE, 0, (MAXSLOT / 128) * 8, m, e, sm); }
    grid.sync();
    phase_norm<3>(p, 1);
}

__global__ void nan_fill(float* out, int n) { int i = blockIdx.x * blockDim.x + threadIdx.x; if (i < n) out[i] = __builtin_nanf(""); }

constexpr int LDS_BYTES = 147456;
extern "C" void kernel_launch(void* const* d_in, const int* in_sizes, int n_in, void* d_out, int out_size, void* d_ws, size_t ws_size, hipStream_t stream) {
    static int grid_blocks = 0;
    if (grid_blocks == 0) {
        int dev = 0, cus = 0, per_cu = 0;
        hipGetDevice(&dev);
        hipDeviceGetAttribute(&cus, hipDeviceAttributeMultiprocessorCount, dev);
        hipFuncSetAttribute((const void*)mega, hipFuncAttributeMaxDynamicSharedMemorySize, LDS_BYTES);
        hipOccupancyMaxActiveBlocksPerMultiprocessor(&per_cu, (const void*)mega, 512, LDS_BYTES);
        if (per_cu < 1) per_cu = 1;
        grid_blocks = cus * (per_cu > 1 ? 1 : per_cu);
        if (grid_blocks <= 0) grid_blocks = 256;
    }
    if (n_in != 37 || ws_size < WS_NEED) { fprintf(stderr, "kernel_launch: bad n_in %d or ws %zu < %zu\n", n_in, ws_size, (size_t)WS_NEED); nan_fill<<<(out_size + 255) / 256, 256, 0, stream>>>((float*)d_out, out_size); return; }
    Params p{};
    for (int i = 0; i < 37; ++i) p.in[i] = (const float*)d_in[i];
    p.out = (float*)d_out; p.ws = (unsigned char*)d_ws;
    void* args[] = {&p};
    hipError_t e = hipLaunchCooperativeKernel((const void*)mega, dim3(grid_blocks), dim3(512), args, LDS_BYTES, stream);
    if (e != hipSuccess) fprintf(stderr, "cooperative launch failed: %s (grid %d)\n", hipGetErrorString(e), grid_blocks);
}
```

```cpp
#include <hip/hip_runtime.h>
#include <hip/hip_cooperative_groups.h>
#include <cstdio>
#include <cstdint>
namespace cg = cooperative_groups;

typedef unsigned short bf16;

constexpr int NB = 4, SEQ = 4096, NCTX = 256, TT = 4352, MROWS = NB * TT, DM = 1024;
constexpr int NTOK = NB * SEQ;
constexpr int FFD = 2816, FFE = 3584, NEXP = 8;
constexpr int AB_IN = 5136, CD_IN = 5696;
constexpr int MAXSLOT = 2 * NTOK + NEXP * 256;

constexpr size_t MiB = 1u << 20;
constexpr size_t OFF_CTL = 0, OFF_MOD = 1 * MiB, OFF_G = 2 * MiB, OFF_XC = 7 * MiB, OFF_TOPI = 11 * MiB, OFF_TOPG = 11 * MiB + 256 * 1024,
                 OFF_SLOT = 11 * MiB + 512 * 1024, OFF_STOK = 12 * MiB, OFF_RGS = 13 * MiB, OFF_H = 18 * MiB, OFF_ZS = 52 * MiB,
                 OFF_SO = 256 * MiB, OFF_HC = 392 * MiB, OFF_Y = 460 * MiB, OFF_W = 528 * MiB;
constexpr int NP_ABIN = 5376, NP_CDIN = 5888;
constexpr size_t OFF_W_ABIN = OFF_W, OFF_W_ABOUT = OFF_W_ABIN + (size_t)NP_ABIN * 1024 * 2, OFF_W_FFN1 = OFF_W_ABOUT + (size_t)1024 * 2048 * 2,
                 OFF_W_FFN2 = OFF_W_FFN1 + (size_t)5632 * 1024 * 2, OFF_W_CDIN = OFF_W_FFN2 + (size_t)1024 * 2816 * 2, OFF_W_CDOUT = OFF_W_CDIN + (size_t)NP_CDIN * 1024 * 2,
                 OFF_W_MOE1 = OFF_W_CDOUT + (size_t)1024 * 2048 * 2, OFF_W_MOE2 = OFF_W_MOE1 + (size_t)8 * 7168 * 1024 * 2, OFF_W_END = OFF_W_MOE2 + (size_t)8 * 1024 * 3584 * 2;
constexpr size_t WS_NEED = OFF_W_END;
constexpr size_t SEG = (size_t)MROWS * DM;
constexpr size_t OFF_ACT = OFF_ZS, OFF_XS = OFF_HC, OFF_ACTM = OFF_ZS, OFF_YS = OFF_HC;
constexpr int CW_CNT = 0, CW_BASE = 8, CW_TOT = 17;

#ifndef NAIVE_MASK
#define NAIVE_MASK 0
#endif
struct Params { const float* in[37]; float* out; unsigned char* ws; };
enum { I_X = 0, I_C, I_CTX, I_CCTX, I_MODW, I_MODB, I_NORMG, I_ABIN, I_MCONVW, I_MCONVB, I_MGATEB, I_MNORMW, I_LCONVW, I_LCONVB, I_LWA, I_LBA, I_LWX, I_LBX,
       I_LLAM, I_ABOUT, I_FFN1, I_FFN2, I_CDIN, I_GALW, I_GALB, I_GNORMW, I_SCONVW, I_SCONVB, I_SDTB, I_SALOG, I_SD, I_SNORMW, I_CDOUT, I_RW, I_RB, I_MOE1, I_MOE2 };

__device__ __forceinline__ float bf2f(unsigned v) { return __uint_as_float(v << 16); }
__device__ __forceinline__ unsigned f2bf(float f) { unsigned u = __float_as_uint(f); return (u + 0x7fffu + ((u >> 16) & 1u)) >> 16; }
__device__ __forceinline__ float sigmoid_f(float x) { return 1.f / (1.f + expf(-x)); }
__device__ __forceinline__ float silu_f(float x) { return x / (1.f + expf(-x)); }
__device__ __forceinline__ float softplus_f(float x) { return fmaxf(x, 0.f) + log1pf(expf(-fabsf(x))); }
__device__ __forceinline__ float logsigmoid_f(float x) { return -softplus_f(-x); }
__device__ __forceinline__ float gelu_f(float x) { return 0.5f * x * (1.f + tanhf(0.7978845608028654f * (x + 0.044715f * x * x * x))); }
__device__ __forceinline__ float wave_sum(float v) {
#pragma unroll
    for (int o = 32; o >= 1; o >>= 1) v += __shfl_xor(v, o);
    return v;
}
__device__ __forceinline__ int tid_op() { int t = threadIdx.x; asm volatile("" : "+v"(t)); return t; }
__device__ __forceinline__ void ld_row_f32(const float* row, int lane, float (&v)[16]) {
#pragma unroll
    for (int j = 0; j < 4; ++j) { const float4 t = ((const float4*)row)[j * 64 + lane]; v[4 * j] = t.x; v[4 * j + 1] = t.y; v[4 * j + 2] = t.z; v[4 * j + 3] = t.w; }
}
__device__ __forceinline__ void st_row_f32(float* row, int lane, const float (&v)[16]) {
#pragma unroll
    for (int j = 0; j < 4; ++j) ((float4*)row)[j * 64 + lane] = make_float4(v[4 * j], v[4 * j + 1], v[4 * j + 2], v[4 * j + 3]);
}
__device__ __forceinline__ void ld_row_bf16(const bf16* row, int lane, float (&v)[16]) {
#pragma unroll
    for (int j = 0; j < 4; ++j) { const uint2 t = ((const uint2*)row)[j * 64 + lane]; v[4 * j] = bf2f(t.x & 0xffffu); v[4 * j + 1] = bf2f(t.x >> 16); v[4 * j + 2] = bf2f(t.y & 0xffffu); v[4 * j + 3] = bf2f(t.y >> 16); }
}
__device__ __forceinline__ void st_row_bf16(bf16* row, int lane, const float (&v)[16]) {
#pragma unroll
    for (int j = 0; j < 4; ++j) { uint2 t; t.x = f2bf(v[4 * j]) | (f2bf(v[4 * j + 1]) << 16); t.y = f2bf(v[4 * j + 2]) | (f2bf(v[4 * j + 3]) << 16); ((uint2*)row)[j * 64 + lane] = t; }
}
__device__ __forceinline__ float row_ss(const float (&v)[16]) { float s = 0.f;
#pragma unroll
    for (int i = 0; i < 16; ++i) s += v[i] * v[i];
    return wave_sum(s); }

__device__ __forceinline__ void seg_bounds(int t, int& lo, int& hi) { if (t < NCTX) { lo = 0; hi = NCTX; } else { lo = NCTX + ((t - NCTX) & ~63); hi = lo + 64; } }
__device__ __forceinline__ float conv4(const bf16* Z, int b, int t, int c, const float* w, int wstride, int wc, float bias) {
    int lo, hi; seg_bounds(t, lo, hi); float s = bias;
#pragma unroll
    for (int j = 0; j < 4; ++j) { const int tt = t + j - 2; if (tt >= lo && tt < hi) s += w[j * wstride + wc] * bf2f(Z[((size_t)(b * TT + tt)) * DM + c]); }
    return s;
}
__device__ __forceinline__ int tokmap(int dir, int tau) { return dir ? (tau < NCTX ? (NCTX - 1 - tau) : (TT + NCTX - 1 - tau)) : tau; }

__device__ __forceinline__ void phase_mod(const Params& p, float* sm) {
    float* sv = sm; float* red = sm + 5 * 1024; const int tid = tid_op();
    for (int i = tid; i < 5 * 1024; i += 512) { const int v = i >> 10, k = i & 1023; const float x = (v < 4) ? p.in[I_C][v * 1024 + k] : p.in[I_CCTX][k]; sv[i] = silu_f(x); }
    __syncthreads();
    float* MOD = (float*)(p.ws + OFF_MOD);
    for (int it = blockIdx.x; it < 192; it += gridDim.x) {
        const int l = it / 96, j0 = (it % 96) * 64, col = tid & 63, kg = tid >> 6;
        const float* w = p.in[I_MODW] + (size_t)l * 1024 * 6144 + j0 + col;
        float a[5] = {0.f, 0.f, 0.f, 0.f, 0.f};
        for (int k = kg * 128; k < kg * 128 + 128; ++k) { const float wv = w[(size_t)k * 6144];
#pragma unroll
            for (int v = 0; v < 5; ++v) a[v] += sv[v * 1024 + k] * wv; }
#pragma unroll
        for (int v = 0; v < 5; ++v) red[(kg * 5 + v) * 64 + col] = a[v];
        __syncthreads();
        if (tid < 320) { const int v = tid >> 6, cc = tid & 63; float s = 0.f;
            for (int g = 0; g < 8; ++g) s += red[(g * 5 + v) * 64 + cc];
            MOD[(size_t)(l * 5 + v) * 6144 + j0 + cc] = s + p.in[I_MODB][l * 6144 + j0 + cc]; }
        __syncthreads();
    }
    if (blockIdx.x == 0 && tid < 32) ((int*)(p.ws + OFF_CTL))[tid] = 0;
}

template <int MODE> __device__ __forceinline__ void phase_norm(const Params& p, int layer) {
    const int tid_ = tid_op(); const int lane = tid_ & 63, gw = blockIdx.x * 8 + (tid_ >> 6), NGW = gridDim.x * 8;
    const float* MOD = (const float*)(p.ws + OFF_MOD);
    const float* NG = p.in[I_NORMG] + (size_t)layer * 4 * 1024;
    float* XC = (float*)(p.ws + OFF_XC); bf16* H = (bf16*)(p.ws + OFF_H); const float* Y = (const float*)(p.ws + OFF_Y);
    const bool last = (layer == 1);
    for (int r = gw; r < MROWS; r += NGW) {
        const int b = r / TT, t = r % TT; const bool isctx = t < NCTX; const int v = isctx ? 4 : b;
        if ((MODE == 3 || (MODE == 1 && last)) && isctx) continue;
        const float* mv = MOD + (size_t)(layer * 5 + v) * 6144;
        const float* xin = isctx ? (p.in[I_CTX] + ((size_t)b * NCTX + t) * DM) : (p.in[I_X] + ((size_t)b * SEQ + (t - NCTX)) * DM);
        float* xst = isctx ? (XC + ((size_t)b * NCTX + t) * DM) : (p.out + ((size_t)b * SEQ + (t - NCTX)) * DM);
        float x[16], g[16], a[16], s[16];
        if (MODE == 0) {
            ld_row_f32(xin, lane, x);
            const float rstd = rsqrtf(row_ss(x) * (1.f / DM) + 1e-6f);
            ld_row_f32(NG, lane, g); ld_row_f32(mv + 1024, lane, a); ld_row_f32(mv, lane, s);
#pragma unroll
            for (int i = 0; i < 16; ++i) x[i] = x[i] * rstd * g[i] * (1.f + a[i]) + s[i];
            st_row_bf16(H + (size_t)r * DM, lane, x);
        } else if (MODE == 1 || MODE == 2) {
            float y[16];
            ld_row_f32(Y + (size_t)r * DM, lane, y);
            const float rstd = rsqrtf(row_ss(y) * (1.f / DM) + 1e-6f);
            ld_row_f32(NG + (MODE == 1 ? 1 : 3) * 1024, lane, g); ld_row_f32(mv + (MODE == 1 ? 2 : 5) * 1024, lane, a);
            if (MODE == 1 && layer == 0) ld_row_f32(xin, lane, x); else ld_row_f32(xst, lane, x);
#pragma unroll
            for (int i = 0; i < 16; ++i) x[i] = x[i] + a[i] * (y[i] * rstd * g[i]);
            st_row_f32(xst, lane, x);
            const float rstd2 = rsqrtf(row_ss(x) * (1.f / DM) + 1e-6f);
            const float* ng2 = (MODE == 1) ? (NG + 2 * 1024) : (p.in[I_NORMG] + (size_t)4 * 1024);
            const float* mv2 = (MODE == 1) ? mv : (MOD + (size_t)(5 + v) * 6144);
            ld_row_f32(ng2, lane, g); ld_row_f32(mv2 + (MODE == 1 ? 4 : 1) * 1024, lane, a); ld_row_f32(mv2 + (MODE == 1 ? 3 : 0) * 1024, lane, s);
#pragma unroll
            for (int i = 0; i < 16; ++i) x[i] = x[i] * rstd2 * g[i] * (1.f + a[i]) + s[i];
            st_row_bf16(H + (size_t)r * DM, lane, x);
            if (MODE == 1 && last) {
                float lg[8];
#pragma unroll
                for (int e = 0; e < 8; ++e) lg[e] = 0.f;
#pragma unroll
                for (int i = 0; i < 16; ++i) { const int col = (i >> 2) * 256 + lane * 4 + (i & 3); const float4 w0 = ((const float4*)(p.in[I_RW] + (size_t)col * 8))[0], w1 = ((const float4*)(p.in[I_RW] + (size_t)col * 8))[1];
                    lg[0] += x[i] * w0.x; lg[1] += x[i] * w0.y; lg[2] += x[i] * w0.z; lg[3] += x[i] * w0.w; lg[4] += x[i] * w1.x; lg[5] += x[i] * w1.y; lg[6] += x[i] * w1.z; lg[7] += x[i] * w1.w; }
#pragma unroll
                for (int e = 0; e < 8; ++e) lg[e] = wave_sum(lg[e]) + p.in[I_RB][e];
                if (lane == 0) {
                    int e0 = 0; float l0 = lg[0];
#pragma unroll
                    for (int e = 1; e < 8; ++e) if (lg[e] > l0) { l0 = lg[e]; e0 = e; }
                    int e1 = -1; float l1 = -3.0e38f;
#pragma unroll
                    for (int e = 0; e < 8; ++e) if (e != e0 && lg[e] > l1) { l1 = lg[e]; e1 = e; }
                    const float ex = expf(l1 - l0), g0 = 1.f / (1.f + ex), g1 = ex / (1.f + ex);
                    const int tok = b * SEQ + (t - NCTX);
                    ((int*)(p.ws + OFF_TOPI))[tok * 2] = e0; ((int*)(p.ws + OFF_TOPI))[tok * 2 + 1] = e1;
                    ((float*)(p.ws + OFF_TOPG))[tok * 2] = g0; ((float*)(p.ws + OFF_TOPG))[tok * 2 + 1] = g1;
                }
            }
        } else {
            const int tok = b * SEQ + (t - NCTX);
            const int s0 = ((const int*)(p.ws + OFF_SLOT))[tok * 2], s1 = ((const int*)(p.ws + OFF_SLOT))[tok * 2 + 1];
            const float g0 = ((const float*)(p.ws + OFF_TOPG))[tok * 2], g1 = ((const float*)(p.ws + OFF_TOPG))[tok * 2 + 1];
            const float* YS = (const float*)(p.ws + OFF_YS);
            float y[16];
            ld_row_f32(YS + (size_t)s0 * DM, lane, y); ld_row_f32(YS + (size_t)s1 * DM, lane, a);
#pragma unroll
            for (int i = 0; i < 16; ++i) y[i] = y[i] * g0 + a[i] * g1;
            const float rstd = rsqrtf(row_ss(y) * (1.f / DM) + 1e-6f);
            ld_row_f32(NG + 3 * 1024, lane, g); ld_row_f32(mv + 5 * 1024, lane, a); ld_row_f32(xst, lane, x);
#pragma unroll
            for (int i = 0; i < 16; ++i) x[i] = x[i] + a[i] * (y[i] * rstd * g[i]);
            st_row_f32(xst, lane, x);
        }
    }
}

template <bool DUAL, class Map, class Epi>
__device__ __forceinline__ void gemm_naive(const bf16* A, int lda, int ldb, int N, int K, int uoff, int ntiles, const Map& map, const Epi& epi, float* sm) {
    constexpr int NC = DUAL ? 4 : 8, TW = DUAL ? 64 : 128;
    float* As = sm;
    float* Bs = sm + 16 * 132;
    const int tid = tid_op(), ty = tid >> 4, tx = tid & 15;
    for (int tile = blockIdx.x; tile < ntiles; tile += gridDim.x) {
        int row0, col0; const float* B;
        if (!map(tile, TW, row0, col0, B)) continue;
        float acc[4][8];
#pragma unroll
        for (int i = 0; i < 4; ++i)
#pragma unroll
            for (int j = 0; j < 8; ++j) acc[i][j] = 0.f;
        for (int k0 = 0; k0 < K; k0 += 16) {
            { const int row = tid >> 2, kq = tid & 3; const uint2 t = *(const uint2*)(A + (size_t)(row0 + row) * lda + k0 + kq * 4);
              As[(kq * 4 + 0) * 132 + row] = bf2f(t.x & 0xffffu); As[(kq * 4 + 1) * 132 + row] = bf2f(t.x >> 16); As[(kq * 4 + 2) * 132 + row] = bf2f(t.y & 0xffffu); As[(kq * 4 + 3) * 132 + row] = bf2f(t.y >> 16); }
            { const int kk = tid >> 5, c4 = (tid & 31) * 4; int col = col0 + c4; bool ok = col + 3 < N;
              if (DUAL) { const int cc = c4 & 63; col = col0 + cc; ok = col + 3 < N; if (c4 >= 64) col += uoff; }
              float4 t = make_float4(0.f, 0.f, 0.f, 0.f); if (ok) t = *(const float4*)(B + (size_t)(k0 + kk) * ldb + col);
              *(float4*)(Bs + kk * 128 + c4) = t; }
            __syncthreads();
#pragma unroll
            for (int kk = 0; kk < 16; ++kk) {
                const float4 a4 = *(const float4*)(As + kk * 132 + ty * 4);
                const float av[4] = {a4.x, a4.y, a4.z, a4.w};
                float bv[8];
                if (DUAL) { const float4 b0 = *(const float4*)(Bs + kk * 128 + tx * 4), b1 = *(const float4*)(Bs + kk * 128 + 64 + tx * 4); bv[0] = b0.x; bv[1] = b0.y; bv[2] = b0.z; bv[3] = b0.w; bv[4] = b1.x; bv[5] = b1.y; bv[6] = b1.z; bv[7] = b1.w; }
                else { const float4 b0 = *(const float4*)(Bs + kk * 128 + tx * 8), b1 = *(const float4*)(Bs + kk * 128 + tx * 8 + 4); bv[0] = b0.x; bv[1] = b0.y; bv[2] = b0.z; bv[3] = b0.w; bv[4] = b1.x; bv[5] = b1.y; bv[6] = b1.z; bv[7] = b1.w; }
#pragma unroll
                for (int i = 0; i < 4; ++i)
#pragma unroll
                    for (int j = 0; j < 8; ++j) acc[i][j] += av[i] * bv[j];
            }
            __syncthreads();
        }
#pragma unroll
        for (int i = 0; i < 4; ++i)
#pragma unroll
            for (int j = 0; j < NC; ++j) { const int c = col0 + tx * NC + j; if (c < N) epi(row0 + ty * 4 + i, c, acc[i][j], DUAL ? acc[i][j + 4] : 0.f); }
    }
}
struct MapDense { int ntn; const float* B; __device__ __forceinline__ bool operator()(int tile, int tw, int& row0, int& col0, const float*& Bp) const { row0 = (tile / ntn) * 128; col0 = (tile % ntn) * tw; Bp = B; return true; } };
struct MapMoe { int ntn; const float* B; size_t estride; const int* ctl;
    __device__ __forceinline__ bool operator()(int tile, int tw, int& row0, int& col0, const float*& Bp) const {
        row0 = (tile / ntn) * 128; col0 = (tile % ntn) * tw; if (row0 >= ctl[CW_TOT]) return false;
        int e = 0;
#pragma unroll
        for (int i = 1; i < 8; ++i) if (row0 >= ctl[CW_BASE + i]) e = i;
        Bp = B + (size_t)e * estride; return true; } };
struct EpiInAB { bf16* ZS; float* G; __device__ __forceinline__ void operator()(int r, int c, float g, float) const {
        if (c < 3072) ZS[(size_t)(c >> 10) * SEG + (size_t)r * DM + (c & 1023)] = (bf16)f2bf(g);
        else if (c < 3088) G[(size_t)r * 64 + (c - 3072)] = g;
        else { const int cc = c - 3088; ZS[(size_t)(3 + (cc >> 10)) * SEG + (size_t)r * DM + (cc & 1023)] = (bf16)f2bf(g); } } };
struct EpiInCD { bf16* ZS; float* G; __device__ __forceinline__ void operator()(int r, int c, float g, float) const {
        if (c < 3072) ZS[(size_t)(c >> 10) * SEG + (size_t)r * DM + (c & 1023)] = (bf16)f2bf(g);
        else if (c < 3104) G[(size_t)r * 64 + (c - 3072)] = g;
        else if (c < 5664) { const int cc = c - 3104; ZS[(size_t)(3 + (cc >> 10)) * SEG + (size_t)r * DM + (cc & 1023)] = (bf16)f2bf(g); }
        else G[(size_t)r * 64 + 32 + (c - 5664)] = g; } };
struct EpiF32 { float* C; int ldc; __device__ __forceinline__ void operator()(int r, int c, float g, float) const { C[(size_t)r * ldc + c] = g; } };
struct EpiSwiglu { bf16* C; int ldc; __device__ __forceinline__ void operator()(int r, int c, float g, float u) const { C[(size_t)r * ldc + c] = (bf16)f2bf(silu_f(g) * u); } };

namespace pg8 {
#define PG8_LAS __attribute__((address_space(3)))
typedef unsigned short bf16_t;
typedef short bf16x8 __attribute__((ext_vector_type(8)));
typedef float f32x4 __attribute__((ext_vector_type(4)));
typedef unsigned u32x4 __attribute__((ext_vector_type(4)));
constexpr int BM = 256, BK = 64, HALF = 128, HTB = HALF * BK * 2, STAGE_BYTES = 8 * HTB, NXCD = 8, WGM = 8;
__host__ __device__ __forceinline__ int lds_byte(int r, int c) { const int st = (r >> 4) * 2 + (c >> 5), rr = r & 15, cc = c & 31, ob = rr * 64 + cc * 2; return st * 1024 + (ob ^ (((ob >> 9) & 1) << 5)); }
__host__ __device__ __forceinline__ void stage_rc(int b, int& R, int& C) { const int st = b / 1024, sb = b % 1024, swz = sb ^ (((sb >> 9) & 1) << 5); R = (st >> 1) * 16 + swz / 64; C = (st & 1) * 32 + (swz % 64) / 2; }
__host__ __device__ __forceinline__ int perm32(int rho) { const int n = rho >> 4, i = rho & 15; return 8 * (i >> 2) + 4 * n + (i & 3); }
struct Unit { int pm, pn; };
struct Gemm { const bf16_t* A; const bf16_t* Bt; int M, N, K; };
struct StaticOrder {
    int nM, nN, nwg, G, c;
    __device__ void init(int M, int N, int G_, int c_) { nM = M / BM; nN = N / BM; nwg = nM * nN; G = G_; c = c_; }
    __device__ bool next(int i, Unit& u) const {
        const long L = (long)i * G + c; if (L >= nwg) return false;
        int wgid = (int)L; { const int q = nwg / NXCD, r = nwg % NXCD, xcd = wgid % NXCD, off = wgid / NXCD; wgid = (xcd < r ? xcd * (q + 1) : r * (q + 1) + (xcd - r) * q) + off; }
        const int nig = WGM * nN, gid = wgid / nig, fm = gid * WGM, gsz = (nM - fm) < WGM ? (nM - fm) : WGM;
        u.pm = fm + ((wgid % nig) % gsz); u.pn = (wgid % nig) / gsz; return true;
    }
    __device__ __forceinline__ size_t boff(const Unit&) const { return 0; }
};
struct MoeOrder : StaticOrder {
    const int* ctl; size_t estride;
    __device__ __forceinline__ size_t boff(const Unit& u) const { const int row0 = u.pm * 256; int e = 0;
#pragma unroll
        for (int i = 1; i < 8; ++i) if (row0 >= ctl[CW_BASE + i]) e = i;
        return (size_t)e * estride; }
};
__device__ __forceinline__ unsigned cvt_pk_bf16(float lo, float hi) { unsigned r; asm volatile("v_cvt_pk_bf16_f32 %0, %1, %2" : "=v"(r) : "v"(lo), "v"(hi)); return r; }
__device__ __forceinline__ float silu_fast(float x) { return x * __builtin_amdgcn_rcpf(1.f + __expf(-x)); }
struct EpiF32 { static constexpr bool PERM = false;
    float* C; int ldc;
    __device__ __forceinline__ void operator()(const f32x4 (&acc)[2][2][4][2], const Unit& u, int wr, int wc, int fr, int fq) const {
        const int row0 = u.pm * BM + wr * 64 + fr, col0 = u.pn * BM + wc * 32 + 4 * fq;
#pragma unroll
        for (int ai = 0; ai < 2; ++ai)
#pragma unroll
            for (int m = 0; m < 4; ++m) { float* rowp = C + (size_t)(row0 + ai * HALF + m * 16) * ldc + col0;
#pragma unroll
                for (int bj = 0; bj < 2; ++bj)
#pragma unroll
                    for (int n = 0; n < 2; ++n) *(f32x4*)(rowp + bj * HALF + n * 16) = acc[ai][bj][m][n]; }
    }
};
struct EpiInProj { static constexpr bool PERM = true;
    bf16_t* ZS; float* G; int gate_tile, ngate;
    __device__ __forceinline__ void operator()(const f32x4 (&acc)[2][2][4][2], const Unit& u, int wr, int wc, int fr, int fq) const {
        const int row0 = u.pm * BM + wr * 64 + fr;
        if (u.pn == gate_tile) {
            if (wc < 2) {
#pragma unroll
                for (int ai = 0; ai < 2; ++ai)
#pragma unroll
                    for (int m = 0; m < 4; ++m)
#pragma unroll
                        for (int n = 0; n < 2; ++n) { const int c0 = 32 * wc + 8 * fq + 4 * n; if (c0 < ngate) *(f32x4*)(G + (size_t)(row0 + ai * HALF + m * 16) * 64 + c0) = acc[ai][0][m][n]; }
            }
        } else {
            bf16_t* base = ZS + (size_t)(u.pn >> 2) * SEG; const int col0 = (u.pn & 3) * 256 + wc * 32 + 8 * fq;
#pragma unroll
            for (int ai = 0; ai < 2; ++ai)
#pragma unroll
                for (int m = 0; m < 4; ++m) { bf16_t* rowp = base + (size_t)(row0 + ai * HALF + m * 16) * DM + col0;
#pragma unroll
                    for (int bj = 0; bj < 2; ++bj) { const f32x4 v0 = acc[ai][bj][m][0], v1 = acc[ai][bj][m][1];
                        u32x4 w; w.x = cvt_pk_bf16(v0[0], v0[1]); w.y = cvt_pk_bf16(v0[2], v0[3]); w.z = cvt_pk_bf16(v1[0], v1[1]); w.w = cvt_pk_bf16(v1[2], v1[3]);
                        *(u32x4*)(rowp + bj * HALF) = w; } }
        }
    }
};
struct EpiSwiglu { static constexpr bool PERM = true;
    bf16_t* O; int ldo;
    __device__ __forceinline__ void operator()(const f32x4 (&acc)[2][2][4][2], const Unit& u, int wr, int wc, int fr, int fq) const {
        const int row0 = u.pm * BM + wr * 64 + fr, col0 = u.pn * HALF + wc * 32 + 8 * fq;
#pragma unroll
        for (int ai = 0; ai < 2; ++ai)
#pragma unroll
            for (int m = 0; m < 4; ++m) { const f32x4 g0 = acc[ai][0][m][0], g1 = acc[ai][0][m][1], u0 = acc[ai][1][m][0], u1 = acc[ai][1][m][1];
                u32x4 w; w.x = cvt_pk_bf16(silu_fast(g0[0]) * u0[0], silu_fast(g0[1]) * u0[1]); w.y = cvt_pk_bf16(silu_fast(g0[2]) * u0[2], silu_fast(g0[3]) * u0[3]);
                w.z = cvt_pk_bf16(silu_fast(g1[0]) * u1[0], silu_fast(g1[1]) * u1[1]); w.w = cvt_pk_bf16(silu_fast(g1[2]) * u1[2], silu_fast(g1[3]) * u1[3]);
                *(u32x4*)(O + (size_t)(row0 + ai * HALF + m * 16) * ldo + col0) = w; }
    }
};

template <class Epi, class Sched>
__device__ __forceinline__ void gemm_phase(PG8_LAS unsigned char* lds, const Gemm g, const Sched& S, const Epi& E) {
    const int tid = tid_op(), wid = __builtin_amdgcn_readfirstlane(tid >> 6), lane = tid & 63, wr = wid >> 2, wc = wid & 3, fr = lane & 15, fq = lane >> 4;
    const int K = g.K, nt = K / BK;
    unsigned voffA[2], voffB[2];
#pragma unroll
    for (int i = 0; i < 2; ++i) { int R, C; stage_rc(tid * 16 + i * 8192, R, C); const int Rb = Epi::PERM ? ((R & ~31) + perm32(R & 31)) : R;
        voffA[i] = (unsigned)(R * K + C) * 2u; voffB[i] = (unsigned)(Rb * K + C) * 2u; }
    const size_t kstep = (size_t)(BK * 2);
    const size_t hstep = (size_t)HALF * K * 2;
    const size_t tstep = 2 * hstep;
    const unsigned ldsw = (unsigned)wid * 1024u;
    const int aoff = lds_byte(wr * 64 + fr, fq * 8), boff = lds_byte(wc * 32 + fr, fq * 8);
#define PG8_SA(b, h) (((b) * 2 + (h)) * HTB)
#define PG8_SB(b, h) ((4 + (b) * 2 + (h)) * HTB)
#define PG8_STAGE(bufoff, gbase, voff) do { _Pragma("unroll") for (int _i = 0; _i < 2; ++_i) \
        __builtin_amdgcn_global_load_lds((const unsigned*)((const char*)(gbase) + (voff)[_i]), (PG8_LAS unsigned*)(lds + (bufoff) + ldsw + _i * 8192), 16, 0, 0); } while (0)
#define PG8_LDA(dst, b, h) do { _Pragma("unroll") for (int m = 0; m < 4; ++m) _Pragma("unroll") for (int k = 0; k < 2; ++k) dst[m][k] = *(const PG8_LAS bf16x8*)(lds + PG8_SA(b, h) + aoff + m * 2048 + k * 1024); } while (0)
#define PG8_LDB(dst, b, h) do { _Pragma("unroll") for (int n = 0; n < 2; ++n) _Pragma("unroll") for (int k = 0; k < 2; ++k) dst[n][k] = *(const PG8_LAS bf16x8*)(lds + PG8_SB(b, h) + boff + n * 2048 + k * 1024); } while (0)
#define PG8_MMA(ai, bj, At, Bt) do { __builtin_amdgcn_s_setprio(1); _Pragma("unroll") for (int m = 0; m < 4; ++m) _Pragma("unroll") for (int n = 0; n < 2; ++n) _Pragma("unroll") for (int k = 0; k < 2; ++k) \
        acc[ai][bj][m][n] = __builtin_amdgcn_mfma_f32_16x16x32_bf16(Bt[n][k], At[m][k], acc[ai][bj][m][n], 0, 0, 0); __builtin_amdgcn_s_setprio(0); } while (0)
#define PG8_WAIT_V(n) asm volatile("s_waitcnt vmcnt(" #n ")" ::: "memory")
#define PG8_WAIT_L(n) asm volatile("s_waitcnt lgkmcnt(" #n ")" ::: "memory")
#define PG8_BAR __builtin_amdgcn_s_barrier()
#define PG8_SCHED __builtin_amdgcn_sched_barrier(0)
    Unit cur, nxt; int ui = 0;
    if (!S.next(0, cur)) return;
    f32x4 acc[2][2][4][2];
#pragma unroll
    for (int a = 0; a < 2; ++a)
#pragma unroll
        for (int b = 0; b < 2; ++b)
#pragma unroll
            for (int m = 0; m < 4; ++m)
#pragma unroll
                for (int n = 0; n < 2; ++n) acc[a][b][m][n] = (f32x4){0.f, 0.f, 0.f, 0.f};
    bf16x8 At[4][2], B0[2][2], B1[2][2];
    const char* cA = (const char*)g.A + (size_t)cur.pm * tstep; const char* cB = (const char*)g.Bt + S.boff(cur) + (size_t)cur.pn * tstep;
    PG8_STAGE(PG8_SB(0, 0), cB, voffB); PG8_STAGE(PG8_SB(0, 1), cB + hstep, voffB); PG8_STAGE(PG8_SA(0, 0), cA, voffA); PG8_STAGE(PG8_SA(0, 1), cA + hstep, voffA);
    if (wr == 1) PG8_BAR;
    PG8_WAIT_V(2); PG8_BAR;
    PG8_STAGE(PG8_SB(1, 0), cB + kstep, voffB); PG8_STAGE(PG8_SA(1, 0), cA + kstep, voffA); PG8_STAGE(PG8_SB(1, 1), cB + hstep + kstep, voffB);
    PG8_WAIT_V(6); PG8_BAR;
    for (;;) {
        const bool has_next = S.next(ui + 1, nxt);
        const char* nA = has_next ? (const char*)g.A + (size_t)nxt.pm * tstep : cA; const char* nB = has_next ? (const char*)g.Bt + S.boff(nxt) + (size_t)nxt.pn * tstep : cB;
        for (int t = 0; t < nt; t += 2) {
            const bool last = (t == nt - 2);
            const char* a1 = cA + (size_t)(t + 1) * kstep;
            const char* a2 = last ? nA : cA + (size_t)(t + 2) * kstep; const char* b2 = last ? nB : cB + (size_t)(t + 2) * kstep;
            const char* a3 = a2 + kstep; const char* b3 = b2 + kstep;
            PG8_LDB(B0, 0, 0); PG8_LDB(B1, 0, 1); PG8_SCHED; PG8_LDA(At, 0, 0); PG8_STAGE(PG8_SA(1, 1), a1 + hstep, voffA);
            PG8_WAIT_V(8); PG8_WAIT_L(0); PG8_BAR; PG8_MMA(0, 0, At, B0); PG8_MMA(0, 1, At, B1); PG8_BAR; PG8_SCHED;
            PG8_LDA(At, 0, 1); PG8_STAGE(PG8_SB(0, 0), b2, voffB); PG8_STAGE(PG8_SB(0, 1), b2 + hstep, voffB); PG8_STAGE(PG8_SA(0, 0), a2, voffA);
            PG8_WAIT_V(8); PG8_WAIT_L(0); PG8_BAR; PG8_MMA(1, 0, At, B0); PG8_MMA(1, 1, At, B1); PG8_BAR; PG8_SCHED;
            PG8_LDB(B0, 1, 0); PG8_LDB(B1, 1, 1); PG8_SCHED; PG8_LDA(At, 1, 0); PG8_STAGE(PG8_SA(0, 1), a2 + hstep, voffA);
            PG8_WAIT_V(8); PG8_WAIT_L(0); PG8_BAR; PG8_MMA(0, 0, At, B0); PG8_MMA(0, 1, At, B1); PG8_BAR; PG8_SCHED;
            PG8_LDA(At, 1, 1); PG8_STAGE(PG8_SB(1, 0), b3, voffB); PG8_STAGE(PG8_SB(1, 1), b3 + hstep, voffB); PG8_STAGE(PG8_SA(1, 0), a3, voffA);
            PG8_WAIT_V(8); PG8_WAIT_L(0); PG8_BAR; PG8_MMA(1, 0, At, B0); PG8_MMA(1, 1, At, B1); PG8_BAR; PG8_SCHED;
        }
        if (wr == 0) PG8_BAR;
        E(acc, cur, wr, wc, fr, fq);
        if (!has_next) break;
#pragma unroll
        for (int a = 0; a < 2; ++a)
#pragma unroll
            for (int b = 0; b < 2; ++b)
#pragma unroll
                for (int m = 0; m < 4; ++m)
#pragma unroll
                    for (int n = 0; n < 2; ++n) acc[a][b][m][n] = (f32x4){0.f, 0.f, 0.f, 0.f};
        cur = nxt; cA = nA; cB = nB; ++ui;
        if (wr == 1) PG8_BAR;
    }
    PG8_WAIT_V(0);
    PG8_BAR;
#undef PG8_SA
#undef PG8_SB
#undef PG8_STAGE
#undef PG8_LDA
#undef PG8_LDB
#undef PG8_MMA
#undef PG8_WAIT_V
#undef PG8_WAIT_L
#undef PG8_BAR
#undef PG8_SCHED
}
}

__device__ __forceinline__ int wsrccol(int map, int n, int FF) {
    if (map == 0) return n;
    if (map == 1) return n < 3072 ? n : (n < 5120 ? n + 16 : (n < 5136 ? 3072 + (n - 5120) : -1));
    if (map == 2) return n < 3072 ? n : (n < 5632 ? n + 32 : (n < 5664 ? 3072 + (n - 5632) : (n < 5696 ? n : -1)));
    const int tile = n >> 8, i = n & 255; return (i < 128) ? tile * 128 + i : FF + tile * 128 + (i - 128);
}
__device__ __forceinline__ void wconv_item(const float* W, int ldsrc, int K, bf16* WT, int nblk, int map, int FF, float* scr, int item, int lane) {
    const int kb = item / nblk, nb = item % nblk, k0 = 64 * kb, n0 = 32 * nb;
    const int sc = wsrccol(map, n0 + (lane & 31), FF);
#pragma unroll 8
    for (int i = 0; i < 32; ++i) { const int kk = 2 * i + (lane >> 5); scr[kk * 33 + (lane & 31)] = (sc >= 0) ? W[(size_t)(k0 + kk) * ldsrc + sc] : 0.f; }
    asm volatile("s_waitcnt lgkmcnt(0)" ::: "memory");
    const int c = lane & 7;
#pragma unroll
    for (int j = 0; j < 4; ++j) { const int n = (lane >> 3) + 8 * j; const float* s = scr + (8 * c) * 33 + n;
        uint4 o; o.x = f2bf(s[0 * 33]) | (f2bf(s[1 * 33]) << 16); o.y = f2bf(s[2 * 33]) | (f2bf(s[3 * 33]) << 16); o.z = f2bf(s[4 * 33]) | (f2bf(s[5 * 33]) << 16); o.w = f2bf(s[6 * 33]) | (f2bf(s[7 * 33]) << 16);
        *(uint4*)(WT + (size_t)(n0 + n) * K + k0 + 8 * c) = o; }
    asm volatile("s_waitcnt lgkmcnt(0)" ::: "memory");
}
__device__ __forceinline__ void phase_wconv(const Params& p, float* sm) {
    const int tid = tid_op(), lane = tid & 63, wave = tid >> 6;
    float* scr = sm + wave * (64 * 33);
    const int gw = blockIdx.x * 8 + wave, NGW = gridDim.x * 8;
    constexpr int I0 = 16 * (NP_ABIN / 32), I1 = 32 * 32, I2 = 16 * (5632 / 32), I3 = 44 * 32, I4 = 16 * (NP_CDIN / 32), I5 = 32 * 32, I6 = 16 * (7168 / 32), I7 = 56 * 32;
    constexpr int NIT = I0 + I1 + I2 + I3 + I4 + I5 + 8 * I6 + 8 * I7;
    unsigned char* ws = p.ws;
    for (int it = gw; it < NIT; it += NGW) {
        int r = it;
        if (r < I0) { wconv_item(p.in[I_ABIN], AB_IN, 1024, (bf16*)(ws + OFF_W_ABIN), NP_ABIN / 32, 1, 0, scr, r, lane); continue; } r -= I0;
        if (r < I1) { wconv_item(p.in[I_ABOUT], 1024, 2048, (bf16*)(ws + OFF_W_ABOUT), 32, 0, 0, scr, r, lane); continue; } r -= I1;
        if (r < I2) { wconv_item(p.in[I_FFN1], 5632, 1024, (bf16*)(ws + OFF_W_FFN1), 5632 / 32, 3, FFD, scr, r, lane); continue; } r -= I2;
        if (r < I3) { wconv_item(p.in[I_FFN2], 1024, 2816, (bf16*)(ws + OFF_W_FFN2), 32, 0, 0, scr, r, lane); continue; } r -= I3;
        if (r < I4) { wconv_item(p.in[I_CDIN], CD_IN, 1024, (bf16*)(ws + OFF_W_CDIN), NP_CDIN / 32, 2, 0, scr, r, lane); continue; } r -= I4;
        if (r < I5) { wconv_item(p.in[I_CDOUT], 1024, 2048, (bf16*)(ws + OFF_W_CDOUT), 32, 0, 0, scr, r, lane); continue; } r -= I5;
        if (r < 8 * I6) { const int e = r / I6; wconv_item(p.in[I_MOE1] + (size_t)e * 1024 * 7168, 7168, 1024, (bf16*)(ws + OFF_W_MOE1) + (size_t)e * 7168 * 1024, 7168 / 32, 3, FFE, scr, r % I6, lane); continue; } r -= 8 * I6;
        { const int e = r / I7; wconv_item(p.in[I_MOE2] + (size_t)e * 3584 * 1024, 1024, 3584, (bf16*)(ws + OFF_W_MOE2) + (size_t)e * 1024 * 3584, 32, 0, 0, scr, r % I7, lane); }
    }
}

template <int MODE  > __device__ __forceinline__ void scan_naive_unit(const Params& p, int b, int h, int dir, int vh, float* sm) {
    constexpr int DV = (MODE == 2) ? 64 : 128, NP = 512 / DV, DPP = 128 / NP;
    float* qe = sm; float* kw = sm + 128; float* dec = sm + 256; float* vv = sm + 384; float* red = sm + 640; float* dred = sm + 640 + 2048;
    const int tid = tid_op(), v = tid % DV, part = tid / DV;
    const bf16* ZS = (const bf16*)(p.ws + OFF_ZS); const float* G = (const float*)(p.ws + OFF_G); bf16* SO = (bf16*)(p.ws + OFF_SO);
    float S[DPP];
#pragma unroll
    for (int i = 0; i < DPP; ++i) S[i] = 0.f;
    float nst = 0.f;
    __syncthreads();
    for (int tau = 0; tau < TT; ++tau) {
        const int t = tokmap(dir, tau); const size_t r = (size_t)b * TT + t;
        if (MODE == 0) {
            const float gi = G[r * 64 + dir * 4 + h] + p.in[I_MGATEB][dir * 4 + h], gf = G[r * 64 + (2 + dir) * 4 + h] + p.in[I_MGATEB][(2 + dir) * 4 + h];
            const float fdec = sigmoid_f(gf), iexp = expf(gi);
            if (tid < 256) { const int c = (tid < 128) ? (h * 128 + tid) : (512 + h * 128 + (tid - 128));
                const float qk = silu_f(conv4(ZS, b, t, c, p.in[I_MCONVW], 1024, c, p.in[I_MCONVB][c]));
                if (tid < 128) { qe[tid] = qk; dec[tid] = fdec; } else kw[tid - 128] = qk * 0.08838834764831845f * iexp; }
            else if (tid < 384) vv[tid - 256] = bf2f(ZS[SEG + r * DM + h * 256 + vh * 128 + (tid - 256)]);
        } else if (MODE == 1) {
            if (tid < 128) { const int d = tid;
                qe[d] = bf2f(ZS[r * DM + h * 128 + d]) * 0.08838834764831845f; kw[d] = bf2f(ZS[r * DM + 512 + h * 128 + d]);
                float pre = p.in[I_GALB][dir * 512 + h * 128 + d];
#pragma unroll
                for (int j = 0; j < 16; ++j) pre += G[r * 64 + dir * 16 + j] * p.in[I_GALW][(size_t)(dir * 16 + j) * 512 + h * 128 + d];
                dec[d] = expf(logsigmoid_f(pre) * (1.f / 16.f)); }
            else if (tid >= 256 && tid < 384) vv[tid - 256] = bf2f(ZS[SEG + r * DM + h * 256 + vh * 128 + (tid - 256)]);
        } else {
            const int g = h >> 3;
            const float dt = softplus_f(G[r * 64 + 32 + dir * 16 + h] + p.in[I_SDTB][dir * 16 + h]);
            const float la = -dt * expf(p.in[I_SALOG][dir * 16 + h]);
            if (tid < 64) { const int c = h * 64 + tid; vv[tid] = silu_f(conv4(ZS + 4 * SEG, b, t, c, p.in[I_SCONVW], 1536, c, p.in[I_SCONVB][c])); }
            else if (tid < 192) { const int n = tid - 64, c = g * 128 + n; kw[n] = dt * silu_f(conv4(ZS + 5 * SEG, b, t, c, p.in[I_SCONVW], 1536, 1024 + c, p.in[I_SCONVB][1024 + c])); dec[n] = expf(la); }
            else if (tid < 320) { const int n = tid - 192, c = 256 + g * 128 + n; qe[n] = silu_f(conv4(ZS + 5 * SEG, b, t, c, p.in[I_SCONVW], 1536, 1024 + c, p.in[I_SCONVB][1024 + c])); }
        }
        __syncthreads();
        const float xv = vv[v]; float po = 0.f;
#pragma unroll
        for (int i = 0; i < DPP; ++i) { const int d = part * DPP + i; S[i] = dec[d] * S[i] + kw[d] * xv; po += qe[d] * S[i]; }
        red[part * DV + v] = po;
        if (MODE == 0 && tid < 128) { nst = dec[tid] * nst + kw[tid]; dred[tid] = qe[tid] * nst; }
        __syncthreads();
        if (tid < DV) { float o = 0.f;
#pragma unroll
            for (int pp = 0; pp < NP; ++pp) o += red[pp * DV + tid];
            if (MODE == 0) { float den = 0.f; for (int d = 0; d < 128; ++d) den += dred[d]; o = o / fmaxf(fabsf(den), 1.f); }
            if (MODE == 2 && dir == 0) o += p.in[I_SD][h] * xv;
            if (MODE == 2) SO[(size_t)(2 + dir) * SEG + r * DM + h * 64 + tid] = (bf16)f2bf(o);
            else SO[(size_t)dir * SEG + r * DM + h * 256 + vh * 128 + tid] = (bf16)f2bf(o); }
    }
}
__device__ __forceinline__ void rglru_naive_unit(const Params& p, int b, int dir, int blk, float* sm) {
    float* xl = sm; float* ra = sm + 128; float* rx = sm + 128 + 512;
    const int tid = tid_op(), c = tid & 127, kp = tid >> 7, ch = blk * 128 + c;
    const bf16* ZS = (const bf16*)(p.ws + OFF_ZS); bf16* SO = (bf16*)(p.ws + OFF_SO);
    const float* wa = p.in[I_LWA] + (size_t)(dir * 8 + blk) * 128 * 128; const float* wx = p.in[I_LWX] + (size_t)(dir * 8 + blk) * 128 * 128;
    const float ba = p.in[I_LBA][dir * 1024 + ch], bx = p.in[I_LBX][dir * 1024 + ch], sp = softplus_f(-p.in[I_LLAM][dir * 1024 + ch]);
    float hst = 0.f;
    __syncthreads();
    for (int tau = 0; tau < TT; ++tau) {
        const int t = tokmap(dir, tau); const size_t r = (size_t)b * TT + t;
        if (tid < 128) xl[c] = conv4(ZS + 3 * SEG, b, t, ch, p.in[I_LCONVW], 1024, ch, p.in[I_LCONVB][ch]);
        __syncthreads();
        float pa = 0.f, px = 0.f;
        asm volatile("" : "+s"(wa), "+s"(wx));
        for (int k = kp * 32; k < kp * 32 + 32; ++k) { const float xk = xl[k]; pa += xk * wa[k * 128 + c]; px += xk * wx[k * 128 + c]; }
        ra[kp * 128 + c] = pa; rx[kp * 128 + c] = px;
        __syncthreads();
        if (tid < 128) {
            const float rr = sigmoid_f(ra[c] + ra[128 + c] + ra[256 + c] + ra[384 + c] + ba), ii = sigmoid_f(rx[c] + rx[128 + c] + rx[256 + c] + rx[384 + c] + bx);
            const float log_a = -8.f * rr * sp, a = expf(log_a), bb = sqrtf(-expm1f(2.f * log_a)) * (ii * xl[c]);
            hst = a * hst + bb;
            SO[(size_t)(2 + dir) * SEG + r * DM + ch] = (bf16)f2bf(hst);
        }
    }
}
__device__ __forceinline__ void phase_scan_naive(const Params& p, int layer, float* sm) {
    if (layer == 0) {
        for (int u = blockIdx.x; u < 128; u += gridDim.x) {
            if (u < 64) scan_naive_unit<0>(p, u >> 4, (u >> 2) & 3, (u >> 1) & 1, u & 1, sm);
            else { const int w = u - 64; rglru_naive_unit(p, w >> 4, (w >> 3) & 1, w & 7, sm); }
            __syncthreads();
        }
    } else {
        for (int u = blockIdx.x; u < 192; u += gridDim.x) {
            if (u < 64) scan_naive_unit<1>(p, u >> 4, (u >> 2) & 3, (u >> 1) & 1, u & 1, sm);
            else { const int w = u - 64; scan_naive_unit<2>(p, w >> 5, (w >> 1) & 15, w & 1, 0, sm); }
            __syncthreads();
        }
    }
}

__device__ __forceinline__ void phase_mix2(const Params& p, int layer) {
    const int tid_ = tid_op(); const int lane = tid_ & 63, gw = blockIdx.x * 8 + (tid_ >> 6), NGW = gridDim.x * 8;
    const bf16* ZS = (const bf16*)(p.ws + OFF_ZS); const bf16* SO = (const bf16*)(p.ws + OFF_SO); bf16* HC = (bf16*)(p.ws + OFF_HC);
    for (int r = gw; r < MROWS; r += NGW) {
        float a[16], c[16], w[16], g[16];
        ld_row_bf16(SO + (size_t)r * DM, lane, a); ld_row_bf16(SO + SEG + (size_t)r * DM, lane, c);
        ld_row_f32(layer == 0 ? p.in[I_MNORMW] : p.in[I_GNORMW], lane, w); ld_row_bf16(ZS + 2 * SEG + (size_t)r * DM, lane, g);
#pragma unroll
        for (int j = 0; j < 4; ++j) {
            float ss = 0.f;
#pragma unroll
            for (int i = 0; i < 4; ++i) { a[4 * j + i] += c[4 * j + i]; ss += a[4 * j + i] * a[4 * j + i]; }
            const float rstd = rsqrtf(wave_sum(ss) * (1.f / 256.f) + 1e-6f);
#pragma unroll
            for (int i = 0; i < 4; ++i) { const float gt = g[4 * j + i]; a[4 * j + i] = a[4 * j + i] * rstd * w[4 * j + i] * (layer == 0 ? sigmoid_f(gt) : silu_f(gt)); }
        }
        st_row_bf16(HC + (size_t)r * 2048, lane, a);
        ld_row_bf16(SO + 2 * SEG + (size_t)r * DM, lane, a); ld_row_bf16(SO + 3 * SEG + (size_t)r * DM, lane, c);
        if (layer == 0) {
            ld_row_bf16(ZS + 4 * SEG + (size_t)r * DM, lane, g);
#pragma unroll
            for (int i = 0; i < 16; ++i) a[i] = (a[i] + c[i]) * gelu_f(g[i]);
        } else {
            ld_row_bf16(ZS + 3 * SEG + (size_t)r * DM, lane, g); ld_row_f32(p.in[I_SNORMW], lane, w);
#pragma unroll
            for (int i = 0; i < 16; ++i) a[i] = (a[i] + c[i]) * silu_f(g[i]);
            const float rstd = rsqrtf(row_ss(a) * (1.f / DM) + 1e-6f);
#pragma unroll
            for (int i = 0; i < 16; ++i) a[i] = a[i] * rstd * w[i];
        }
        st_row_bf16(HC + (size_t)r * 2048 + 1024, lane, a);
    }
}

__device__ __forceinline__ void phase_route_naive(const Params& p, float* sm) {
    if (blockIdx.x != 0) return;
    int* cnt = (int*)sm; int* cur = cnt + 8; int* base = cnt + 16; const int tid = tid_op();
    const int* TOPI = (const int*)(p.ws + OFF_TOPI); int* SLOT = (int*)(p.ws + OFF_SLOT); int* STOK = (int*)(p.ws + OFF_STOK); int* ctl = (int*)(p.ws + OFF_CTL);
    if (tid < 16) cnt[tid] = 0;
    __syncthreads();
    for (int a = tid; a < 2 * NTOK; a += 512) atomicAdd(&cnt[TOPI[a]], 1);
    __syncthreads();
    if (tid == 0) { int acc = 0; for (int e = 0; e < 8; ++e) { base[e] = acc; ctl[CW_CNT + e] = cnt[e]; ctl[CW_BASE + e] = acc; acc += (cnt[e] + 255) / 256 * 256; } base[8] = acc; ctl[CW_BASE + 8] = acc; ctl[CW_TOT] = acc; }
    __syncthreads();
    for (int s = tid; s < MAXSLOT; s += 512) STOK[s] = -1;
    __syncthreads();
    for (int a = tid; a < 2 * NTOK; a += 512) { const int e = TOPI[a]; const int pos = atomicAdd(&cur[e], 1); const int s = base[e] + pos; SLOT[a] = s; STOK[s] = a >> 1; }
}
__device__ __forceinline__ void phase_gather(const Params& p) {
    const int tid_ = tid_op(); const int lane = tid_ & 63, gw = blockIdx.x * 8 + (tid_ >> 6), NGW = gridDim.x * 8;
    const int* STOK = (const int*)(p.ws + OFF_STOK); const int tot = ((const int*)(p.ws + OFF_CTL))[CW_TOT];
    const bf16* H = (const bf16*)(p.ws + OFF_H); bf16* XS = (bf16*)(p.ws + OFF_XS);
    for (int s = gw; s < tot; s += NGW) {
        const int tok = STOK[s]; uint2* dst = (uint2*)(XS + (size_t)s * DM);
        if (tok < 0) { for (int j = 0; j < 4; ++j) dst[j * 64 + lane] = make_uint2(0u, 0u); }
        else { const int b = tok >> 12, tl = tok & 4095; const uint2* src = (const uint2*)(H + ((size_t)b * TT + NCTX + tl) * DM); for (int j = 0; j < 4; ++j) dst[j * 64 + lane] = src[j * 64 + lane]; }
    }
}

__global__ void __launch_bounds__(512, 2) mega(Params p) {
    extern __shared__ __attribute__((aligned(16))) unsigned char lds[];
    cg::grid_group grid = cg::this_grid();
    float* sm = (float*)lds;
    PG8_LAS unsigned char* LDS = (PG8_LAS unsigned char*)lds;
    unsigned char* ws = p.ws;
    bf16* H = (bf16*)(ws + OFF_H); bf16* ZS = (bf16*)(ws + OFF_ZS); float* G = (float*)(ws + OFF_G); bf16* HC = (bf16*)(ws + OFF_HC); float* Y = (float*)(ws + OFF_Y);
    const int* ctl = (const int*)(ws + OFF_CTL);

    phase_mod(p, sm);
    phase_wconv(p, sm);
    grid.sync();
    phase_norm<0>(p, 0);
    grid.sync();
#if (NAIVE_MASK & 1)
    { MapDense m{(AB_IN + 127) / 128, p.in[I_ABIN]}; EpiInAB e{ZS, G}; gemm_naive<false>(H, DM, AB_IN, AB_IN, DM, 0, (MROWS / 128) * ((AB_IN + 127) / 128), m, e, sm); }
#else
    { pg8::Gemm g{H, (const bf16*)(ws + OFF_W_ABIN), MROWS, NP_ABIN, DM}; pg8::StaticOrder S; S.init(MROWS, NP_ABIN, gridDim.x, blockIdx.x); pg8::EpiInProj E{ZS, G, 20, 16}; pg8::gemm_phase(LDS, g, S, E); }
#endif
    grid.sync();
    phase_scan_naive(p, 0, sm);
    grid.sync();
    phase_mix2(p, 0);
    grid.sync();
#if (NAIVE_MASK & 2)
    { MapDense m{8, p.in[I_ABOUT]}; EpiF32 e{Y, DM}; gemm_naive<false>(HC, 2048, DM, DM, 2048, 0, (MROWS / 128) * 8, m, e, sm); }
#else
    { pg8::Gemm g{HC, (const bf16*)(ws + OFF_W_ABOUT), MROWS, DM, 2048}; pg8::StaticOrder S; S.init(MROWS, DM, gridDim.x, blockIdx.x); pg8::EpiF32 E{Y, DM}; pg8::gemm_phase(LDS, g, S, E); }
#endif
    grid.sync();
    phase_norm<1>(p, 0);
    grid.sync();
#if (NAIVE_MASK & 4)
    { MapDense m{FFD / 64, p.in[I_FFN1]}; EpiSwiglu e{(bf16*)(ws + OFF_ACT), FFD}; gemm_naive<true>(H, DM, 2 * FFD, FFD, DM, FFD, (MROWS / 128) * (FFD / 64), m, e, sm); }
#else
    { pg8::Gemm g{H, (const bf16*)(ws + OFF_W_FFN1), MROWS, 2 * FFD, DM}; pg8::StaticOrder S; S.init(MROWS, 2 * FFD, gridDim.x, blockIdx.x); pg8::EpiSwiglu E{(bf16*)(ws + OFF_ACT), FFD}; pg8::gemm_phase(LDS, g, S, E); }
#endif
    grid.sync();
#if (NAIVE_MASK & 8)
    { MapDense m{8, p.in[I_FFN2]}; EpiF32 e{Y, DM}; gemm_naive<false>((const bf16*)(ws + OFF_ACT), FFD, DM, DM, FFD, 0, (MROWS / 128) * 8, m, e, sm); }
#else
    { pg8::Gemm g{(const bf16*)(ws + OFF_ACT), (const bf16*)(ws + OFF_W_FFN2), MROWS, DM, FFD}; pg8::StaticOrder S; S.init(MROWS, DM, gridDim.x, blockIdx.x); pg8::EpiF32 E{Y, DM}; pg8::gemm_phase(LDS, g, S, E); }
#endif
    grid.sync();
    phase_norm<2>(p, 0);
    grid.sync();
#if (NAIVE_MASK & 16)
    { MapDense m{(CD_IN + 127) / 128, p.in[I_CDIN]}; EpiInCD e{ZS, G}; gemm_naive<false>(H, DM, CD_IN, CD_IN, DM, 0, (MROWS / 128) * ((CD_IN + 127) / 128), m, e, sm); }
#else
    { pg8::Gemm g{H, (const bf16*)(ws + OFF_W_CDIN), MROWS, NP_CDIN, DM}; pg8::StaticOrder S; S.init(MROWS, NP_CDIN, gridDim.x, blockIdx.x); pg8::EpiInProj E{ZS, G, 22, 64}; pg8::gemm_phase(LDS, g, S, E); }
#endif
    grid.sync();
    phase_scan_naive(p, 1, sm);
    grid.sync();
    phase_mix2(p, 1);
    grid.sync();
#if (NAIVE_MASK & 32)
    { MapDense m{8, p.in[I_CDOUT]}; EpiF32 e{Y, DM}; gemm_naive<false>(HC, 2048, DM, DM, 2048, 0, (MROWS / 128) * 8, m, e, sm); }
#else
    { pg8::Gemm g{HC, (const bf16*)(ws + OFF_W_CDOUT), MROWS, DM, 2048}; pg8::StaticOrder S; S.init(MROWS, DM, gridDim.x, blockIdx.x); pg8::EpiF32 E{Y, DM}; pg8::gemm_phase(LDS, g, S, E); }
#endif
    grid.sync();
    phase_norm<1>(p, 1);
    grid.sync();
    phase_route_naive(p, sm);
    grid.sync();
    phase_gather(p);
    grid.sync();
#if (NAIVE_MASK & 64)
    { MapMoe m{FFE / 64, p.in[I_MOE1], (size_t)DM * 2 * FFE, ctl}; EpiSwiglu e{(bf16*)(ws + OFF_ACTM), FFE}; gemm_naive<true>((const bf16*)(ws + OFF_XS), DM, 2 * FFE, FFE, DM, FFE, (MAXSLOT / 128) * (FFE / 64), m, e, sm); }
#else
    { pg8::Gemm g{(const bf16*)(ws + OFF_XS), (const bf16*)(ws + OFF_W_MOE1), ctl[CW_TOT], 2 * FFE, DM}; pg8::MoeOrder S; S.init(ctl[CW_TOT], 2 * FFE, gridDim.x, blockIdx.x); S.ctl = ctl; S.estride = (size_t)2 * FFE * DM * 2; pg8::EpiSwiglu E{(bf16*)(ws + OFF_ACTM), FFE}; pg8::gemm_phase(LDS, g, S, E); }
#endif
    grid.sync();
#if (NAIVE_MASK & 128)
    { MapMoe m{8, p.in[I_MOE2], (size_t)FFE * DM, ctl}; EpiF32 e{(float*)(ws + OFF_YS), DM}; gemm_naive<false>((const bf16*)(ws + OFF_ACTM), FFE, DM, DM, FFE, 0, (MAXSLOT / 128) * 8, m, e, sm); }
#else
    { pg8::Gemm g{(const bf16*)(ws + OFF_ACTM), (const bf16*)(ws + OFF_W_MOE2), ctl[CW_TOT], DM, FFE}; pg8::MoeOrder S; S.init(ctl[CW_TOT], DM, gridDim.x, blockIdx.x); S.ctl = ctl; S.estride = (size_t)DM * FFE * 2; pg8::EpiF32 E{(float*)(ws + OFF_YS), DM}; pg8::gemm_phase(LDS, g, S, E); }
#endif
    grid.sync();
    phase_norm<3>(p, 1);
}

__global__ void nan_fill(float* out, int n) { int i = blockIdx.x * blockDim.x + threadIdx.x; if (i < n) out[i] = __builtin_nanf(""); }

constexpr int LDS_BYTES = 147456;
extern "C" void kernel_launch(void* const* d_in, const int* in_sizes, int n_in, void* d_out, int out_size, void* d_ws, size_t ws_size, hipStream_t stream) {
    static int grid_blocks = 0;
    if (grid_blocks == 0) {
        int dev = 0, cus = 0, per_cu = 0;
        hipGetDevice(&dev);
        hipDeviceGetAttribute(&cus, hipDeviceAttributeMultiprocessorCount, dev);
        hipFuncSetAttribute((const void*)mega, hipFuncAttributeMaxDynamicSharedMemorySize, LDS_BYTES);
        hipOccupancyMaxActiveBlocksPerMultiprocessor(&per_cu, (const void*)mega, 512, LDS_BYTES);
        if (per_cu < 1) per_cu = 1;
        grid_blocks = cus * (per_cu > 1 ? 1 : per_cu);
        if (grid_blocks <= 0) grid_blocks = 256;
    }
    if (n_in != 37 || ws_size < WS_NEED) { fprintf(stderr, "kernel_launch: bad n_in %d or ws %zu < %zu\n", n_in, ws_size, (size_t)WS_NEED); nan_fill<<<(out_size + 255) / 256, 256, 0, stream>>>((float*)d_out, out_size); return; }
    Params p{};
    for (int i = 0; i < 37; ++i) p.in[i] = (const float*)d_in[i];
    p.out = (float*)d_out; p.ws = (unsigned char*)d_ws;
    void* args[] = {&p};
    hipError_t e = hipLaunchCooperativeKernel((const void*)mega, dim3(grid_blocks), dim3(512), args, LDS_BYTES, stream);
    if (e != hipSuccess) fprintf(stderr, "cooperative launch failed: %s (grid %d)\n", hipGetErrorString(e), grid_blocks);
}
```

```cpp
#include <hip/hip_runtime.h>
#include <hip/hip_cooperative_groups.h>
#include <cstdio>
#include <cstdint>
namespace cg = cooperative_groups;

typedef unsigned short bf16;

constexpr int NB = 4, SEQ = 4096, NCTX = 256, TT = 4352, MROWS = NB * TT, DM = 1024;
constexpr int NTOK = NB * SEQ;
constexpr int FFD = 2816, FFE = 3584, NEXP = 8;
constexpr int AB_IN = 5136, CD_IN = 5696;
constexpr int MAXSLOT = 2 * NTOK + NEXP * 256;

constexpr size_t MiB = 1u << 20;
constexpr size_t OFF_CTL = 0, OFF_MOD = 1 * MiB, OFF_G = 2 * MiB, OFF_XC = 7 * MiB, OFF_TOPI = 11 * MiB, OFF_TOPG = 11 * MiB + 256 * 1024,
                 OFF_SLOT = 11 * MiB + 512 * 1024, OFF_STOK = 12 * MiB, OFF_RGS = 13 * MiB, OFF_H = 18 * MiB, OFF_ZS = 52 * MiB,
                 OFF_SO = 256 * MiB, OFF_HC = 392 * MiB, OFF_Y = 460 * MiB, OFF_W = 528 * MiB;
constexpr int NP_ABIN = 5376, NP_CDIN = 5888;
constexpr size_t OFF_W_ABIN = OFF_W, OFF_W_ABOUT = OFF_W_ABIN + (size_t)NP_ABIN * 1024 * 2, OFF_W_FFN1 = OFF_W_ABOUT + (size_t)1024 * 2048 * 2,
                 OFF_W_FFN2 = OFF_W_FFN1 + (size_t)5632 * 1024 * 2, OFF_W_CDIN = OFF_W_FFN2 + (size_t)1024 * 2816 * 2, OFF_W_CDOUT = OFF_W_CDIN + (size_t)NP_CDIN * 1024 * 2,
                 OFF_W_MOE1 = OFF_W_CDOUT + (size_t)1024 * 2048 * 2, OFF_W_MOE2 = OFF_W_MOE1 + (size_t)8 * 7168 * 1024 * 2, OFF_W_RG = OFF_W_MOE2 + (size_t)8 * 1024 * 3584 * 2, OFF_W_END = OFF_W_RG + (size_t)32 * 128 * 128 * 2;
constexpr size_t WS_NEED = OFF_W_END;
constexpr size_t SEG = (size_t)MROWS * DM;
constexpr size_t OFF_ACT = OFF_ZS, OFF_XS = OFF_HC, OFF_ACTM = OFF_ZS, OFF_YS = OFF_HC;
constexpr int CW_CNT = 0, CW_BASE = 8, CW_TOT = 17;

#ifndef NAIVE_MASK
#define NAIVE_MASK 0
#endif
struct Params { const float* in[37]; float* out; unsigned char* ws; };
enum { I_X = 0, I_C, I_CTX, I_CCTX, I_MODW, I_MODB, I_NORMG, I_ABIN, I_MCONVW, I_MCONVB, I_MGATEB, I_MNORMW, I_LCONVW, I_LCONVB, I_LWA, I_LBA, I_LWX, I_LBX,
       I_LLAM, I_ABOUT, I_FFN1, I_FFN2, I_CDIN, I_GALW, I_GALB, I_GNORMW, I_SCONVW, I_SCONVB, I_SDTB, I_SALOG, I_SD, I_SNORMW, I_CDOUT, I_RW, I_RB, I_MOE1, I_MOE2 };

__device__ __forceinline__ float bf2f(unsigned v) { return __uint_as_float(v << 16); }
__device__ __forceinline__ unsigned f2bf(float f) { unsigned u = __float_as_uint(f); return (u + 0x7fffu + ((u >> 16) & 1u)) >> 16; }
__device__ __forceinline__ float sigmoid_f(float x) { return 1.f / (1.f + expf(-x)); }
__device__ __forceinline__ float silu_f(float x) { return x / (1.f + expf(-x)); }
__device__ __forceinline__ float softplus_f(float x) { return fmaxf(x, 0.f) + log1pf(expf(-fabsf(x))); }
__device__ __forceinline__ float logsigmoid_f(float x) { return -softplus_f(-x); }
__device__ __forceinline__ float gelu_f(float x) { return 0.5f * x * (1.f + tanhf(0.7978845608028654f * (x + 0.044715f * x * x * x))); }
__device__ __forceinline__ float wave_sum(float v) {
#pragma unroll
    for (int o = 32; o >= 1; o >>= 1) v += __shfl_xor(v, o);
    return v;
}
__device__ __forceinline__ int tid_op() { int t = threadIdx.x; asm volatile("" : "+v"(t)); return t; }
__device__ __forceinline__ void ld_row_f32(const float* row, int lane, float (&v)[16]) {
#pragma unroll
    for (int j = 0; j < 4; ++j) { const float4 t = ((const float4*)row)[j * 64 + lane]; v[4 * j] = t.x; v[4 * j + 1] = t.y; v[4 * j + 2] = t.z; v[4 * j + 3] = t.w; }
}
__device__ __forceinline__ void st_row_f32(float* row, int lane, const float (&v)[16]) {
#pragma unroll
    for (int j = 0; j < 4; ++j) ((float4*)row)[j * 64 + lane] = make_float4(v[4 * j], v[4 * j + 1], v[4 * j + 2], v[4 * j + 3]);
}
__device__ __forceinline__ void ld_row_bf16(const bf16* row, int lane, float (&v)[16]) {
#pragma unroll
    for (int j = 0; j < 4; ++j) { const uint2 t = ((const uint2*)row)[j * 64 + lane]; v[4 * j] = bf2f(t.x & 0xffffu); v[4 * j + 1] = bf2f(t.x >> 16); v[4 * j + 2] = bf2f(t.y & 0xffffu); v[4 * j + 3] = bf2f(t.y >> 16); }
}
__device__ __forceinline__ void st_row_bf16(bf16* row, int lane, const float (&v)[16]) {
#pragma unroll
    for (int j = 0; j < 4; ++j) { uint2 t; t.x = f2bf(v[4 * j]) | (f2bf(v[4 * j + 1]) << 16); t.y = f2bf(v[4 * j + 2]) | (f2bf(v[4 * j + 3]) << 16); ((uint2*)row)[j * 64 + lane] = t; }
}
__device__ __forceinline__ float row_ss(const float (&v)[16]) { float s = 0.f;
#pragma unroll
    for (int i = 0; i < 16; ++i) s += v[i] * v[i];
    return wave_sum(s); }

__device__ __forceinline__ void seg_bounds(int t, int& lo, int& hi) { if (t < NCTX) { lo = 0; hi = NCTX; } else { lo = NCTX + ((t - NCTX) & ~63); hi = lo + 64; } }
__device__ __forceinline__ float conv4(const bf16* Z, int b, int t, int c, const float* w, int wstride, int wc, float bias) {
    int lo, hi; seg_bounds(t, lo, hi); float s = bias;
#pragma unroll
    for (int j = 0; j < 4; ++j) { const int tt = t + j - 2; if (tt >= lo && tt < hi) s += w[j * wstride + wc] * bf2f(Z[((size_t)(b * TT + tt)) * DM + c]); }
    return s;
}
__device__ __forceinline__ int tokmap(int dir, int tau) { return dir ? (tau < NCTX ? (NCTX - 1 - tau) : (TT + NCTX - 1 - tau)) : tau; }

__device__ __forceinline__ void phase_mod(const Params& p, float* sm) {
    float* sv = sm; float* red = sm + 5 * 1024; const int tid = tid_op();
    for (int i = tid; i < 5 * 1024; i += 512) { const int v = i >> 10, k = i & 1023; const float x = (v < 4) ? p.in[I_C][v * 1024 + k] : p.in[I_CCTX][k]; sv[i] = silu_f(x); }
    __syncthreads();
    float* MOD = (float*)(p.ws + OFF_MOD);
    for (int it = blockIdx.x; it < 192; it += gridDim.x) {
        const int l = it / 96, j0 = (it % 96) * 64, col = tid & 63, kg = tid >> 6;
        const float* w = p.in[I_MODW] + (size_t)l * 1024 * 6144 + j0 + col;
        float a[5] = {0.f, 0.f, 0.f, 0.f, 0.f};
        for (int k = kg * 128; k < kg * 128 + 128; ++k) { const float wv = w[(size_t)k * 6144];
#pragma unroll
            for (int v = 0; v < 5; ++v) a[v] += sv[v * 1024 + k] * wv; }
#pragma unroll
        for (int v = 0; v < 5; ++v) red[(kg * 5 + v) * 64 + col] = a[v];
        __syncthreads();
        if (tid < 320) { const int v = tid >> 6, cc = tid & 63; float s = 0.f;
            for (int g = 0; g < 8; ++g) s += red[(g * 5 + v) * 64 + cc];
            MOD[(size_t)(l * 5 + v) * 6144 + j0 + cc] = s + p.in[I_MODB][l * 6144 + j0 + cc]; }
        __syncthreads();
    }
    if (blockIdx.x == 0 && tid < 32) ((int*)(p.ws + OFF_CTL))[tid] = 0;
}

template <int MODE> __device__ __forceinline__ void phase_norm(const Params& p, int layer) {
    const int tid_ = tid_op(); const int lane = tid_ & 63, gw = blockIdx.x * 8 + (tid_ >> 6), NGW = gridDim.x * 8;
    const float* MOD = (const float*)(p.ws + OFF_MOD);
    const float* NG = p.in[I_NORMG] + (size_t)layer * 4 * 1024;
    float* XC = (float*)(p.ws + OFF_XC); bf16* H = (bf16*)(p.ws + OFF_H); const float* Y = (const float*)(p.ws + OFF_Y);
    const bool last = (layer == 1);
    for (int r = gw; r < MROWS; r += NGW) {
        const int b = r / TT, t = r % TT; const bool isctx = t < NCTX; const int v = isctx ? 4 : b;
        if ((MODE == 3 || (MODE == 1 && last)) && isctx) continue;
        const float* mv = MOD + (size_t)(layer * 5 + v) * 6144;
        const float* xin = isctx ? (p.in[I_CTX] + ((size_t)b * NCTX + t) * DM) : (p.in[I_X] + ((size_t)b * SEQ + (t - NCTX)) * DM);
        float* xst = isctx ? (XC + ((size_t)b * NCTX + t) * DM) : (p.out + ((size_t)b * SEQ + (t - NCTX)) * DM);
        float x[16], g[16], a[16], s[16];
        if (MODE == 0) {
            ld_row_f32(xin, lane, x);
            const float rstd = rsqrtf(row_ss(x) * (1.f / DM) + 1e-6f);
            ld_row_f32(NG, lane, g); ld_row_f32(mv + 1024, lane, a); ld_row_f32(mv, lane, s);
#pragma unroll
            for (int i = 0; i < 16; ++i) x[i] = x[i] * rstd * g[i] * (1.f + a[i]) + s[i];
            st_row_bf16(H + (size_t)r * DM, lane, x);
        } else if (MODE == 1 || MODE == 2) {
            float y[16];
            ld_row_f32(Y + (size_t)r * DM, lane, y);
            const float rstd = rsqrtf(row_ss(y) * (1.f / DM) + 1e-6f);
            ld_row_f32(NG + (MODE == 1 ? 1 : 3) * 1024, lane, g); ld_row_f32(mv + (MODE == 1 ? 2 : 5) * 1024, lane, a);
            if (MODE == 1 && layer == 0) ld_row_f32(xin, lane, x); else ld_row_f32(xst, lane, x);
#pragma unroll
            for (int i = 0; i < 16; ++i) x[i] = x[i] + a[i] * (y[i] * rstd * g[i]);
            st_row_f32(xst, lane, x);
            const float rstd2 = rsqrtf(row_ss(x) * (1.f / DM) + 1e-6f);
            const float* ng2 = (MODE == 1) ? (NG + 2 * 1024) : (p.in[I_NORMG] + (size_t)4 * 1024);
            const float* mv2 = (MODE == 1) ? mv : (MOD + (size_t)(5 + v) * 6144);
            ld_row_f32(ng2, lane, g); ld_row_f32(mv2 + (MODE == 1 ? 4 : 1) * 1024, lane, a); ld_row_f32(mv2 + (MODE == 1 ? 3 : 0) * 1024, lane, s);
#pragma unroll
            for (int i = 0; i < 16; ++i) x[i] = x[i] * rstd2 * g[i] * (1.f + a[i]) + s[i];
            st_row_bf16(H + (size_t)r * DM, lane, x);
            if (MODE == 1 && last) {
                float lg[8];
#pragma unroll
                for (int e = 0; e < 8; ++e) lg[e] = 0.f;
#pragma unroll
                for (int i = 0; i < 16; ++i) { const int col = (i >> 2) * 256 + lane * 4 + (i & 3); const float4 w0 = ((const float4*)(p.in[I_RW] + (size_t)col * 8))[0], w1 = ((const float4*)(p.in[I_RW] + (size_t)col * 8))[1];
                    lg[0] += x[i] * w0.x; lg[1] += x[i] * w0.y; lg[2] += x[i] * w0.z; lg[3] += x[i] * w0.w; lg[4] += x[i] * w1.x; lg[5] += x[i] * w1.y; lg[6] += x[i] * w1.z; lg[7] += x[i] * w1.w; }
#pragma unroll
                for (int e = 0; e < 8; ++e) lg[e] = wave_sum(lg[e]) + p.in[I_RB][e];
                if (lane == 0) {
                    int e0 = 0; float l0 = lg[0];
#pragma unroll
                    for (int e = 1; e < 8; ++e) if (lg[e] > l0) { l0 = lg[e]; e0 = e; }
                    int e1 = -1; float l1 = -3.0e38f;
#pragma unroll
                    for (int e = 0; e < 8; ++e) if (e != e0 && lg[e] > l1) { l1 = lg[e]; e1 = e; }
                    const float ex = expf(l1 - l0), g0 = 1.f / (1.f + ex), g1 = ex / (1.f + ex);
                    const int tok = b * SEQ + (t - NCTX);
                    ((int*)(p.ws + OFF_TOPI))[tok * 2] = e0; ((int*)(p.ws + OFF_TOPI))[tok * 2 + 1] = e1;
                    ((float*)(p.ws + OFF_TOPG))[tok * 2] = g0; ((float*)(p.ws + OFF_TOPG))[tok * 2 + 1] = g1;
                }
            }
        } else {
            const int tok = b * SEQ + (t - NCTX);
            const int s0 = ((const int*)(p.ws + OFF_SLOT))[tok * 2], s1 = ((const int*)(p.ws + OFF_SLOT))[tok * 2 + 1];
            const float g0 = ((const float*)(p.ws + OFF_TOPG))[tok * 2], g1 = ((const float*)(p.ws + OFF_TOPG))[tok * 2 + 1];
            const float* YS = (const float*)(p.ws + OFF_YS);
            float y[16];
            ld_row_f32(YS + (size_t)s0 * DM, lane, y); ld_row_f32(YS + (size_t)s1 * DM, lane, a);
#pragma unroll
            for (int i = 0; i < 16; ++i) y[i] = y[i] * g0 + a[i] * g1;
            const float rstd = rsqrtf(row_ss(y) * (1.f / DM) + 1e-6f);
            ld_row_f32(NG + 3 * 1024, lane, g); ld_row_f32(mv + 5 * 1024, lane, a); ld_row_f32(xst, lane, x);
#pragma unroll
            for (int i = 0; i < 16; ++i) x[i] = x[i] + a[i] * (y[i] * rstd * g[i]);
            st_row_f32(xst, lane, x);
        }
    }
}

template <bool DUAL, class Map, class Epi>
__device__ __forceinline__ void gemm_naive(const bf16* A, int lda, int ldb, int N, int K, int uoff, int ntiles, const Map& map, const Epi& epi, float* sm) {
    constexpr int NC = DUAL ? 4 : 8, TW = DUAL ? 64 : 128;
    float* As = sm;
    float* Bs = sm + 16 * 132;
    const int tid = tid_op(), ty = tid >> 4, tx = tid & 15;
    for (int tile = blockIdx.x; tile < ntiles; tile += gridDim.x) {
        int row0, col0; const float* B;
        if (!map(tile, TW, row0, col0, B)) continue;
        float acc[4][8];
#pragma unroll
        for (int i = 0; i < 4; ++i)
#pragma unroll
            for (int j = 0; j < 8; ++j) acc[i][j] = 0.f;
        for (int k0 = 0; k0 < K; k0 += 16) {
            { const int row = tid >> 2, kq = tid & 3; const uint2 t = *(const uint2*)(A + (size_t)(row0 + row) * lda + k0 + kq * 4);
              As[(kq * 4 + 0) * 132 + row] = bf2f(t.x & 0xffffu); As[(kq * 4 + 1) * 132 + row] = bf2f(t.x >> 16); As[(kq * 4 + 2) * 132 + row] = bf2f(t.y & 0xffffu); As[(kq * 4 + 3) * 132 + row] = bf2f(t.y >> 16); }
            { const int kk = tid >> 5, c4 = (tid & 31) * 4; int col = col0 + c4; bool ok = col + 3 < N;
              if (DUAL) { const int cc = c4 & 63; col = col0 + cc; ok = col + 3 < N; if (c4 >= 64) col += uoff; }
              float4 t = make_float4(0.f, 0.f, 0.f, 0.f); if (ok) t = *(const float4*)(B + (size_t)(k0 + kk) * ldb + col);
              *(float4*)(Bs + kk * 128 + c4) = t; }
            __syncthreads();
#pragma unroll
            for (int kk = 0; kk < 16; ++kk) {
                const float4 a4 = *(const float4*)(As + kk * 132 + ty * 4);
                const float av[4] = {a4.x, a4.y, a4.z, a4.w};
                float bv[8];
                if (DUAL) { const float4 b0 = *(const float4*)(Bs + kk * 128 + tx * 4), b1 = *(const float4*)(Bs + kk * 128 + 64 + tx * 4); bv[0] = b0.x; bv[1] = b0.y; bv[2] = b0.z; bv[3] = b0.w; bv[4] = b1.x; bv[5] = b1.y; bv[6] = b1.z; bv[7] = b1.w; }
                else { const float4 b0 = *(const float4*)(Bs + kk * 128 + tx * 8), b1 = *(const float4*)(Bs + kk * 128 + tx * 8 + 4); bv[0] = b0.x; bv[1] = b0.y; bv[2] = b0.z; bv[3] = b0.w; bv[4] = b1.x; bv[5] = b1.y; bv[6] = b1.z; bv[7] = b1.w; }
#pragma unroll
                for (int i = 0; i < 4; ++i)
#pragma unroll
                    for (int j = 0; j < 8; ++j) acc[i][j] += av[i] * bv[j];
            }
            __syncthreads();
        }
#pragma unroll
        for (int i = 0; i < 4; ++i)
#pragma unroll
            for (int j = 0; j < NC; ++j) { const int c = col0 + tx * NC + j; if (c < N) epi(row0 + ty * 4 + i, c, acc[i][j], DUAL ? acc[i][j + 4] : 0.f); }
    }
}
struct MapDense { int ntn; const float* B; __device__ __forceinline__ bool operator()(int tile, int tw, int& row0, int& col0, const float*& Bp) const { row0 = (tile / ntn) * 128; col0 = (tile % ntn) * tw; Bp = B; return true; } };
struct MapMoe { int ntn; const float* B; size_t estride; const int* ctl;
    __device__ __forceinline__ bool operator()(int tile, int tw, int& row0, int& col0, const float*& Bp) const {
        row0 = (tile / ntn) * 128; col0 = (tile % ntn) * tw; if (row0 >= ctl[CW_TOT]) return false;
        int e = 0;
#pragma unroll
        for (int i = 1; i < 8; ++i) if (row0 >= ctl[CW_BASE + i]) e = i;
        Bp = B + (size_t)e * estride; return true; } };
struct EpiInAB { bf16* ZS; float* G; __device__ __forceinline__ void operator()(int r, int c, float g, float) const {
        if (c < 3072) ZS[(size_t)(c >> 10) * SEG + (size_t)r * DM + (c & 1023)] = (bf16)f2bf(g);
        else if (c < 3088) G[(size_t)r * 64 + (c - 3072)] = g;
        else { const int cc = c - 3088; ZS[(size_t)(3 + (cc >> 10)) * SEG + (size_t)r * DM + (cc & 1023)] = (bf16)f2bf(g); } } };
struct EpiInCD { bf16* ZS; float* G; __device__ __forceinline__ void operator()(int r, int c, float g, float) const {
        if (c < 3072) ZS[(size_t)(c >> 10) * SEG + (size_t)r * DM + (c & 1023)] = (bf16)f2bf(g);
        else if (c < 3104) G[(size_t)r * 64 + (c - 3072)] = g;
        else if (c < 5664) { const int cc = c - 3104; ZS[(size_t)(3 + (cc >> 10)) * SEG + (size_t)r * DM + (cc & 1023)] = (bf16)f2bf(g); }
        else G[(size_t)r * 64 + 32 + (c - 5664)] = g; } };
struct EpiF32 { float* C; int ldc; __device__ __forceinline__ void operator()(int r, int c, float g, float) const { C[(size_t)r * ldc + c] = g; } };
struct EpiSwiglu { bf16* C; int ldc; __device__ __forceinline__ void operator()(int r, int c, float g, float u) const { C[(size_t)r * ldc + c] = (bf16)f2bf(silu_f(g) * u); } };

namespace pg8 {
#define PG8_LAS __attribute__((address_space(3)))
typedef unsigned short bf16_t;
typedef short bf16x8 __attribute__((ext_vector_type(8)));
typedef float f32x4 __attribute__((ext_vector_type(4)));
typedef unsigned u32x4 __attribute__((ext_vector_type(4)));
constexpr int BM = 256, BK = 64, HALF = 128, HTB = HALF * BK * 2, STAGE_BYTES = 8 * HTB, NXCD = 8, WGM = 8;
__host__ __device__ __forceinline__ int lds_byte(int r, int c) { const int st = (r >> 4) * 2 + (c >> 5), rr = r & 15, cc = c & 31, ob = rr * 64 + cc * 2; return st * 1024 + (ob ^ (((ob >> 9) & 1) << 5)); }
__host__ __device__ __forceinline__ void stage_rc(int b, int& R, int& C) { const int st = b / 1024, sb = b % 1024, swz = sb ^ (((sb >> 9) & 1) << 5); R = (st >> 1) * 16 + swz / 64; C = (st & 1) * 32 + (swz % 64) / 2; }
__host__ __device__ __forceinline__ int perm32(int rho) { const int n = rho >> 4, i = rho & 15; return 8 * (i >> 2) + 4 * n + (i & 3); }
struct Unit { int pm, pn; };
struct Gemm { const bf16_t* A; const bf16_t* Bt; int M, N, K; };
struct StaticOrder {
    int nM, nN, nwg, G, c;
    __device__ void init(int M, int N, int G_, int c_) { nM = M / BM; nN = N / BM; nwg = nM * nN; G = G_; c = c_; }
    __device__ bool next(int i, Unit& u) const {
        const long L = (long)i * G + c; if (L >= nwg) return false;
        int wgid = (int)L; { const int q = nwg / NXCD, r = nwg % NXCD, xcd = wgid % NXCD, off = wgid / NXCD; wgid = (xcd < r ? xcd * (q + 1) : r * (q + 1) + (xcd - r) * q) + off; }
        const int nig = WGM * nN, gid = wgid / nig, fm = gid * WGM, gsz = (nM - fm) < WGM ? (nM - fm) : WGM;
        u.pm = fm + ((wgid % nig) % gsz); u.pn = (wgid % nig) / gsz; return true;
    }
    __device__ __forceinline__ size_t boff(const Unit&) const { return 0; }
};
struct MoeOrder : StaticOrder {
    const int* ctl; size_t estride;
    __device__ __forceinline__ size_t boff(const Unit& u) const { const int row0 = u.pm * 256; int e = 0;
#pragma unroll
        for (int i = 1; i < 8; ++i) if (row0 >= ctl[CW_BASE + i]) e = i;
        return (size_t)e * estride; }
};
__device__ __forceinline__ unsigned cvt_pk_bf16(float lo, float hi) { unsigned r; asm volatile("v_cvt_pk_bf16_f32 %0, %1, %2" : "=v"(r) : "v"(lo), "v"(hi)); return r; }
__device__ __forceinline__ float silu_fast(float x) { return x * __builtin_amdgcn_rcpf(1.f + __expf(-x)); }
struct EpiF32 { static constexpr bool PERM = false;
    float* C; int ldc;
    __device__ __forceinline__ void operator()(const f32x4 (&acc)[2][2][4][2], const Unit& u, int wr, int wc, int fr, int fq) const {
        const int row0 = u.pm * BM + wr * 64 + fr, col0 = u.pn * BM + wc * 32 + 4 * fq;
#pragma unroll
        for (int ai = 0; ai < 2; ++ai)
#pragma unroll
            for (int m = 0; m < 4; ++m) { float* rowp = C + (size_t)(row0 + ai * HALF + m * 16) * ldc + col0;
#pragma unroll
                for (int bj = 0; bj < 2; ++bj)
#pragma unroll
                    for (int n = 0; n < 2; ++n) *(f32x4*)(rowp + bj * HALF + n * 16) = acc[ai][bj][m][n]; }
    }
};
struct EpiInProj { static constexpr bool PERM = true;
    bf16_t* ZS; float* G; int gate_tile, ngate;
    __device__ __forceinline__ void operator()(const f32x4 (&acc)[2][2][4][2], const Unit& u, int wr, int wc, int fr, int fq) const {
        const int row0 = u.pm * BM + wr * 64 + fr;
        if (u.pn == gate_tile) {
            if (wc < 2) {
#pragma unroll
                for (int ai = 0; ai < 2; ++ai)
#pragma unroll
                    for (int m = 0; m < 4; ++m)
#pragma unroll
                        for (int n = 0; n < 2; ++n) { const int c0 = 32 * wc + 8 * fq + 4 * n; if (c0 < ngate) *(f32x4*)(G + (size_t)(row0 + ai * HALF + m * 16) * 64 + c0) = acc[ai][0][m][n]; }
            }
        } else {
            bf16_t* base = ZS + (size_t)(u.pn >> 2) * SEG; const int col0 = (u.pn & 3) * 256 + wc * 32 + 8 * fq;
#pragma unroll
            for (int ai = 0; ai < 2; ++ai)
#pragma unroll
                for (int m = 0; m < 4; ++m) { bf16_t* rowp = base + (size_t)(row0 + ai * HALF + m * 16) * DM + col0;
#pragma unroll
                    for (int bj = 0; bj < 2; ++bj) { const f32x4 v0 = acc[ai][bj][m][0], v1 = acc[ai][bj][m][1];
                        u32x4 w; w.x = cvt_pk_bf16(v0[0], v0[1]); w.y = cvt_pk_bf16(v0[2], v0[3]); w.z = cvt_pk_bf16(v1[0], v1[1]); w.w = cvt_pk_bf16(v1[2], v1[3]);
                        *(u32x4*)(rowp + bj * HALF) = w; } }
        }
    }
};
struct EpiSwiglu { static constexpr bool PERM = true;
    bf16_t* O; int ldo;
    __device__ __forceinline__ void operator()(const f32x4 (&acc)[2][2][4][2], const Unit& u, int wr, int wc, int fr, int fq) const {
        const int row0 = u.pm * BM + wr * 64 + fr, col0 = u.pn * HALF + wc * 32 + 8 * fq;
#pragma unroll
        for (int ai = 0; ai < 2; ++ai)
#pragma unroll
            for (int m = 0; m < 4; ++m) { const f32x4 g0 = acc[ai][0][m][0], g1 = acc[ai][0][m][1], u0 = acc[ai][1][m][0], u1 = acc[ai][1][m][1];
                u32x4 w; w.x = cvt_pk_bf16(silu_fast(g0[0]) * u0[0], silu_fast(g0[1]) * u0[1]); w.y = cvt_pk_bf16(silu_fast(g0[2]) * u0[2], silu_fast(g0[3]) * u0[3]);
                w.z = cvt_pk_bf16(silu_fast(g1[0]) * u1[0], silu_fast(g1[1]) * u1[1]); w.w = cvt_pk_bf16(silu_fast(g1[2]) * u1[2], silu_fast(g1[3]) * u1[3]);
                *(u32x4*)(O + (size_t)(row0 + ai * HALF + m * 16) * ldo + col0) = w; }
    }
};

template <class Epi, class Sched>
__device__ __forceinline__ void gemm_phase(PG8_LAS unsigned char* lds, const Gemm g, const Sched& S, const Epi& E) {
    const int tid = tid_op(), wid = __builtin_amdgcn_readfirstlane(tid >> 6), lane = tid & 63, wr = wid >> 2, wc = wid & 3, fr = lane & 15, fq = lane >> 4;
    const int K = g.K, nt = K / BK;
    unsigned voffA[2], voffB[2];
#pragma unroll
    for (int i = 0; i < 2; ++i) { int R, C; stage_rc(tid * 16 + i * 8192, R, C); const int Rb = Epi::PERM ? ((R & ~31) + perm32(R & 31)) : R;
        voffA[i] = (unsigned)(R * K + C) * 2u; voffB[i] = (unsigned)(Rb * K + C) * 2u; }
    const size_t kstep = (size_t)(BK * 2);
    const size_t hstep = (size_t)HALF * K * 2;
    const size_t tstep = 2 * hstep;
    const unsigned ldsw = (unsigned)wid * 1024u;
    const int aoff = lds_byte(wr * 64 + fr, fq * 8), boff = lds_byte(wc * 32 + fr, fq * 8);
#define PG8_SA(b, h) (((b) * 2 + (h)) * HTB)
#define PG8_SB(b, h) ((4 + (b) * 2 + (h)) * HTB)
#define PG8_STAGE(bufoff, gbase, voff) do { _Pragma("unroll") for (int _i = 0; _i < 2; ++_i) \
        __builtin_amdgcn_global_load_lds((const unsigned*)((const char*)(gbase) + (voff)[_i]), (PG8_LAS unsigned*)(lds + (bufoff) + ldsw + _i * 8192), 16, 0, 0); } while (0)
#define PG8_LDA(dst, b, h) do { _Pragma("unroll") for (int m = 0; m < 4; ++m) _Pragma("unroll") for (int k = 0; k < 2; ++k) dst[m][k] = *(const PG8_LAS bf16x8*)(lds + PG8_SA(b, h) + aoff + m * 2048 + k * 1024); } while (0)
#define PG8_LDB(dst, b, h) do { _Pragma("unroll") for (int n = 0; n < 2; ++n) _Pragma("unroll") for (int k = 0; k < 2; ++k) dst[n][k] = *(const PG8_LAS bf16x8*)(lds + PG8_SB(b, h) + boff + n * 2048 + k * 1024); } while (0)
#define PG8_MMA(ai, bj, At, Bt) do { __builtin_amdgcn_s_setprio(1); _Pragma("unroll") for (int m = 0; m < 4; ++m) _Pragma("unroll") for (int n = 0; n < 2; ++n) _Pragma("unroll") for (int k = 0; k < 2; ++k) \
        acc[ai][bj][m][n] = __builtin_amdgcn_mfma_f32_16x16x32_bf16(Bt[n][k], At[m][k], acc[ai][bj][m][n], 0, 0, 0); __builtin_amdgcn_s_setprio(0); } while (0)
#define PG8_WAIT_V(n) asm volatile("s_waitcnt vmcnt(" #n ")" ::: "memory")
#define PG8_WAIT_L(n) asm volatile("s_waitcnt lgkmcnt(" #n ")" ::: "memory")
#define PG8_BAR __builtin_amdgcn_s_barrier()
#define PG8_SCHED __builtin_amdgcn_sched_barrier(0)
    Unit cur, nxt; int ui = 0;
    if (!S.next(0, cur)) return;
    f32x4 acc[2][2][4][2];
#pragma unroll
    for (int a = 0; a < 2; ++a)
#pragma unroll
        for (int b = 0; b < 2; ++b)
#pragma unroll
            for (int m = 0; m < 4; ++m)
#pragma unroll
                for (int n = 0; n < 2; ++n) acc[a][b][m][n] = (f32x4){0.f, 0.f, 0.f, 0.f};
    bf16x8 At[4][2], B0[2][2], B1[2][2];
    const char* cA = (const char*)g.A + (size_t)cur.pm * tstep; const char* cB = (const char*)g.Bt + S.boff(cur) + (size_t)cur.pn * tstep;
    PG8_STAGE(PG8_SB(0, 0), cB, voffB); PG8_STAGE(PG8_SB(0, 1), cB + hstep, voffB); PG8_STAGE(PG8_SA(0, 0), cA, voffA); PG8_STAGE(PG8_SA(0, 1), cA + hstep, voffA);
    if (wr == 1) PG8_BAR;
    PG8_WAIT_V(2); PG8_BAR;
    PG8_STAGE(PG8_SB(1, 0), cB + kstep, voffB); PG8_STAGE(PG8_SA(1, 0), cA + kstep, voffA); PG8_STAGE(PG8_SB(1, 1), cB + hstep + kstep, voffB);
    PG8_WAIT_V(6); PG8_BAR;
    for (;;) {
        const bool has_next = S.next(ui + 1, nxt);
        const char* nA = has_next ? (const char*)g.A + (size_t)nxt.pm * tstep : cA; const char* nB = has_next ? (const char*)g.Bt + S.boff(nxt) + (size_t)nxt.pn * tstep : cB;
        for (int t = 0; t < nt; t += 2) {
            const bool last = (t == nt - 2);
            const char* a1 = cA + (size_t)(t + 1) * kstep;
            const char* a2 = last ? nA : cA + (size_t)(t + 2) * kstep; const char* b2 = last ? nB : cB + (size_t)(t + 2) * kstep;
            const char* a3 = a2 + kstep; const char* b3 = b2 + kstep;
            PG8_LDB(B0, 0, 0); PG8_LDB(B1, 0, 1); PG8_SCHED; PG8_LDA(At, 0, 0); PG8_STAGE(PG8_SA(1, 1), a1 + hstep, voffA);
            PG8_WAIT_V(8); PG8_WAIT_L(0); PG8_BAR; PG8_MMA(0, 0, At, B0); PG8_MMA(0, 1, At, B1); PG8_BAR; PG8_SCHED;
            PG8_LDA(At, 0, 1); PG8_STAGE(PG8_SB(0, 0), b2, voffB); PG8_STAGE(PG8_SB(0, 1), b2 + hstep, voffB); PG8_STAGE(PG8_SA(0, 0), a2, voffA);
            PG8_WAIT_V(8); PG8_WAIT_L(0); PG8_BAR; PG8_MMA(1, 0, At, B0); PG8_MMA(1, 1, At, B1); PG8_BAR; PG8_SCHED;
            PG8_LDB(B0, 1, 0); PG8_LDB(B1, 1, 1); PG8_SCHED; PG8_LDA(At, 1, 0); PG8_STAGE(PG8_SA(0, 1), a2 + hstep, voffA);
            PG8_WAIT_V(8); PG8_WAIT_L(0); PG8_BAR; PG8_MMA(0, 0, At, B0); PG8_MMA(0, 1, At, B1); PG8_BAR; PG8_SCHED;
            PG8_LDA(At, 1, 1); PG8_STAGE(PG8_SB(1, 0), b3, voffB); PG8_STAGE(PG8_SB(1, 1), b3 + hstep, voffB); PG8_STAGE(PG8_SA(1, 0), a3, voffA);
            PG8_WAIT_V(8); PG8_WAIT_L(0); PG8_BAR; PG8_MMA(1, 0, At, B0); PG8_MMA(1, 1, At, B1); PG8_BAR; PG8_SCHED;
        }
        if (wr == 0) PG8_BAR;
        E(acc, cur, wr, wc, fr, fq);
        if (!has_next) break;
#pragma unroll
        for (int a = 0; a < 2; ++a)
#pragma unroll
            for (int b = 0; b < 2; ++b)
#pragma unroll
                for (int m = 0; m < 4; ++m)
#pragma unroll
                    for (int n = 0; n < 2; ++n) acc[a][b][m][n] = (f32x4){0.f, 0.f, 0.f, 0.f};
        cur = nxt; cA = nA; cB = nB; ++ui;
        if (wr == 1) PG8_BAR;
    }
    PG8_WAIT_V(0);
    PG8_BAR;
#undef PG8_SA
#undef PG8_SB
#undef PG8_STAGE
#undef PG8_LDA
#undef PG8_LDB
#undef PG8_MMA
#undef PG8_WAIT_V
#undef PG8_WAIT_L
#undef PG8_BAR
#undef PG8_SCHED
}
}

__device__ __forceinline__ int wsrccol(int map, int n, int FF) {
    if (map == 0) return n;
    if (map == 1) return n < 3072 ? n : (n < 5120 ? n + 16 : (n < 5136 ? 3072 + (n - 5120) : -1));
    if (map == 2) return n < 3072 ? n : (n < 5632 ? n + 32 : (n < 5664 ? 3072 + (n - 5632) : (n < 5696 ? n : -1)));
    const int tile = n >> 8, i = n & 255; return (i < 128) ? tile * 128 + i : FF + tile * 128 + (i - 128);
}
__device__ __forceinline__ void wconv_item(const float* W, int ldsrc, int K, bf16* WT, int nblk, int map, int FF, float* scr, int item, int lane) {
    const int kb = item / nblk, nb = item % nblk, k0 = 64 * kb, n0 = 32 * nb;
    const int sc = wsrccol(map, n0 + (lane & 31), FF);
#pragma unroll 8
    for (int i = 0; i < 32; ++i) { const int kk = 2 * i + (lane >> 5); scr[kk * 33 + (lane & 31)] = (sc >= 0) ? W[(size_t)(k0 + kk) * ldsrc + sc] : 0.f; }
    asm volatile("s_waitcnt lgkmcnt(0)" ::: "memory");
    const int c = lane & 7;
#pragma unroll
    for (int j = 0; j < 4; ++j) { const int n = (lane >> 3) + 8 * j; const float* s = scr + (8 * c) * 33 + n;
        uint4 o; o.x = f2bf(s[0 * 33]) | (f2bf(s[1 * 33]) << 16); o.y = f2bf(s[2 * 33]) | (f2bf(s[3 * 33]) << 16); o.z = f2bf(s[4 * 33]) | (f2bf(s[5 * 33]) << 16); o.w = f2bf(s[6 * 33]) | (f2bf(s[7 * 33]) << 16);
        *(uint4*)(WT + (size_t)(n0 + n) * K + k0 + 8 * c) = o; }
    asm volatile("s_waitcnt lgkmcnt(0)" ::: "memory");
}
__device__ __forceinline__ void phase_wconv(const Params& p, float* sm) {
    const int tid = tid_op(), lane = tid & 63, wave = tid >> 6;
    float* scr = sm + wave * (64 * 33);
    const int gw = blockIdx.x * 8 + wave, NGW = gridDim.x * 8;
    constexpr int I0 = 16 * (NP_ABIN / 32), I1 = 32 * 32, I2 = 16 * (5632 / 32), I3 = 44 * 32, I4 = 16 * (NP_CDIN / 32), I5 = 32 * 32, I6 = 16 * (7168 / 32), I7 = 56 * 32;
    constexpr int NIT = I0 + I1 + I2 + I3 + I4 + I5 + 8 * I6 + 8 * I7, I8 = 8;
    unsigned char* ws = p.ws;
    for (int it = gw; it < NIT + 32 * I8; it += NGW) {
        int r = it;
        if (r >= NIT) { r -= NIT; const int mtx = r >> 3; wconv_item((mtx < 16 ? p.in[I_LWA] : p.in[I_LWX]) + (size_t)(mtx & 15) * 128 * 128, 128, 128, (bf16*)(ws + OFF_W_RG) + (size_t)mtx * 128 * 128, 4, 0, 0, scr, r & 7, lane); continue; }
        if (r < I0) { wconv_item(p.in[I_ABIN], AB_IN, 1024, (bf16*)(ws + OFF_W_ABIN), NP_ABIN / 32, 1, 0, scr, r, lane); continue; } r -= I0;
        if (r < I1) { wconv_item(p.in[I_ABOUT], 1024, 2048, (bf16*)(ws + OFF_W_ABOUT), 32, 0, 0, scr, r, lane); continue; } r -= I1;
        if (r < I2) { wconv_item(p.in[I_FFN1], 5632, 1024, (bf16*)(ws + OFF_W_FFN1), 5632 / 32, 3, FFD, scr, r, lane); continue; } r -= I2;
        if (r < I3) { wconv_item(p.in[I_FFN2], 1024, 2816, (bf16*)(ws + OFF_W_FFN2), 32, 0, 0, scr, r, lane); continue; } r -= I3;
        if (r < I4) { wconv_item(p.in[I_CDIN], CD_IN, 1024, (bf16*)(ws + OFF_W_CDIN), NP_CDIN / 32, 2, 0, scr, r, lane); continue; } r -= I4;
        if (r < I5) { wconv_item(p.in[I_CDOUT], 1024, 2048, (bf16*)(ws + OFF_W_CDOUT), 32, 0, 0, scr, r, lane); continue; } r -= I5;
        if (r < 8 * I6) { const int e = r / I6; wconv_item(p.in[I_MOE1] + (size_t)e * 1024 * 7168, 7168, 1024, (bf16*)(ws + OFF_W_MOE1) + (size_t)e * 7168 * 1024, 7168 / 32, 3, FFE, scr, r % I6, lane); continue; } r -= 8 * I6;
        { const int e = r / I7; wconv_item(p.in[I_MOE2] + (size_t)e * 3584 * 1024, 1024, 3584, (bf16*)(ws + OFF_W_MOE2) + (size_t)e * 1024 * 3584, 32, 0, 0, scr, r % I7, lane); }
    }
}

namespace sc {
typedef short bf16x8 __attribute__((ext_vector_type(8)));
typedef float f32x4 __attribute__((ext_vector_type(4)));
#define SLAS __attribute__((address_space(3)))
typedef unsigned u32x2 __attribute__((ext_vector_type(2)));
typedef unsigned u32x4 __attribute__((ext_vector_type(4)));
constexpr int QS = 136, TS = 72;
constexpr int L_QA = 0, L_KA = L_QA + 64 * QS * 2, L_KT = L_KA + 64 * QS * 2, L_VU = L_KT + 128 * TS * 2, L_VS = L_VU + 80 * TS * 2, L_ST0 = L_VS + 80 * TS * 2,
              L_ST1 = L_ST0 + 80 * QS * 2, L_P = L_ST1 + 80 * QS * 2, L_SC = L_P + 64 * TS * 2, L_END = L_SC + 2048 + 2048;
__device__ __forceinline__ bf16x8 ldfrag(const SLAS unsigned char* base, int row, int stride, int k) { return *(const SLAS bf16x8*)(base + (size_t)(row * stride + k) * 2); }
typedef float f32x2_t __attribute__((ext_vector_type(2)));
typedef __bf16 bf16x2_t __attribute__((ext_vector_type(2)));
__device__ __forceinline__ unsigned pk2(float lo, float hi) { f32x2_t v = {lo, hi}; bf16x2_t b = __builtin_convertvector(v, bf16x2_t); return __builtin_bit_cast(unsigned, b); }
__device__ __forceinline__ f32x4 mfma(bf16x8 a, bf16x8 b, f32x4 c) { return __builtin_amdgcn_mfma_f32_16x16x32_bf16(a, b, c, 0, 0, 0); }
__device__ __forceinline__ int chunk_of_step(int dir, int c) { return dir ? (c < 4 ? 3 - c : 71 - c) : c; }

template <int MODE, int dir>
__device__ __forceinline__ void chunk_compute(SLAS unsigned char* lds, int cur, f32x4 (&S)[5], float decs, float dskip, bf16* obase  , int b, int t0, int tid) {
    constexpr bool ONES = (MODE == 0), PERD = (MODE == 1), EXPD = (MODE != 1);
    const int lane = tid & 63, w = tid >> 6, r = lane & 15, q = lane >> 4;
    const SLAS unsigned char* Qa = lds + L_QA; const SLAS unsigned char* Ka = lds + L_KA; const SLAS unsigned char* KT = lds + L_KT;
    const SLAS unsigned char* VU = lds + L_VU; const SLAS unsigned char* VS = lds + (MODE == 1 ? L_VU : L_VS);
    const SLAS unsigned char* STc = lds + (cur ? L_ST1 : L_ST0); SLAS unsigned char* STn = lds + (cur ? L_ST0 : L_ST1);
    SLAS unsigned char* P = lds + L_P; const SLAS float* scal = (const SLAS float*)(lds + L_SC);
    {
        const int sb = w >> 1;
        bf16x8 a[4];
#pragma unroll
        for (int ks = 0; ks < 4; ++ks) a[ks] = ldfrag(Ka, sb * 16 + r, QS, ks * 32 + 8 * q);
#pragma unroll
        for (int tt = 0; tt < 2; ++tt) {
            const int tb = (w & 1) * 2 + tt, t = tb * 16 + r;
            float pv[4] = {0.f, 0.f, 0.f, 0.f};
            if (sb <= tb) {
                f32x4 acc = {0.f, 0.f, 0.f, 0.f};
#pragma unroll
                for (int ks = 0; ks < 4; ++ks) acc = mfma(a[ks], ldfrag(Qa, tb * 16 + r, QS, ks * 32 + 8 * q), acc);
                const float btv = EXPD ? scal[t] : 0.f;
                const f32x4 csv = EXPD ? *(const SLAS f32x4*)(scal + 64 + sb * 16 + 4 * q) : (f32x4){0.f, 0.f, 0.f, 0.f};
#pragma unroll
                for (int j = 0; j < 4; ++j) { const int sidx = sb * 16 + 4 * q + j; float v = acc[j]; if (EXPD) v *= __expf(btv + csv[j]); v = (sidx <= t) ? v : 0.f; if (MODE == 2 && sidx == t) v += dskip; pv[j] = v; }
            }
            u32x2 o; o.x = pk2(pv[0], pv[1]); o.y = pk2(pv[2], pv[3]);
            *(SLAS u32x2*)(P + (size_t)(t * TS + sb * 16 + 4 * q) * 2) = o;
        }
    }
    __syncthreads();
    {
        const int tb = w & 3, vb0 = (w >> 2) * 2, t = tb * 16 + r;
        bf16x8 bq[4], bp[2];
#pragma unroll
        for (int ks = 0; ks < 4; ++ks) bq[ks] = ldfrag(Qa, t, QS, ks * 32 + 8 * q);
#pragma unroll
        for (int ks = 0; ks < 2; ++ks) bp[ks] = ldfrag(P, t, TS, ks * 32 + 8 * q);
        const float rsv = EXPD ? scal[128 + t] : 1.f;
        float rden = 1.f;
        if (ONES) {
            f32x4 a = {0.f, 0.f, 0.f, 0.f};
#pragma unroll
            for (int ks = 0; ks < 4; ++ks) a = mfma(ldfrag(STc, 64 + r, QS, ks * 32 + 8 * q), bq[ks], a);
            a = a * rsv;
#pragma unroll
            for (int ks = 0; ks < 2; ++ks) a = mfma(ldfrag(VU, 64 + r, TS, ks * 32 + 8 * q), bp[ks], a);
            const float den = __shfl(a[0], r);
            rden = 1.f / fmaxf(fabsf(den), 1.f);
        }
        const int m = dir ? 63 - t : t;
        bf16* orow = obase + ((size_t)b * TT + t0 + m) * DM;
#pragma unroll
        for (int vv = 0; vv < 2; ++vv) {
            const int vb = vb0 + vv;
            f32x4 a = {0.f, 0.f, 0.f, 0.f};
#pragma unroll
            for (int ks = 0; ks < 4; ++ks) a = mfma(ldfrag(STc, vb * 16 + r, QS, ks * 32 + 8 * q), bq[ks], a);
            if (EXPD) a = a * rsv;
#pragma unroll
            for (int ks = 0; ks < 2; ++ks) a = mfma(ldfrag(VU, vb * 16 + r, TS, ks * 32 + 8 * q), bp[ks], a);
            if (ONES) a = a * rden;
            uint2 o; o.x = pk2(a[0], a[1]); o.y = pk2(a[2], a[3]);
            *(uint2*)(orow + vb * 16 + 4 * q) = o;
        }
    }
    {
        const int d0 = w * 16;
        bf16x8 ak[2];
#pragma unroll
        for (int ks = 0; ks < 2; ++ks) ak[ks] = ldfrag(KT, d0 + r, TS, ks * 32 + 8 * q);
        f32x4 dv = {decs, decs, decs, decs};
        if (PERD) dv = *(const SLAS f32x4*)(scal + 192 + d0 + 4 * q);
#pragma unroll
        for (int vb = 0; vb < 4 + (ONES ? 1 : 0); ++vb) {
            f32x4 a = S[vb] * dv;
#pragma unroll
            for (int ks = 0; ks < 2; ++ks) a = mfma(ak[ks], ldfrag(VS, vb * 16 + r, TS, ks * 32 + 8 * q), a);
            S[vb] = a;
            u32x2 o; o.x = pk2(a[0], a[1]); o.y = pk2(a[2], a[3]);
            *(SLAS u32x2*)(STn + (size_t)((vb * 16 + r) * QS + d0 + 4 * q) * 2) = o;
        }
    }
}

struct Blk48 { f32x4 lo[4], hi[4]; };
__device__ __forceinline__ f32x4 bf4lo(uint4 v) { return (f32x4){bf2f(v.x & 0xffffu), bf2f(v.x >> 16), bf2f(v.y & 0xffffu), bf2f(v.y >> 16)}; }
__device__ __forceinline__ f32x4 bf4hi(uint4 v) { return (f32x4){bf2f(v.z & 0xffffu), bf2f(v.z >> 16), bf2f(v.w & 0xffffu), bf2f(v.w >> 16)}; }
__device__ __forceinline__ float silu_fast(float x) { return x * __builtin_amdgcn_rcpf(1.f + __expf(-x)); }
__device__ __forceinline__ f32x4 silu4(f32x4 x, float sc) { return (f32x4){silu_fast(x[0]) * sc, silu_fast(x[1]) * sc, silu_fast(x[2]) * sc, silu_fast(x[3]) * sc}; }
template <bool ACT> __device__ __forceinline__ void conv_4x8(const bf16* Z, size_t rowbase  , int t0, int m0, int lo, int hi, int col, const float* cw, int wstride, int wcol, const float* cb, float scale, Blk48& out) {
    f32x4 ilo[7], ihi[7];
#pragma unroll
    for (int rr = 0; rr < 7; ++rr) { const int tt = t0 + m0 + rr - 2; uint4 v = make_uint4(0u, 0u, 0u, 0u);
        if (tt >= lo && tt < hi) v = *(const uint4*)(Z + (rowbase + tt) * DM + col);
        ilo[rr] = bf4lo(v); ihi[rr] = bf4hi(v); }
    f32x4 wlo[4], whi[4];
#pragma unroll
    for (int j = 0; j < 4; ++j) { wlo[j] = *(const f32x4*)(cw + (size_t)j * wstride + wcol); whi[j] = *(const f32x4*)(cw + (size_t)j * wstride + wcol + 4); }
    const f32x4 blo = *(const f32x4*)(cb + wcol), bhi = *(const f32x4*)(cb + wcol + 4);
#pragma unroll
    for (int jj = 0; jj < 4; ++jj) { f32x4 a = blo, c = bhi;
#pragma unroll
        for (int j = 0; j < 4; ++j) { a = a + wlo[j] * ilo[jj + j]; c = c + whi[j] * ihi[jj + j]; }
        if (ACT) { a = silu4(a, scale); c = silu4(c, scale); }
        out.lo[jj] = a; out.hi[jj] = c; }
}
template <int dir> __device__ __forceinline__ void put_rows(SLAS unsigned char* tile, int m0, int ch, const Blk48& v) {
#pragma unroll
    for (int jj = 0; jj < 4; ++jj) { const int i = dir ? 63 - (m0 + jj) : (m0 + jj);
        u32x4 o; o.x = pk2(v.lo[jj][0], v.lo[jj][1]); o.y = pk2(v.lo[jj][2], v.lo[jj][3]); o.z = pk2(v.hi[jj][0], v.hi[jj][1]); o.w = pk2(v.hi[jj][2], v.hi[jj][3]);
        *(SLAS u32x4*)(tile + (size_t)(i * QS + ch) * 2) = o; }
}
template <int dir> __device__ __forceinline__ void put_cols(SLAS unsigned char* tile, int m0, int ch, const Blk48& v) {
    const int i0 = dir ? 63 - (m0 + 3) : m0;
#pragma unroll
    for (int e = 0; e < 4; ++e) { u32x2 o, o2;
        if (dir) { o.x = pk2(v.lo[3][e], v.lo[2][e]); o.y = pk2(v.lo[1][e], v.lo[0][e]); o2.x = pk2(v.hi[3][e], v.hi[2][e]); o2.y = pk2(v.hi[1][e], v.hi[0][e]); }
        else     { o.x = pk2(v.lo[0][e], v.lo[1][e]); o.y = pk2(v.lo[2][e], v.lo[3][e]); o2.x = pk2(v.hi[0][e], v.hi[1][e]); o2.y = pk2(v.hi[2][e], v.hi[3][e]); }
        *(SLAS u32x2*)(tile + (size_t)((ch + e) * TS + i0) * 2) = o; *(SLAS u32x2*)(tile + (size_t)((ch + 4 + e) * TS + i0) * 2) = o2; }
}

template <int dir> __device__ __forceinline__ void mlstm_unit(const Params& p, int b, int h, int vs, unsigned char* lds_) {
    SLAS unsigned char* lds = (SLAS unsigned char*)lds_;
    const int tid = tid_op(), lane = tid & 63, w = tid >> 6;
    const bf16* ZS = (const bf16*)(p.ws + OFF_ZS); const float* G = (const float*)(p.ws + OFF_G);
    bf16* obase = (bf16*)(p.ws + OFF_SO) + (size_t)dir * SEG + h * 256 + vs * 64;
    const float gbi = p.in[I_MGATEB][dir * 4 + h], gbf = p.in[I_MGATEB][(2 + dir) * 4 + h];
    SLAS float* scal = (SLAS float*)(lds + L_SC);
    for (int i = tid; i < 80 * QS / 2; i += 512) ((SLAS unsigned*)(lds + L_ST0))[i] = 0u;
    for (int i = tid; i < 16 * TS / 2; i += 512) { ((SLAS unsigned*)(lds + L_VU + 64 * TS * 2))[i] = (i < TS / 2) ? 0x3f803f80u : 0u; ((SLAS unsigned*)(lds + L_VS + 64 * TS * 2))[i] = 0u; }
    f32x4 S[5];
#pragma unroll
    for (int i = 0; i < 5; ++i) S[i] = (f32x4){0.f, 0.f, 0.f, 0.f};
    const size_t rowbase = (size_t)b * TT;
    for (int c = 0; c < 68; ++c) {
        const int mc = chunk_of_step(dir, c), t0 = mc * 64, lo = (mc < 4) ? 0 : t0, hi = (mc < 4) ? NCTX : t0 + 64;
        __syncthreads();
        float bsum, ksfac, bl;
        { const int m = dir ? 63 - lane : lane; const size_t row = rowbase + t0 + m;
          const float gi = G[row * 64 + dir * 4 + h] + gbi, gf = G[row * 64 + (2 + dir) * 4 + h] + gbf;
          bsum = logsigmoid_f(gf);
#pragma unroll
          for (int o = 1; o < 64; o <<= 1) { const float tv = __shfl_up(bsum, o); if (lane >= o) bsum += tv; }
          bl = __shfl(bsum, 63); ksfac = __expf(bl - bsum + gi);
          if (w == 0) { scal[lane] = bsum; scal[64 + lane] = gi - bsum; scal[128 + lane] = __expf(bsum); ((SLAS bf16*)(lds + L_VS + 64 * TS * 2))[lane] = (bf16)f2bf(ksfac); } }
        { const int tg = tid >> 5, cg = tid & 31, m0 = tg * 4; const bool isk = cg >= 16; const int ch = (cg & 15) * 8, col = (isk ? 512 : 0) + h * 128 + ch;
          Blk48 v;
          conv_4x8<true>(ZS, rowbase, t0, m0, lo, hi, col, p.in[I_MCONVW], 1024, col, p.in[I_MCONVB], isk ? 0.08838834764831845f : 1.f, v);
          put_rows<dir>(lds + (isk ? L_KA : L_QA), m0, ch, v); put_cols<dir>(lds + (isk ? L_KT : ((c & 1) ? L_ST0 : L_ST1)), m0, ch, v); }
        { const int tg = tid >> 5, c2 = tid & 31, m0 = tg * 4; const bf16* vp = ZS + SEG + (rowbase + t0 + m0) * DM + h * 256 + vs * 64 + c2 * 2;
          const unsigned x0 = *(const unsigned*)(vp), x1 = *(const unsigned*)(vp + DM), x2 = *(const unsigned*)(vp + 2 * DM), x3 = *(const unsigned*)(vp + 3 * DM);
          const float k0 = __shfl(ksfac, dir ? 63 - m0 : m0), k1 = __shfl(ksfac, dir ? 62 - m0 : m0 + 1), k2 = __shfl(ksfac, dir ? 61 - m0 : m0 + 2), k3 = __shfl(ksfac, dir ? 60 - m0 : m0 + 3);
          const float a0 = bf2f(x0 & 0xffffu), b0 = bf2f(x0 >> 16), a1 = bf2f(x1 & 0xffffu), b1 = bf2f(x1 >> 16), a2 = bf2f(x2 & 0xffffu), b2 = bf2f(x2 >> 16), a3 = bf2f(x3 & 0xffffu), b3 = bf2f(x3 >> 16);
          const int i0 = dir ? 63 - (m0 + 3) : m0;
          u32x2 ua, ub, sa, sb;
          if (dir) { ua.x = pk2(a3, a2); ua.y = pk2(a1, a0); ub.x = pk2(b3, b2); ub.y = pk2(b1, b0); sa.x = pk2(a3 * k3, a2 * k2); sa.y = pk2(a1 * k1, a0 * k0); sb.x = pk2(b3 * k3, b2 * k2); sb.y = pk2(b1 * k1, b0 * k0); }
          else     { ua.x = pk2(a0, a1); ua.y = pk2(a2, a3); ub.x = pk2(b0, b1); ub.y = pk2(b2, b3); sa.x = pk2(a0 * k0, a1 * k1); sa.y = pk2(a2 * k2, a3 * k3); sb.x = pk2(b0 * k0, b1 * k1); sb.y = pk2(b2 * k2, b3 * k3); }
          *(SLAS u32x2*)(lds + L_VU + (size_t)((c2 * 2) * TS + i0) * 2) = ua; *(SLAS u32x2*)(lds + L_VU + (size_t)((c2 * 2 + 1) * TS + i0) * 2) = ub;
          *(SLAS u32x2*)(lds + L_VS + (size_t)((c2 * 2) * TS + i0) * 2) = sa; *(SLAS u32x2*)(lds + L_VS + (size_t)((c2 * 2 + 1) * TS + i0) * 2) = sb; }
        __syncthreads();
        chunk_compute<0, dir>(lds, c & 1, S, __expf(bl), 0.f, obase, b, t0, tid);
    }
}
template <int dir> __device__ __forceinline__ void ssd_unit(const Params& p, int b, int h, unsigned char* lds_) {
    SLAS unsigned char* lds = (SLAS unsigned char*)lds_;
    const int tid = tid_op(), lane = tid & 63, w = tid >> 6, g = h >> 3;
    const bf16* ZS = (const bf16*)(p.ws + OFF_ZS); const float* G = (const float*)(p.ws + OFF_G);
    bf16* obase = (bf16*)(p.ws + OFF_SO) + (size_t)(2 + dir) * SEG + h * 64;
    const float dtb = p.in[I_SDTB][dir * 16 + h], Aneg = -__expf(p.in[I_SALOG][dir * 16 + h]), dskip = dir ? 0.f : p.in[I_SD][h];
    SLAS float* scal = (SLAS float*)(lds + L_SC);
    for (int i = tid; i < 80 * QS / 2; i += 512) ((SLAS unsigned*)(lds + L_ST0))[i] = 0u;
    f32x4 S[5];
#pragma unroll
    for (int i = 0; i < 5; ++i) S[i] = (f32x4){0.f, 0.f, 0.f, 0.f};
    const size_t rowbase = (size_t)b * TT;
    for (int c = 0; c < 68; ++c) {
        const int mc = chunk_of_step(dir, c), t0 = mc * 64, lo = (mc < 4) ? 0 : t0, hi = (mc < 4) ? NCTX : t0 + 64;
        __syncthreads();
        float bsum, ksfac, bl;
        { const int m = dir ? 63 - lane : lane; const size_t row = rowbase + t0 + m;
          const float dtv = softplus_f(G[row * 64 + 32 + dir * 16 + h] + dtb);
          bsum = dtv * Aneg;
#pragma unroll
          for (int o = 1; o < 64; o <<= 1) { const float tv = __shfl_up(bsum, o); if (lane >= o) bsum += tv; }
          bl = __shfl(bsum, 63); ksfac = __expf(bl - bsum) * dtv;
          if (w == 0) { scal[lane] = bsum; scal[64 + lane] = __logf(dtv) - bsum; scal[128 + lane] = __expf(bsum); } }
        for (int it = tid; it < 640; it += 512) {
            const int tg = it / 40, cg = it % 40, m0 = tg * 4;
            Blk48 v;
            if (cg < 32) { const bool isb = cg >= 16; const int ch = (cg & 15) * 8, col = (isb ? 0 : 256) + g * 128 + ch;
                conv_4x8<true>(ZS + 5 * SEG, rowbase, t0, m0, lo, hi, col, p.in[I_SCONVW], 1536, 1024 + col, p.in[I_SCONVB], 1.f, v);
                put_rows<dir>(lds + (isb ? L_KA : L_QA), m0, ch, v); put_cols<dir>(lds + (isb ? L_KT : ((c & 1) ? L_ST0 : L_ST1)), m0, ch, v);
            } else { const int ch = (cg - 32) * 8, col = h * 64 + ch;
                conv_4x8<true>(ZS + 4 * SEG, rowbase, t0, m0, lo, hi, col, p.in[I_SCONVW], 1536, col, p.in[I_SCONVB], 1.f, v);
                put_cols<dir>(lds + L_VU, m0, ch, v); }
        }
        __syncthreads();
        { const int vr = tid >> 3, s0 = (tid & 7) * 8; const u32x4 x = *(const SLAS u32x4*)(lds + L_VU + (size_t)(vr * TS + s0) * 2);
          float kf[8];
#pragma unroll
          for (int e = 0; e < 8; ++e) kf[e] = __shfl(ksfac, s0 + e);
          u32x4 o; o.x = pk2(bf2f(x.x & 0xffffu) * kf[0], bf2f(x.x >> 16) * kf[1]); o.y = pk2(bf2f(x.y & 0xffffu) * kf[2], bf2f(x.y >> 16) * kf[3]);
          o.z = pk2(bf2f(x.z & 0xffffu) * kf[4], bf2f(x.z >> 16) * kf[5]); o.w = pk2(bf2f(x.w & 0xffffu) * kf[6], bf2f(x.w >> 16) * kf[7]);
          *(SLAS u32x4*)(lds + L_VS + (size_t)(vr * TS + s0) * 2) = o; }
        __syncthreads();
        chunk_compute<2, dir>(lds, c & 1, S, __expf(bl), dskip, obase, b, t0, tid);
    }
}
template <int dir> __device__ __forceinline__ void gla_unit(const Params& p, int b, int h, int vs, unsigned char* lds_) {
    SLAS unsigned char* lds = (SLAS unsigned char*)lds_;
    const int tid = tid_op(), d = tid & 127, qt = tid >> 7;
    const bf16* ZS = (const bf16*)(p.ws + OFF_ZS); const float* G = (const float*)(p.ws + OFF_G);
    bf16* obase = (bf16*)(p.ws + OFF_SO) + (size_t)dir * SEG + h * 256 + vs * 64;
    SLAS float* scal = (SLAS float*)(lds + L_SC); SLAS float* qtot = scal + 512;
    float wg[16];
#pragma unroll
    for (int j = 0; j < 16; ++j) wg[j] = p.in[I_GALW][(size_t)(dir * 16 + j) * 512 + h * 128 + d];
    const float bg = p.in[I_GALB][dir * 512 + h * 128 + d];
    for (int i = tid; i < 80 * QS / 2; i += 512) ((SLAS unsigned*)(lds + L_ST0))[i] = 0u;
    f32x4 S[5];
#pragma unroll
    for (int i = 0; i < 5; ++i) S[i] = (f32x4){0.f, 0.f, 0.f, 0.f};
    const size_t rowbase = (size_t)b * TT;
    for (int c = 0; c < 68; ++c) {
        const int mc = chunk_of_step(dir, c), t0 = mc * 64;
        __syncthreads();
        float loc[16]; float run = 0.f;
#pragma unroll
        for (int ii = 0; ii < 16; ++ii) { const int i = qt * 16 + ii, m = dir ? 63 - i : i; const float* ga = G + (rowbase + t0 + m) * 64 + dir * 16;
            float pre = bg;
#pragma unroll
            for (int j4 = 0; j4 < 4; ++j4) { const float4 a = *(const float4*)(ga + 4 * j4); pre += a.x * wg[4 * j4] + a.y * wg[4 * j4 + 1] + a.z * wg[4 * j4 + 2] + a.w * wg[4 * j4 + 3]; }
            run += logsigmoid_f(pre) * (1.f / 16.f); loc[ii] = run; }
        qtot[qt * 128 + d] = run;
        { const int tg = tid >> 5, c2 = tid & 31, m0 = tg * 4; const bf16* vp = ZS + SEG + (rowbase + t0 + m0) * DM + h * 256 + vs * 64 + c2 * 2;
          const unsigned x0 = *(const unsigned*)(vp), x1 = *(const unsigned*)(vp + DM), x2 = *(const unsigned*)(vp + 2 * DM), x3 = *(const unsigned*)(vp + 3 * DM);
          const int i0 = dir ? 63 - (m0 + 3) : m0;
          u32x2 ua, ub;
          if (dir) { ua.x = (x3 & 0xffffu) | (x2 << 16); ua.y = (x1 & 0xffffu) | (x0 << 16); ub.x = (x3 >> 16) | (x2 & 0xffff0000u); ub.y = (x1 >> 16) | (x0 & 0xffff0000u); }
          else     { ua.x = (x0 & 0xffffu) | (x1 << 16); ua.y = (x2 & 0xffffu) | (x3 << 16); ub.x = (x0 >> 16) | (x1 & 0xffff0000u); ub.y = (x2 >> 16) | (x3 & 0xffff0000u); }
          *(SLAS u32x2*)(lds + L_VU + (size_t)((c2 * 2) * TS + i0) * 2) = ua; *(SLAS u32x2*)(lds + L_VU + (size_t)((c2 * 2 + 1) * TS + i0) * 2) = ub; }
        __syncthreads();
        float off = 0.f, tot = 0.f;
#pragma unroll
        for (int q2 = 0; q2 < 4; ++q2) { const float tq = qtot[q2 * 128 + d]; if (q2 < qt) off += tq; tot += tq; }
        if (qt == 0) scal[192 + d] = __expf(tot);
        unsigned kp[8];
#pragma unroll
        for (int ii = 0; ii < 16; ++ii) { const int i = qt * 16 + ii, m = dir ? 63 - i : i; const bf16* zr = ZS + (rowbase + t0 + m) * DM + h * 128 + d;
            const float qv = bf2f(zr[0]) * 0.08838834764831845f, kv = bf2f(zr[512]), bb = off + loc[ii];
            ((SLAS bf16*)(lds + L_QA))[i * QS + d] = (bf16)f2bf(qv * __expf(bb));
            ((SLAS bf16*)(lds + L_KA))[i * QS + d] = (bf16)f2bf(kv * __expf(-bb));
            const unsigned ks = f2bf(kv * __expf(tot - bb));
            if (ii & 1) kp[ii >> 1] |= ks << 16; else kp[ii >> 1] = ks; }
        { u32x4 o0 = {kp[0], kp[1], kp[2], kp[3]}, o1 = {kp[4], kp[5], kp[6], kp[7]};
          *(SLAS u32x4*)(lds + L_KT + (size_t)(d * TS + qt * 16) * 2) = o0; *(SLAS u32x4*)(lds + L_KT + (size_t)(d * TS + qt * 16 + 8) * 2) = o1; }
        __syncthreads();
        chunk_compute<1, dir>(lds, c & 1, S, 1.f, 0.f, obase, b, t0, tid);
    }
}
}

namespace rg {
using sc::bf16x8; using sc::f32x4; using sc::u32x4; using sc::mfma; using sc::ldfrag; using sc::QS;
constexpr int L_XL = 0, L_OUT = 64 * QS * 2, OS = 132;
template <int PHASE>
__device__ __forceinline__ void rglru_units(const Params& p, int u0, int ustride, unsigned char* lds_) {
    SLAS unsigned char* lds = (SLAS unsigned char*)lds_;
    const int tid = tid_op(), lane = tid & 63, w = tid >> 6, r = lane & 15, q = lane >> 4;
    const int blk = u0 & 7, ch = blk * 128 + w * 16 + r;
    const bf16* ZS = (const bf16*)(p.ws + OFF_ZS); const bf16* WT = (const bf16*)(p.ws + OFF_W_RG);
    float2* RGS = (float2*)(p.ws + OFF_RGS); bf16* HC = (bf16*)(p.ws + OFF_HC);
    bf16x8 bw[4][4];
#pragma unroll
    for (int mm = 0; mm < 4; ++mm)
#pragma unroll
        for (int ks = 0; ks < 4; ++ks) bw[mm][ks] = *(const bf16x8*)(WT + ((size_t)((mm & 1) * 16 + (mm >> 1) * 8 + blk) * 128 + (w * 16 + r)) * 128 + ks * 32 + 8 * q);
    float ba[2], bx[2], sp[2];
#pragma unroll
    for (int dd = 0; dd < 2; ++dd) { ba[dd] = p.in[I_LBA][dd * 1024 + ch]; bx[dd] = p.in[I_LBX][dd * 1024 + ch]; sp[dd] = -8.f * softplus_f(-p.in[I_LLAM][dd * 1024 + ch]); }
    for (int u = u0; u < 2176; u += ustride) {
        const int bm = u >> 3, b = bm / 68, mc = bm % 68, t0 = mc * 64, lo = (mc < 4) ? 0 : t0, hi = (mc < 4) ? NCTX : t0 + 64;
        const size_t rowbase = (size_t)b * TT;
        __syncthreads();
        if (tid < 256) { const int tg = tid >> 4, cg = tid & 15, m0 = tg * 4, col = blk * 128 + cg * 8; sc::Blk48 v;
            sc::conv_4x8<false>(ZS + 3 * SEG, rowbase, t0, m0, lo, hi, col, p.in[I_LCONVW], 1024, col, p.in[I_LCONVB], 1.f, v);
            sc::put_rows<0>(lds + L_XL, m0, cg * 8, v); }
        float cin0 = 0.f, cin1 = 0.f;
        if (PHASE == 1) {
            for (int cp = 0; cp < mc; ++cp) { const float2 ab = RGS[((size_t)(b * 68 + cp) * 2 + 0) * 1024 + ch]; cin0 = ab.x * cin0 + ab.y; }
            const int cst = (mc < 4) ? 3 - mc : 71 - mc;
            for (int cp = 0; cp < cst; ++cp) { const int mcp = sc::chunk_of_step(1, cp); const float2 ab = RGS[((size_t)(b * 68 + mcp) * 2 + 1) * 1024 + ch]; cin1 = ab.x * cin1 + ab.y; }
        }
        __syncthreads();
        f32x4 av[2][4], bv[2][4];
#pragma unroll
        for (int tb = 0; tb < 4; ++tb) {
            bf16x8 af[4];
#pragma unroll
            for (int ks = 0; ks < 4; ++ks) af[ks] = ldfrag(lds + L_XL, tb * 16 + r, QS, ks * 32 + 8 * q);
            f32x4 acc[4];
#pragma unroll
            for (int mm = 0; mm < 4; ++mm) { acc[mm] = (f32x4){0.f, 0.f, 0.f, 0.f};
#pragma unroll
                for (int ks = 0; ks < 4; ++ks) acc[mm] = mfma(af[ks], bw[mm][ks], acc[mm]); }
            f32x4 xl4;
#pragma unroll
            for (int j = 0; j < 4; ++j) xl4[j] = bf2f(((const SLAS bf16*)(lds + L_XL))[(tb * 16 + 4 * q + j) * QS + w * 16 + r]);
#pragma unroll
            for (int dd = 0; dd < 2; ++dd) { f32x4 a4, b4;
#pragma unroll
                for (int j = 0; j < 4; ++j) { const float rr = sigmoid_f(acc[dd * 2][j] + ba[dd]), ii = sigmoid_f(acc[dd * 2 + 1][j] + bx[dd]);
                    const float a = __expf(rr * sp[dd]); a4[j] = a; b4[j] = sqrtf(fmaxf(1.f - a * a, 0.f)) * (ii * xl4[j]); }
                av[dd][tb] = a4; bv[dd][tb] = b4; }
        }
        f32x4 o[4];
        { float carry = cin0, aprod = 1.f;
#pragma unroll
          for (int tb = 0; tb < 4; ++tb) {
              const f32x4 A = av[0][tb], B = bv[0][tb]; f32x4 hl, ac;
              hl[0] = B[0]; ac[0] = A[0];
#pragma unroll
              for (int j = 1; j < 4; ++j) { hl[j] = A[j] * hl[j - 1] + B[j]; ac[j] = A[j] * ac[j - 1]; }
              float Ae = 1.f, Be = 0.f, At = 1.f, Bt = 0.f;
#pragma unroll
              for (int qq = 0; qq < 4; ++qq) { const float Aq = __shfl(ac[3], r + 16 * qq), Bq = __shfl(hl[3], r + 16 * qq);
                  if (qq < q) { Be = Aq * Be + Bq; Ae = Aq * Ae; }
                  Bt = Aq * Bt + Bq; At = Aq * At; }
              const float hin = Ae * carry + Be;
              o[tb] = ac * hin + hl;
              carry = At * carry + Bt; aprod *= At; }
          if (PHASE == 0 && q == 0) RGS[((size_t)(b * 68 + mc) * 2 + 0) * 1024 + ch] = make_float2(aprod, carry); }
        { float carry = cin1, aprod = 1.f;
#pragma unroll
          for (int tb = 3; tb >= 0; --tb) {
              const f32x4 A = av[1][tb], B = bv[1][tb]; f32x4 hl, ac;
              hl[3] = B[3]; ac[3] = A[3];
#pragma unroll
              for (int j = 2; j >= 0; --j) { hl[j] = A[j] * hl[j + 1] + B[j]; ac[j] = A[j] * ac[j + 1]; }
              float Ae = 1.f, Be = 0.f, At = 1.f, Bt = 0.f;
#pragma unroll
              for (int qq = 3; qq >= 0; --qq) { const float Aq = __shfl(ac[0], r + 16 * qq), Bq = __shfl(hl[0], r + 16 * qq);
                  if (qq > q) { Be = Aq * Be + Bq; Ae = Aq * Ae; }
                  Bt = Aq * Bt + Bq; At = Aq * At; }
              const float hin = Ae * carry + Be;
              o[tb] = o[tb] + (ac * hin + hl);
              carry = At * carry + Bt; aprod *= At; }
          if (PHASE == 0 && q == 0) RGS[((size_t)(b * 68 + mc) * 2 + 1) * 1024 + ch] = make_float2(aprod, carry); }
        if (PHASE == 1) {
            SLAS float* OUT = (SLAS float*)(lds + L_OUT);
#pragma unroll
            for (int tb = 0; tb < 4; ++tb)
#pragma unroll
                for (int j = 0; j < 4; ++j) OUT[(tb * 16 + 4 * q + j) * OS + w * 16 + r] = o[tb][j];
            __syncthreads();
#pragma unroll
            for (int rep = 0; rep < 2; ++rep) { const int idx = tid + rep * 512, t = idx >> 4, cc = idx & 15; const size_t row = rowbase + t0 + t;
                const f32x4 x0 = *(const SLAS f32x4*)(OUT + t * OS + cc * 8), x1 = *(const SLAS f32x4*)(OUT + t * OS + cc * 8 + 4);
                const uint4 g = *(const uint4*)(ZS + 4 * SEG + row * DM + blk * 128 + cc * 8);
                uint4 ov; ov.x = sc::pk2(x0[0] * gelu_f(bf2f(g.x & 0xffffu)), x0[1] * gelu_f(bf2f(g.x >> 16))); ov.y = sc::pk2(x0[2] * gelu_f(bf2f(g.y & 0xffffu)), x0[3] * gelu_f(bf2f(g.y >> 16)));
                ov.z = sc::pk2(x1[0] * gelu_f(bf2f(g.z & 0xffffu)), x1[1] * gelu_f(bf2f(g.z >> 16))); ov.w = sc::pk2(x1[2] * gelu_f(bf2f(g.w & 0xffffu)), x1[3] * gelu_f(bf2f(g.w >> 16)));
                *(uint4*)(HC + row * 2048 + 1024 + blk * 128 + cc * 8) = ov; }
        }
    }
}
}

template <int MODE  > __device__ __forceinline__ void scan_naive_unit(const Params& p, int b, int h, int dir, int vh, float* sm) {
    constexpr int DV = (MODE == 2) ? 64 : 128, NP = 512 / DV, DPP = 128 / NP;
    float* qe = sm; float* kw = sm + 128; float* dec = sm + 256; float* vv = sm + 384; float* red = sm + 640; float* dred = sm + 640 + 2048;
    const int tid = tid_op(), v = tid % DV, part = tid / DV;
    const bf16* ZS = (const bf16*)(p.ws + OFF_ZS); const float* G = (const float*)(p.ws + OFF_G); bf16* SO = (bf16*)(p.ws + OFF_SO);
    float S[DPP];
#pragma unroll
    for (int i = 0; i < DPP; ++i) S[i] = 0.f;
    float nst = 0.f;
    __syncthreads();
    for (int tau = 0; tau < TT; ++tau) {
        const int t = tokmap(dir, tau); const size_t r = (size_t)b * TT + t;
        if (MODE == 0) {
            const float gi = G[r * 64 + dir * 4 + h] + p.in[I_MGATEB][dir * 4 + h], gf = G[r * 64 + (2 + dir) * 4 + h] + p.in[I_MGATEB][(2 + dir) * 4 + h];
            const float fdec = sigmoid_f(gf), iexp = expf(gi);
            if (tid < 256) { const int c = (tid < 128) ? (h * 128 + tid) : (512 + h * 128 + (tid - 128));
                const float qk = silu_f(conv4(ZS, b, t, c, p.in[I_MCONVW], 1024, c, p.in[I_MCONVB][c]));
                if (tid < 128) { qe[tid] = qk; dec[tid] = fdec; } else kw[tid - 128] = qk * 0.08838834764831845f * iexp; }
            else if (tid < 384) vv[tid - 256] = bf2f(ZS[SEG + r * DM + h * 256 + vh * 128 + (tid - 256)]);
        } else if (MODE == 1) {
            if (tid < 128) { const int d = tid;
                qe[d] = bf2f(ZS[r * DM + h * 128 + d]) * 0.08838834764831845f; kw[d] = bf2f(ZS[r * DM + 512 + h * 128 + d]);
                float pre = p.in[I_GALB][dir * 512 + h * 128 + d];
#pragma unroll
                for (int j = 0; j < 16; ++j) pre += G[r * 64 + dir * 16 + j] * p.in[I_GALW][(size_t)(dir * 16 + j) * 512 + h * 128 + d];
                dec[d] = expf(logsigmoid_f(pre) * (1.f / 16.f)); }
            else if (tid >= 256 && tid < 384) vv[tid - 256] = bf2f(ZS[SEG + r * DM + h * 256 + vh * 128 + (tid - 256)]);
        } else {
            const int g = h >> 3;
            const float dt = softplus_f(G[r * 64 + 32 + dir * 16 + h] + p.in[I_SDTB][dir * 16 + h]);
            const float la = -dt * expf(p.in[I_SALOG][dir * 16 + h]);
            if (tid < 64) { const int c = h * 64 + tid; vv[tid] = silu_f(conv4(ZS + 4 * SEG, b, t, c, p.in[I_SCONVW], 1536, c, p.in[I_SCONVB][c])); }
            else if (tid < 192) { const int n = tid - 64, c = g * 128 + n; kw[n] = dt * silu_f(conv4(ZS + 5 * SEG, b, t, c, p.in[I_SCONVW], 1536, 1024 + c, p.in[I_SCONVB][1024 + c])); dec[n] = expf(la); }
            else if (tid < 320) { const int n = tid - 192, c = 256 + g * 128 + n; qe[n] = silu_f(conv4(ZS + 5 * SEG, b, t, c, p.in[I_SCONVW], 1536, 1024 + c, p.in[I_SCONVB][1024 + c])); }
        }
        __syncthreads();
        const float xv = vv[v]; float po = 0.f;
#pragma unroll
        for (int i = 0; i < DPP; ++i) { const int d = part * DPP + i; S[i] = dec[d] * S[i] + kw[d] * xv; po += qe[d] * S[i]; }
        red[part * DV + v] = po;
        if (MODE == 0 && tid < 128) { nst = dec[tid] * nst + kw[tid]; dred[tid] = qe[tid] * nst; }
        __syncthreads();
        if (tid < DV) { float o = 0.f;
#pragma unroll
            for (int pp = 0; pp < NP; ++pp) o += red[pp * DV + tid];
            if (MODE == 0) { float den = 0.f; for (int d = 0; d < 128; ++d) den += dred[d]; o = o / fmaxf(fabsf(den), 1.f); }
            if (MODE == 2 && dir == 0) o += p.in[I_SD][h] * xv;
            if (MODE == 2) SO[(size_t)(2 + dir) * SEG + r * DM + h * 64 + tid] = (bf16)f2bf(o);
            else SO[(size_t)dir * SEG + r * DM + h * 256 + vh * 128 + tid] = (bf16)f2bf(o); }
    }
}
__device__ __forceinline__ void rglru_naive_unit(const Params& p, int b, int dir, int blk, float* sm) {
    float* xl = sm; float* ra = sm + 128; float* rx = sm + 128 + 512;
    const int tid = tid_op(), c = tid & 127, kp = tid >> 7, ch = blk * 128 + c;
    const bf16* ZS = (const bf16*)(p.ws + OFF_ZS); bf16* SO = (bf16*)(p.ws + OFF_SO);
    const float* wa = p.in[I_LWA] + (size_t)(dir * 8 + blk) * 128 * 128; const float* wx = p.in[I_LWX] + (size_t)(dir * 8 + blk) * 128 * 128;
    const float ba = p.in[I_LBA][dir * 1024 + ch], bx = p.in[I_LBX][dir * 1024 + ch], sp = softplus_f(-p.in[I_LLAM][dir * 1024 + ch]);
    float hst = 0.f;
    __syncthreads();
    for (int tau = 0; tau < TT; ++tau) {
        const int t = tokmap(dir, tau); const size_t r = (size_t)b * TT + t;
        if (tid < 128) xl[c] = conv4(ZS + 3 * SEG, b, t, ch, p.in[I_LCONVW], 1024, ch, p.in[I_LCONVB][ch]);
        __syncthreads();
        float pa = 0.f, px = 0.f;
        asm volatile("" : "+s"(wa), "+s"(wx));
        for (int k = kp * 32; k < kp * 32 + 32; ++k) { const float xk = xl[k]; pa += xk * wa[k * 128 + c]; px += xk * wx[k * 128 + c]; }
        ra[kp * 128 + c] = pa; rx[kp * 128 + c] = px;
        __syncthreads();
        if (tid < 128) {
            const float rr = sigmoid_f(ra[c] + ra[128 + c] + ra[256 + c] + ra[384 + c] + ba), ii = sigmoid_f(rx[c] + rx[128 + c] + rx[256 + c] + rx[384 + c] + bx);
            const float log_a = -8.f * rr * sp, a = expf(log_a), bb = sqrtf(-expm1f(2.f * log_a)) * (ii * xl[c]);
            hst = a * hst + bb;
            SO[(size_t)(2 + dir) * SEG + r * DM + ch] = (bf16)f2bf(hst);
        }
    }
}
__device__ __forceinline__ void phase_scan_naive(const Params& p, int layer, float* sm) {
    if (layer == 0) {
        if (gridDim.x == 256) {
            const int u = blockIdx.x;
            if (u < 128) { if ((u >> 2) & 1) sc::mlstm_unit<1>(p, u >> 5, (u >> 3) & 3, u & 3, (unsigned char*)sm); else sc::mlstm_unit<0>(p, u >> 5, (u >> 3) & 3, u & 3, (unsigned char*)sm); }
            else rg::rglru_units<0>(p, u - 128, 128, (unsigned char*)sm);
        } else {
            for (int u = blockIdx.x; u < 128; u += gridDim.x) { if ((u >> 2) & 1) sc::mlstm_unit<1>(p, u >> 5, (u >> 3) & 3, u & 3, (unsigned char*)sm); else sc::mlstm_unit<0>(p, u >> 5, (u >> 3) & 3, u & 3, (unsigned char*)sm); __syncthreads(); }
            if ((gridDim.x & 7) == 0) rg::rglru_units<0>(p, blockIdx.x, gridDim.x, (unsigned char*)sm); else if (blockIdx.x < 8) rg::rglru_units<0>(p, blockIdx.x, 8, (unsigned char*)sm);
        }
    } else {
        for (int u = blockIdx.x; u < 256; u += gridDim.x) {
            if (u < 128) { if ((u >> 2) & 1) sc::gla_unit<1>(p, u >> 5, (u >> 3) & 3, u & 3, (unsigned char*)sm); else sc::gla_unit<0>(p, u >> 5, (u >> 3) & 3, u & 3, (unsigned char*)sm); }
            else { const int w = u - 128; if (w & 1) sc::ssd_unit<1>(p, w >> 5, (w >> 1) & 15, (unsigned char*)sm); else sc::ssd_unit<0>(p, w >> 5, (w >> 1) & 15, (unsigned char*)sm); }
            __syncthreads();
        }
    }
}

__device__ __forceinline__ void phase_mix2(const Params& p, int layer, float* sm) {
    if (layer == 0) { if ((gridDim.x & 7) == 0) rg::rglru_units<1>(p, blockIdx.x, gridDim.x, (unsigned char*)sm); else if (blockIdx.x < 8) rg::rglru_units<1>(p, blockIdx.x, 8, (unsigned char*)sm); }
    const int tid_ = tid_op(); const int lane = tid_ & 63, gw = blockIdx.x * 8 + (tid_ >> 6), NGW = gridDim.x * 8;
    const bf16* ZS = (const bf16*)(p.ws + OFF_ZS); const bf16* SO = (const bf16*)(p.ws + OFF_SO); bf16* HC = (bf16*)(p.ws + OFF_HC);
    for (int r = gw; r < MROWS; r += NGW) {
        float a[16], c[16], w[16], g[16];
        ld_row_bf16(SO + (size_t)r * DM, lane, a); ld_row_bf16(SO + SEG + (size_t)r * DM, lane, c);
        ld_row_f32(layer == 0 ? p.in[I_MNORMW] : p.in[I_GNORMW], lane, w); ld_row_bf16(ZS + 2 * SEG + (size_t)r * DM, lane, g);
#pragma unroll
        for (int j = 0; j < 4; ++j) {
            float ss = 0.f;
#pragma unroll
            for (int i = 0; i < 4; ++i) { a[4 * j + i] += c[4 * j + i]; ss += a[4 * j + i] * a[4 * j + i]; }
            const float rstd = rsqrtf(wave_sum(ss) * (1.f / 256.f) + 1e-6f);
#pragma unroll
            for (int i = 0; i < 4; ++i) { const float gt = g[4 * j + i]; a[4 * j + i] = a[4 * j + i] * rstd * w[4 * j + i] * (layer == 0 ? sigmoid_f(gt) : silu_f(gt)); }
        }
        st_row_bf16(HC + (size_t)r * 2048, lane, a);
        if (layer == 0) continue;
        ld_row_bf16(SO + 2 * SEG + (size_t)r * DM, lane, a); ld_row_bf16(SO + 3 * SEG + (size_t)r * DM, lane, c);
        if (layer == 0) {
            ld_row_bf16(ZS + 4 * SEG + (size_t)r * DM, lane, g);
#pragma unroll
            for (int i = 0; i < 16; ++i) a[i] = (a[i] + c[i]) * gelu_f(g[i]);
        } else {
            ld_row_bf16(ZS + 3 * SEG + (size_t)r * DM, lane, g); ld_row_f32(p.in[I_SNORMW], lane, w);
#pragma unroll
            for (int i = 0; i < 16; ++i) a[i] = (a[i] + c[i]) * silu_f(g[i]);
            const float rstd = rsqrtf(row_ss(a) * (1.f / DM) + 1e-6f);
#pragma unroll
            for (int i = 0; i < 16; ++i) a[i] = a[i] * rstd * w[i];
        }
        st_row_bf16(HC + (size_t)r * 2048 + 1024, lane, a);
    }
}

__device__ __forceinline__ void phase_route_naive(const Params& p, float* sm) {
    if (blockIdx.x != 0) return;
    int* cnt = (int*)sm; int* cur = cnt + 8; int* base = cnt + 16; const int tid = tid_op();
    const int* TOPI = (const int*)(p.ws + OFF_TOPI); int* SLOT = (int*)(p.ws + OFF_SLOT); int* STOK = (int*)(p.ws + OFF_STOK); int* ctl = (int*)(p.ws + OFF_CTL);
    if (tid < 16) cnt[tid] = 0;
    __syncthreads();
    for (int a = tid; a < 2 * NTOK; a += 512) atomicAdd(&cnt[TOPI[a]], 1);
    __syncthreads();
    if (tid == 0) { int acc = 0; for (int e = 0; e < 8; ++e) { base[e] = acc; ctl[CW_CNT + e] = cnt[e]; ctl[CW_BASE + e] = acc; acc += (cnt[e] + 255) / 256 * 256; } base[8] = acc; ctl[CW_BASE + 8] = acc; ctl[CW_TOT] = acc; }
    __syncthreads();
    for (int s = tid; s < MAXSLOT; s += 512) STOK[s] = -1;
    __syncthreads();
    for (int a = tid; a < 2 * NTOK; a += 512) { const int e = TOPI[a]; const int pos = atomicAdd(&cur[e], 1); const int s = base[e] + pos; SLOT[a] = s; STOK[s] = a >> 1; }
}
__device__ __forceinline__ void phase_gather(const Params& p) {
    const int tid_ = tid_op(); const int lane = tid_ & 63, gw = blockIdx.x * 8 + (tid_ >> 6), NGW = gridDim.x * 8;
    const int* STOK = (const int*)(p.ws + OFF_STOK); const int tot = ((const int*)(p.ws + OFF_CTL))[CW_TOT];
    const bf16* H = (const bf16*)(p.ws + OFF_H); bf16* XS = (bf16*)(p.ws + OFF_XS);
    for (int s = gw; s < tot; s += NGW) {
        const int tok = STOK[s]; uint2* dst = (uint2*)(XS + (size_t)s * DM);
        if (tok < 0) { for (int j = 0; j < 4; ++j) dst[j * 64 + lane] = make_uint2(0u, 0u); }
        else { const int b = tok >> 12, tl = tok & 4095; const uint2* src = (const uint2*)(H + ((size_t)b * TT + NCTX + tl) * DM); for (int j = 0; j < 4; ++j) dst[j * 64 + lane] = src[j * 64 + lane]; }
    }
}

__global__ void __launch_bounds__(512, 2) mega(Params p) {
    extern __shared__ __attribute__((aligned(16))) unsigned char lds[];
    cg::grid_group grid = cg::this_grid();
    float* sm = (float*)lds;
    PG8_LAS unsigned char* LDS = (PG8_LAS unsigned char*)lds;
    unsigned char* ws = p.ws;
    bf16* H = (bf16*)(ws + OFF_H); bf16* ZS = (bf16*)(ws + OFF_ZS); float* G = (float*)(ws + OFF_G); bf16* HC = (bf16*)(ws + OFF_HC); float* Y = (float*)(ws + OFF_Y);
    const int* ctl = (const int*)(ws + OFF_CTL);

    phase_mod(p, sm);
    phase_wconv(p, sm);
    grid.sync();
    phase_norm<0>(p, 0);
    grid.sync();
#if (NAIVE_MASK & 1)
    { MapDense m{(AB_IN + 127) / 128, p.in[I_ABIN]}; EpiInAB e{ZS, G}; gemm_naive<false>(H, DM, AB_IN, AB_IN, DM, 0, (MROWS / 128) * ((AB_IN + 127) / 128), m, e, sm); }
#else
    { pg8::Gemm g{H, (const bf16*)(ws + OFF_W_ABIN), MROWS, NP_ABIN, DM}; pg8::StaticOrder S; S.init(MROWS, NP_ABIN, gridDim.x, blockIdx.x); pg8::EpiInProj E{ZS, G, 20, 16}; pg8::gemm_phase(LDS, g, S, E); }
#endif
    grid.sync();
    phase_scan_naive(p, 0, sm);
    grid.sync();
    phase_mix2(p, 0, sm);
    grid.sync();
#if (NAIVE_MASK & 2)
    { MapDense m{8, p.in[I_ABOUT]}; EpiF32 e{Y, DM}; gemm_naive<false>(HC, 2048, DM, DM, 2048, 0, (MROWS / 128) * 8, m, e, sm); }
#else
    { pg8::Gemm g{HC, (const bf16*)(ws + OFF_W_ABOUT), MROWS, DM, 2048}; pg8::StaticOrder S; S.init(MROWS, DM, gridDim.x, blockIdx.x); pg8::EpiF32 E{Y, DM}; pg8::gemm_phase(LDS, g, S, E); }
#endif
    grid.sync();
    phase_norm<1>(p, 0);
    grid.sync();
#if (NAIVE_MASK & 4)
    { MapDense m{FFD / 64, p.in[I_FFN1]}; EpiSwiglu e{(bf16*)(ws + OFF_ACT), FFD}; gemm_naive<true>(H, DM, 2 * FFD, FFD, DM, FFD, (MROWS / 128) * (FFD / 64), m, e, sm); }
#else
    { pg8::Gemm g{H, (const bf16*)(ws + OFF_W_FFN1), MROWS, 2 * FFD, DM}; pg8::StaticOrder S; S.init(MROWS, 2 * FFD, gridDim.x, blockIdx.x); pg8::EpiSwiglu E{(bf16*)(ws + OFF_ACT), FFD}; pg8::gemm_phase(LDS, g, S, E); }
#endif
    grid.sync();
#if (NAIVE_MASK & 8)
    { MapDense m{8, p.in[I_FFN2]}; EpiF32 e{Y, DM}; gemm_naive<false>((const bf16*)(ws + OFF_ACT), FFD, DM, DM, FFD, 0, (MROWS / 128) * 8, m, e, sm); }
#else
    { pg8::Gemm g{(const bf16*)(ws + OFF_ACT), (const bf16*)(ws + OFF_W_FFN2), MROWS, DM, FFD}; pg8::StaticOrder S; S.init(MROWS, DM, gridDim.x, blockIdx.x); pg8::EpiF32 E{Y, DM}; pg8::gemm_phase(LDS, g, S, E); }
#endif
    grid.sync();
    phase_norm<2>(p, 0);
    grid.sync();
#if (NAIVE_MASK & 16)
    { MapDense m{(CD_IN + 127) / 128, p.in[I_CDIN]}; EpiInCD e{ZS, G}; gemm_naive<false>(H, DM, CD_IN, CD_IN, DM, 0, (MROWS / 128) * ((CD_IN + 127) / 128), m, e, sm); }
#else
    { pg8::Gemm g{H, (const bf16*)(ws + OFF_W_CDIN), MROWS, NP_CDIN, DM}; pg8::StaticOrder S; S.init(MROWS, NP_CDIN, gridDim.x, blockIdx.x); pg8::EpiInProj E{ZS, G, 22, 64}; pg8::gemm_phase(LDS, g, S, E); }
#endif
    grid.sync();
    phase_scan_naive(p, 1, sm);
    grid.sync();
    phase_mix2(p, 1, sm);
    grid.sync();
#if (NAIVE_MASK & 32)
    { MapDense m{8, p.in[I_CDOUT]}; EpiF32 e{Y, DM}; gemm_naive<false>(HC, 2048, DM, DM, 2048, 0, (MROWS / 128) * 8, m, e, sm); }
#else
    { pg8::Gemm g{HC, (const bf16*)(ws + OFF_W_CDOUT), MROWS, DM, 2048}; pg8::StaticOrder S; S.init(MROWS, DM, gridDim.x, blockIdx.x); pg8::EpiF32 E{Y, DM}; pg8::gemm_phase(LDS, g, S, E); }
#endif
    grid.sync();
    phase_norm<1>(p, 1);
    grid.sync();
    phase_route_naive(p, sm);
    grid.sync();
    phase_gather(p);
    grid.sync();
#if (NAIVE_MASK & 64)
    { MapMoe m{FFE / 64, p.in[I_MOE1], (size_t)DM * 2 * FFE, ctl}; EpiSwiglu e{(bf16*)(ws + OFF_ACTM), FFE}; gemm_naive<true>((const bf16*)(ws + OFF_XS), DM, 2 * FFE, FFE, DM, FFE, (MAXSLOT / 128) * (FFE / 64), m, e, sm); }
#else
    { pg8::Gemm g{(const bf16*)(ws + OFF_XS), (const bf16*)(ws + OFF_W_MOE1), ctl[CW_TOT], 2 * FFE, DM}; pg8::MoeOrder S; S.init(ctl[CW_TOT], 2 * FFE, gridDim.x, blockIdx.x); S.ctl = ctl; S.estride = (size_t)2 * FFE * DM * 2; pg8::EpiSwiglu E{(bf16*)(ws + OFF_ACTM), FFE}; pg8::gemm_phase(LDS, g, S, E); }
#endif
    grid.sync();
#if (NAIVE_MASK & 128)
    { MapMoe m{8, p.in[I_MOE2], (size_t)FFE * DM, ctl}; EpiF32 e{(float*)(ws + OFF_YS), DM}; gemm_naive<false>((const bf16*)(ws + OFF_ACTM), FFE, DM, DM, FFE, 0, (MAXSLOT / 128) * 8, m, e, sm); }
#else
    { pg8::Gemm g{(const bf16*)(ws + OFF_ACTM), (const bf16*)(ws + OFF_W_MOE2), ctl[CW_TOT], DM, FFE}; pg8::MoeOrder S; S.init(ctl[CW_TOT], DM, gridDim.x, blockIdx.x); S.ctl = ctl; S.estride = (size_t)DM * FFE * 2; pg8::EpiF32 E{(float*)(ws + OFF_YS), DM}; pg8::gemm_phase(LDS, g, S, E); }
#endif
    grid.sync();
    phase_norm<3>(p, 1);
}

__global__ void nan_fill(float* out, int n) { int i = blockIdx.x * blockDim.x + threadIdx.x; if (i < n) out[i] = __builtin_nanf(""); }

constexpr int LDS_BYTES = 147456;
extern "C" void kernel_launch(void* const* d_in, const int* in_sizes, int n_in, void* d_out, int out_size, void* d_ws, size_t ws_size, hipStream_t stream) {
    static int grid_blocks = 0;
    if (grid_blocks == 0) {
        int dev = 0, cus = 0, per_cu = 0;
        hipGetDevice(&dev);
        hipDeviceGetAttribute(&cus, hipDeviceAttributeMultiprocessorCount, dev);
        hipFuncSetAttribute((const void*)mega, hipFuncAttributeMaxDynamicSharedMemorySize, LDS_BYTES);
        hipOccupancyMaxActiveBlocksPerMultiprocessor(&per_cu, (const void*)mega, 512, LDS_BYTES);
        if (per_cu < 1) per_cu = 1;
        grid_blocks = cus * (per_cu > 1 ? 1 : per_cu);
        if (grid_blocks <= 0) grid_blocks = 256;
    }
    if (n_in != 37 || ws_size < WS_NEED) { fprintf(stderr, "kernel_launch: bad n_in %d or ws %zu < %zu\n", n_in, ws_size, (size_t)WS_NEED); nan_fill<<<(out_size + 255) / 256, 256, 0, stream>>>((float*)d_out, out_size); return; }
    Params p{};
    for (int i = 0; i < 37; ++i) p.in[i] = (const float*)d_in[i];
    p.out = (float*)d_out; p.ws = (unsigned char*)d_ws;
    void* args[] = {&p};
    hipError_t e = hipLaunchCooperativeKernel((const void*)mega, dim3(grid_blocks), dim3(512), args, LDS_BYTES, stream);
    if (e != hipSuccess) fprintf(stderr, "cooperative launch failed: %s (grid %d)\n", hipGetErrorString(e), grid_blocks);
}
```

```cpp
#include <hip/hip_runtime.h>
#include <cstdio>
#include <cstdint>

typedef unsigned short bf16;

constexpr int NB = 4, SEQ = 4096, NCTX = 256, TT = 4352, MROWS = NB * TT, DM = 1024;
constexpr int NTOK = NB * SEQ;
constexpr int FFD = 2816, FFE = 3584, NEXP = 8;
constexpr int AB_IN = 5136, CD_IN = 5696;
constexpr int MAXSLOT = 2 * NTOK + NEXP * 256;

constexpr size_t MiB = 1u << 20;
constexpr size_t OFF_CTL = 0, OFF_MOD = 1 * MiB, OFF_G = 2 * MiB, OFF_XC = 7 * MiB, OFF_TOPI = 11 * MiB, OFF_TOPG = 11 * MiB + 256 * 1024,
                 OFF_SLOT = 11 * MiB + 512 * 1024, OFF_STOK = 12 * MiB, OFF_RGS = 13 * MiB, OFF_H = 18 * MiB, OFF_ZS = 52 * MiB,
                 OFF_SO = 256 * MiB, OFF_HC = 392 * MiB, OFF_Y = 460 * MiB, OFF_W = 528 * MiB;
constexpr int NP_ABIN = 5376, NP_CDIN = 5888;
constexpr size_t OFF_W_ABIN = OFF_W, OFF_W_ABOUT = OFF_W_ABIN + (size_t)NP_ABIN * 1024 * 2, OFF_W_FFN1 = OFF_W_ABOUT + (size_t)1024 * 2048 * 2,
                 OFF_W_FFN2 = OFF_W_FFN1 + (size_t)5632 * 1024 * 2, OFF_W_CDIN = OFF_W_FFN2 + (size_t)1024 * 2816 * 2, OFF_W_CDOUT = OFF_W_CDIN + (size_t)NP_CDIN * 1024 * 2,
                 OFF_W_MOE1 = OFF_W_CDOUT + (size_t)1024 * 2048 * 2, OFF_W_MOE2 = OFF_W_MOE1 + (size_t)8 * 7168 * 1024 * 2, OFF_W_RG = OFF_W_MOE2 + (size_t)8 * 1024 * 3584 * 2, OFF_W_END = OFF_W_RG + (size_t)32 * 128 * 128 * 2;
constexpr size_t WS_NEED = OFF_W_END;
constexpr size_t SEG = (size_t)MROWS * DM;
constexpr size_t OFF_ACT = OFF_ZS, OFF_XS = OFF_HC, OFF_ACTM = OFF_ZS, OFF_YS = OFF_HC;
constexpr int CW_CNT = 0, CW_BASE = 8, CW_TOT = 17;

#ifndef REP_MASK
#define REP_MASK 0
#endif
constexpr int LDS_BYTES = 147456;
constexpr size_t OFF_BAR = 4096;
struct Params { const float* in[37]; float* out; unsigned char* ws; };
enum { I_X = 0, I_C, I_CTX, I_CCTX, I_MODW, I_MODB, I_NORMG, I_ABIN, I_MCONVW, I_MCONVB, I_MGATEB, I_MNORMW, I_LCONVW, I_LCONVB, I_LWA, I_LBA, I_LWX, I_LBX,
       I_LLAM, I_ABOUT, I_FFN1, I_FFN2, I_CDIN, I_GALW, I_GALB, I_GNORMW, I_SCONVW, I_SCONVB, I_SDTB, I_SALOG, I_SD, I_SNORMW, I_CDOUT, I_RW, I_RB, I_MOE1, I_MOE2 };

__device__ __forceinline__ float bf2f(unsigned v) { return __uint_as_float(v << 16); }
__device__ __forceinline__ unsigned f2bf(float f) { unsigned u = __float_as_uint(f); return (u + 0x7fffu + ((u >> 16) & 1u)) >> 16; }
__device__ __forceinline__ float sigmoid_f(float x) { return 1.f / (1.f + expf(-x)); }
__device__ __forceinline__ float silu_f(float x) { return x / (1.f + expf(-x)); }
__device__ __forceinline__ float softplus_f(float x) { return fmaxf(x, 0.f) + log1pf(expf(-fabsf(x))); }
__device__ __forceinline__ float logsigmoid_f(float x) { return -softplus_f(-x); }
__device__ __forceinline__ float gelu_f(float x) { return 0.5f * x * (1.f + tanhf(0.7978845608028654f * (x + 0.044715f * x * x * x))); }
__device__ __forceinline__ float wave_sum(float v) {
#pragma unroll
    for (int o = 32; o >= 1; o >>= 1) v += __shfl_xor(v, o);
    return v;
}
__device__ __forceinline__ int tid_op() { int t = threadIdx.x; asm volatile("" : "+v"(t)); return t; }
__device__ __forceinline__ void ld_row_f32(const float* row, int lane, float (&v)[16]) {
#pragma unroll
    for (int j = 0; j < 4; ++j) { const float4 t = ((const float4*)row)[j * 64 + lane]; v[4 * j] = t.x; v[4 * j + 1] = t.y; v[4 * j + 2] = t.z; v[4 * j + 3] = t.w; }
}
__device__ __forceinline__ void st_row_f32(float* row, int lane, const float (&v)[16]) {
#pragma unroll
    for (int j = 0; j < 4; ++j) ((float4*)row)[j * 64 + lane] = make_float4(v[4 * j], v[4 * j + 1], v[4 * j + 2], v[4 * j + 3]);
}
__device__ __forceinline__ void ld_row_bf16(const bf16* row, int lane, float (&v)[16]) {
#pragma unroll
    for (int j = 0; j < 4; ++j) { const uint2 t = ((const uint2*)row)[j * 64 + lane]; v[4 * j] = bf2f(t.x & 0xffffu); v[4 * j + 1] = bf2f(t.x >> 16); v[4 * j + 2] = bf2f(t.y & 0xffffu); v[4 * j + 3] = bf2f(t.y >> 16); }
}
__device__ __forceinline__ void st_row_bf16(bf16* row, int lane, const float (&v)[16]) {
#pragma unroll
    for (int j = 0; j < 4; ++j) { uint2 t; t.x = f2bf(v[4 * j]) | (f2bf(v[4 * j + 1]) << 16); t.y = f2bf(v[4 * j + 2]) | (f2bf(v[4 * j + 3]) << 16); ((uint2*)row)[j * 64 + lane] = t; }
}
__device__ __forceinline__ float row_ss(const float (&v)[16]) { float s = 0.f;
#pragma unroll
    for (int i = 0; i < 16; ++i) s += v[i] * v[i];
    return wave_sum(s); }

__device__ __forceinline__ void seg_bounds(int t, int& lo, int& hi) { if (t < NCTX) { lo = 0; hi = NCTX; } else { lo = NCTX + ((t - NCTX) & ~63); hi = lo + 64; } }
__device__ __forceinline__ float conv4(const bf16* Z, int b, int t, int c, const float* w, int wstride, int wc, float bias) {
    int lo, hi; seg_bounds(t, lo, hi); float s = bias;
#pragma unroll
    for (int j = 0; j < 4; ++j) { const int tt = t + j - 2; if (tt >= lo && tt < hi) s += w[j * wstride + wc] * bf2f(Z[((size_t)(b * TT + tt)) * DM + c]); }
    return s;
}
__device__ __forceinline__ int tokmap(int dir, int tau) { return dir ? (tau < NCTX ? (NCTX - 1 - tau) : (TT + NCTX - 1 - tau)) : tau; }

__device__ __forceinline__ void phase_mod(const Params& p, float* sm) {
    float* sv = sm; float* red = sm + 5 * 1024; const int tid = tid_op();
    for (int i = tid; i < 5 * 1024; i += 512) { const int v = i >> 10, k = i & 1023; const float x = (v < 4) ? p.in[I_C][v * 1024 + k] : p.in[I_CCTX][k]; sv[i] = silu_f(x); }
    __syncthreads();
    float* MOD = (float*)(p.ws + OFF_MOD);
    for (int it = blockIdx.x; it < 192; it += gridDim.x) {
        const int l = it / 96, j0 = (it % 96) * 64, col = tid & 63, kg = tid >> 6;
        const float* w = p.in[I_MODW] + (size_t)l * 1024 * 6144 + j0 + col;
        float a[5] = {0.f, 0.f, 0.f, 0.f, 0.f};
        for (int k = kg * 128; k < kg * 128 + 128; ++k) { const float wv = w[(size_t)k * 6144];
#pragma unroll
            for (int v = 0; v < 5; ++v) a[v] += sv[v * 1024 + k] * wv; }
#pragma unroll
        for (int v = 0; v < 5; ++v) red[(kg * 5 + v) * 64 + col] = a[v];
        __syncthreads();
        if (tid < 320) { const int v = tid >> 6, cc = tid & 63; float s = 0.f;
            for (int g = 0; g < 8; ++g) s += red[(g * 5 + v) * 64 + cc];
            MOD[(size_t)(l * 5 + v) * 6144 + j0 + cc] = s + p.in[I_MODB][l * 6144 + j0 + cc]; }
        __syncthreads();
    }
    if (blockIdx.x == 0 && tid < 32) ((int*)(p.ws + OFF_CTL))[tid] = 0;
}

__device__ __forceinline__ float rstd_of(float ss) { return __builtin_amdgcn_rsqf(ss * (1.f / DM) + 1e-6f); }
__device__ __forceinline__ void router_row(const Params& p, const float (&x)[16], int lane, int tok) {
    float lg[8];
#pragma unroll
    for (int e = 0; e < 8; ++e) lg[e] = 0.f;
#pragma unroll
    for (int i = 0; i < 16; ++i) { const int col = (i >> 2) * 256 + lane * 4 + (i & 3); const float4 w0 = ((const float4*)(p.in[I_RW] + (size_t)col * 8))[0], w1 = ((const float4*)(p.in[I_RW] + (size_t)col * 8))[1];
        lg[0] += x[i] * w0.x; lg[1] += x[i] * w0.y; lg[2] += x[i] * w0.z; lg[3] += x[i] * w0.w; lg[4] += x[i] * w1.x; lg[5] += x[i] * w1.y; lg[6] += x[i] * w1.z; lg[7] += x[i] * w1.w; }
#pragma unroll
    for (int e = 0; e < 8; ++e) lg[e] = wave_sum(lg[e]) + p.in[I_RB][e];
    if (lane == 0) {
        int e0 = 0; float l0 = lg[0];
#pragma unroll
        for (int e = 1; e < 8; ++e) if (lg[e] > l0) { l0 = lg[e]; e0 = e; }
        int e1 = -1; float l1 = -3.0e38f;
#pragma unroll
        for (int e = 0; e < 8; ++e) if (e != e0 && lg[e] > l1) { l1 = lg[e]; e1 = e; }
        const float ex = expf(l1 - l0), g0 = 1.f / (1.f + ex), g1 = ex / (1.f + ex);
        ((int*)(p.ws + OFF_TOPI))[tok * 2] = e0; ((int*)(p.ws + OFF_TOPI))[tok * 2 + 1] = e1;
        ((float*)(p.ws + OFF_TOPG))[tok * 2] = g0; ((float*)(p.ws + OFF_TOPG))[tok * 2 + 1] = g1;
    }
}
template <int MODE> __device__ __forceinline__ void phase_norm(const Params& p, int layer) {
    const int tid_ = tid_op(); const int lane = tid_ & 63, gw = blockIdx.x * 8 + (tid_ >> 6), NGW = gridDim.x * 8;
    const float* MOD = (const float*)(p.ws + OFF_MOD);
    const float* NG = p.in[I_NORMG] + (size_t)layer * 4 * 1024;
    float* XC = (float*)(p.ws + OFF_XC); bf16* H = (bf16*)(p.ws + OFF_H); const float* Y = (const float*)(p.ws + OFF_Y);
    const bool last = (layer == 1);
    for (int pr = gw; pr < MROWS / 2; pr += NGW) {
        const int r = 2 * pr, b = r / TT, t = r % TT; const bool isctx = t < NCTX; const int v = isctx ? 4 : b;
        if ((MODE == 3 || (MODE == 1 && last)) && isctx) continue;
        const float* mv = MOD + (size_t)(layer * 5 + v) * 6144;
        const float* xin = isctx ? (p.in[I_CTX] + ((size_t)b * NCTX + t) * DM) : (p.in[I_X] + ((size_t)b * SEQ + (t - NCTX)) * DM);
        float* xst = isctx ? (XC + ((size_t)b * NCTX + t) * DM) : (p.out + ((size_t)b * SEQ + (t - NCTX)) * DM);
        float xa[16], xb[16], g[16], a[16], s[16];
        if (MODE == 0) {
            ld_row_f32(xin, lane, xa); ld_row_f32(xin + DM, lane, xb);
            ld_row_f32(NG, lane, g); ld_row_f32(mv + 1024, lane, a); ld_row_f32(mv, lane, s);
            const float ra = rstd_of(row_ss(xa)), rb = rstd_of(row_ss(xb));
#pragma unroll
            for (int i = 0; i < 16; ++i) { const float gg = g[i] * (1.f + a[i]); xa[i] = xa[i] * ra * gg + s[i]; xb[i] = xb[i] * rb * gg + s[i]; }
            st_row_bf16(H + (size_t)r * DM, lane, xa); st_row_bf16(H + (size_t)(r + 1) * DM, lane, xb);
        } else if (MODE == 1 || MODE == 2) {
            float ya[16], yb[16];
            ld_row_f32(Y + (size_t)r * DM, lane, ya); ld_row_f32(Y + (size_t)(r + 1) * DM, lane, yb);
            if (MODE == 1 && layer == 0) { ld_row_f32(xin, lane, xa); ld_row_f32(xin + DM, lane, xb); } else { ld_row_f32(xst, lane, xa); ld_row_f32(xst + DM, lane, xb); }
            ld_row_f32(NG + (MODE == 1 ? 1 : 3) * 1024, lane, g); ld_row_f32(mv + (MODE == 1 ? 2 : 5) * 1024, lane, a);
            const float ra = rstd_of(row_ss(ya)), rb = rstd_of(row_ss(yb));
#pragma unroll
            for (int i = 0; i < 16; ++i) { const float gg = a[i] * g[i]; xa[i] += gg * (ya[i] * ra); xb[i] += gg * (yb[i] * rb); }
            st_row_f32(xst, lane, xa); st_row_f32(xst + DM, lane, xb);
            const float* ng2 = (MODE == 1) ? (NG + 2 * 1024) : (p.in[I_NORMG] + (size_t)4 * 1024);
            const float* mv2 = (MODE == 1) ? mv : (MOD + (size_t)(5 + v) * 6144);
            ld_row_f32(ng2, lane, g); ld_row_f32(mv2 + (MODE == 1 ? 4 : 1) * 1024, lane, a); ld_row_f32(mv2 + (MODE == 1 ? 3 : 0) * 1024, lane, s);
            const float ra2 = rstd_of(row_ss(xa)), rb2 = rstd_of(row_ss(xb));
#pragma unroll
            for (int i = 0; i < 16; ++i) { const float gg = g[i] * (1.f + a[i]); xa[i] = xa[i] * ra2 * gg + s[i]; xb[i] = xb[i] * rb2 * gg + s[i]; }
            st_row_bf16(H + (size_t)r * DM, lane, xa); st_row_bf16(H + (size_t)(r + 1) * DM, lane, xb);
            if (MODE == 1 && last) { const int tok = b * SEQ + (t - NCTX); router_row(p, xa, lane, tok); router_row(p, xb, lane, tok + 1); }
        } else {
            const int tok = b * SEQ + (t - NCTX);
            const int4 sl = *(const int4*)((const int*)(p.ws + OFF_SLOT) + tok * 2); const float4 gt = *(const float4*)((const float*)(p.ws + OFF_TOPG) + tok * 2);
            const float* YS = (const float*)(p.ws + OFF_YS);
            float ya[16], yb[16];
            ld_row_f32(YS + (size_t)sl.x * DM, lane, ya); ld_row_f32(YS + (size_t)sl.y * DM, lane, a); ld_row_f32(YS + (size_t)sl.z * DM, lane, yb); ld_row_f32(YS + (size_t)sl.w * DM, lane, s);
            ld_row_f32(xst, lane, xa); ld_row_f32(xst + DM, lane, xb);
#pragma unroll
            for (int i = 0; i < 16; ++i) { ya[i] = ya[i] * gt.x + a[i] * gt.y; yb[i] = yb[i] * gt.z + s[i] * gt.w; }
            ld_row_f32(NG + 3 * 1024, lane, g); ld_row_f32(mv + 5 * 1024, lane, a);
            const float ra = rstd_of(row_ss(ya)), rb = rstd_of(row_ss(yb));
#pragma unroll
            for (int i = 0; i < 16; ++i) { const float gg = a[i] * g[i]; xa[i] += gg * (ya[i] * ra); xb[i] += gg * (yb[i] * rb); }
            st_row_f32(xst, lane, xa); st_row_f32(xst + DM, lane, xb);
        }
    }
}

namespace pg8 {
#define PG8_LAS __attribute__((address_space(3)))
typedef unsigned short bf16_t;
typedef short bf16x8 __attribute__((ext_vector_type(8)));
typedef float f32x4 __attribute__((ext_vector_type(4)));
typedef unsigned u32x4 __attribute__((ext_vector_type(4)));
constexpr int BM = 256, BK = 64, HALF = 128, HTB = HALF * BK * 2, STAGE_BYTES = 8 * HTB, NXCD = 8, WGM = 8;
__host__ __device__ __forceinline__ int lds_byte(int r, int c) { const int st = (r >> 4) * 2 + (c >> 5), rr = r & 15, cc = c & 31, ob = rr * 64 + cc * 2; return st * 1024 + (ob ^ (((ob >> 9) & 1) << 5)); }
__host__ __device__ __forceinline__ void stage_rc(int b, int& R, int& C) { const int st = b / 1024, sb = b % 1024, swz = sb ^ (((sb >> 9) & 1) << 5); R = (st >> 1) * 16 + swz / 64; C = (st & 1) * 32 + (swz % 64) / 2; }
__host__ __device__ __forceinline__ int perm32(int rho) { const int n = rho >> 4, i = rho & 15; return 8 * (i >> 2) + 4 * n + (i & 3); }
struct Unit { int pm, pn; };
struct Gemm { const bf16_t* A; const bf16_t* Bt; int M, N, K; };
struct StaticOrder {
    int nM, nN, nwg, G, c;
    __device__ void init(int M, int N, int G_, int c_) { nM = M / BM; nN = N / BM; nwg = nM * nN; G = G_; c = c_; }
    __device__ bool next(int i, Unit& u) const {
        const long L = (long)i * G + c; if (L >= nwg) return false;
        int wgid = (int)L; { const int q = nwg / NXCD, r = nwg % NXCD, xcd = wgid % NXCD, off = wgid / NXCD; wgid = (xcd < r ? xcd * (q + 1) : r * (q + 1) + (xcd - r) * q) + off; }
        const int nig = WGM * nN, gid = wgid / nig, fm = gid * WGM, gsz = (nM - fm) < WGM ? (nM - fm) : WGM;
        u.pm = fm + ((wgid % nig) % gsz); u.pn = (wgid % nig) / gsz; return true;
    }
    __device__ __forceinline__ size_t boff(const Unit&) const { return 0; }
};
struct MoeOrder : StaticOrder {
    const int* ctl; size_t estride;
    __device__ __forceinline__ size_t boff(const Unit& u) const { const int row0 = u.pm * 256; int e = 0;
#pragma unroll
        for (int i = 1; i < 8; ++i) if (row0 >= ctl[CW_BASE + i]) e = i;
        return (size_t)e * estride; }
};
__device__ __forceinline__ unsigned cvt_pk_bf16(float lo, float hi) { unsigned r; asm volatile("v_cvt_pk_bf16_f32 %0, %1, %2" : "=v"(r) : "v"(lo), "v"(hi)); return r; }
__device__ __forceinline__ float silu_fast(float x) { return x * __builtin_amdgcn_rcpf(1.f + __expf(-x)); }
struct EpiF32 { static constexpr bool PERM = false;
    float* C; int ldc;
    __device__ __forceinline__ void operator()(const f32x4 (&acc)[2][2][4][2], const Unit& u, int wr, int wc, int fr, int fq) const {
        const int row0 = u.pm * BM + wr * 64 + fr, col0 = u.pn * BM + wc * 32 + 4 * fq;
#pragma unroll
        for (int ai = 0; ai < 2; ++ai)
#pragma unroll
            for (int m = 0; m < 4; ++m) { float* rowp = C + (size_t)(row0 + ai * HALF + m * 16) * ldc + col0;
#pragma unroll
                for (int bj = 0; bj < 2; ++bj)
#pragma unroll
                    for (int n = 0; n < 2; ++n) *(f32x4*)(rowp + bj * HALF + n * 16) = acc[ai][bj][m][n]; }
    }
};
struct EpiInProj { static constexpr bool PERM = true;
    bf16_t* ZS; float* G; int gate_tile, ngate;
    __device__ __forceinline__ void operator()(const f32x4 (&acc)[2][2][4][2], const Unit& u, int wr, int wc, int fr, int fq) const {
        const int row0 = u.pm * BM + wr * 64 + fr;
        if (u.pn == gate_tile) {
            if (wc < 2) {
#pragma unroll
                for (int ai = 0; ai < 2; ++ai)
#pragma unroll
                    for (int m = 0; m < 4; ++m)
#pragma unroll
                        for (int n = 0; n < 2; ++n) { const int c0 = 32 * wc + 8 * fq + 4 * n; if (c0 < ngate) *(f32x4*)(G + (size_t)(row0 + ai * HALF + m * 16) * 64 + c0) = acc[ai][0][m][n]; }
            }
        } else {
            bf16_t* base = ZS + (size_t)(u.pn >> 2) * SEG; const int col0 = (u.pn & 3) * 256 + wc * 32 + 8 * fq;
#pragma unroll
            for (int ai = 0; ai < 2; ++ai)
#pragma unroll
                for (int m = 0; m < 4; ++m) { bf16_t* rowp = base + (size_t)(row0 + ai * HALF + m * 16) * DM + col0;
#pragma unroll
                    for (int bj = 0; bj < 2; ++bj) { const f32x4 v0 = acc[ai][bj][m][0], v1 = acc[ai][bj][m][1];
                        u32x4 w; w.x = cvt_pk_bf16(v0[0], v0[1]); w.y = cvt_pk_bf16(v0[2], v0[3]); w.z = cvt_pk_bf16(v1[0], v1[1]); w.w = cvt_pk_bf16(v1[2], v1[3]);
                        *(u32x4*)(rowp + bj * HALF) = w; } }
        }
    }
};
struct EpiSwiglu { static constexpr bool PERM = true;
    bf16_t* O; int ldo;
    __device__ __forceinline__ void operator()(const f32x4 (&acc)[2][2][4][2], const Unit& u, int wr, int wc, int fr, int fq) const {
        const int row0 = u.pm * BM + wr * 64 + fr, col0 = u.pn * HALF + wc * 32 + 8 * fq;
#pragma unroll
        for (int ai = 0; ai < 2; ++ai)
#pragma unroll
            for (int m = 0; m < 4; ++m) { const f32x4 g0 = acc[ai][0][m][0], g1 = acc[ai][0][m][1], u0 = acc[ai][1][m][0], u1 = acc[ai][1][m][1];
                u32x4 w; w.x = cvt_pk_bf16(silu_fast(g0[0]) * u0[0], silu_fast(g0[1]) * u0[1]); w.y = cvt_pk_bf16(silu_fast(g0[2]) * u0[2], silu_fast(g0[3]) * u0[3]);
                w.z = cvt_pk_bf16(silu_fast(g1[0]) * u1[0], silu_fast(g1[1]) * u1[1]); w.w = cvt_pk_bf16(silu_fast(g1[2]) * u1[2], silu_fast(g1[3]) * u1[3]);
                *(u32x4*)(O + (size_t)(row0 + ai * HALF + m * 16) * ldo + col0) = w; }
    }
};

template <class Epi, class Sched>
__device__ __forceinline__ void gemm_phase(PG8_LAS unsigned char* lds, const Gemm g, const Sched& S, const Epi& E) {
    const int tid = tid_op(), wid = __builtin_amdgcn_readfirstlane(tid >> 6), lane = tid & 63, wr = wid >> 2, wc = wid & 3, fr = lane & 15, fq = lane >> 4;
    const int K = g.K, nt = K / BK;
    unsigned voffA[2], voffB[2];
#pragma unroll
    for (int i = 0; i < 2; ++i) { int R, C; stage_rc(tid * 16 + i * 8192, R, C); const int Rb = Epi::PERM ? ((R & ~31) + perm32(R & 31)) : R;
        voffA[i] = (unsigned)(R * K + C) * 2u; voffB[i] = (unsigned)(Rb * K + C) * 2u; }
    const size_t kstep = (size_t)(BK * 2);
    const size_t hstep = (size_t)HALF * K * 2;
    const size_t tstep = 2 * hstep;
    const unsigned ldsw = (unsigned)wid * 1024u;
    const int aoff = lds_byte(wr * 64 + fr, fq * 8), boff = lds_byte(wc * 32 + fr, fq * 8);
#define PG8_SA(b, h) (((b) * 2 + (h)) * HTB)
#define PG8_SB(b, h) ((4 + (b) * 2 + (h)) * HTB)
#define PG8_STAGE(bufoff, gbase, voff) do { _Pragma("unroll") for (int _i = 0; _i < 2; ++_i) \
        __builtin_amdgcn_global_load_lds((const unsigned*)((const char*)(gbase) + (voff)[_i]), (PG8_LAS unsigned*)(lds + (bufoff) + ldsw + _i * 8192), 16, 0, 0); } while (0)
#define PG8_LDA(dst, b, h) do { _Pragma("unroll") for (int m = 0; m < 4; ++m) _Pragma("unroll") for (int k = 0; k < 2; ++k) dst[m][k] = *(const PG8_LAS bf16x8*)(lds + PG8_SA(b, h) + aoff + m * 2048 + k * 1024); } while (0)
#define PG8_LDB(dst, b, h) do { _Pragma("unroll") for (int n = 0; n < 2; ++n) _Pragma("unroll") for (int k = 0; k < 2; ++k) dst[n][k] = *(const PG8_LAS bf16x8*)(lds + PG8_SB(b, h) + boff + n * 2048 + k * 1024); } while (0)
#define PG8_MMA(ai, bj, At, Bt) do { __builtin_amdgcn_s_setprio(1); _Pragma("unroll") for (int m = 0; m < 4; ++m) _Pragma("unroll") for (int n = 0; n < 2; ++n) _Pragma("unroll") for (int k = 0; k < 2; ++k) \
        acc[ai][bj][m][n] = __builtin_amdgcn_mfma_f32_16x16x32_bf16(Bt[n][k], At[m][k], acc[ai][bj][m][n], 0, 0, 0); __builtin_amdgcn_s_setprio(0); } while (0)
#define PG8_WAIT_V(n) asm volatile("s_waitcnt vmcnt(" #n ")" ::: "memory")
#define PG8_WAIT_L(n) asm volatile("s_waitcnt lgkmcnt(" #n ")" ::: "memory")
#define PG8_BAR __builtin_amdgcn_s_barrier()
#define PG8_SCHED __builtin_amdgcn_sched_barrier(0)
    Unit cur, nxt; int ui = 0;
    if (!S.next(0, cur)) return;
    f32x4 acc[2][2][4][2];
#pragma unroll
    for (int a = 0; a < 2; ++a)
#pragma unroll
        for (int b = 0; b < 2; ++b)
#pragma unroll
            for (int m = 0; m < 4; ++m)
#pragma unroll
                for (int n = 0; n < 2; ++n) acc[a][b][m][n] = (f32x4){0.f, 0.f, 0.f, 0.f};
    bf16x8 At[4][2], B0[2][2], B1[2][2];
    const char* cA = (const char*)g.A + (size_t)cur.pm * tstep; const char* cB = (const char*)g.Bt + S.boff(cur) + (size_t)cur.pn * tstep;
    PG8_STAGE(PG8_SB(0, 0), cB, voffB); PG8_STAGE(PG8_SB(0, 1), cB + hstep, voffB); PG8_STAGE(PG8_SA(0, 0), cA, voffA); PG8_STAGE(PG8_SA(0, 1), cA + hstep, voffA);
    if (wr == 1) PG8_BAR;
    PG8_WAIT_V(2); PG8_BAR;
    PG8_STAGE(PG8_SB(1, 0), cB + kstep, voffB); PG8_STAGE(PG8_SA(1, 0), cA + kstep, voffA); PG8_STAGE(PG8_SB(1, 1), cB + hstep + kstep, voffB);
    PG8_WAIT_V(6); PG8_BAR;
    for (;;) {
        const bool has_next = S.next(ui + 1, nxt);
        const char* nA = has_next ? (const char*)g.A + (size_t)nxt.pm * tstep : cA; const char* nB = has_next ? (const char*)g.Bt + S.boff(nxt) + (size_t)nxt.pn * tstep : cB;
        for (int t = 0; t < nt; t += 2) {
            const bool last = (t == nt - 2);
            const char* a1 = cA + (size_t)(t + 1) * kstep;
            const char* a2 = last ? nA : cA + (size_t)(t + 2) * kstep; const char* b2 = last ? nB : cB + (size_t)(t + 2) * kstep;
            const char* a3 = a2 + kstep; const char* b3 = b2 + kstep;
            PG8_LDB(B0, 0, 0); PG8_LDB(B1, 0, 1); PG8_SCHED; PG8_LDA(At, 0, 0); PG8_STAGE(PG8_SA(1, 1), a1 + hstep, voffA);
            PG8_WAIT_V(8); PG8_WAIT_L(0); PG8_BAR; PG8_MMA(0, 0, At, B0); PG8_MMA(0, 1, At, B1); PG8_BAR; PG8_SCHED;
            PG8_LDA(At, 0, 1); PG8_STAGE(PG8_SB(0, 0), b2, voffB); PG8_STAGE(PG8_SB(0, 1), b2 + hstep, voffB); PG8_STAGE(PG8_SA(0, 0), a2, voffA);
            PG8_WAIT_V(8); PG8_WAIT_L(0); PG8_BAR; PG8_MMA(1, 0, At, B0); PG8_MMA(1, 1, At, B1); PG8_BAR; PG8_SCHED;
            PG8_LDB(B0, 1, 0); PG8_LDB(B1, 1, 1); PG8_SCHED; PG8_LDA(At, 1, 0); PG8_STAGE(PG8_SA(0, 1), a2 + hstep, voffA);
            PG8_WAIT_V(8); PG8_WAIT_L(0); PG8_BAR; PG8_MMA(0, 0, At, B0); PG8_MMA(0, 1, At, B1); PG8_BAR; PG8_SCHED;
            PG8_LDA(At, 1, 1); PG8_STAGE(PG8_SB(1, 0), b3, voffB); PG8_STAGE(PG8_SB(1, 1), b3 + hstep, voffB); PG8_STAGE(PG8_SA(1, 0), a3, voffA);
            PG8_WAIT_V(8); PG8_WAIT_L(0); PG8_BAR; PG8_MMA(1, 0, At, B0); PG8_MMA(1, 1, At, B1); PG8_BAR; PG8_SCHED;
        }
        if (wr == 0) PG8_BAR;
        E(acc, cur, wr, wc, fr, fq);
        if (!has_next) break;
#pragma unroll
        for (int a = 0; a < 2; ++a)
#pragma unroll
            for (int b = 0; b < 2; ++b)
#pragma unroll
                for (int m = 0; m < 4; ++m)
#pragma unroll
                    for (int n = 0; n < 2; ++n) acc[a][b][m][n] = (f32x4){0.f, 0.f, 0.f, 0.f};
        cur = nxt; cA = nA; cB = nB; ++ui;
        if (wr == 1) PG8_BAR;
    }
    PG8_WAIT_V(0);
    PG8_BAR;
#undef PG8_SA
#undef PG8_SB
#undef PG8_STAGE
#undef PG8_LDA
#undef PG8_LDB
#undef PG8_MMA
#undef PG8_WAIT_V
#undef PG8_WAIT_L
#undef PG8_BAR
#undef PG8_SCHED
}
}

__device__ __forceinline__ int wsrccol(int map, int n, int FF) {
    if (map == 0) return n;
    if (map == 1) return n < 3072 ? n : (n < 5120 ? n + 16 : (n < 5136 ? 3072 + (n - 5120) : -1));
    if (map == 2) return n < 3072 ? n : (n < 5632 ? n + 32 : (n < 5664 ? 3072 + (n - 5632) : (n < 5696 ? n : -1)));
    const int tile = n >> 8, i = n & 255; return (i < 128) ? tile * 128 + i : FF + tile * 128 + (i - 128);
}
__device__ __forceinline__ void wconv_item(const float* W, int ldsrc, int K, bf16* WT, int nblk, int map, int FF, float* scr, int item, int lane) {
    const int kb = item / nblk, nb = item % nblk, k0 = 64 * kb, n0 = 32 * nb;
    const int sc = wsrccol(map, n0 + (lane & 31), FF);
#pragma unroll 8
    for (int i = 0; i < 32; ++i) { const int kk = 2 * i + (lane >> 5); scr[kk * 33 + (lane & 31)] = (sc >= 0) ? W[(size_t)(k0 + kk) * ldsrc + sc] : 0.f; }
    asm volatile("s_waitcnt lgkmcnt(0)" ::: "memory");
    const int c = lane & 7;
#pragma unroll
    for (int j = 0; j < 4; ++j) { const int n = (lane >> 3) + 8 * j; const float* s = scr + (8 * c) * 33 + n;
        uint4 o; o.x = f2bf(s[0 * 33]) | (f2bf(s[1 * 33]) << 16); o.y = f2bf(s[2 * 33]) | (f2bf(s[3 * 33]) << 16); o.z = f2bf(s[4 * 33]) | (f2bf(s[5 * 33]) << 16); o.w = f2bf(s[6 * 33]) | (f2bf(s[7 * 33]) << 16);
        *(uint4*)(WT + (size_t)(n0 + n) * K + k0 + 8 * c) = o; }
    asm volatile("s_waitcnt lgkmcnt(0)" ::: "memory");
}
__device__ __forceinline__ void phase_wconv(const Params& p, float* sm) {
    const int tid = tid_op(), lane = tid & 63, wave = tid >> 6;
    float* scr = sm + wave * (64 * 33);
    const int gw = blockIdx.x * 8 + wave, NGW = gridDim.x * 8;
    constexpr int I0 = 16 * (NP_ABIN / 32), I1 = 32 * 32, I2 = 16 * (5632 / 32), I3 = 44 * 32, I4 = 16 * (NP_CDIN / 32), I5 = 32 * 32, I6 = 16 * (7168 / 32), I7 = 56 * 32;
    constexpr int NIT = I0 + I1 + I2 + I3 + I4 + I5 + 8 * I6 + 8 * I7, I8 = 8;
    unsigned char* ws = p.ws;
    for (int it = gw; it < NIT + 32 * I8; it += NGW) {
        int r = it;
        if (r >= NIT) { r -= NIT; const int mtx = r >> 3; wconv_item((mtx < 16 ? p.in[I_LWA] : p.in[I_LWX]) + (size_t)(mtx & 15) * 128 * 128, 128, 128, (bf16*)(ws + OFF_W_RG) + (size_t)mtx * 128 * 128, 4, 0, 0, scr, r & 7, lane); continue; }
        if (r < I0) { wconv_item(p.in[I_ABIN], AB_IN, 1024, (bf16*)(ws + OFF_W_ABIN), NP_ABIN / 32, 1, 0, scr, r, lane); continue; } r -= I0;
        if (r < I1) { wconv_item(p.in[I_ABOUT], 1024, 2048, (bf16*)(ws + OFF_W_ABOUT), 32, 0, 0, scr, r, lane); continue; } r -= I1;
        if (r < I2) { wconv_item(p.in[I_FFN1], 5632, 1024, (bf16*)(ws + OFF_W_FFN1), 5632 / 32, 3, FFD, scr, r, lane); continue; } r -= I2;
        if (r < I3) { wconv_item(p.in[I_FFN2], 1024, 2816, (bf16*)(ws + OFF_W_FFN2), 32, 0, 0, scr, r, lane); continue; } r -= I3;
        if (r < I4) { wconv_item(p.in[I_CDIN], CD_IN, 1024, (bf16*)(ws + OFF_W_CDIN), NP_CDIN / 32, 2, 0, scr, r, lane); continue; } r -= I4;
        if (r < I5) { wconv_item(p.in[I_CDOUT], 1024, 2048, (bf16*)(ws + OFF_W_CDOUT), 32, 0, 0, scr, r, lane); continue; } r -= I5;
        if (r < 8 * I6) { const int e = r / I6; wconv_item(p.in[I_MOE1] + (size_t)e * 1024 * 7168, 7168, 1024, (bf16*)(ws + OFF_W_MOE1) + (size_t)e * 7168 * 1024, 7168 / 32, 3, FFE, scr, r % I6, lane); continue; } r -= 8 * I6;
        { const int e = r / I7; wconv_item(p.in[I_MOE2] + (size_t)e * 3584 * 1024, 1024, 3584, (bf16*)(ws + OFF_W_MOE2) + (size_t)e * 1024 * 3584, 32, 0, 0, scr, r % I7, lane); }
    }
}

namespace sc {
typedef short bf16x8 __attribute__((ext_vector_type(8)));
typedef float f32x4 __attribute__((ext_vector_type(4)));
#define SLAS __attribute__((address_space(3)))
typedef unsigned u32x2 __attribute__((ext_vector_type(2)));
typedef unsigned u32x4 __attribute__((ext_vector_type(4)));
constexpr int QS = 136, TS = 72;
constexpr int L_QA = 0, L_KA = L_QA + 64 * QS * 2, L_KT = L_KA + 64 * QS * 2, L_VU = L_KT + 128 * TS * 2, L_VS = L_VU + 80 * TS * 2, L_ST0 = L_VS + 80 * TS * 2,
              L_ST1 = L_ST0 + 80 * QS * 2, L_P = L_ST1 + 80 * QS * 2, L_SC = L_P + 64 * TS * 2, L_END = L_SC + 2048 + 2048;
__device__ __forceinline__ bf16x8 ldfrag(const SLAS unsigned char* base, int row, int stride, int k) { return *(const SLAS bf16x8*)(base + (size_t)(row * stride + k) * 2); }
typedef float f32x2_t __attribute__((ext_vector_type(2)));
typedef __bf16 bf16x2_t __attribute__((ext_vector_type(2)));
__device__ __forceinline__ unsigned pk2(float lo, float hi) { f32x2_t v = {lo, hi}; bf16x2_t b = __builtin_convertvector(v, bf16x2_t); return __builtin_bit_cast(unsigned, b); }
__device__ __forceinline__ f32x4 mfma(bf16x8 a, bf16x8 b, f32x4 c) { return __builtin_amdgcn_mfma_f32_16x16x32_bf16(a, b, c, 0, 0, 0); }
__device__ __forceinline__ int kt_off(int d, int s) { return (d * TS + ((((s >> 3) ^ (d >> 3)) & 7) << 3) + (s & 7)) * 2; }
__device__ __forceinline__ int chunk_of_step(int dir, int c) { return dir ? (c < 4 ? 3 - c : 71 - c) : c; }

template <int MODE, int dir>
__device__ __forceinline__ void chunk_compute(SLAS unsigned char* lds, int cur, f32x4 (&S)[5], float decs, float dskip, bf16* obase  , int b, int t0, int tid) {
    constexpr bool ONES = (MODE == 0), PERD = (MODE == 1), EXPD = (MODE != 1);
    const int lane = tid & 63, w = tid >> 6, r = lane & 15, q = lane >> 4;
    const SLAS unsigned char* Qa = lds + L_QA; const SLAS unsigned char* Ka = lds + L_KA; const SLAS unsigned char* KT = lds + L_KT;
    const SLAS unsigned char* VU = lds + L_VU; const SLAS unsigned char* VS = lds + (MODE == 1 ? L_VU : L_VS);
    const SLAS unsigned char* STc = lds + (cur ? L_ST1 : L_ST0); SLAS unsigned char* STn = lds + (cur ? L_ST0 : L_ST1);
    SLAS unsigned char* P = lds + L_P; const SLAS float* scal = (const SLAS float*)(lds + L_SC);
    {
        const int sb = w >> 1;
        bf16x8 a[4];
#pragma unroll
        for (int ks = 0; ks < 4; ++ks) a[ks] = ldfrag(Ka, sb * 16 + r, QS, ks * 32 + 8 * q);
#pragma unroll
        for (int tt = 0; tt < 2; ++tt) {
            const int tb = (w & 1) * 2 + tt, t = tb * 16 + r;
            float pv[4] = {0.f, 0.f, 0.f, 0.f};
            if (dir ? (sb >= tb) : (sb <= tb)) {
                f32x4 acc = {0.f, 0.f, 0.f, 0.f};
#pragma unroll
                for (int ks = 0; ks < 4; ++ks) acc = mfma(a[ks], ldfrag(Qa, tb * 16 + r, QS, ks * 32 + 8 * q), acc);
                const float btv = EXPD ? scal[t] : 0.f;
                const f32x4 csv = EXPD ? *(const SLAS f32x4*)(scal + 64 + sb * 16 + 4 * q) : (f32x4){0.f, 0.f, 0.f, 0.f};
#pragma unroll
                for (int j = 0; j < 4; ++j) { const int sidx = sb * 16 + 4 * q + j; float v = acc[j]; if (EXPD) v *= __expf(btv + csv[j]); v = (dir ? (sidx >= t) : (sidx <= t)) ? v : 0.f; if (MODE == 2 && sidx == t) v += dskip; pv[j] = v; }
            }
            u32x2 o; o.x = pk2(pv[0], pv[1]); o.y = pk2(pv[2], pv[3]);
            *(SLAS u32x2*)(P + (size_t)(t * TS + sb * 16 + 4 * q) * 2) = o;
        }
    }
    __syncthreads();
    {
        const int tb = w & 3, vb0 = (w >> 2) * 2, t = tb * 16 + r;
        bf16x8 bq[4], bp[2];
#pragma unroll
        for (int ks = 0; ks < 4; ++ks) bq[ks] = ldfrag(Qa, t, QS, ks * 32 + 8 * q);
#pragma unroll
        for (int ks = 0; ks < 2; ++ks) bp[ks] = ldfrag(P, t, TS, ks * 32 + 8 * q);
        const float rsv = EXPD ? scal[128 + t] : 1.f;
        float rden = 1.f;
        if (ONES) {
            f32x4 a = {0.f, 0.f, 0.f, 0.f};
#pragma unroll
            for (int ks = 0; ks < 4; ++ks) a = mfma(ldfrag(STc, 64 + r, QS, ks * 32 + 8 * q), bq[ks], a);
            a = a * rsv;
#pragma unroll
            for (int ks = 0; ks < 2; ++ks) a = mfma(ldfrag(VU, 64 + r, TS, ks * 32 + 8 * q), bp[ks], a);
            const float den = __shfl(a[0], r);
            rden = 1.f / fmaxf(fabsf(den), 1.f);
        }
        bf16* orow = obase + ((size_t)b * TT + t0 + t) * DM;
#pragma unroll
        for (int vv = 0; vv < 2; ++vv) {
            const int vb = vb0 + vv;
            f32x4 a = {0.f, 0.f, 0.f, 0.f};
#pragma unroll
            for (int ks = 0; ks < 4; ++ks) a = mfma(ldfrag(STc, vb * 16 + r, QS, ks * 32 + 8 * q), bq[ks], a);
            if (EXPD) a = a * rsv;
#pragma unroll
            for (int ks = 0; ks < 2; ++ks) a = mfma(ldfrag(VU, vb * 16 + r, TS, ks * 32 + 8 * q), bp[ks], a);
            if (ONES) a = a * rden;
            uint2 o; o.x = pk2(a[0], a[1]); o.y = pk2(a[2], a[3]);
            *(uint2*)(orow + vb * 16 + 4 * q) = o;
        }
    }
    {
        const int d0 = w * 16;
        bf16x8 ak[2];
#pragma unroll
        for (int ks = 0; ks < 2; ++ks) ak[ks] = *(const SLAS bf16x8*)(KT + kt_off(d0 + r, ks * 32 + 8 * q));
        f32x4 dv = {decs, decs, decs, decs};
        if (PERD) dv = *(const SLAS f32x4*)(scal + 192 + d0 + 4 * q);
#pragma unroll
        for (int vb = 0; vb < 4 + (ONES ? 1 : 0); ++vb) {
            f32x4 a = S[vb] * dv;
#pragma unroll
            for (int ks = 0; ks < 2; ++ks) a = mfma(ak[ks], ldfrag(VS, vb * 16 + r, TS, ks * 32 + 8 * q), a);
            S[vb] = a;
            u32x2 o; o.x = pk2(a[0], a[1]); o.y = pk2(a[2], a[3]);
            *(SLAS u32x2*)(STn + (size_t)((vb * 16 + r) * QS + d0 + 4 * q) * 2) = o;
        }
    }
}

struct Blk48 { f32x4 lo[4], hi[4]; };
struct Rows7 { uint4 r[7]; };
__device__ __forceinline__ f32x4 bf4lo(uint4 v) { return (f32x4){bf2f(v.x & 0xffffu), bf2f(v.x >> 16), bf2f(v.y & 0xffffu), bf2f(v.y >> 16)}; }
__device__ __forceinline__ f32x4 bf4hi(uint4 v) { return (f32x4){bf2f(v.z & 0xffffu), bf2f(v.z >> 16), bf2f(v.w & 0xffffu), bf2f(v.w >> 16)}; }
__device__ __forceinline__ float silu_fast(float x) { return x * __builtin_amdgcn_rcpf(1.f + __expf(-x)); }
__device__ __forceinline__ float sigmoid_fast(float x) { return __builtin_amdgcn_rcpf(1.f + __expf(-x)); }
__device__ __forceinline__ float softplus_fast(float x) { return fmaxf(x, 0.f) + __logf(1.f + __expf(-fabsf(x))); }
__device__ __forceinline__ f32x4 silu4(f32x4 x, float sc) { return (f32x4){silu_fast(x[0]) * sc, silu_fast(x[1]) * sc, silu_fast(x[2]) * sc, silu_fast(x[3]) * sc}; }
template <bool ACT> __device__ __forceinline__ void conv_4x8(const bf16* Z, size_t rowbase, int t0, int m0, int lo, int hi, int col, const float* cw, int wstride, int wcol, const float* cb, float scale, Blk48& out) {
    Rows7 R;
#pragma unroll
    for (int rr = 0; rr < 7; ++rr) { const int tt = t0 + m0 + rr - 2; uint4 v = make_uint4(0u, 0u, 0u, 0u);
        if (tt >= lo && tt < hi) v = *(const uint4*)(Z + (rowbase + tt) * DM + col);
        R.r[rr] = v; }
    f32x4 wlo[4], whi[4];
#pragma unroll
    for (int j = 0; j < 4; ++j) { wlo[j] = *(const f32x4*)(cw + (size_t)j * wstride + wcol); whi[j] = *(const f32x4*)(cw + (size_t)j * wstride + wcol + 4); }
    const f32x4 blo = *(const f32x4*)(cb + wcol), bhi = *(const f32x4*)(cb + wcol + 4);
#pragma unroll
    for (int jj = 0; jj < 4; ++jj) { f32x4 a = blo, c = bhi;
#pragma unroll
        for (int j = 0; j < 4; ++j) { a = a + wlo[j] * bf4lo(R.r[jj + j]); c = c + whi[j] * bf4hi(R.r[jj + j]); }
        if (ACT) { a = silu4(a, scale); c = silu4(c, scale); }
        out.lo[jj] = a; out.hi[jj] = c; }
}
__device__ __forceinline__ void put_rows(SLAS unsigned char* tile, int m0, int ch, const Blk48& v) {
#pragma unroll
    for (int jj = 0; jj < 4; ++jj) { u32x4 o; o.x = pk2(v.lo[jj][0], v.lo[jj][1]); o.y = pk2(v.lo[jj][2], v.lo[jj][3]); o.z = pk2(v.hi[jj][0], v.hi[jj][1]); o.w = pk2(v.hi[jj][2], v.hi[jj][3]);
        *(SLAS u32x4*)(tile + (size_t)((m0 + jj) * QS + ch) * 2) = o; }
}
struct Raw4 { uint4 r[4]; };
__device__ __forceinline__ void raw4_issue(const bf16* p0  , Raw4& R) {
#pragma unroll
    for (int jj = 0; jj < 4; ++jj) R.r[jj] = *(const uint4*)(p0 + (size_t)jj * DM);
}
__device__ __forceinline__ void raw4_put_rows(SLAS unsigned char* tile, int m0, int ch, const Raw4& R) {
#pragma unroll
    for (int jj = 0; jj < 4; ++jj) { u32x4 o = {R.r[jj].x, R.r[jj].y, R.r[jj].z, R.r[jj].w}; *(SLAS u32x4*)(tile + (size_t)((m0 + jj) * QS + ch) * 2) = o; }
}
__device__ __forceinline__ void raw4_put_cols(SLAS unsigned char* tile, int m0, int ch, const Raw4& R) {
    const unsigned w0[4] = {R.r[0].x, R.r[0].y, R.r[0].z, R.r[0].w}, w1[4] = {R.r[1].x, R.r[1].y, R.r[1].z, R.r[1].w}, w2[4] = {R.r[2].x, R.r[2].y, R.r[2].z, R.r[2].w}, w3[4] = {R.r[3].x, R.r[3].y, R.r[3].z, R.r[3].w};
#pragma unroll
    for (int pr = 0; pr < 4; ++pr) { u32x2 ev, od;
        ev.x = (w0[pr] & 0xffffu) | (w1[pr] << 16); ev.y = (w2[pr] & 0xffffu) | (w3[pr] << 16);
        od.x = (w0[pr] >> 16) | (w1[pr] & 0xffff0000u); od.y = (w2[pr] >> 16) | (w3[pr] & 0xffff0000u);
        *(SLAS u32x2*)(tile + kt_off(ch + 2 * pr, m0)) = ev; *(SLAS u32x2*)(tile + kt_off(ch + 2 * pr + 1, m0)) = od; }
}
__device__ __forceinline__ void raw4_put_cols_scaled(SLAS unsigned char* tile, int m0, int ch, const Raw4& R, f32x4 dlo, f32x4 dhi) {
    const f32x4 a0 = bf4lo(R.r[0]), a1 = bf4lo(R.r[1]), a2 = bf4lo(R.r[2]), a3 = bf4lo(R.r[3]), c0 = bf4hi(R.r[0]), c1 = bf4hi(R.r[1]), c2 = bf4hi(R.r[2]), c3 = bf4hi(R.r[3]);
#pragma unroll
    for (int e = 0; e < 4; ++e) { u32x2 o, o2; o.x = pk2(a0[e] * dlo[e], a1[e] * dlo[e]); o.y = pk2(a2[e] * dlo[e], a3[e] * dlo[e]); o2.x = pk2(c0[e] * dhi[e], c1[e] * dhi[e]); o2.y = pk2(c2[e] * dhi[e], c3[e] * dhi[e]);
        *(SLAS u32x2*)(tile + kt_off(ch + e, m0)) = o; *(SLAS u32x2*)(tile + kt_off(ch + 4 + e, m0)) = o2; }
}
struct VRaw { unsigned x0, x1, x2, x3; };
__device__ __forceinline__ void v_issue(const bf16* vp  , VRaw& R) { R.x0 = *(const unsigned*)(vp); R.x1 = *(const unsigned*)(vp + DM); R.x2 = *(const unsigned*)(vp + 2 * DM); R.x3 = *(const unsigned*)(vp + 3 * DM); }
template <bool SCALED> __device__ __forceinline__ void v_put(SLAS unsigned char* lds, const VRaw& R, int m0, int c2, float ksfac) {
    u32x2 ua, ub;
    ua.x = (R.x0 & 0xffffu) | (R.x1 << 16); ua.y = (R.x2 & 0xffffu) | (R.x3 << 16); ub.x = (R.x0 >> 16) | (R.x1 & 0xffff0000u); ub.y = (R.x2 >> 16) | (R.x3 & 0xffff0000u);
    *(SLAS u32x2*)(lds + L_VU + (size_t)((c2 * 2) * TS + m0) * 2) = ua; *(SLAS u32x2*)(lds + L_VU + (size_t)((c2 * 2 + 1) * TS + m0) * 2) = ub;
    if (SCALED) {
        const float k0 = __shfl(ksfac, m0), k1 = __shfl(ksfac, m0 + 1), k2 = __shfl(ksfac, m0 + 2), k3 = __shfl(ksfac, m0 + 3);
        u32x2 sa, sb;
        sa.x = pk2(bf2f(R.x0 & 0xffffu) * k0, bf2f(R.x1 & 0xffffu) * k1); sa.y = pk2(bf2f(R.x2 & 0xffffu) * k2, bf2f(R.x3 & 0xffffu) * k3);
        sb.x = pk2(bf2f(R.x0 >> 16) * k0, bf2f(R.x1 >> 16) * k1); sb.y = pk2(bf2f(R.x2 >> 16) * k2, bf2f(R.x3 >> 16) * k3);
        *(SLAS u32x2*)(lds + L_VS + (size_t)((c2 * 2) * TS + m0) * 2) = sa; *(SLAS u32x2*)(lds + L_VS + (size_t)((c2 * 2 + 1) * TS + m0) * 2) = sb; }
}
template <int dir> __device__ __forceinline__ float dir_scan(float x, int lane, float& bl) {
#pragma unroll
    for (int o = 1; o < 64; o <<= 1) { const float tv = dir ? __shfl_down(x, o) : __shfl_up(x, o); if (dir ? (lane + o < 64) : (lane >= o)) x += tv; }
    bl = __shfl(x, dir ? 0 : 63); return x;
}
constexpr int L_GA = L_END;
static_assert(L_GA + 4096 <= 147456, "scan LDS map");

template <int dir> __device__ __forceinline__ void mlstm_unit(const Params& p, int b, int h, int vs, unsigned char* lds_) {
    SLAS unsigned char* lds = (SLAS unsigned char*)lds_;
    const int tid = tid_op(), lane = tid & 63, w = tid >> 6;
    const bf16* QKC = (const bf16*)(p.ws + OFF_HC); const bf16* ZS = (const bf16*)(p.ws + OFF_ZS); const float* G = (const float*)(p.ws + OFF_G);
    bf16* obase = (bf16*)(p.ws + OFF_SO) + (size_t)dir * SEG + h * 256 + vs * 64;
    const float gbi = p.in[I_MGATEB][dir * 4 + h], gbf = p.in[I_MGATEB][(2 + dir) * 4 + h];
    SLAS float* scal = (SLAS float*)(lds + L_SC);
    for (int i = tid; i < 80 * QS / 2; i += 512) ((SLAS unsigned*)(lds + L_ST0))[i] = 0u;
    for (int i = tid; i < 16 * TS / 2; i += 512) { ((SLAS unsigned*)(lds + L_VU + 64 * TS * 2))[i] = (i < TS / 2) ? 0x3f803f80u : 0u; ((SLAS unsigned*)(lds + L_VS + 64 * TS * 2))[i] = 0u; }
    f32x4 S[5];
#pragma unroll
    for (int i = 0; i < 5; ++i) S[i] = (f32x4){0.f, 0.f, 0.f, 0.f};
    const size_t rowbase = (size_t)b * TT;
    const int tg = tid >> 5, cg = tid & 31, m0 = tg * 4; const bool isk = cg >= 16; const int ch = (cg & 15) * 8;
    const bf16* qkp = QKC + (rowbase + m0) * DM + (isk ? 512 : 0) + h * 128 + ch;
    const bf16* vp = ZS + SEG + (rowbase + m0) * DM + h * 256 + vs * 64 + cg * 2;
    const float* gp = G + (rowbase + lane) * 64;
    struct Pre { Raw4 R; VRaw V; float gi, gf; } PA, PB;
#define MLSTM_ISSUE(P_, cc) do { const size_t to_ = (size_t)chunk_of_step(dir, (cc)) * 64; raw4_issue(qkp + to_ * DM, P_.R); v_issue(vp + to_ * DM, P_.V); P_.gi = gp[to_ * 64 + dir * 4 + h]; P_.gf = gp[to_ * 64 + (2 + dir) * 4 + h]; } while (0)
#define MLSTM_STEP(P_, c_) do { const int c = (c_); const int t0 = chunk_of_step(dir, c) * 64; \
        __syncthreads();                                       \
        float bl; const float gin = P_.gi + gbi; const float bsum = dir_scan<dir>(-softplus_fast(-(P_.gf + gbf)), lane, bl); const float ksfac = __expf(bl - bsum + gin); \
        if (w == 0) { scal[lane] = bsum; scal[64 + lane] = gin - bsum; scal[128 + lane] = __expf(bsum); ((SLAS bf16*)(lds + L_VS + 64 * TS * 2))[lane] = (bf16)f2bf(ksfac); } \
        raw4_put_rows(lds + (isk ? L_KA : L_QA), m0, ch, P_.R); \
        if (isk) raw4_put_cols(lds + L_KT, m0, ch, P_.R); \
        v_put<true>(lds, P_.V, m0, cg, ksfac); \
        if (c + 2 < 68) MLSTM_ISSUE(P_, c + 2); \
        __syncthreads(); \
        chunk_compute<0, dir>(lds, c & 1, S, __expf(bl), 0.f, obase, b, t0, tid); } while (0)
    MLSTM_ISSUE(PA, 0); MLSTM_ISSUE(PB, 1);
    for (int c2 = 0; c2 < 68; c2 += 2) { MLSTM_STEP(PA, c2); MLSTM_STEP(PB, c2 + 1); }
#undef MLSTM_STEP
#undef MLSTM_ISSUE
}
template <int dir> __device__ __forceinline__ void ssd_unit(const Params& p, int b, int h, unsigned char* lds_) {
    SLAS unsigned char* lds = (SLAS unsigned char*)lds_;
    const int tid = tid_op(), lane = tid & 63, w = tid >> 6, g = h >> 3;
    const bf16* XC = (const bf16*)(p.ws + OFF_HC); const float* G = (const float*)(p.ws + OFF_G);
    bf16* obase = (bf16*)(p.ws + OFF_SO) + (size_t)(2 + dir) * SEG + h * 64;
    const float dtb = p.in[I_SDTB][dir * 16 + h], Aneg = -__expf(p.in[I_SALOG][dir * 16 + h]), dskip = dir ? 0.f : p.in[I_SD][h];
    SLAS float* scal = (SLAS float*)(lds + L_SC);
    for (int i = tid; i < 80 * QS / 2; i += 512) ((SLAS unsigned*)(lds + L_ST0))[i] = 0u;
    f32x4 S[5];
#pragma unroll
    for (int i = 0; i < 5; ++i) S[i] = (f32x4){0.f, 0.f, 0.f, 0.f};
    const size_t rowbase = (size_t)b * TT;
    const int tg = tid >> 5, cg = tid & 31, m0 = tg * 4; const bool isb = cg >= 16; const int ch = (cg & 15) * 8;
    const bf16* bcp = XC + SEG + (rowbase + m0) * DM + (isb ? 0 : 256) + g * 128 + ch;
    const bf16* xp = XC + (rowbase + m0) * DM + h * 64 + cg * 2;
    const float* gp = G + (rowbase + lane) * 64 + 32 + dir * 16 + h;
    struct Pre { Raw4 R; VRaw V; float dtraw; } PA, PB;
#define SSD_ISSUE(P_, cc) do { const size_t to_ = (size_t)chunk_of_step(dir, (cc)) * 64; raw4_issue(bcp + to_ * DM, P_.R); v_issue(xp + to_ * DM, P_.V); P_.dtraw = gp[to_ * 64]; } while (0)
#define SSD_STEP(P_, c_) do { const int c = (c_); const int t0 = chunk_of_step(dir, c) * 64; \
        __syncthreads(); \
        const float dtv = softplus_fast(P_.dtraw + dtb); \
        float bl; const float bsum = dir_scan<dir>(dtv * Aneg, lane, bl); const float ksfac = __expf(bl - bsum) * dtv; \
        if (w == 0) { scal[lane] = bsum; scal[64 + lane] = __logf(dtv) - bsum; scal[128 + lane] = __expf(bsum); } \
        raw4_put_rows(lds + (isb ? L_KA : L_QA), m0, ch, P_.R); \
        if (isb) raw4_put_cols(lds + L_KT, m0, ch, P_.R); \
        v_put<true>(lds, P_.V, m0, cg, ksfac); \
        if (c + 2 < 68) SSD_ISSUE(P_, c + 2); \
        __syncthreads(); \
        chunk_compute<2, dir>(lds, c & 1, S, __expf(bl), dskip, obase, b, t0, tid); } while (0)
    SSD_ISSUE(PA, 0); SSD_ISSUE(PB, 1);
    for (int c2 = 0; c2 < 68; c2 += 2) { SSD_STEP(PA, c2); SSD_STEP(PB, c2 + 1); }
#undef SSD_STEP
#undef SSD_ISSUE
}
template <int dir> __device__ __forceinline__ void gla_unit(const Params& p, int b, int h, int vs, unsigned char* lds_) {
    SLAS unsigned char* lds = (SLAS unsigned char*)lds_;
    const int tid = tid_op();
    const bf16* QA = (const bf16*)(p.ws + OFF_HC) + (size_t)(2 + dir) * SEG; const bf16* ZS = (const bf16*)(p.ws + OFF_ZS); const float* DEC = (const float*)(p.ws + OFF_RGS);
    bf16* obase = (bf16*)(p.ws + OFF_SO) + (size_t)dir * SEG + h * 256 + vs * 64;
    SLAS float* scal = (SLAS float*)(lds + L_SC);
    for (int i = tid; i < 80 * QS / 2; i += 512) ((SLAS unsigned*)(lds + L_ST0))[i] = 0u;
    f32x4 S[5];
#pragma unroll
    for (int i = 0; i < 5; ++i) S[i] = (f32x4){0.f, 0.f, 0.f, 0.f};
    const size_t rowbase = (size_t)b * TT;
    const int tg = tid >> 5, cg = tid & 31, m0 = tg * 4; const bool isk = cg >= 16; const int ch = (cg & 15) * 8;
    const bf16* qkp = QA + (rowbase + m0) * DM + (isk ? 512 : 0) + h * 128 + ch;
    const bf16* vp = ZS + SEG + (rowbase + m0) * DM + h * 256 + vs * 64 + cg * 2;
    struct Pre { Raw4 R; VRaw V; f32x4 dlo, dhi; } PA, PB;
#define GLA_ISSUE(P_, cc) do { const int mc_ = chunk_of_step(dir, (cc)); const size_t to_ = (size_t)mc_ * 64; raw4_issue(qkp + to_ * DM, P_.R); v_issue(vp + to_ * DM, P_.V); \
        const float* dp_ = DEC + ((size_t)((b * 68 + mc_) * 4 + h) * 2 + dir) * 128 + ch; P_.dlo = *(const f32x4*)dp_; P_.dhi = *(const f32x4*)(dp_ + 4); } while (0)
#define GLA_STEP(P_, c_) do { const int c = (c_); const int t0 = chunk_of_step(dir, c) * 64; \
        __syncthreads(); \
        raw4_put_rows(lds + (isk ? L_KA : L_QA), m0, ch, P_.R); \
        if (isk) { raw4_put_cols_scaled(lds + L_KT, m0, ch, P_.R, P_.dlo, P_.dhi); if (tg == 0) { *(SLAS f32x4*)(scal + 192 + ch) = P_.dlo; *(SLAS f32x4*)(scal + 192 + ch + 4) = P_.dhi; } } \
        v_put<false>(lds, P_.V, m0, cg, 0.f); \
        if (c + 2 < 68) GLA_ISSUE(P_, c + 2); \
        __syncthreads(); \
        chunk_compute<1, dir>(lds, c & 1, S, 1.f, 0.f, obase, b, t0, tid); } while (0)
    GLA_ISSUE(PA, 0); GLA_ISSUE(PB, 1);
    for (int c2 = 0; c2 < 68; c2 += 2) { GLA_STEP(PA, c2); GLA_STEP(PB, c2 + 1); }
#undef GLA_STEP
#undef GLA_ISSUE
}

__device__ __forceinline__ void prep_conv(const Params& p, int layer) {
    const int tid = tid_op(); const long gtid = (long)blockIdx.x * 512 + tid, gstride = (long)gridDim.x * 512;
    const bf16* ZS = (const bf16*)(p.ws + OFF_ZS); bf16* OUT = (bf16*)(p.ws + OFF_HC);
    const int ngrp = (layer == 0) ? 128 : 192;
    const long nitems = (long)(MROWS / 4) * ngrp;
    for (long it = gtid; it < nitems; it += gstride) {
        const int cgi = (int)(it % ngrp), tgi = (int)(it / ngrp), row4 = tgi * 4, b = row4 / TT, t = row4 % TT, t0 = t & ~63, m0 = t & 63, mc = t0 >> 6;
        const int lo = (mc < 4) ? 0 : t0, hi = (mc < 4) ? NCTX : t0 + 64;
        Blk48 v; const bf16* src; bf16* dst; int col;
        if (layer == 0) { col = cgi * 8; src = ZS; dst = OUT;
            conv_4x8<true>(src, (size_t)b * TT, t0, m0, lo, hi, col, p.in[I_MCONVW], 1024, col, p.in[I_MCONVB], col >= 512 ? 0.08838834764831845f : 1.f, v); }
        else { const int xc = cgi * 8;
            col = (xc < 1024) ? xc : xc - 1024; src = ZS + (size_t)(xc < 1024 ? 4 : 5) * SEG; dst = OUT + (size_t)(xc < 1024 ? 0 : 1) * SEG;
            conv_4x8<true>(src, (size_t)b * TT, t0, m0, lo, hi, col, p.in[I_SCONVW], 1536, xc, p.in[I_SCONVB], 1.f, v); }
#pragma unroll
        for (int jj = 0; jj < 4; ++jj) { uint4 o; o.x = pk2(v.lo[jj][0], v.lo[jj][1]); o.y = pk2(v.lo[jj][2], v.lo[jj][3]); o.z = pk2(v.hi[jj][0], v.hi[jj][1]); o.w = pk2(v.hi[jj][2], v.hi[jj][3]);
            *(uint4*)(dst + ((size_t)b * TT + t0 + m0 + jj) * DM + col) = o; }
    }
}
__device__ __forceinline__ void prep_gla(const Params& p, unsigned char* lds_) {
    SLAS unsigned char* lds = (SLAS unsigned char*)lds_;
    const int tid = tid_op(), d = tid & 127, qt = tid >> 7;
    const bf16* ZS = (const bf16*)(p.ws + OFF_ZS); const float* G = (const float*)(p.ws + OFF_G); float* DEC = (float*)(p.ws + OFF_RGS);
    SLAS float* qtot = (SLAS float*)(lds + L_SC) + 512; SLAS float* GA = (SLAS float*)(lds + L_GA); SLAS bf16* E = (SLAS bf16*)(lds + L_ST0);
    const int tg = tid >> 5, cg = tid & 31, m0 = tg * 4; const bool isk = cg >= 16; const int ch = (cg & 15) * 8;
    for (int u = blockIdx.x; u < 2176; u += gridDim.x) {
        const int dir = u & 1, h = (u >> 1) & 3, bm = u >> 3, b = bm / 68, mc = bm % 68; const size_t rowbase = (size_t)b * TT + mc * 64;
        float wg[16];
#pragma unroll
        for (int j = 0; j < 16; ++j) wg[j] = p.in[I_GALW][(size_t)(dir * 16 + j) * 512 + h * 128 + d];
        const float bg = p.in[I_GALB][dir * 512 + h * 128 + d];
        __syncthreads();
        if (tid < 256) { const float4 a = *(const float4*)(G + (rowbase + (tid >> 2)) * 64 + dir * 16 + (tid & 3) * 4); *(SLAS f32x4*)(GA + (tid >> 2) * 16 + (tid & 3) * 4) = (f32x4){a.x, a.y, a.z, a.w}; }
        Raw4 R; raw4_issue(ZS + (rowbase + m0) * DM + (isk ? 512 : 0) + h * 128 + ch, R);
        __syncthreads();
        f32x4 loc[4]; float run = 0.f;
#pragma unroll
        for (int i2 = 0; i2 < 16; ++i2) { const int ii = dir ? 15 - i2 : i2; const SLAS float* ga = GA + (qt * 16 + ii) * 16;
            float pre = bg;
#pragma unroll
            for (int j4 = 0; j4 < 4; ++j4) { const f32x4 a = *(const SLAS f32x4*)(ga + 4 * j4); pre += a[0] * wg[4 * j4] + a[1] * wg[4 * j4 + 1] + a[2] * wg[4 * j4 + 2] + a[3] * wg[4 * j4 + 3]; }
            run -= softplus_fast(-pre) * (1.f / 16.f); loc[ii >> 2][ii & 3] = run; }
        qtot[qt * 128 + d] = run;
        __syncthreads();
        float off = 0.f, tot = 0.f;
#pragma unroll
        for (int q2 = 0; q2 < 4; ++q2) { const float tq = qtot[q2 * 128 + d]; if (dir ? (q2 > qt) : (q2 < qt)) off += tq; tot += tq; }
        if (qt == 0) DEC[((size_t)((b * 68 + mc) * 4 + h) * 2 + dir) * 128 + d] = __expf(tot);
#pragma unroll
        for (int ii = 0; ii < 16; ++ii) E[(qt * 16 + ii) * QS + d] = (bf16)f2bf(__expf(off + loc[ii >> 2][ii & 3]));
        __syncthreads();
        bf16* dst = (bf16*)(p.ws + OFF_HC) + (size_t)(2 + dir) * SEG + (rowbase + m0) * DM + (isk ? 512 : 0) + h * 128 + ch;
#pragma unroll
        for (int jj = 0; jj < 4; ++jj) { const u32x4 ev = *(const SLAS u32x4*)((const SLAS unsigned char*)E + (size_t)((m0 + jj) * QS + ch) * 2);
            const uint4 e4 = make_uint4(ev.x, ev.y, ev.z, ev.w); const f32x4 elo = bf4lo(e4), ehi = bf4hi(e4), xlo = bf4lo(R.r[jj]), xhi = bf4hi(R.r[jj]); f32x4 alo, ahi;
            if (!isk) { alo = xlo * elo * 0.08838834764831845f; ahi = xhi * ehi * 0.08838834764831845f; }
            else {
#pragma unroll
                for (int e = 0; e < 4; ++e) { alo[e] = xlo[e] * __builtin_amdgcn_rcpf(elo[e]); ahi[e] = xhi[e] * __builtin_amdgcn_rcpf(ehi[e]); } }
            uint4 o; o.x = pk2(alo[0], alo[1]); o.y = pk2(alo[2], alo[3]); o.z = pk2(ahi[0], ahi[1]); o.w = pk2(ahi[2], ahi[3]);
            *(uint4*)(dst + (size_t)jj * DM) = o; }
    }
}
}

namespace rg {
using sc::bf16x8; using sc::f32x4; using sc::u32x4; using sc::mfma; using sc::ldfrag; using sc::QS;
constexpr int L_XL = 0, L_OUT = 64 * QS * 2, OS = 132;
template <int PHASE>
__device__ __forceinline__ void rglru_units(const Params& p, int u0, int ustride, unsigned char* lds_) {
    SLAS unsigned char* lds = (SLAS unsigned char*)lds_;
    const int tid = tid_op(), lane = tid & 63, w = tid >> 6, r = lane & 15, q = lane >> 4;
    const int blk = u0 & 7, ch = blk * 128 + w * 16 + r;
    const bf16* ZS = (const bf16*)(p.ws + OFF_ZS); const bf16* WT = (const bf16*)(p.ws + OFF_W_RG);
    float2* RGS = (float2*)(p.ws + OFF_RGS); bf16* HC = (bf16*)(p.ws + OFF_HC);
    bf16x8 bw[4][4];
#pragma unroll
    for (int mm = 0; mm < 4; ++mm)
#pragma unroll
        for (int ks = 0; ks < 4; ++ks) bw[mm][ks] = *(const bf16x8*)(WT + ((size_t)((mm & 1) * 16 + (mm >> 1) * 8 + blk) * 128 + (w * 16 + r)) * 128 + ks * 32 + 8 * q);
    float ba[2], bx[2], sp[2];
#pragma unroll
    for (int dd = 0; dd < 2; ++dd) { ba[dd] = p.in[I_LBA][dd * 1024 + ch]; bx[dd] = p.in[I_LBX][dd * 1024 + ch]; sp[dd] = -8.f * softplus_f(-p.in[I_LLAM][dd * 1024 + ch]); }
    for (int u = u0; u < 2176; u += ustride) {
        const int bm = u >> 3, b = bm / 68, mc = bm % 68, t0 = mc * 64, lo = (mc < 4) ? 0 : t0, hi = (mc < 4) ? NCTX : t0 + 64;
        const size_t rowbase = (size_t)b * TT;
        __syncthreads();
        if (tid < 256) { const int tg = tid >> 4, cg = tid & 15, m0 = tg * 4, col = blk * 128 + cg * 8; sc::Blk48 v;
            sc::conv_4x8<false>(ZS + 3 * SEG, rowbase, t0, m0, lo, hi, col, p.in[I_LCONVW], 1024, col, p.in[I_LCONVB], 1.f, v);
            sc::put_rows(lds + L_XL, m0, cg * 8, v); }
        float cin0 = 0.f, cin1 = 0.f;
        if (PHASE == 1) {
#pragma unroll
            for (int dd = 0; dd < 2; ++dd) {
                const int n = dd ? ((mc < 4) ? 3 - mc : 71 - mc) : mc, per = (n + 3) >> 2, lo_q = min(q * per, n), hi_q = min(lo_q + per, n);
                float A = 1.f, B = 0.f;
#pragma unroll 4
                for (int cp = lo_q; cp < hi_q; ++cp) { const int mcp = dd ? sc::chunk_of_step(1, cp) : cp; const float2 ab = RGS[((size_t)(b * 68 + mcp) * 2 + dd) * 1024 + ch]; B = ab.x * B + ab.y; A = ab.x * A; }
                float carry = 0.f;
#pragma unroll
                for (int qq = 0; qq < 4; ++qq) { const float Aq = __shfl(A, r + 16 * qq), Bq = __shfl(B, r + 16 * qq); carry = Aq * carry + Bq; }
                if (dd) cin1 = carry; else cin0 = carry; }
        }
        __syncthreads();
        f32x4 av[2][4], bv[2][4];
#pragma unroll
        for (int tb = 0; tb < 4; ++tb) {
            bf16x8 af[4];
#pragma unroll
            for (int ks = 0; ks < 4; ++ks) af[ks] = ldfrag(lds + L_XL, tb * 16 + r, QS, ks * 32 + 8 * q);
            f32x4 acc[4];
#pragma unroll
            for (int mm = 0; mm < 4; ++mm) { acc[mm] = (f32x4){0.f, 0.f, 0.f, 0.f};
#pragma unroll
                for (int ks = 0; ks < 4; ++ks) acc[mm] = mfma(af[ks], bw[mm][ks], acc[mm]); }
            f32x4 xl4;
#pragma unroll
            for (int j = 0; j < 4; ++j) xl4[j] = bf2f(((const SLAS bf16*)(lds + L_XL))[(tb * 16 + 4 * q + j) * QS + w * 16 + r]);
#pragma unroll
            for (int dd = 0; dd < 2; ++dd) { f32x4 a4, b4;
#pragma unroll
                for (int j = 0; j < 4; ++j) { const float rr = sigmoid_f(acc[dd * 2][j] + ba[dd]), ii = sigmoid_f(acc[dd * 2 + 1][j] + bx[dd]);
                    const float a = __expf(rr * sp[dd]); a4[j] = a; b4[j] = sqrtf(fmaxf(1.f - a * a, 0.f)) * (ii * xl4[j]); }
                av[dd][tb] = a4; bv[dd][tb] = b4; }
        }
        f32x4 o[4];
        { float carry = cin0, aprod = 1.f;
#pragma unroll
          for (int tb = 0; tb < 4; ++tb) {
              const f32x4 A = av[0][tb], B = bv[0][tb]; f32x4 hl, ac;
              hl[0] = B[0]; ac[0] = A[0];
#pragma unroll
              for (int j = 1; j < 4; ++j) { hl[j] = A[j] * hl[j - 1] + B[j]; ac[j] = A[j] * ac[j - 1]; }
              float Ae = 1.f, Be = 0.f, At = 1.f, Bt = 0.f;
#pragma unroll
              for (int qq = 0; qq < 4; ++qq) { const float Aq = __shfl(ac[3], r + 16 * qq), Bq = __shfl(hl[3], r + 16 * qq);
                  if (qq < q) { Be = Aq * Be + Bq; Ae = Aq * Ae; }
                  Bt = Aq * Bt + Bq; At = Aq * At; }
              const float hin = Ae * carry + Be;
              o[tb] = ac * hin + hl;
              carry = At * carry + Bt; aprod *= At; }
          if (PHASE == 0 && q == 0) RGS[((size_t)(b * 68 + mc) * 2 + 0) * 1024 + ch] = make_float2(aprod, carry); }
        { float carry = cin1, aprod = 1.f;
#pragma unroll
          for (int tb = 3; tb >= 0; --tb) {
              const f32x4 A = av[1][tb], B = bv[1][tb]; f32x4 hl, ac;
              hl[3] = B[3]; ac[3] = A[3];
#pragma unroll
              for (int j = 2; j >= 0; --j) { hl[j] = A[j] * hl[j + 1] + B[j]; ac[j] = A[j] * ac[j + 1]; }
              float Ae = 1.f, Be = 0.f, At = 1.f, Bt = 0.f;
#pragma unroll
              for (int qq = 3; qq >= 0; --qq) { const float Aq = __shfl(ac[0], r + 16 * qq), Bq = __shfl(hl[0], r + 16 * qq);
                  if (qq > q) { Be = Aq * Be + Bq; Ae = Aq * Ae; }
                  Bt = Aq * Bt + Bq; At = Aq * At; }
              const float hin = Ae * carry + Be;
              o[tb] = o[tb] + (ac * hin + hl);
              carry = At * carry + Bt; aprod *= At; }
          if (PHASE == 0 && q == 0) RGS[((size_t)(b * 68 + mc) * 2 + 1) * 1024 + ch] = make_float2(aprod, carry); }
        if (PHASE == 1) {
            SLAS float* OUT = (SLAS float*)(lds + L_OUT);
#pragma unroll
            for (int tb = 0; tb < 4; ++tb)
#pragma unroll
                for (int j = 0; j < 4; ++j) OUT[(tb * 16 + 4 * q + j) * OS + w * 16 + r] = o[tb][j];
            __syncthreads();
#pragma unroll
            for (int rep = 0; rep < 2; ++rep) { const int idx = tid + rep * 512, t = idx >> 4, cc = idx & 15; const size_t row = rowbase + t0 + t;
                const f32x4 x0 = *(const SLAS f32x4*)(OUT + t * OS + cc * 8), x1 = *(const SLAS f32x4*)(OUT + t * OS + cc * 8 + 4);
                const uint4 g = *(const uint4*)(ZS + 4 * SEG + row * DM + blk * 128 + cc * 8);
                uint4 ov; ov.x = sc::pk2(x0[0] * gelu_f(bf2f(g.x & 0xffffu)), x0[1] * gelu_f(bf2f(g.x >> 16))); ov.y = sc::pk2(x0[2] * gelu_f(bf2f(g.y & 0xffffu)), x0[3] * gelu_f(bf2f(g.y >> 16)));
                ov.z = sc::pk2(x1[0] * gelu_f(bf2f(g.z & 0xffffu)), x1[1] * gelu_f(bf2f(g.z >> 16))); ov.w = sc::pk2(x1[2] * gelu_f(bf2f(g.w & 0xffffu)), x1[3] * gelu_f(bf2f(g.w >> 16)));
                *(uint4*)(HC + row * 2048 + 1024 + blk * 128 + cc * 8) = ov; }
        }
    }
}
}

__device__ __forceinline__ void phase_scan(const Params& p, int layer, float* sm) {
    if (layer == 0) {
        if (gridDim.x == 256) {
            const int u = blockIdx.x;
            if (u < 128) { if ((u >> 2) & 1) sc::mlstm_unit<1>(p, u >> 5, (u >> 3) & 3, u & 3, (unsigned char*)sm); else sc::mlstm_unit<0>(p, u >> 5, (u >> 3) & 3, u & 3, (unsigned char*)sm); }
            else rg::rglru_units<0>(p, u - 128, 128, (unsigned char*)sm);
        } else {
            for (int u = blockIdx.x; u < 128; u += gridDim.x) { if ((u >> 2) & 1) sc::mlstm_unit<1>(p, u >> 5, (u >> 3) & 3, u & 3, (unsigned char*)sm); else sc::mlstm_unit<0>(p, u >> 5, (u >> 3) & 3, u & 3, (unsigned char*)sm); __syncthreads(); }
            if ((gridDim.x & 7) == 0) rg::rglru_units<0>(p, blockIdx.x, gridDim.x, (unsigned char*)sm); else if (blockIdx.x < 8) rg::rglru_units<0>(p, blockIdx.x, 8, (unsigned char*)sm);
        }
    } else {
        for (int u = blockIdx.x; u < 256; u += gridDim.x) {
            if (u < 128) { if ((u >> 2) & 1) sc::gla_unit<1>(p, u >> 5, (u >> 3) & 3, u & 3, (unsigned char*)sm); else sc::gla_unit<0>(p, u >> 5, (u >> 3) & 3, u & 3, (unsigned char*)sm); }
            else { const int w = u - 128; if (w & 1) sc::ssd_unit<1>(p, w >> 5, (w >> 1) & 15, (unsigned char*)sm); else sc::ssd_unit<0>(p, w >> 5, (w >> 1) & 15, (unsigned char*)sm); }
            __syncthreads();
        }
    }
}

__device__ __forceinline__ float sigmoid_fast_(float x) { return __builtin_amdgcn_rcpf(1.f + __expf(-x)); }
__device__ __forceinline__ void phase_mix2(const Params& p, int layer, float* sm) {
    if (layer == 0) { if ((gridDim.x & 7) == 0) rg::rglru_units<1>(p, blockIdx.x, gridDim.x, (unsigned char*)sm); else if (blockIdx.x < 8) rg::rglru_units<1>(p, blockIdx.x, 8, (unsigned char*)sm); }
    const int tid_ = tid_op(); const int lane = tid_ & 63, gw = blockIdx.x * 8 + (tid_ >> 6), NGW = gridDim.x * 8;
    const bf16* ZS = (const bf16*)(p.ws + OFF_ZS); const bf16* SO = (const bf16*)(p.ws + OFF_SO); bf16* HC = (bf16*)(p.ws + OFF_HC);
    for (int pr = gw; pr < MROWS / 2; pr += NGW) {
        const size_t r = (size_t)2 * pr;
        float a0[16], c0[16], g0[16], a1[16], c1[16], g1[16], w[16];
        ld_row_bf16(SO + r * DM, lane, a0); ld_row_bf16(SO + SEG + r * DM, lane, c0); ld_row_bf16(ZS + 2 * SEG + r * DM, lane, g0);
        ld_row_bf16(SO + (r + 1) * DM, lane, a1); ld_row_bf16(SO + SEG + (r + 1) * DM, lane, c1); ld_row_bf16(ZS + 2 * SEG + (r + 1) * DM, lane, g1);
        ld_row_f32(layer == 0 ? p.in[I_MNORMW] : p.in[I_GNORMW], lane, w);
#pragma unroll
        for (int j = 0; j < 4; ++j) {
            float ss0 = 0.f, ss1 = 0.f;
#pragma unroll
            for (int i = 0; i < 4; ++i) { a0[4 * j + i] += c0[4 * j + i]; ss0 += a0[4 * j + i] * a0[4 * j + i]; a1[4 * j + i] += c1[4 * j + i]; ss1 += a1[4 * j + i] * a1[4 * j + i]; }
            const float r0 = __builtin_amdgcn_rsqf(wave_sum(ss0) * (1.f / 256.f) + 1e-6f), r1 = __builtin_amdgcn_rsqf(wave_sum(ss1) * (1.f / 256.f) + 1e-6f);
#pragma unroll
            for (int i = 0; i < 4; ++i) { const float q0 = g0[4 * j + i], q1 = g1[4 * j + i]; const float s0 = sigmoid_fast_(q0), s1 = sigmoid_fast_(q1);
                a0[4 * j + i] = a0[4 * j + i] * r0 * w[4 * j + i] * (layer == 0 ? s0 : q0 * s0); a1[4 * j + i] = a1[4 * j + i] * r1 * w[4 * j + i] * (layer == 0 ? s1 : q1 * s1); }
        }
        st_row_bf16(HC + r * 2048, lane, a0); st_row_bf16(HC + (r + 1) * 2048, lane, a1);
        if (layer == 0) continue;
        ld_row_bf16(SO + 2 * SEG + r * DM, lane, a0); ld_row_bf16(SO + 3 * SEG + r * DM, lane, c0); ld_row_bf16(ZS + 3 * SEG + r * DM, lane, g0);
        ld_row_bf16(SO + 2 * SEG + (r + 1) * DM, lane, a1); ld_row_bf16(SO + 3 * SEG + (r + 1) * DM, lane, c1); ld_row_bf16(ZS + 3 * SEG + (r + 1) * DM, lane, g1);
        ld_row_f32(p.in[I_SNORMW], lane, w);
#pragma unroll
        for (int i = 0; i < 16; ++i) { a0[i] = (a0[i] + c0[i]) * (g0[i] * sigmoid_fast_(g0[i])); a1[i] = (a1[i] + c1[i]) * (g1[i] * sigmoid_fast_(g1[i])); }
        const float r0 = rstd_of(row_ss(a0)), r1 = rstd_of(row_ss(a1));
#pragma unroll
        for (int i = 0; i < 16; ++i) { a0[i] = a0[i] * r0 * w[i]; a1[i] = a1[i] * r1 * w[i]; }
        st_row_bf16(HC + r * 2048 + 1024, lane, a0); st_row_bf16(HC + (r + 1) * 2048 + 1024, lane, a1);
    }
}

__device__ __forceinline__ void phase_route_naive(const Params& p, float* sm) {
    if (blockIdx.x != 0) return;
    int* cnt = (int*)sm; int* cur = cnt + 8; int* base = cnt + 16; const int tid = tid_op();
    const int* TOPI = (const int*)(p.ws + OFF_TOPI); int* SLOT = (int*)(p.ws + OFF_SLOT); int* STOK = (int*)(p.ws + OFF_STOK); int* ctl = (int*)(p.ws + OFF_CTL);
    if (tid < 16) cnt[tid] = 0;
    __syncthreads();
    for (int a = tid; a < 2 * NTOK; a += 512) atomicAdd(&cnt[TOPI[a]], 1);
    __syncthreads();
    if (tid == 0) { int acc = 0; for (int e = 0; e < 8; ++e) { base[e] = acc; ctl[CW_CNT + e] = cnt[e]; ctl[CW_BASE + e] = acc; acc += (cnt[e] + 255) / 256 * 256; } base[8] = acc; ctl[CW_BASE + 8] = acc; ctl[CW_TOT] = acc; }
    __syncthreads();
    for (int s = tid; s < MAXSLOT; s += 512) STOK[s] = -1;
    __syncthreads();
    for (int a = tid; a < 2 * NTOK; a += 512) { const int e = TOPI[a]; const int pos = atomicAdd(&cur[e], 1); const int s = base[e] + pos; SLOT[a] = s; STOK[s] = a >> 1; }
}
__device__ __forceinline__ void phase_gather(const Params& p) {
    const int tid_ = tid_op(); const int lane = tid_ & 63, gw = blockIdx.x * 8 + (tid_ >> 6), NGW = gridDim.x * 8;
    const int* STOK = (const int*)(p.ws + OFF_STOK); const int tot = ((const int*)(p.ws + OFF_CTL))[CW_TOT];
    const bf16* H = (const bf16*)(p.ws + OFF_H); bf16* XS = (bf16*)(p.ws + OFF_XS);
    for (int s = gw; s < tot; s += NGW) {
        const int tok = STOK[s]; uint2* dst = (uint2*)(XS + (size_t)s * DM);
        if (tok < 0) { for (int j = 0; j < 4; ++j) dst[j * 64 + lane] = make_uint2(0u, 0u); }
        else { const int b = tok >> 12, tl = tok & 4095; const uint2* src = (const uint2*)(H + ((size_t)b * TT + NCTX + tl) * DM); for (int j = 0; j < 4; ++j) dst[j * 64 + lane] = src[j * 64 + lane]; }
    }
}

#define XB_TMO      128
#define XB_XCNT(j)  (256  + 64 * (j))
#define XB_XSUB(j)  (1280 + 64 * (j))
#define XB_XGEN(j)  (2304 + 64 * (j))
#define XB_TOP      3328
#define XB_TOPGEN   3392
#define XCD_BAR_WORDS 3456
#define XB_SPIN_CAP (1u << 22)
__device__ __forceinline__ unsigned xb_ld(unsigned* p)              { return __hip_atomic_load(p, __ATOMIC_RELAXED, __HIP_MEMORY_SCOPE_AGENT); }
__device__ __forceinline__ unsigned xb_add(unsigned* p, unsigned v) { return __hip_atomic_fetch_add(p, v, __ATOMIC_RELAXED, __HIP_MEMORY_SCOPE_AGENT); }
__device__ __forceinline__ unsigned xb_xcc_id() { return (unsigned)__builtin_amdgcn_s_getreg((3 << 11) | 20) & 0xFu; }
#define XB_SPIN(cond, bar) do { unsigned _sp = 0; while (cond) { __builtin_amdgcn_s_sleep(1); \
    if ((++_sp & 255u) == 0u) { if (xb_ld(&(bar)[XB_TMO])) break; if (_sp > XB_SPIN_CAP) { atomicAdd(&(bar)[XB_TMO], 1u); break; } } } } while (0)
struct XcdBarrier { unsigned* bar; unsigned x; volatile __attribute__((address_space(3))) unsigned* st; };
__device__ __forceinline__ XcdBarrier xcd_barrier_post(unsigned* bar, volatile __attribute__((address_space(3))) unsigned* st) {
    XcdBarrier b; b.bar = bar; b.x = xb_xcc_id(); b.st = st;
    if (threadIdx.x == 0) (void)xb_add(&bar[XB_XCNT(b.x)], 1u);
    return b;
}
__device__ __forceinline__ void xcd_barrier_complete(unsigned* bar, unsigned x, unsigned& nloc, unsigned& nx) {
    const unsigned G = gridDim.x * gridDim.y * gridDim.z;
    unsigned sum, cnt, mine, sp = 0u;
    for (;;) {
        sum = 0u; cnt = 0u; mine = 0u;
#pragma unroll
        for (unsigned j = 0; j < 16; ++j) { const unsigned c = xb_ld(&bar[XB_XCNT(j)]); sum += c; cnt += (c > 0u) ? 1u : 0u; mine = (j == x) ? c : mine; }
        if (sum == G) break;
        __builtin_amdgcn_s_sleep(1);
        if ((++sp & 255u) == 0u) { if (xb_ld(&bar[XB_TMO])) break; if (sp > XB_SPIN_CAP) { atomicAdd(&bar[XB_TMO], 1u); break; } }
    }
    nloc = mine > 0u ? mine : 1u; nx = cnt > 0u ? cnt : 1u;
}
__device__ __forceinline__ void xcd_barrier(const XcdBarrier& b) {
    asm volatile("s_waitcnt vmcnt(0)" ::: "memory");
    __syncthreads();
    if (threadIdx.x == 0) {
        unsigned* bar = b.bar;
        __builtin_amdgcn_s_waitcnt(0);
        unsigned nloc = b.st[0], nx = b.st[1];
        if (nloc == 0u) { xcd_barrier_complete(bar, b.x, nloc, nx); b.st[0] = nloc; b.st[1] = nx; }
        const unsigned old = xb_add(&bar[XB_XSUB(b.x)], 1u);
        const unsigned gen = old / nloc;
        if (old + 1u == (gen + 1u) * nloc) {
            __builtin_amdgcn_fence(__ATOMIC_RELEASE, "agent");
            asm volatile("s_waitcnt vmcnt(0)" ::: "memory");
            const unsigned og = xb_add(&bar[XB_TOP], 1u);
            const unsigned tg = og / nx;
            if (og + 1u == (tg + 1u) * nx) xb_add(&bar[XB_TOPGEN], 1u);
            else XB_SPIN(xb_ld(&bar[XB_TOPGEN]) == tg, bar);
            __builtin_amdgcn_fence(__ATOMIC_ACQUIRE, "agent");
            xb_add(&bar[XB_XGEN(b.x)], 1u);
            asm volatile("s_waitcnt vmcnt(0)" ::: "memory");
        } else {
            XB_SPIN(xb_ld(&bar[XB_XGEN(b.x)]) == gen, bar);
            __builtin_amdgcn_fence(__ATOMIC_ACQUIRE, "agent");
            asm volatile("s_waitcnt vmcnt(0)" ::: "memory");
        }
    }
    __syncthreads();
}

__global__ void __launch_bounds__(512, 2) mega(Params p) {
    extern __shared__ __attribute__((aligned(16))) unsigned char lds[];
    float* sm = (float*)lds;
    PG8_LAS unsigned char* LDS = (PG8_LAS unsigned char*)lds;
    unsigned char* ws = p.ws;
    bf16* H = (bf16*)(ws + OFF_H); bf16* ZS = (bf16*)(ws + OFF_ZS); float* G = (float*)(ws + OFF_G); bf16* HC = (bf16*)(ws + OFF_HC); float* Y = (float*)(ws + OFF_Y);
    const int* ctl = (const int*)(ws + OFF_CTL);
    volatile __attribute__((address_space(3))) unsigned* bst = (volatile __attribute__((address_space(3))) unsigned*)((PG8_LAS unsigned char*)lds + LDS_BYTES - 64);
    if (threadIdx.x < 2) bst[threadIdx.x] = 0u;
    __syncthreads();
    const XcdBarrier gbar = xcd_barrier_post((unsigned*)(ws + OFF_BAR), bst);

#define PH(k, ...) do { for (int _r = 0; _r < (((REP_MASK >> (k)) & 1) ? 2 : 1); ++_r) { __VA_ARGS__; xcd_barrier(gbar); } } while (0)
    PH(0, phase_mod(p, sm); phase_wconv(p, sm));
    PH(1, phase_norm<0>(p, 0));
    PH(2, { pg8::Gemm g{H, (const bf16*)(ws + OFF_W_ABIN), MROWS, NP_ABIN, DM}; pg8::StaticOrder S; S.init(MROWS, NP_ABIN, gridDim.x, blockIdx.x); pg8::EpiInProj E{ZS, G, 20, 16}; pg8::gemm_phase(LDS, g, S, E); });
    PH(19, sc::prep_conv(p, 0));
    PH(3, phase_scan(p, 0, sm));
    PH(4, phase_mix2(p, 0, sm));
    PH(5, { pg8::Gemm g{HC, (const bf16*)(ws + OFF_W_ABOUT), MROWS, DM, 2048}; pg8::StaticOrder S; S.init(MROWS, DM, gridDim.x, blockIdx.x); pg8::EpiF32 E{Y, DM}; pg8::gemm_phase(LDS, g, S, E); });
    PH(6, phase_norm<1>(p, 0));
    PH(7, { pg8::Gemm g{H, (const bf16*)(ws + OFF_W_FFN1), MROWS, 2 * FFD, DM}; pg8::StaticOrder S; S.init(MROWS, 2 * FFD, gridDim.x, blockIdx.x); pg8::EpiSwiglu E{(bf16*)(ws + OFF_ACT), FFD}; pg8::gemm_phase(LDS, g, S, E); });
    PH(8, { pg8::Gemm g{(const bf16*)(ws + OFF_ACT), (const bf16*)(ws + OFF_W_FFN2), MROWS, DM, FFD}; pg8::StaticOrder S; S.init(MROWS, DM, gridDim.x, blockIdx.x); pg8::EpiF32 E{Y, DM}; pg8::gemm_phase(LDS, g, S, E); });
    PH(9, phase_norm<2>(p, 0));
    PH(10, { pg8::Gemm g{H, (const bf16*)(ws + OFF_W_CDIN), MROWS, NP_CDIN, DM}; pg8::StaticOrder S; S.init(MROWS, NP_CDIN, gridDim.x, blockIdx.x); pg8::EpiInProj E{ZS, G, 22, 64}; pg8::gemm_phase(LDS, g, S, E); });
    PH(20, sc::prep_conv(p, 1); sc::prep_gla(p, (unsigned char*)sm));
    PH(11, phase_scan(p, 1, sm));
    PH(12, phase_mix2(p, 1, sm));
    PH(13, { pg8::Gemm g{HC, (const bf16*)(ws + OFF_W_CDOUT), MROWS, DM, 2048}; pg8::StaticOrder S; S.init(MROWS, DM, gridDim.x, blockIdx.x); pg8::EpiF32 E{Y, DM}; pg8::gemm_phase(LDS, g, S, E); });
    PH(14, phase_norm<1>(p, 1));
    PH(15, phase_route_naive(p, sm));
    PH(16, phase_gather(p));
    PH(17, { pg8::Gemm g{(const bf16*)(ws + OFF_XS), (const bf16*)(ws + OFF_W_MOE1), ctl[CW_TOT], 2 * FFE, DM}; pg8::MoeOrder S; S.init(ctl[CW_TOT], 2 * FFE, gridDim.x, blockIdx.x); S.ctl = ctl; S.estride = (size_t)2 * FFE * DM * 2; pg8::EpiSwiglu E{(bf16*)(ws + OFF_ACTM), FFE}; pg8::gemm_phase(LDS, g, S, E); });
    PH(18, { pg8::Gemm g{(const bf16*)(ws + OFF_ACTM), (const bf16*)(ws + OFF_W_MOE2), ctl[CW_TOT], DM, FFE}; pg8::MoeOrder S; S.init(ctl[CW_TOT], DM, gridDim.x, blockIdx.x); S.ctl = ctl; S.estride = (size_t)DM * FFE * 2; pg8::EpiF32 E{(float*)(ws + OFF_YS), DM}; pg8::gemm_phase(LDS, g, S, E); });
    phase_norm<3>(p, 1);
#ifdef EXTRA_SYNCS
    for (int i_ = 0; i_ < EXTRA_SYNCS; ++i_) xcd_barrier(gbar);
#endif
#undef PH
}

__global__ void nan_fill(float* out, int n) { int i = blockIdx.x * blockDim.x + threadIdx.x; if (i < n) out[i] = __builtin_nanf(""); }

extern "C" void kernel_launch(void* const* d_in, const int* in_sizes, int n_in, void* d_out, int out_size, void* d_ws, size_t ws_size, hipStream_t stream) {
    static int grid_blocks = 0;
    if (grid_blocks == 0) {
        int dev = 0, cus = 0, per_cu = 0;
        hipGetDevice(&dev);
        hipDeviceGetAttribute(&cus, hipDeviceAttributeMultiprocessorCount, dev);
        hipFuncSetAttribute((const void*)mega, hipFuncAttributeMaxDynamicSharedMemorySize, LDS_BYTES);
        hipOccupancyMaxActiveBlocksPerMultiprocessor(&per_cu, (const void*)mega, 512, LDS_BYTES);
        if (per_cu < 1) per_cu = 1;
        grid_blocks = cus * (per_cu > 1 ? 1 : per_cu);
        if (grid_blocks <= 0) grid_blocks = 256;
    }
    if (n_in != 37 || ws_size < WS_NEED) { fprintf(stderr, "kernel_launch: bad n_in %d or ws %zu < %zu\n", n_in, ws_size, (size_t)WS_NEED); nan_fill<<<(out_size + 255) / 256, 256, 0, stream>>>((float*)d_out, out_size); return; }
    Params p{};
    for (int i = 0; i < 37; ++i) p.in[i] = (const float*)d_in[i];
    p.out = (float*)d_out; p.ws = (unsigned char*)d_ws;
    if (hipMemsetAsync(d_ws, 0, 65536, stream) != hipSuccess) { fprintf(stderr, "kernel_launch: memset failed\n"); return; }
    hipLaunchKernelGGL(mega, dim3(grid_blocks), dim3(512), LDS_BYTES, stream, p);
    const hipError_t e = hipPeekAtLastError();
    if (e != hipSuccess) fprintf(stderr, "launch failed: %s (grid %d)\n", hipGetErrorString(e), grid_blocks);
}
```

```cpp
#include <hip/hip_runtime.h>
#include <cstdio>
#include <cstdint>

typedef unsigned short bf16;

constexpr int NB = 4, SEQ = 4096, NCTX = 256, TT = 4352, MROWS = NB * TT, DM = 1024;
constexpr int NTOK = NB * SEQ;
constexpr int FFD = 2816, FFE = 3584, NEXP = 8;
constexpr int AB_IN = 5136, CD_IN = 5696;
constexpr int MAXSLOT = 2 * NTOK + NEXP * 256;
constexpr float F8_XS = 4.f, F8_W1S = 128.f, F8_AS = 4.f, F8_W2S = 256.f;

constexpr size_t MiB = 1u << 20;
constexpr size_t OFF_CTL = 0, OFF_MOD = 1 * MiB, OFF_G = 2 * MiB, OFF_XC = 7 * MiB, OFF_TOPI = 11 * MiB, OFF_TOPG = 11 * MiB + 256 * 1024,
                 OFF_SLOT = 11 * MiB + 512 * 1024, OFF_STOK = 12 * MiB, OFF_RGS = 13 * MiB, OFF_H = 18 * MiB, OFF_ZS = 52 * MiB,
                 OFF_SO = 256 * MiB, OFF_HC = 392 * MiB, OFF_Y = 460 * MiB, OFF_W = 528 * MiB;
constexpr int NP_ABIN = 5376, NP_CDIN = 5888;
constexpr size_t OFF_W_ABIN = OFF_W, OFF_W_ABOUT = OFF_W_ABIN + (size_t)NP_ABIN * 1024 * 2, OFF_W_FFN1 = OFF_W_ABOUT + (size_t)1024 * 2048 * 2,
                 OFF_W_FFN2 = OFF_W_FFN1 + (size_t)5632 * 1024 * 2, OFF_W_CDIN = OFF_W_FFN2 + (size_t)1024 * 2816 * 2, OFF_W_CDOUT = OFF_W_CDIN + (size_t)NP_CDIN * 1024 * 2,
                 OFF_W_MOE1 = OFF_W_CDOUT + (size_t)1024 * 2048 * 2, OFF_W_MOE2 = OFF_W_MOE1 + (size_t)8 * 7168 * 1024 * 2, OFF_W_RG = OFF_W_MOE2 + (size_t)8 * 1024 * 3584 * 2, OFF_W_END = OFF_W_RG + (size_t)32 * 128 * 128 * 2;
constexpr size_t OFF_XB = (OFF_W_END + MiB - 1) / MiB * MiB;
constexpr size_t WS_NEED = OFF_XB + (size_t)MROWS * DM * 2;
constexpr size_t SEG = (size_t)MROWS * DM;
constexpr size_t OFF_ACT = OFF_ZS, OFF_XS = OFF_HC, OFF_ACTM = OFF_ZS, OFF_YS = OFF_HC;
constexpr int CW_CNT = 0, CW_BASE = 8, CW_TOT = 17;

#ifndef REP_MASK
#define REP_MASK 0
#endif
constexpr int LDS_BYTES = 147456;
constexpr size_t OFF_BAR = 4096;
#if defined(PROBE_SC) && PROBE_SC == 1
#define PROBE_STAGE_REPS 2
#else
#define PROBE_STAGE_REPS 1
#endif
struct Params { const float* in[37]; float* out; unsigned char* ws; };
enum { I_X = 0, I_C, I_CTX, I_CCTX, I_MODW, I_MODB, I_NORMG, I_ABIN, I_MCONVW, I_MCONVB, I_MGATEB, I_MNORMW, I_LCONVW, I_LCONVB, I_LWA, I_LBA, I_LWX, I_LBX,
       I_LLAM, I_ABOUT, I_FFN1, I_FFN2, I_CDIN, I_GALW, I_GALB, I_GNORMW, I_SCONVW, I_SCONVB, I_SDTB, I_SALOG, I_SD, I_SNORMW, I_CDOUT, I_RW, I_RB, I_MOE1, I_MOE2 };

__device__ __forceinline__ float bf2f(unsigned v) { return __uint_as_float(v << 16); }
__device__ __forceinline__ unsigned f2bf(float f) { unsigned u = __float_as_uint(f); return (u + 0x7fffu + ((u >> 16) & 1u)) >> 16; }
__device__ __forceinline__ float sigmoid_f(float x) { return 1.f / (1.f + expf(-x)); }
__device__ __forceinline__ float silu_f(float x) { return x / (1.f + expf(-x)); }
__device__ __forceinline__ float softplus_f(float x) { return fmaxf(x, 0.f) + log1pf(expf(-fabsf(x))); }
__device__ __forceinline__ float logsigmoid_f(float x) { return -softplus_f(-x); }
__device__ __forceinline__ float gelu_fast(float x) { const float u2 = 1.5957691216057308f * (x + 0.044715f * x * x * x); return x * __builtin_amdgcn_rcpf(1.f + __expf(-u2)); }
__device__ __forceinline__ float gelu_f(float x) { return 0.5f * x * (1.f + tanhf(0.7978845608028654f * (x + 0.044715f * x * x * x))); }
__device__ __forceinline__ float wave_sum(float v) {
#pragma unroll
    for (int o = 32; o >= 1; o >>= 1) v += __shfl_xor(v, o);
    return v;
}
__device__ __forceinline__ int tid_op() { int t = threadIdx.x; asm volatile("" : "+v"(t)); return t; }
__device__ __forceinline__ void ld_row_f32(const float* row, int lane, float (&v)[16]) {
#pragma unroll
    for (int j = 0; j < 4; ++j) { const float4 t = ((const float4*)row)[j * 64 + lane]; v[4 * j] = t.x; v[4 * j + 1] = t.y; v[4 * j + 2] = t.z; v[4 * j + 3] = t.w; }
}
__device__ __forceinline__ void st_row_f32(float* row, int lane, const float (&v)[16]) {
#pragma unroll
    for (int j = 0; j < 4; ++j) ((float4*)row)[j * 64 + lane] = make_float4(v[4 * j], v[4 * j + 1], v[4 * j + 2], v[4 * j + 3]);
}
__device__ __forceinline__ void ld_row_bf16(const bf16* row, int lane, float (&v)[16]) {
#pragma unroll
    for (int j = 0; j < 4; ++j) { const uint2 t = ((const uint2*)row)[j * 64 + lane]; v[4 * j] = bf2f(t.x & 0xffffu); v[4 * j + 1] = bf2f(t.x >> 16); v[4 * j + 2] = bf2f(t.y & 0xffffu); v[4 * j + 3] = bf2f(t.y >> 16); }
}
__device__ __forceinline__ void st_row_bf16(bf16* row, int lane, const float (&v)[16]) {
#pragma unroll
    for (int j = 0; j < 4; ++j) { uint2 t; t.x = f2bf(v[4 * j]) | (f2bf(v[4 * j + 1]) << 16); t.y = f2bf(v[4 * j + 2]) | (f2bf(v[4 * j + 3]) << 16); ((uint2*)row)[j * 64 + lane] = t; }
}
__device__ __forceinline__ unsigned pack4_fp8(float a, float b, float c, float d) {
    a = __builtin_amdgcn_fmed3f(a, -448.f, 448.f); b = __builtin_amdgcn_fmed3f(b, -448.f, 448.f); c = __builtin_amdgcn_fmed3f(c, -448.f, 448.f); d = __builtin_amdgcn_fmed3f(d, -448.f, 448.f);
    int w = __builtin_amdgcn_cvt_pk_fp8_f32(a, b, 0, false); w = __builtin_amdgcn_cvt_pk_fp8_f32(c, d, w, true); return (unsigned)w;
}
__device__ __forceinline__ void st_row_fp8(unsigned char* row, int lane, const float (&v)[16], float sc) {
#pragma unroll
    for (int j = 0; j < 4; ++j) ((unsigned*)row)[j * 64 + lane] = pack4_fp8(v[4 * j] * sc, v[4 * j + 1] * sc, v[4 * j + 2] * sc, v[4 * j + 3] * sc);
}
__device__ __forceinline__ void ld_row_parts(const float* P, int KS, size_t rows_per_part, size_t row, int lane, float (&v)[16]) {
#pragma unroll
    for (int i = 0; i < 16; ++i) v[i] = 0.f;
    for (int kz = 0; kz < KS; ++kz) { float t[16]; ld_row_f32(P + ((size_t)kz * rows_per_part + row) * DM, lane, t);
#pragma unroll
        for (int i = 0; i < 16; ++i) v[i] += t[i]; }
}
__device__ __forceinline__ float row_ss(const float (&v)[16]) { float s = 0.f;
#pragma unroll
    for (int i = 0; i < 16; ++i) s += v[i] * v[i];
    return wave_sum(s); }

__device__ __forceinline__ void seg_bounds(int t, int& lo, int& hi) { if (t < NCTX) { lo = 0; hi = NCTX; } else { lo = NCTX + ((t - NCTX) & ~63); hi = lo + 64; } }
__device__ __forceinline__ float conv4(const bf16* Z, int b, int t, int c, const float* w, int wstride, int wc, float bias) {
    int lo, hi; seg_bounds(t, lo, hi); float s = bias;
#pragma unroll
    for (int j = 0; j < 4; ++j) { const int tt = t + j - 2; if (tt >= lo && tt < hi) s += w[j * wstride + wc] * bf2f(Z[((size_t)(b * TT + tt)) * DM + c]); }
    return s;
}
__device__ __forceinline__ int tokmap(int dir, int tau) { return dir ? (tau < NCTX ? (NCTX - 1 - tau) : (TT + NCTX - 1 - tau)) : tau; }

__device__ __forceinline__ void phase_mod(const Params& p, float* sm) {
    float* sv = sm; float* red = sm + 5 * 1024; const int tid = tid_op();
    if (blockIdx.x == 48) { float* RWT = (float*)(p.ws + OFF_MOD + 512 * 1024); for (int i = tid; i < 8 * 1024; i += 512) RWT[i] = p.in[I_RW][(size_t)(i & 1023) * 8 + (i >> 10)]; }
    if (blockIdx.x < 48) {
        for (int i = tid; i < 5 * 1024; i += 512) { const int v = i >> 10, k = i & 1023; const float x = (v < 4) ? p.in[I_C][v * 1024 + k] : p.in[I_CCTX][k]; sv[i] = silu_f(x); }
        __syncthreads();
        float* MOD = (float*)(p.ws + OFF_MOD);
        for (int it = blockIdx.x; it < 48; it += gridDim.x) {
            const int l = it / 24, j0 = (it % 24) * 256, c4 = (tid & 63) * 4, kg = tid >> 6;
            const float* w = p.in[I_MODW] + (size_t)l * 1024 * 6144 + j0 + c4;
            float a[5][4];
#pragma unroll
            for (int v = 0; v < 5; ++v)
#pragma unroll
                for (int e = 0; e < 4; ++e) a[v][e] = 0.f;
#pragma unroll 8
            for (int k = kg * 128; k < kg * 128 + 128; ++k) { const float4 wv = *(const float4*)(w + (size_t)k * 6144);
#pragma unroll
                for (int v = 0; v < 5; ++v) { const float x = sv[v * 1024 + k]; a[v][0] += x * wv.x; a[v][1] += x * wv.y; a[v][2] += x * wv.z; a[v][3] += x * wv.w; } }
#pragma unroll
            for (int v = 0; v < 5; ++v) *(float4*)(red + (kg * 5 + v) * 256 + c4) = make_float4(a[v][0], a[v][1], a[v][2], a[v][3]);
            __syncthreads();
            for (int o = tid; o < 5 * 256; o += 512) { const int v = o >> 8, cc = o & 255; float sacc = 0.f;
#pragma unroll
                for (int g = 0; g < 8; ++g) sacc += red[(g * 5 + v) * 256 + cc];
                MOD[(size_t)(l * 5 + v) * 6144 + j0 + cc] = sacc + p.in[I_MODB][l * 6144 + j0 + cc]; }
            __syncthreads();
        }
    }
}

__device__ __forceinline__ float rstd_of(float ss) { return __builtin_amdgcn_rsqf(ss * (1.f / DM) + 1e-6f); }
__device__ __forceinline__ void router_reduce_pick(const Params& p, float (&lg)[8], int lane, int tok, int* hist) {
    float v4[4], v2[2], v1;
    { const bool hi = lane & 32;
#pragma unroll
      for (int e = 0; e < 4; ++e) { const float send = hi ? lg[e] : lg[e + 4], keep = hi ? lg[e + 4] : lg[e]; v4[e] = keep + __shfl_xor(send, 32); } }
    { const bool hi = lane & 16;
#pragma unroll
      for (int e = 0; e < 2; ++e) { const float send = hi ? v4[e] : v4[e + 2], keep = hi ? v4[e + 2] : v4[e]; v2[e] = keep + __shfl_xor(send, 16); } }
    { const bool hi = lane & 8; const float send = hi ? v2[0] : v2[1], keep = hi ? v2[1] : v2[0]; v1 = keep + __shfl_xor(send, 8); }
    v1 += __shfl_xor(v1, 4); v1 += __shfl_xor(v1, 2); v1 += __shfl_xor(v1, 1);
#pragma unroll
    for (int e = 0; e < 8; ++e) lg[e] = __shfl(v1, e * 8) + p.in[I_RB][e];
    if (lane == 0) {
        int e0 = 0; float l0 = lg[0];
#pragma unroll
        for (int e = 1; e < 8; ++e) if (lg[e] > l0) { l0 = lg[e]; e0 = e; }
        int e1 = -1; float l1 = -3.0e38f;
#pragma unroll
        for (int e = 0; e < 8; ++e) if (e != e0 && lg[e] > l1) { l1 = lg[e]; e1 = e; }
        const float ex = __expf(l1 - l0), g0 = 1.f / (1.f + ex), g1 = ex / (1.f + ex);
        ((int*)(p.ws + OFF_TOPI))[tok * 2] = e0; ((int*)(p.ws + OFF_TOPI))[tok * 2 + 1] = e1;
        ((float*)(p.ws + OFF_TOPG))[tok * 2] = g0; ((float*)(p.ws + OFF_TOPG))[tok * 2 + 1] = g1;
        atomicAdd(&hist[e0], 1); atomicAdd(&hist[e1], 1);
    }
}
__device__ __forceinline__ void router_pair(const Params& p, const float (&xa)[16], const float (&xb)[16], int lane, int tok, int* hist, const float* rw) {
#ifdef DIAG_NOROUTER
    return;
#endif
    float la[8], lb[8];
#pragma unroll
    for (int e = 0; e < 8; ++e) { la[e] = 0.f; lb[e] = 0.f; }
#pragma unroll
    for (int e = 0; e < 8; ++e)
#pragma unroll
        for (int j = 0; j < 4; ++j) { const float4 w = ((const float4*)(rw + e * 1024))[j * 64 + lane];
            la[e] += xa[4 * j] * w.x + xa[4 * j + 1] * w.y + xa[4 * j + 2] * w.z + xa[4 * j + 3] * w.w; lb[e] += xb[4 * j] * w.x + xb[4 * j + 1] * w.y + xb[4 * j + 2] * w.z + xb[4 * j + 3] * w.w; }
    router_reduce_pick(p, la, lane, tok, hist); router_reduce_pick(p, lb, lane, tok + 1, hist);
}
template <int MODE> __device__ __forceinline__ void phase_norm(const Params& p, int layer, int* hist, int KS = 0) {
    const int tid_ = tid_op(); const int lane = tid_ & 63, gw = blockIdx.x * 8 + (tid_ >> 6), NGW = gridDim.x * 8;
    const float* MOD = (const float*)(p.ws + OFF_MOD);
    const float* NG = p.in[I_NORMG] + (size_t)layer * 4 * 1024;
    bf16* H = (bf16*)(p.ws + OFF_H); const bf16* Y = (const bf16*)(p.ws + OFF_Y);
    const bool last = (layer == 1);
    const float* rw = (const float*)(hist + 64);
    if (MODE == 1 && last) { if (tid_ < 64) hist[tid_] = 0; const float* RWT = (const float*)(p.ws + OFF_MOD + 512 * 1024); for (int i = tid_; i < 2048; i += 512) ((float4*)(hist + 64))[i] = ((const float4*)RWT)[i]; __syncthreads(); }
    const int npair = (KS > 0) ? NTOK / 2 : MROWS / 2, nitem = npair + ((KS > 0) ? (MROWS - NTOK) : 0);
    for (int it = gw; it < nitem; it += NGW) {
        const bool two = it < npair; const int pr = it;
        const int r = two ? 2 * pr : NTOK + (it - npair), b = r / TT, t = r % TT; const bool isctx = t < NCTX; const int v = isctx ? 4 : b;
        if ((MODE == 3 || (MODE == 1 && last)) && isctx) continue;
        const float* mv = MOD + (size_t)(layer * 5 + v) * 6144;
        const float* xin = isctx ? (p.in[I_CTX] + ((size_t)b * NCTX + t) * DM) : (p.in[I_X] + ((size_t)b * SEQ + (t - NCTX)) * DM);
        bf16* xst = (bf16*)(p.ws + OFF_XB) + (size_t)r * DM;
        float xa[16], xb[16], g[16], a[16], s[16];
        if (MODE == 0) {
            ld_row_f32(xin, lane, xa); ld_row_f32(xin + DM, lane, xb);
            ld_row_f32(NG, lane, g); ld_row_f32(mv + 1024, lane, a); ld_row_f32(mv, lane, s);
            const float ra = rstd_of(row_ss(xa)), rb = rstd_of(row_ss(xb));
#pragma unroll
            for (int i = 0; i < 16; ++i) { const float gg = g[i] * (1.f + a[i]); xa[i] = xa[i] * ra * gg + s[i]; xb[i] = xb[i] * rb * gg + s[i]; }
            st_row_bf16(H + (size_t)r * DM, lane, xa); st_row_bf16(H + (size_t)(r + 1) * DM, lane, xb);
        } else if (MODE == 1 || MODE == 2) {
            float ya[16], yb[16];
            if (!two) { const float* P = (const float*)(p.ws + OFF_SO); ld_row_parts(P, KS, 1024, (size_t)(r - NTOK), lane, ya); }
            else { ld_row_bf16(Y + (size_t)r * DM, lane, ya); ld_row_bf16(Y + (size_t)(r + 1) * DM, lane, yb); }
            if (MODE == 1 && layer == 0) { ld_row_f32(xin, lane, xa); if (two) ld_row_f32(xin + DM, lane, xb); } else { ld_row_bf16(xst, lane, xa); if (two) ld_row_bf16(xst + DM, lane, xb); }
            if (!two) {
#pragma unroll
                for (int i = 0; i < 16; ++i) { yb[i] = ya[i]; xb[i] = xa[i]; } }
            ld_row_f32(NG + (MODE == 1 ? 1 : 3) * 1024, lane, g); ld_row_f32(mv + (MODE == 1 ? 2 : 5) * 1024, lane, a);
            const float ra = rstd_of(row_ss(ya)), rb = rstd_of(row_ss(yb));
#pragma unroll
            for (int i = 0; i < 16; ++i) { const float gg = a[i] * g[i]; xa[i] += gg * (ya[i] * ra); xb[i] += gg * (yb[i] * rb); }
            st_row_bf16(xst, lane, xa); if (two) st_row_bf16(xst + DM, lane, xb);
            const float* ng2 = (MODE == 1) ? (NG + 2 * 1024) : (p.in[I_NORMG] + (size_t)4 * 1024);
            const float* mv2 = (MODE == 1) ? mv : (MOD + (size_t)(5 + v) * 6144);
            ld_row_f32(ng2, lane, g); ld_row_f32(mv2 + (MODE == 1 ? 4 : 1) * 1024, lane, a); ld_row_f32(mv2 + (MODE == 1 ? 3 : 0) * 1024, lane, s);
            const float ra2 = rstd_of(row_ss(xa)), rb2 = rstd_of(row_ss(xb));
#pragma unroll
            for (int i = 0; i < 16; ++i) { const float gg = g[i] * (1.f + a[i]); xa[i] = xa[i] * ra2 * gg + s[i]; xb[i] = xb[i] * rb2 * gg + s[i]; }
            if (MODE == 1) { unsigned char* H8 = (unsigned char*)H; st_row_fp8(H8 + (size_t)r * DM, lane, xa, F8_XS); if (two) st_row_fp8(H8 + (size_t)(r + 1) * DM, lane, xb, F8_XS); }
            else { st_row_bf16(H + (size_t)r * DM, lane, xa); if (two) st_row_bf16(H + (size_t)(r + 1) * DM, lane, xb); }
            if (MODE == 1 && last) { const int tok = b * SEQ + (t - NCTX); router_pair(p, xa, xb, lane, tok, hist + (tid_ >> 6) * 8, rw); }
        } else {
            const int tok = b * SEQ + (t - NCTX);
            const int4 sl = *(const int4*)((const int*)(p.ws + OFF_SLOT) + tok * 2); const float4 gt = *(const float4*)((const float*)(p.ws + OFF_TOPG) + tok * 2);
            const bf16* YS = (const bf16*)(p.ws + OFF_YS);
            float ya[16], yb[16];
            const float* PS = (const float*)(p.ws + OFF_YS + 68 * MiB);
            if (sl.x >= 2 * NTOK) ld_row_parts(PS, 7, 2048, (size_t)(sl.x - 2 * NTOK), lane, ya); else ld_row_bf16(YS + (size_t)sl.x * DM, lane, ya);
            if (sl.y >= 2 * NTOK) ld_row_parts(PS, 7, 2048, (size_t)(sl.y - 2 * NTOK), lane, a); else ld_row_bf16(YS + (size_t)sl.y * DM, lane, a);
            if (sl.z >= 2 * NTOK) ld_row_parts(PS, 7, 2048, (size_t)(sl.z - 2 * NTOK), lane, yb); else ld_row_bf16(YS + (size_t)sl.z * DM, lane, yb);
            if (sl.w >= 2 * NTOK) ld_row_parts(PS, 7, 2048, (size_t)(sl.w - 2 * NTOK), lane, s); else ld_row_bf16(YS + (size_t)sl.w * DM, lane, s);
            ld_row_bf16(xst, lane, xa); ld_row_bf16(xst + DM, lane, xb);
#pragma unroll
            for (int i = 0; i < 16; ++i) { ya[i] = ya[i] * gt.x + a[i] * gt.y; yb[i] = yb[i] * gt.z + s[i] * gt.w; }
            ld_row_f32(NG + 3 * 1024, lane, g); ld_row_f32(mv + 5 * 1024, lane, a);
            const float ra = rstd_of(row_ss(ya)), rb = rstd_of(row_ss(yb));
#pragma unroll
            for (int i = 0; i < 16; ++i) { const float gg = a[i] * g[i]; xa[i] += gg * (ya[i] * ra); xb[i] += gg * (yb[i] * rb); }
            float* xo = p.out + ((size_t)b * SEQ + (t - NCTX)) * DM; st_row_f32(xo, lane, xa); st_row_f32(xo + DM, lane, xb);
        }
    }
    if (MODE == 1 && last) { __syncthreads(); if (tid_ < 64) ((int*)(p.ws + OFF_STOK))[blockIdx.x * 64 + tid_] = hist[tid_]; }
}

namespace pg8 {
#define PG8_LAS __attribute__((address_space(3)))
typedef unsigned short bf16_t;
typedef short bf16x8 __attribute__((ext_vector_type(8)));
typedef float f32x4 __attribute__((ext_vector_type(4)));
typedef unsigned u32x4 __attribute__((ext_vector_type(4)));
typedef unsigned u32x2 __attribute__((ext_vector_type(2)));
typedef int i32x4 __attribute__((ext_vector_type(4)));
typedef int i32x8 __attribute__((ext_vector_type(8)));
constexpr int BM = 256, BK = 64, HALF = 128, HTB = HALF * BK * 2, STAGE_BYTES = 8 * HTB, NXCD = 8, WGM = 8;
__host__ __device__ __forceinline__ int lds_byte(int r, int c) { const int st = (r >> 4) * 2 + (c >> 5), rr = r & 15, cc = c & 31, ob = rr * 64 + cc * 2; return st * 1024 + (ob ^ (((ob >> 9) & 1) << 5)); }
__host__ __device__ __forceinline__ void stage_rc(int b, int& R, int& C) { const int st = b / 1024, sb = b % 1024, swz = sb ^ (((sb >> 9) & 1) << 5); R = (st >> 1) * 16 + swz / 64; C = (st & 1) * 32 + (swz % 64) / 2; }
__host__ __device__ __forceinline__ int perm32(int rho) { const int n = rho >> 4, i = rho & 15; return 8 * (i >> 2) + 4 * n + (i & 3); }
struct Unit { int pm, pn, kz; };
struct Gemm { const bf16_t* A; const bf16_t* Bt; int M, N, K, ld; };
struct StaticOrder {
    int nM, nN, nwg, G, c;
    __device__ void init(int M, int N, int G_, int c_) { nM = M / BM; nN = N / BM; nwg = nM * nN; G = G_; c = c_; }
    __device__ bool next(int i, Unit& u) const {
        const long L = (long)i * G + c; if (L >= nwg) return false;
        int wgid = (int)L; { const int q = nwg / NXCD, r = nwg % NXCD, xcd = wgid % NXCD, off = wgid / NXCD; wgid = (xcd < r ? xcd * (q + 1) : r * (q + 1) + (xcd - r) * q) + off; }
        const int nig = WGM * nN, gid = wgid / nig, fm = gid * WGM, gsz = (nM - fm) < WGM ? (nM - fm) : WGM;
        u.pm = fm + ((wgid % nig) % gsz); u.pn = (wgid % nig) / gsz; u.kz = 0; return true;
    }
    __device__ __forceinline__ size_t boff(const Unit&) const { return 0; }
    __device__ __forceinline__ size_t koff(const Unit&) const { return 0; }
};
struct SplitOrder {
    int base, novf, KS, kpart, G, c; const int* ctl; size_t estride;
    __device__ bool next(int i, Unit& u) const { const int L = i * G + c; if (L >= novf * 4 * KS) return false; u.kz = L % KS; const int rest = L / KS; u.pn = rest & 3; u.pm = base + (rest >> 2); return true; }
    __device__ __forceinline__ size_t koff(const Unit& u) const { return (size_t)u.kz * kpart * 2; }
    __device__ __forceinline__ size_t boff(const Unit& u) const { if (!ctl) return 0; const int row0 = u.pm * 256; int e = 0;
#pragma unroll
        for (int i = 1; i < 8; ++i) if (row0 >= ctl[CW_BASE + i]) e = i;
        return (size_t)e * estride; }
};
template <bool SC> struct EpiPartT { static constexpr bool PERM = false;
    float* P; int base, novf_max; float sc = 1.f;
    __device__ __forceinline__ void operator()(const f32x4 (&acc)[2][2][4][2], const Unit& u, int wr, int wc, int fr, int fq) const {
        asm volatile("" : "+v"(fr));
        float* C = P + ((size_t)u.kz * novf_max + (u.pm - base)) * 256 * 1024; const int row0 = wr * 64 + fr, col0 = u.pn * BM + wc * 32 + 4 * fq;
#pragma unroll
        for (int ai = 0; ai < 2; ++ai)
#pragma unroll
            for (int m = 0; m < 4; ++m) { float* rowp = C + (size_t)(row0 + ai * HALF + m * 16) * 1024 + col0;
#pragma unroll
                for (int bj = 0; bj < 2; ++bj)
#pragma unroll
                    for (int n = 0; n < 2; ++n) *(f32x4*)(rowp + bj * HALF + n * 16) = SC ? acc[ai][bj][m][n] * sc : acc[ai][bj][m][n]; }
    }
};
typedef EpiPartT<false> EpiPart; typedef EpiPartT<true> EpiPartS;
struct SkipCtxOrder : StaticOrder {
    __device__ bool next(int i, Unit& u) const { if (!StaticOrder::next(i, u)) return false; u.pm = u.pm + (u.pm >> 4) + 1; return true; }
};
struct InProj1Order : StaticOrder {
    __device__ bool next(int i, Unit& u) const {
        const long L = (long)i * G + c;
        if (L < nwg) { StaticOrder::next(i, u); u.pm = u.pm + (u.pm >> 4) + 1; return true; }
        const int idx = (int)(L - nwg); if (idx >= 48) return false;
        const int j = idx % 12; u.pm = (idx / 12) * 17; u.pn = j < 6 ? 2 + j : (j < 11 ? 10 + j : 22); u.kz = 0; return true;
    }
};
struct MoeOrder : StaticOrder {
    const int* ctl; size_t estride;
    __device__ __forceinline__ size_t boff(const Unit& u) const { const int row0 = u.pm * 256; int e = 0;
#pragma unroll
        for (int i = 1; i < 8; ++i) if (row0 >= ctl[CW_BASE + i]) e = i;
        return (size_t)e * estride; }
};
__device__ __forceinline__ unsigned cvt_pk_bf16(float lo, float hi) { unsigned r; asm volatile("v_cvt_pk_bf16_f32 %0, %1, %2" : "=v"(r) : "v"(lo), "v"(hi)); return r; }
__device__ __forceinline__ float silu_fast(float x) { return x * __builtin_amdgcn_rcpf(1.f + __expf(-x)); }
struct EpiF32 { static constexpr bool PERM = false;
    float* C; int ldc;
    __device__ __forceinline__ void operator()(const f32x4 (&acc)[2][2][4][2], const Unit& u, int wr, int wc, int fr, int fq) const {
        const int row0 = u.pm * BM + wr * 64 + fr, col0 = u.pn * BM + wc * 32 + 4 * fq;
#pragma unroll
        for (int ai = 0; ai < 2; ++ai)
#pragma unroll
            for (int m = 0; m < 4; ++m) { float* rowp = C + (size_t)(row0 + ai * HALF + m * 16) * ldc + col0;
#pragma unroll
                for (int bj = 0; bj < 2; ++bj)
#pragma unroll
                    for (int n = 0; n < 2; ++n) *(f32x4*)(rowp + bj * HALF + n * 16) = acc[ai][bj][m][n]; }
    }
};
template <bool SC> struct EpiBf16T { static constexpr bool PERM = true;
    bf16_t* O; int ldc; float sc = 1.f;
    __device__ __forceinline__ void operator()(const f32x4 (&acc)[2][2][4][2], const Unit& u, int wr, int wc, int fr, int fq) const {
        const int row0 = u.pm * BM + wr * 64 + fr, col0 = u.pn * BM + wc * 32 + 8 * fq;
#pragma unroll
        for (int ai = 0; ai < 2; ++ai)
#pragma unroll
            for (int m = 0; m < 4; ++m) { bf16_t* rowp = O + (size_t)(row0 + ai * HALF + m * 16) * ldc + col0;
#pragma unroll
                for (int bj = 0; bj < 2; ++bj) { const f32x4 v0 = SC ? acc[ai][bj][m][0] * sc : acc[ai][bj][m][0], v1 = SC ? acc[ai][bj][m][1] * sc : acc[ai][bj][m][1];
                    u32x4 w; w.x = cvt_pk_bf16(v0[0], v0[1]); w.y = cvt_pk_bf16(v0[2], v0[3]); w.z = cvt_pk_bf16(v1[0], v1[1]); w.w = cvt_pk_bf16(v1[2], v1[3]);
                    *(u32x4*)(rowp + bj * HALF) = w; } }
    }
};
typedef EpiBf16T<false> EpiBf16; typedef EpiBf16T<true> EpiBf16S;
struct EpiInProj { static constexpr bool PERM = true;
    bf16_t* ZS; float* G; int gate_tile, ngate;
    __device__ __forceinline__ void operator()(const f32x4 (&acc)[2][2][4][2], const Unit& u, int wr, int wc, int fr, int fq) const {
        const int row0 = u.pm * BM + wr * 64 + fr;
        if (u.pn == gate_tile) {
            if (wc < 2) {
#pragma unroll
                for (int ai = 0; ai < 2; ++ai)
#pragma unroll
                    for (int m = 0; m < 4; ++m)
#pragma unroll
                        for (int n = 0; n < 2; ++n) { const int c0 = 32 * wc + 8 * fq + 4 * n; if (c0 < ngate) *(f32x4*)(G + (size_t)(row0 + ai * HALF + m * 16) * 64 + c0) = acc[ai][0][m][n]; }
            }
        } else {
            bf16_t* base = ZS + (size_t)(u.pn >> 2) * SEG; const int col0 = (u.pn & 3) * 256 + wc * 32 + 8 * fq;
#pragma unroll
            for (int ai = 0; ai < 2; ++ai)
#pragma unroll
                for (int m = 0; m < 4; ++m) { bf16_t* rowp = base + (size_t)(row0 + ai * HALF + m * 16) * DM + col0;
#pragma unroll
                    for (int bj = 0; bj < 2; ++bj) { const f32x4 v0 = acc[ai][bj][m][0], v1 = acc[ai][bj][m][1];
                        u32x4 w; w.x = cvt_pk_bf16(v0[0], v0[1]); w.y = cvt_pk_bf16(v0[2], v0[3]); w.z = cvt_pk_bf16(v1[0], v1[1]); w.w = cvt_pk_bf16(v1[2], v1[3]);
                        *(u32x4*)(rowp + bj * HALF) = w; } }
        }
    }
};
struct EpiSwiglu { static constexpr bool PERM = true;
    bf16_t* O; int ldo;
    __device__ __forceinline__ void operator()(const f32x4 (&acc)[2][2][4][2], const Unit& u, int wr, int wc, int fr, int fq) const {
        const int row0 = u.pm * BM + wr * 64 + fr, col0 = u.pn * HALF + wc * 32 + 8 * fq;
#pragma unroll
        for (int ai = 0; ai < 2; ++ai)
#pragma unroll
            for (int m = 0; m < 4; ++m) { const f32x4 g0 = acc[ai][0][m][0], g1 = acc[ai][0][m][1], u0 = acc[ai][1][m][0], u1 = acc[ai][1][m][1];
                u32x4 w; w.x = cvt_pk_bf16(silu_fast(g0[0]) * u0[0], silu_fast(g0[1]) * u0[1]); w.y = cvt_pk_bf16(silu_fast(g0[2]) * u0[2], silu_fast(g0[3]) * u0[3]);
                w.z = cvt_pk_bf16(silu_fast(g1[0]) * u1[0], silu_fast(g1[1]) * u1[1]); w.w = cvt_pk_bf16(silu_fast(g1[2]) * u1[2], silu_fast(g1[3]) * u1[3]);
                *(u32x4*)(O + (size_t)(row0 + ai * HALF + m * 16) * ldo + col0) = w; }
    }
};

struct EpiSwigluF8 { static constexpr bool PERM = true;
    unsigned char* O; int ldo; float dsc, osc;
    __device__ __forceinline__ void operator()(const f32x4 (&acc)[2][2][4][2], const Unit& u, int wr, int wc, int fr, int fq) const {
        const int row0 = u.pm * BM + wr * 64 + fr, col0 = u.pn * HALF + wc * 32 + 8 * fq;
#pragma unroll
        for (int ai = 0; ai < 2; ++ai)
#pragma unroll
            for (int m = 0; m < 4; ++m) { const f32x4 g0 = acc[ai][0][m][0] * dsc, g1 = acc[ai][0][m][1] * dsc, u0 = acc[ai][1][m][0] * (dsc * osc), u1 = acc[ai][1][m][1] * (dsc * osc);
                u32x2 w; w.x = pack4_fp8(silu_fast(g0[0]) * u0[0], silu_fast(g0[1]) * u0[1], silu_fast(g0[2]) * u0[2], silu_fast(g0[3]) * u0[3]);
                w.y = pack4_fp8(silu_fast(g1[0]) * u1[0], silu_fast(g1[1]) * u1[1], silu_fast(g1[2]) * u1[2], silu_fast(g1[3]) * u1[3]);
                *(u32x2*)(O + (size_t)(row0 + ai * HALF + m * 16) * ldo + col0) = w; }
    }
};

template <class Epi, class Sched, bool F8 = false>
__device__ __forceinline__ void gemm_phase(PG8_LAS unsigned char* lds, const Gemm g, const Sched& S, const Epi& E) {
    const int tid = tid_op(), wid = __builtin_amdgcn_readfirstlane(tid >> 6), lane = tid & 63, wr = wid >> 2, wc = wid & 3, fr = lane & 15, fq = lane >> 4;
    const int K = g.ld, nt = g.K / BK;
    unsigned voffA[2], voffB[2];
#pragma unroll
    for (int i = 0; i < 2; ++i) { int R, C; stage_rc(tid * 16 + i * 8192, R, C); const int Rb = Epi::PERM ? ((R & ~31) + perm32(R & 31)) : R;
        voffA[i] = (unsigned)(R * K + C) * 2u; voffB[i] = (unsigned)(Rb * K + C) * 2u; }
    const size_t kstep = (size_t)(BK * 2);
    const size_t hstep = (size_t)HALF * K * 2;
    const size_t tstep = 2 * hstep;
    const unsigned ldsw = (unsigned)wid * 1024u;
    const int aoff = lds_byte(wr * 64 + fr, fq * 8), boff = lds_byte(wc * 32 + fr, fq * 8);
#define PG8_SA(b, h) (((b) * 2 + (h)) * HTB)
#define PG8_SB(b, h) ((4 + (b) * 2 + (h)) * HTB)
#define PG8_STAGE(bufoff, gbase, voff) do { _Pragma("unroll") for (int _i = 0; _i < 2; ++_i) \
        __builtin_amdgcn_global_load_lds((const unsigned*)((const char*)(gbase) + (voff)[_i]), (PG8_LAS unsigned*)(lds + (bufoff) + ldsw + _i * 8192), 16, 0, 0); } while (0)
#define PG8_LD16(p_) (*(const PG8_LAS i32x4*)(p_))
#define PG8_LDA(dst, b, h) do { if (F8) { _Pragma("unroll") for (int m = 0; m < 4; ++m) dst##8[m] = __builtin_shufflevector(PG8_LD16(lds + PG8_SA(b, h) + aoff + m * 2048), PG8_LD16(lds + PG8_SA(b, h) + aoff + m * 2048 + 1024), 0, 1, 2, 3, 4, 5, 6, 7); } \
      else { _Pragma("unroll") for (int m = 0; m < 4; ++m) _Pragma("unroll") for (int k = 0; k < 2; ++k) dst[m][k] = *(const PG8_LAS bf16x8*)(lds + PG8_SA(b, h) + aoff + m * 2048 + k * 1024); } } while (0)
#define PG8_LDB(dst, b, h) do { if (F8) { _Pragma("unroll") for (int n = 0; n < 2; ++n) dst##8[n] = __builtin_shufflevector(PG8_LD16(lds + PG8_SB(b, h) + boff + n * 2048), PG8_LD16(lds + PG8_SB(b, h) + boff + n * 2048 + 1024), 0, 1, 2, 3, 4, 5, 6, 7); } \
      else { _Pragma("unroll") for (int n = 0; n < 2; ++n) _Pragma("unroll") for (int k = 0; k < 2; ++k) dst[n][k] = *(const PG8_LAS bf16x8*)(lds + PG8_SB(b, h) + boff + n * 2048 + k * 1024); } } while (0)
#define PG8_MMA(ai, bj, At, Bt) do { __builtin_amdgcn_s_setprio(1); if (F8) { _Pragma("unroll") for (int m = 0; m < 4; ++m) _Pragma("unroll") for (int n = 0; n < 2; ++n) \
        asm volatile("v_mfma_f32_16x16x128_f8f6f4 %0, %1, %2, %0" : "+v"(acc[ai][bj][m][n]) : "v"(Bt##8[n]), "v"(At##8[m])); } \
      else { _Pragma("unroll") for (int m = 0; m < 4; ++m) _Pragma("unroll") for (int n = 0; n < 2; ++n) _Pragma("unroll") for (int k = 0; k < 2; ++k) \
        acc[ai][bj][m][n] = __builtin_amdgcn_mfma_f32_16x16x32_bf16(Bt[n][k], At[m][k], acc[ai][bj][m][n], 0, 0, 0); } __builtin_amdgcn_s_setprio(0); } while (0)
#define PG8_ACCF8(a_, b_) asm volatile("" : "+v"(acc[a_][b_][0][0]), "+v"(acc[a_][b_][0][1]), "+v"(acc[a_][b_][1][0]), "+v"(acc[a_][b_][1][1]), "+v"(acc[a_][b_][2][0]), "+v"(acc[a_][b_][2][1]), "+v"(acc[a_][b_][3][0]), "+v"(acc[a_][b_][3][1]))
#define PG8_ACC_FENCE() do { if (F8) { PG8_ACCF8(0, 0); PG8_ACCF8(0, 1); PG8_ACCF8(1, 0); PG8_ACCF8(1, 1); asm volatile("s_nop 7" ::: "memory"); } } while (0)
#define PG8_WAIT_V(n) asm volatile("s_waitcnt vmcnt(" #n ")" ::: "memory")
#define PG8_WAIT_L(n) asm volatile("s_waitcnt lgkmcnt(" #n ")" ::: "memory")
#define PG8_BAR __builtin_amdgcn_s_barrier()
#define PG8_SCHED __builtin_amdgcn_sched_barrier(0)
    Unit cur, nxt; int ui = 0;
    if (!S.next(0, cur)) return;
    f32x4 acc[2][2][4][2];
#pragma unroll
    for (int a = 0; a < 2; ++a)
#pragma unroll
        for (int b = 0; b < 2; ++b)
#pragma unroll
            for (int m = 0; m < 4; ++m)
#pragma unroll
                for (int n = 0; n < 2; ++n) acc[a][b][m][n] = (f32x4){0.f, 0.f, 0.f, 0.f};
    PG8_ACC_FENCE();
    bf16x8 At[4][2], B0[2][2], B1[2][2]; i32x8 At8[4], B08[2], B18[2];
    const char* cA = (const char*)g.A + (size_t)cur.pm * tstep + S.koff(cur); const char* cB = (const char*)g.Bt + S.boff(cur) + (size_t)cur.pn * tstep + S.koff(cur);
    PG8_STAGE(PG8_SB(0, 0), cB, voffB); PG8_STAGE(PG8_SB(0, 1), cB + hstep, voffB); PG8_STAGE(PG8_SA(0, 0), cA, voffA); PG8_STAGE(PG8_SA(0, 1), cA + hstep, voffA);
    if (wr == 1) PG8_BAR;
    PG8_WAIT_V(2); PG8_BAR;
    PG8_STAGE(PG8_SB(1, 0), cB + kstep, voffB); PG8_STAGE(PG8_SA(1, 0), cA + kstep, voffA); PG8_STAGE(PG8_SB(1, 1), cB + hstep + kstep, voffB);
    PG8_WAIT_V(6); PG8_BAR;
    for (;;) {
        const bool has_next = S.next(ui + 1, nxt);
        const char* nA = has_next ? (const char*)g.A + (size_t)nxt.pm * tstep + S.koff(nxt) : cA; const char* nB = has_next ? (const char*)g.Bt + S.boff(nxt) + (size_t)nxt.pn * tstep + S.koff(nxt) : cB;
        for (int t = 0; t < nt; t += 2) {
            const bool last = (t == nt - 2);
            const char* a1 = cA + (size_t)(t + 1) * kstep;
            const char* a2 = last ? nA : cA + (size_t)(t + 2) * kstep; const char* b2 = last ? nB : cB + (size_t)(t + 2) * kstep;
            const char* a3 = a2 + kstep; const char* b3 = b2 + kstep;
            PG8_LDB(B0, 0, 0); PG8_LDB(B1, 0, 1); PG8_SCHED; PG8_LDA(At, 0, 0); PG8_STAGE(PG8_SA(1, 1), a1 + hstep, voffA);
            PG8_WAIT_V(8); PG8_WAIT_L(0); PG8_BAR; PG8_MMA(0, 0, At, B0); PG8_MMA(0, 1, At, B1); PG8_BAR; PG8_SCHED;
            PG8_LDA(At, 0, 1); PG8_STAGE(PG8_SB(0, 0), b2, voffB); PG8_STAGE(PG8_SB(0, 1), b2 + hstep, voffB); PG8_STAGE(PG8_SA(0, 0), a2, voffA);
            PG8_WAIT_V(8); PG8_WAIT_L(0); PG8_BAR; PG8_MMA(1, 0, At, B0); PG8_MMA(1, 1, At, B1); PG8_BAR; PG8_SCHED;
            PG8_LDB(B0, 1, 0); PG8_LDB(B1, 1, 1); PG8_SCHED; PG8_LDA(At, 1, 0); PG8_STAGE(PG8_SA(0, 1), a2 + hstep, voffA);
            PG8_WAIT_V(8); PG8_WAIT_L(0); PG8_BAR; PG8_MMA(0, 0, At, B0); PG8_MMA(0, 1, At, B1); PG8_BAR; PG8_SCHED;
            PG8_LDA(At, 1, 1); PG8_STAGE(PG8_SB(1, 0), b3, voffB); PG8_STAGE(PG8_SB(1, 1), b3 + hstep, voffB); PG8_STAGE(PG8_SA(1, 0), a3, voffA);
            PG8_WAIT_V(8); PG8_WAIT_L(0); PG8_BAR; PG8_MMA(1, 0, At, B0); PG8_MMA(1, 1, At, B1); PG8_BAR; PG8_SCHED;
        }
        if (F8) { asm volatile("s_nop 15\n\ts_nop 15\n\ts_nop 15\n\ts_nop 15" ::: "memory"); PG8_ACCF8(0, 0); PG8_ACCF8(0, 1); PG8_ACCF8(1, 0); PG8_ACCF8(1, 1); }
        if (wr == 0) PG8_BAR;
        E(acc, cur, wr, wc, fr, fq);
        if (!has_next) break;
#pragma unroll
        for (int a = 0; a < 2; ++a)
#pragma unroll
            for (int b = 0; b < 2; ++b)
#pragma unroll
                for (int m = 0; m < 4; ++m)
#pragma unroll
                    for (int n = 0; n < 2; ++n) acc[a][b][m][n] = (f32x4){0.f, 0.f, 0.f, 0.f};
        PG8_ACC_FENCE();
        cur = nxt; cA = nA; cB = nB; ++ui;
        if (wr == 1) PG8_BAR;
    }
    PG8_WAIT_V(0);
    PG8_BAR;
#undef PG8_SA
#undef PG8_SB
#undef PG8_STAGE
#undef PG8_LDA
#undef PG8_LD16
#undef PG8_LDB
#undef PG8_MMA
#undef PG8_WAIT_V
#undef PG8_ACCF8
#undef PG8_ACC_FENCE
#undef PG8_WAIT_L
#undef PG8_BAR
#undef PG8_SCHED
}
template <class Epi, class Sched> __device__ __forceinline__ void gemm_phase_f8(PG8_LAS unsigned char* lds, const Gemm g, const Sched& S, const Epi& E) { gemm_phase<Epi, Sched, true>(lds, g, S, E); }
}

__device__ __forceinline__ int wsrccol(int map, int n, int FF) {
    if (map == 0) return n;
    if (map == 1) return n < 3072 ? n : (n < 5120 ? n + 16 : (n < 5136 ? 3072 + (n - 5120) : -1));
    if (map == 2) return n < 3072 ? n : (n < 5632 ? n + 32 : (n < 5664 ? 3072 + (n - 5632) : (n < 5696 ? n : -1)));
    const int tile = n >> 8, i = n & 255; return (i < 128) ? tile * 128 + i : FF + tile * 128 + (i - 128);
}
typedef float sc4f __attribute__((ext_vector_type(4)));
struct WItem { const float* W; bf16* WT; int ldsrc, K, nblk, map, FF, item; float wsc; };
struct WRegs { float4 v[16]; };
__device__ __forceinline__ void wconv_load(const WItem& d, int lane, WRegs& R) {
    const bool f8 = d.wsc != 0.f;
    const int kb = d.item / d.nblk, nb = d.item % d.nblk, k0 = (f8 ? 128 : 64) * kb, n0 = (f8 ? 32 : 64) * nb, n4 = (f8 ? (lane & 7) : (lane & 15)) * 4, kr = f8 ? (lane >> 3) : (lane >> 4), kstep = f8 ? 8 : 4;
    const int sc = wsrccol(d.map, n0 + n4, d.FF);
#pragma unroll
    for (int i = 0; i < 16; ++i) { if (sc >= 0) { const sc4f t = __builtin_nontemporal_load((const sc4f*)(d.W + (size_t)(k0 + kstep * i + kr) * d.ldsrc + sc)); R.v[i] = make_float4(t[0], t[1], t[2], t[3]); } else R.v[i] = make_float4(0.f, 0.f, 0.f, 0.f); }
}
__device__ __forceinline__ void wconv_finish(const WItem& d, int lane, const WRegs& R, float* scr) {
    if (d.wsc != 0.f) {
        const int kb = d.item / d.nblk, nb = d.item % d.nblk, k0 = 128 * kb, n0 = 32 * nb, n4 = (lane & 7) * 4, kr = lane >> 3; const float ws_ = d.wsc;
#pragma unroll
        for (int i = 0; i < 16; ++i) { float* q = scr + (8 * i + kr) * 33 + n4; q[0] = R.v[i].x; q[1] = R.v[i].y; q[2] = R.v[i].z; q[3] = R.v[i].w; }
        asm volatile("s_waitcnt lgkmcnt(0)" ::: "memory");
        const int c = lane & 7;
#pragma unroll
        for (int j = 0; j < 4; ++j) { const int n = (lane >> 3) + 8 * j; const float* q = scr + (16 * c) * 33 + n;
            uint4 o; o.x = pack4_fp8(q[0 * 33] * ws_, q[1 * 33] * ws_, q[2 * 33] * ws_, q[3 * 33] * ws_); o.y = pack4_fp8(q[4 * 33] * ws_, q[5 * 33] * ws_, q[6 * 33] * ws_, q[7 * 33] * ws_);
            o.z = pack4_fp8(q[8 * 33] * ws_, q[9 * 33] * ws_, q[10 * 33] * ws_, q[11 * 33] * ws_); o.w = pack4_fp8(q[12 * 33] * ws_, q[13 * 33] * ws_, q[14 * 33] * ws_, q[15 * 33] * ws_);
            *(uint4*)((unsigned char*)d.WT + (size_t)(n0 + n) * d.K + k0 + 16 * c) = o; }
        asm volatile("s_waitcnt lgkmcnt(0)" ::: "memory");
        return;
    }
    const int kb = d.item / d.nblk, nb = d.item % d.nblk, k0 = 64 * kb, n0 = 64 * nb, n4 = (lane & 15) * 4, kr = lane >> 4;
#pragma unroll
    for (int i = 0; i < 16; ++i) { float* q = scr + (4 * i + kr) * 65 + n4; q[0] = R.v[i].x; q[1] = R.v[i].y; q[2] = R.v[i].z; q[3] = R.v[i].w; }
    asm volatile("s_waitcnt lgkmcnt(0)" ::: "memory");
    const int c = lane & 7;
#pragma unroll
    for (int j = 0; j < 8; ++j) { const int n = (lane >> 3) + 8 * j; const float* q = scr + (8 * c) * 65 + n;
        uint4 o; o.x = f2bf(q[0 * 65]) | (f2bf(q[1 * 65]) << 16); o.y = f2bf(q[2 * 65]) | (f2bf(q[3 * 65]) << 16); o.z = f2bf(q[4 * 65]) | (f2bf(q[5 * 65]) << 16); o.w = f2bf(q[6 * 65]) | (f2bf(q[7 * 65]) << 16);
        *(uint4*)(d.WT + (size_t)(n0 + n) * d.K + k0 + 8 * c) = o; }
    asm volatile("s_waitcnt lgkmcnt(0)" ::: "memory");
}
__device__ __forceinline__ WItem wconv_decode(const Params& p, int r) {
    constexpr int I0 = 16 * (NP_ABIN / 64), I1 = 32 * 16, I2 = 16 * (5632 / 64), I3 = 44 * 16, I4 = 16 * (NP_CDIN / 64), I5 = 32 * 16, I6 = 16 * (7168 / 64), I7 = 56 * 16;
    constexpr int NIT = I0 + I1 + I2 + I3 + I4 + I5;
    unsigned char* ws = p.ws;
    if (r >= NIT) { r -= NIT; const int mtx = r >> 2; return WItem{(mtx < 16 ? p.in[I_LWA] : p.in[I_LWX]) + (size_t)(mtx & 15) * 128 * 128, (bf16*)(ws + OFF_W_RG) + (size_t)mtx * 128 * 128, 128, 128, 2, 0, 0, r & 3}; }
    if (r < I0) return WItem{p.in[I_ABIN], (bf16*)(ws + OFF_W_ABIN), AB_IN, 1024, NP_ABIN / 64, 1, 0, r}; r -= I0;
    if (r < I1) return WItem{p.in[I_ABOUT], (bf16*)(ws + OFF_W_ABOUT), 1024, 2048, 16, 0, 0, r}; r -= I1;
    if (r < I2) return WItem{p.in[I_FFN1], (bf16*)(ws + OFF_W_FFN1), 5632, 1024, 5632 / 32, 3, FFD, r, F8_W1S}; r -= I2;
    if (r < I3) return WItem{p.in[I_FFN2], (bf16*)(ws + OFF_W_FFN2), 1024, 2816, 32, 0, 0, r, F8_W2S}; r -= I3;
    if (r < I4) return WItem{p.in[I_CDIN], (bf16*)(ws + OFF_W_CDIN), CD_IN, 1024, NP_CDIN / 64, 2, 0, r}; r -= I4;
    if (r < I5) return WItem{p.in[I_CDOUT], (bf16*)(ws + OFF_W_CDOUT), 1024, 2048, 16, 0, 0, r}; r -= I5;
    return WItem{p.in[I_CDOUT], (bf16*)(ws + OFF_W_CDOUT), 1024, 2048, 16, 0, 0, r % I5};
}
__device__ __forceinline__ void phase_wconv(const Params& p, float* sm, int part, int gwb, int NGW) {
    const int tid = tid_op(), lane = tid & 63, wave = tid >> 6;
    float* scr = sm + wave * (128 * 33);
    constexpr int NTOT = 16 * (NP_ABIN / 64) + 32 * 16 + 16 * (5632 / 64) + 44 * 16 + 16 * (NP_CDIN / 64) + 32 * 16 + 32 * 4;
    (void)part; (void)NGW;
    const int grp = gwb & 31; unsigned* tick = (unsigned*)(p.ws + OFF_CTL + 65536) + 64 * grp;
#define WC_TICKET() ((int)__builtin_amdgcn_readfirstlane((lane == 0) ? (int)__hip_atomic_fetch_add(tick, 1u, __ATOMIC_RELAXED, __HIP_MEMORY_SCOPE_AGENT) : 0) * 32 + grp)
    int itA = WC_TICKET();
    if (itA >= NTOT) return;
    WItem dA = wconv_decode(p, itA), dB = dA; WRegs RA, RB;
    wconv_load(dA, lane, RA);
    for (;;) {
        const int itB = WC_TICKET(); const bool hB = itB < NTOT;
        if (hB) { dB = wconv_decode(p, itB); wconv_load(dB, lane, RB); }
        wconv_finish(dA, lane, RA, scr);
        if (!hB) break;
        itA = WC_TICKET(); const bool hA = itA < NTOT;
        if (hA) { dA = wconv_decode(p, itA); wconv_load(dA, lane, RA); }
        wconv_finish(dB, lane, RB, scr);
        if (!hA) break;
    }
#undef WC_TICKET
}

namespace sc {
#if defined(DIAG_SEL) && DIAG_SEL >= 10
#define DSTAMP(k) do { const unsigned long long n_ = __builtin_amdgcn_s_memrealtime(); dacc[k] += n_ - dlast; dlast = n_; } while (0)
#define DARGS , unsigned long long (&dacc)[8], unsigned long long& dlast
#define DPASS , dacc, dlast
#else
#define DSTAMP(k) do {} while (0)
#define DARGS
#define DPASS
#endif
typedef short bf16x8 __attribute__((ext_vector_type(8)));
typedef float f32x4 __attribute__((ext_vector_type(4)));
#define SLAS __attribute__((address_space(3)))
typedef unsigned u32x2 __attribute__((ext_vector_type(2)));
typedef unsigned u32x4 __attribute__((ext_vector_type(4)));
constexpr int QS = 136, TS = 72;
constexpr int L_QA = 0, L_KA = L_QA + 64 * QS * 2, L_KT = L_KA + 64 * QS * 2, L_VU = L_KT + 128 * TS * 2, L_VS = L_VU + 80 * TS * 2, L_ST0 = L_VS + 80 * TS * 2,
              L_ST1 = L_ST0 + 80 * QS * 2, L_P = L_ST1 + 80 * QS * 2, L_SC = L_P + 64 * TS * 2, L_END = L_SC + 2048 + 2048;
__device__ __forceinline__ bf16x8 ldfrag(const SLAS unsigned char* base, int row, int stride, int k) { return *(const SLAS bf16x8*)(base + (size_t)(row * stride + k) * 2); }
typedef float f32x2_t __attribute__((ext_vector_type(2)));
typedef __bf16 bf16x2_t __attribute__((ext_vector_type(2)));
__device__ __forceinline__ unsigned pk2(float lo, float hi) { f32x2_t v = {lo, hi}; bf16x2_t b = __builtin_convertvector(v, bf16x2_t); return __builtin_bit_cast(unsigned, b); }
__device__ __forceinline__ f32x4 mfma(bf16x8 a, bf16x8 b, f32x4 c) { return __builtin_amdgcn_mfma_f32_16x16x32_bf16(a, b, c, 0, 0, 0); }
__device__ __forceinline__ int kt_off(int d, int s) { return (d * TS + ((((s >> 3) ^ (d >> 3)) & 7) << 3) + (s & 7)) * 2; }
__device__ __forceinline__ int chunk_of_step(int dir, int c) { return dir ? (c < 4 ? 3 - c : 71 - c) : c; }

template <int MODE, int dir>
__device__ __forceinline__ void chunk_compute(SLAS unsigned char* lds, int cur, f32x4 (&S)[5], float decs, float dskip, bf16* obase  , int b, int t0, int tid DARGS) {
    constexpr bool ONES = (MODE == 0), PERD = (MODE == 1), EXPD = (MODE != 1);
    const int lane = tid & 63, w = __builtin_amdgcn_readfirstlane(tid >> 6), r = lane & 15, q = lane >> 4;
    const SLAS unsigned char* Qa = lds + L_QA; const SLAS unsigned char* Ka = lds + L_KA; const SLAS unsigned char* KT = lds + L_KT;
    const SLAS unsigned char* VU = lds + L_VU; const SLAS unsigned char* VS = lds + (MODE == 1 ? L_VU : L_VS);
    const SLAS unsigned char* STc = lds + (cur ? L_ST1 : L_ST0); SLAS unsigned char* STn = lds + (cur ? L_ST0 : L_ST1);
    SLAS unsigned char* P = lds + L_P; const SLAS float* scal = (const SLAS float*)(lds + L_SC);
    DSTAMP(2);
#if defined(PROBE_SC) && PROBE_SC == 4
    __syncthreads(); __syncthreads(); __syncthreads();
#endif
#if defined(PROBE_SC) && PROBE_SC == 5
    if (tid == 0) __builtin_amdgcn_s_sleep(127);
#endif
    {
        const int sb = w >> 1, tbA = (w & 1) * 2;
        const bool on0 = dir ? (sb >= tbA) : (sb <= tbA), on1 = dir ? (sb >= tbA + 1) : (sb <= tbA + 1);
        bf16x8 a[4], b0[4], b1[4];
#pragma unroll
        for (int ks = 0; ks < 4; ++ks) { a[ks] = ldfrag(Ka, sb * 16 + r, QS, ks * 32 + 8 * q); b0[ks] = ldfrag(Qa, tbA * 16 + r, QS, ks * 32 + 8 * q); b1[ks] = ldfrag(Qa, tbA * 16 + 16 + r, QS, ks * 32 + 8 * q); }
        f32x4 acc0 = {0.f, 0.f, 0.f, 0.f}, acc1 = {0.f, 0.f, 0.f, 0.f};
#pragma unroll
        for (int ks = 0; ks < 4; ++ks) { if (on0) acc0 = mfma(a[ks], b0[ks], acc0); if (on1) acc1 = mfma(a[ks], b1[ks], acc1); }
        const f32x4 csv = EXPD ? *(const SLAS f32x4*)(scal + 64 + sb * 16 + 4 * q) : (f32x4){0.f, 0.f, 0.f, 0.f};
#pragma unroll
        for (int tt = 0; tt < 2; ++tt) {
            const int tb = tbA + tt, t = tb * 16 + r; const f32x4 acc = tt ? acc1 : acc0; const bool on = tt ? on1 : on0;
            float pv[4] = {0.f, 0.f, 0.f, 0.f};
            if (on) { const float btv = EXPD ? scal[t] : 0.f;
#pragma unroll
                for (int j = 0; j < 4; ++j) { const int sidx = sb * 16 + 4 * q + j; float v = acc[j]; if (EXPD) v *= __expf(btv + csv[j]); v = (dir ? (sidx >= t) : (sidx <= t)) ? v : 0.f; if (MODE == 2 && sidx == t) v += dskip; pv[j] = v; } }
            u32x2 o; o.x = pk2(pv[0], pv[1]); o.y = pk2(pv[2], pv[3]);
            *(SLAS u32x2*)(P + (size_t)(t * TS + sb * 16 + 4 * q) * 2) = o;
        }
    }
    DSTAMP(3);
    const int tb2 = w & 3, vb0 = (w >> 2) * 2, t2 = tb2 * 16 + r;
    const float rsv = EXPD ? scal[128 + t2] : 1.f;
    f32x4 oa0 = {0.f, 0.f, 0.f, 0.f}, oa1 = {0.f, 0.f, 0.f, 0.f}, oad = {0.f, 0.f, 0.f, 0.f};
    {
        bf16x8 bq[4], s0[4], s1[4], sd[4];
#pragma unroll
        for (int ks = 0; ks < 4; ++ks) { bq[ks] = ldfrag(Qa, t2, QS, ks * 32 + 8 * q); s0[ks] = ldfrag(STc, vb0 * 16 + r, QS, ks * 32 + 8 * q); s1[ks] = ldfrag(STc, vb0 * 16 + 16 + r, QS, ks * 32 + 8 * q);
            if (ONES) sd[ks] = ldfrag(STc, 64 + r, QS, ks * 32 + 8 * q); }
#pragma unroll
        for (int ks = 0; ks < 4; ++ks) { oa0 = mfma(s0[ks], bq[ks], oa0); oa1 = mfma(s1[ks], bq[ks], oa1); if (ONES) oad = mfma(sd[ks], bq[ks], oad); }
        if (EXPD) { oa0 = oa0 * rsv; oa1 = oa1 * rsv; if (ONES) oad = oad * rsv; }
    }
    {
        const int d0 = w * 16; constexpr int NT = 4 + (ONES ? 1 : 0);
        bf16x8 ak[2], vs[NT][2];
#pragma unroll
        for (int ks = 0; ks < 2; ++ks) { ak[ks] = *(const SLAS bf16x8*)(KT + kt_off(d0 + r, ks * 32 + 8 * q));
#pragma unroll
            for (int vb = 0; vb < NT; ++vb) vs[vb][ks] = ldfrag(VS, vb * 16 + r, TS, ks * 32 + 8 * q); }
        f32x4 dv = {decs, decs, decs, decs};
        if (PERD) dv = *(const SLAS f32x4*)(scal + 192 + d0 + 4 * q);
#pragma unroll
        for (int vb = 0; vb < NT; ++vb) S[vb] = S[vb] * dv;
#pragma unroll
        for (int ks = 0; ks < 2; ++ks)
#pragma unroll
            for (int vb = 0; vb < NT; ++vb) S[vb] = mfma(ak[ks], vs[vb][ks], S[vb]);
#pragma unroll
        for (int vb = 0; vb < NT; ++vb) { u32x2 o; o.x = pk2(S[vb][0], S[vb][1]); o.y = pk2(S[vb][2], S[vb][3]);
            *(SLAS u32x2*)(STn + (size_t)((vb * 16 + r) * QS + d0 + 4 * q) * 2) = o; }
    }
    DSTAMP(4);
    __syncthreads();
    DSTAMP(5);
    {
        bf16x8 bp[2], v0[2], v1[2], vd[2];
#pragma unroll
        for (int ks = 0; ks < 2; ++ks) { bp[ks] = ldfrag(P, t2, TS, ks * 32 + 8 * q); v0[ks] = ldfrag(VU, vb0 * 16 + r, TS, ks * 32 + 8 * q); v1[ks] = ldfrag(VU, vb0 * 16 + 16 + r, TS, ks * 32 + 8 * q);
            if (ONES) vd[ks] = ldfrag(VU, 64 + r, TS, ks * 32 + 8 * q); }
#pragma unroll
        for (int ks = 0; ks < 2; ++ks) { oa0 = mfma(v0[ks], bp[ks], oa0); oa1 = mfma(v1[ks], bp[ks], oa1); if (ONES) oad = mfma(vd[ks], bp[ks], oad); }
        if (ONES) { const float den = __shfl(oad[0], r); const float rden = __builtin_amdgcn_rcpf(fmaxf(fabsf(den), 1.f)); oa0 = oa0 * rden; oa1 = oa1 * rden; }
        bf16* orow = obase + ((size_t)b * TT + t0 + t2) * DM + vb0 * 16 + 4 * q;
        uint2 o; o.x = pk2(oa0[0], oa0[1]); o.y = pk2(oa0[2], oa0[3]); *(uint2*)(orow) = o;
        o.x = pk2(oa1[0], oa1[1]); o.y = pk2(oa1[2], oa1[3]); *(uint2*)(orow + 16) = o;
    }
    DSTAMP(6);
}

struct Blk48 { f32x4 lo[4], hi[4]; };
struct Rows7 { uint4 r[7]; };
__device__ __forceinline__ f32x4 bf4lo(uint4 v) { return (f32x4){bf2f(v.x & 0xffffu), bf2f(v.x >> 16), bf2f(v.y & 0xffffu), bf2f(v.y >> 16)}; }
__device__ __forceinline__ f32x4 bf4hi(uint4 v) { return (f32x4){bf2f(v.z & 0xffffu), bf2f(v.z >> 16), bf2f(v.w & 0xffffu), bf2f(v.w >> 16)}; }
__device__ __forceinline__ float silu_fast(float x) { return x * __builtin_amdgcn_rcpf(1.f + __expf(-x)); }
__device__ __forceinline__ float sigmoid_fast(float x) { return __builtin_amdgcn_rcpf(1.f + __expf(-x)); }
__device__ __forceinline__ float softplus_fast(float x) { return fmaxf(x, 0.f) + __logf(1.f + __expf(-fabsf(x))); }
__device__ __forceinline__ f32x4 silu4(f32x4 x, float sc) { return (f32x4){silu_fast(x[0]) * sc, silu_fast(x[1]) * sc, silu_fast(x[2]) * sc, silu_fast(x[3]) * sc}; }
template <bool ACT> __device__ __forceinline__ void conv_4x8(const bf16* Z, size_t rowbase, int t0, int m0, int lo, int hi, int col, const float* cw, int wstride, int wcol, const float* cb, float scale, Blk48& out) {
    Rows7 R;
#pragma unroll
    for (int rr = 0; rr < 7; ++rr) { const int tt = t0 + m0 + rr - 2; uint4 v = make_uint4(0u, 0u, 0u, 0u);
        if (tt >= lo && tt < hi) v = *(const uint4*)(Z + (rowbase + tt) * DM + col);
        R.r[rr] = v; }
    f32x4 wlo[4], whi[4];
#pragma unroll
    for (int j = 0; j < 4; ++j) { wlo[j] = *(const f32x4*)(cw + (size_t)j * wstride + wcol); whi[j] = *(const f32x4*)(cw + (size_t)j * wstride + wcol + 4); }
    const f32x4 blo = *(const f32x4*)(cb + wcol), bhi = *(const f32x4*)(cb + wcol + 4);
#pragma unroll
    for (int jj = 0; jj < 4; ++jj) { f32x4 a = blo, c = bhi;
#pragma unroll
        for (int j = 0; j < 4; ++j) { a = a + wlo[j] * bf4lo(R.r[jj + j]); c = c + whi[j] * bf4hi(R.r[jj + j]); }
        if (ACT) { a = silu4(a, scale); c = silu4(c, scale); }
        out.lo[jj] = a; out.hi[jj] = c; }
}
__device__ __forceinline__ void put_rows(SLAS unsigned char* tile, int m0, int ch, const Blk48& v) {
#pragma unroll
    for (int jj = 0; jj < 4; ++jj) { u32x4 o; o.x = pk2(v.lo[jj][0], v.lo[jj][1]); o.y = pk2(v.lo[jj][2], v.lo[jj][3]); o.z = pk2(v.hi[jj][0], v.hi[jj][1]); o.w = pk2(v.hi[jj][2], v.hi[jj][3]);
        *(SLAS u32x4*)(tile + (size_t)((m0 + jj) * QS + ch) * 2) = o; }
}
struct Raw4 { uint4 r[4]; };
__device__ __forceinline__ void raw4_issue(const bf16* p0  , Raw4& R) {
#pragma unroll
    for (int jj = 0; jj < 4; ++jj) R.r[jj] = *(const uint4*)(p0 + (size_t)jj * DM);
}
__device__ __forceinline__ void raw4_put_rows(SLAS unsigned char* tile, int m0, int ch, const Raw4& R) {
#pragma unroll
    for (int jj = 0; jj < 4; ++jj) { u32x4 o = {R.r[jj].x, R.r[jj].y, R.r[jj].z, R.r[jj].w}; *(SLAS u32x4*)(tile + (size_t)((m0 + jj) * QS + ch) * 2) = o; }
}
__device__ __forceinline__ void raw4_put_cols(SLAS unsigned char* tile, int m0, int ch, const Raw4& R) {
    const unsigned w0[4] = {R.r[0].x, R.r[0].y, R.r[0].z, R.r[0].w}, w1[4] = {R.r[1].x, R.r[1].y, R.r[1].z, R.r[1].w}, w2[4] = {R.r[2].x, R.r[2].y, R.r[2].z, R.r[2].w}, w3[4] = {R.r[3].x, R.r[3].y, R.r[3].z, R.r[3].w};
#pragma unroll
    for (int pr = 0; pr < 4; ++pr) { u32x2 ev, od;
        ev.x = (w0[pr] & 0xffffu) | (w1[pr] << 16); ev.y = (w2[pr] & 0xffffu) | (w3[pr] << 16);
        od.x = (w0[pr] >> 16) | (w1[pr] & 0xffff0000u); od.y = (w2[pr] >> 16) | (w3[pr] & 0xffff0000u);
        *(SLAS u32x2*)(tile + kt_off(ch + 2 * pr, m0)) = ev; *(SLAS u32x2*)(tile + kt_off(ch + 2 * pr + 1, m0)) = od; }
}
__device__ __forceinline__ void raw4_put_cols_scaled(SLAS unsigned char* tile, int m0, int ch, const Raw4& R, f32x4 dlo, f32x4 dhi) {
    const f32x4 a0 = bf4lo(R.r[0]), a1 = bf4lo(R.r[1]), a2 = bf4lo(R.r[2]), a3 = bf4lo(R.r[3]), c0 = bf4hi(R.r[0]), c1 = bf4hi(R.r[1]), c2 = bf4hi(R.r[2]), c3 = bf4hi(R.r[3]);
#pragma unroll
    for (int e = 0; e < 4; ++e) { u32x2 o, o2; o.x = pk2(a0[e] * dlo[e], a1[e] * dlo[e]); o.y = pk2(a2[e] * dlo[e], a3[e] * dlo[e]); o2.x = pk2(c0[e] * dhi[e], c1[e] * dhi[e]); o2.y = pk2(c2[e] * dhi[e], c3[e] * dhi[e]);
        *(SLAS u32x2*)(tile + kt_off(ch + e, m0)) = o; *(SLAS u32x2*)(tile + kt_off(ch + 4 + e, m0)) = o2; }
}
struct VRaw { unsigned x0, x1, x2, x3; };
__device__ __forceinline__ void v_issue(const bf16* vp  , VRaw& R) { R.x0 = *(const unsigned*)(vp); R.x1 = *(const unsigned*)(vp + DM); R.x2 = *(const unsigned*)(vp + 2 * DM); R.x3 = *(const unsigned*)(vp + 3 * DM); }
template <bool SCALED> __device__ __forceinline__ void v_put(SLAS unsigned char* lds, const VRaw& R, int m0, int c2, float4 kf) {
    u32x2 ua, ub;
    ua.x = (R.x0 & 0xffffu) | (R.x1 << 16); ua.y = (R.x2 & 0xffffu) | (R.x3 << 16); ub.x = (R.x0 >> 16) | (R.x1 & 0xffff0000u); ub.y = (R.x2 >> 16) | (R.x3 & 0xffff0000u);
    *(SLAS u32x2*)(lds + L_VU + (size_t)((c2 * 2) * TS + m0) * 2) = ua; *(SLAS u32x2*)(lds + L_VU + (size_t)((c2 * 2 + 1) * TS + m0) * 2) = ub;
    if (SCALED) {
        const float k0 = kf.x, k1 = kf.y, k2 = kf.z, k3 = kf.w;
        u32x2 sa, sb;
        sa.x = pk2(bf2f(R.x0 & 0xffffu) * k0, bf2f(R.x1 & 0xffffu) * k1); sa.y = pk2(bf2f(R.x2 & 0xffffu) * k2, bf2f(R.x3 & 0xffffu) * k3);
        sb.x = pk2(bf2f(R.x0 >> 16) * k0, bf2f(R.x1 >> 16) * k1); sb.y = pk2(bf2f(R.x2 >> 16) * k2, bf2f(R.x3 >> 16) * k3);
        *(SLAS u32x2*)(lds + L_VS + (size_t)((c2 * 2) * TS + m0) * 2) = sa; *(SLAS u32x2*)(lds + L_VS + (size_t)((c2 * 2 + 1) * TS + m0) * 2) = sb; }
}
template <int dir> __device__ __forceinline__ float dir_scan(float x, int lane, float& bl) {
#pragma unroll
    for (int o = 1; o < 64; o <<= 1) { const float tv = dir ? __shfl_down(x, o) : __shfl_up(x, o); if (dir ? (lane + o < 64) : (lane >= o)) x += tv; }
    bl = __shfl(x, dir ? 0 : 63); return x;
}
constexpr int L_GA = L_END;
static_assert(L_GA + 4096 <= 147456, "scan LDS map");

__device__ __forceinline__ const float* gate_base(const Params& p, int layer) { return (const float*)(p.ws + (layer == 0 ? OFF_TOPI : OFF_H)); }
__device__ __forceinline__ void prep_gates(const Params& p, int layer) {
    const int tid = tid_op(), lane = tid & 63, gw = blockIdx.x * 8 + (tid >> 6), NGW = gridDim.x * 8;
    const int NH = layer == 0 ? 4 : 16, nseq = NB * NH * 2;
    float* gb = (float*)gate_base(p, layer); const float* G = (const float*)(p.ws + OFF_G);
    float* BS = gb; float* CS = gb + (size_t)nseq * TT; float* KF = gb + (size_t)2 * nseq * TT; float* DECS = gb + (size_t)3 * nseq * TT;
    for (int task = gw; task < nseq * 68; task += NGW) {
        const int seq = task / 68, mc = task % 68, dir = seq & 1, h = (seq >> 1) % NH, b = seq / (2 * NH);
        const size_t row = (size_t)b * TT + mc * 64 + lane;
        float l, gs, mul = 1.f;
        if (layer == 0) { const float gi = G[row * 64 + dir * 4 + h] + p.in[I_MGATEB][dir * 4 + h], gf = G[row * 64 + (2 + dir) * 4 + h] + p.in[I_MGATEB][(2 + dir) * 4 + h];
            l = -softplus_fast(-gf); gs = gi; }
        else { const float dtv = softplus_fast(G[row * 64 + 32 + dir * 16 + h] + p.in[I_SDTB][dir * 16 + h]); l = -dtv * __expf(p.in[I_SALOG][dir * 16 + h]); gs = __logf(dtv); mul = dtv; }
        float bl; const float bsum = dir ? dir_scan<1>(l, lane, bl) : dir_scan<0>(l, lane, bl);
        const size_t o = (size_t)seq * TT + mc * 64 + lane;
        BS[o] = bsum; CS[o] = gs - bsum; KF[o] = (layer == 0) ? __expf(bl - bsum + gs) : __expf(bl - bsum) * mul;
        if (lane == 0) DECS[seq * 68 + mc] = __expf(bl);
    }
}

struct WFly { f32x4 v[4]; };
constexpr int L_WF = L_END, WF_PITCH = 144;
static_assert(L_WF + 64 * WF_PITCH <= 147456 - 64, "wfly tile");
__device__ __forceinline__ unsigned pack4_fp8_nc(float a, float b, float c, float d) { int w = __builtin_amdgcn_cvt_pk_fp8_f32(a, b, 0, false); w = __builtin_amdgcn_cvt_pk_fp8_f32(c, d, w, true); return (unsigned)w; }
struct WPiece { const float* src; size_t ld; unsigned char* dst; size_t pitch; };
__device__ __forceinline__ WPiece wfly_piece(const Params& p, int ord, int uidx) {
    WPiece q;
    if (ord < 14) { const int nb = uidx & 15, t_ = ord * 16 + (uidx >> 4), e = t_ / 28, kg = t_ - e * 28;
        q.src = p.in[I_MOE2] + ((size_t)e * 3584 + kg * 128) * 1024 + nb * 64; q.ld = 1024; q.dst = p.ws + OFF_W_MOE2 + (size_t)e * 1024 * 3584 + (size_t)(nb * 64) * 3584 + kg * 128; q.pitch = 3584; }
    else { const int i = (ord - 14) * 256 + uidx, t_ = i / 112, nb = i - t_ * 112, kg = t_ & 7, e = t_ >> 3, n0 = nb * 64, tile = n0 >> 8, i0 = n0 & 255, scol = (i0 < 128) ? tile * 128 + i0 : FFE + tile * 128 + (i0 - 128);
        q.src = p.in[I_MOE1] + ((size_t)e * 1024 + kg * 128) * 7168 + scol; q.ld = 7168; q.dst = p.ws + OFF_W_MOE1 + (size_t)e * 7168 * 1024 + (size_t)n0 * 1024 + kg * 128; q.pitch = 1024; }
    return q;
}
__device__ __forceinline__ void wfly_issue(const Params& p, int ord, int uidx, int wv, int lane, WFly& F) {
    const WPiece q = wfly_piece(p, ord, uidx);
    const float* s0 = q.src + (size_t)(wv * 16 + (lane >> 4) * 4) * q.ld + (lane & 15) * 4;
#pragma unroll
    for (int i = 0; i < 4; ++i) F.v[i] = __builtin_nontemporal_load((const f32x4*)(s0 + (size_t)i * q.ld));
}
__device__ __forceinline__ void wfly_fill(SLAS unsigned char* lds, int ord_prev, int wv, int lane, const WFly& F) {
    const float sc = ord_prev < 14 ? F8_W2S : F8_W1S;
#pragma unroll
    for (int nn = 0; nn < 4; ++nn) *(SLAS unsigned*)(lds + L_WF + ((lane & 15) * 4 + nn) * WF_PITCH + wv * 16 + (lane >> 4) * 4) = pack4_fp8_nc(F.v[0][nn] * sc, F.v[1][nn] * sc, F.v[2][nn] * sc, F.v[3][nn] * sc);
}
__device__ __forceinline__ void wfly_drain(const Params& p, SLAS unsigned char* lds, int ord_prev, int uidx, int wv, int lane) {
    const WPiece q = wfly_piece(p, ord_prev, uidx); const int row = wv * 8 + (lane >> 3), pc = lane & 7;
    const u32x4 v = *(const SLAS u32x4*)(lds + L_WF + row * WF_PITCH + pc * 16);
    *(uint4*)(q.dst + (size_t)row * q.pitch + pc * 16) = make_uint4(v.x, v.y, v.z, v.w);
}
#define WFLY_FILL() do { if (c >= 1 && c <= 42) wfly_fill(lds, c - 1, wfw, tid & 63, WF); if (c < 42) wfly_issue(p, c, uidx, wfw, tid & 63, WF); } while (0)
#define WFLY_DRAIN() do { if (c >= 1 && c <= 42) wfly_drain(p, lds, c - 1, uidx, wfw, tid & 63); } while (0)
template <int dir> __device__ __forceinline__ void mlstm_unit(const Params& p, int b, int h, int vs, unsigned char* lds_, int uidx) {
    SLAS unsigned char* lds = (SLAS unsigned char*)lds_;
    const int tid = tid_op(), lane = tid & 63, w = __builtin_amdgcn_readfirstlane(tid >> 6); (void)uidx;
    const bf16* QKC = (const bf16*)(p.ws + OFF_Y); const bf16* ZS = (const bf16*)(p.ws + OFF_ZS); const float* G = (const float*)(p.ws + OFF_G);
    bf16* obase = (bf16*)(p.ws + OFF_SO) + (size_t)dir * SEG + h * 256 + vs * 64;
    const int seq = (b * 4 + h) * 2 + dir; const float* gb = gate_base(p, 0);
    const float* BSq = gb + (size_t)seq * TT; const float* CSq = gb + (size_t)(32 + seq) * TT; const float* KFq = gb + (size_t)(64 + seq) * TT; const float* DECq = gb + (size_t)96 * TT + seq * 68;
    SLAS float* scal = (SLAS float*)(lds + L_SC);
    for (int i = tid; i < 80 * QS / 2; i += 512) ((SLAS unsigned*)(lds + L_ST0))[i] = 0u;
    for (int i = tid; i < 16 * TS / 2; i += 512) { ((SLAS unsigned*)(lds + L_VU + 64 * TS * 2))[i] = (i < TS / 2) ? 0x3f803f80u : 0u; ((SLAS unsigned*)(lds + L_VS + 64 * TS * 2))[i] = 0u; }
    f32x4 S[5];
#pragma unroll
    for (int i = 0; i < 5; ++i) S[i] = (f32x4){0.f, 0.f, 0.f, 0.f};
    const size_t rowbase = (size_t)b * TT;
    const int tg = tid >> 5, cg = tid & 31, m0 = tg * 4; const bool isk = cg >= 16; const int ch = (cg & 15) * 8;
    const bf16* qkp = QKC + (rowbase + m0) * DM + (isk ? 512 : 0) + h * 128 + ch;
    const bf16* vp = ZS + SEG + (rowbase + m0) * DM + h * 256 + vs * 64 + cg * 2;
    struct Pre { Raw4 R; VRaw V; float4 kf; float bs, cs, kfl, dec; } PA, PB;
#define MLSTM_ISSUE(P_, cc) do { const int mc_ = chunk_of_step(dir, (cc)); const size_t to_ = (size_t)mc_ * 64; raw4_issue(qkp + to_ * DM, P_.R); v_issue(vp + to_ * DM, P_.V); \
        P_.kf = *(const float4*)(KFq + to_ + m0); P_.dec = DECq[mc_]; if (w == 0) { P_.bs = BSq[to_ + lane]; P_.cs = CSq[to_ + lane]; P_.kfl = KFq[to_ + lane]; } } while (0)
#define MLSTM_STEP(P_, c_) do { const int c = (c_); const int t0 = chunk_of_step(dir, c) * 64; float blk_ = 0.f; \
        __syncthreads();                                       \
        DSTAMP(0); \
        for (int rep_ = 0; rep_ < PROBE_STAGE_REPS; ++rep_) { \
        if (w == 0) { scal[lane] = P_.bs; scal[64 + lane] = P_.cs; scal[128 + lane] = __expf(P_.bs); ((SLAS bf16*)(lds + L_VS + 64 * TS * 2))[lane] = (bf16)f2bf(P_.kfl); } \
        raw4_put_rows(lds + (isk ? L_KA : L_QA), m0, ch, P_.R); \
        if (isk) raw4_put_cols(lds + L_KT, m0, ch, P_.R); \
        v_put<true>(lds, P_.V, m0, cg, P_.kf); blk_ = P_.dec; } \
        MLSTM_ISSUE(P_, (c + 2 < 68) ? c + 2 : 67);        \
        DSTAMP(1); \
        __syncthreads(); \
        chunk_compute<0, dir>(lds, c & 1, S, blk_, 0.f, obase, b, t0, tid DPASS); } while (0)
#if defined(DIAG_SEL) && DIAG_SEL >= 10
    unsigned long long dacc[8] = {0, 0, 0, 0, 0, 0, 0, 0}; unsigned long long dlast = __builtin_amdgcn_s_memrealtime();
#endif
    MLSTM_ISSUE(PA, 0); MLSTM_ISSUE(PB, 1);
    for (int c2 = 0; c2 < 68; c2 += 2) { MLSTM_STEP(PA, c2); MLSTM_STEP(PB, c2 + 1); }
#undef MLSTM_STEP
#if defined(DIAG_SEL) && DIAG_SEL >= 10
    if (tid == 0 && blockIdx.x == 0) { unsigned long long* dg = (unsigned long long*)(p.ws + OFF_CTL + 98304); for (int k = 0; k < 7; ++k) dg[10 + k] = dacc[k]; }
#endif
#undef MLSTM_ISSUE
}
template <int dir> __device__ __forceinline__ void ssd_unit(const Params& p, int b, int h, unsigned char* lds_, int uidx) {
    SLAS unsigned char* lds = (SLAS unsigned char*)lds_;
    const int tid = tid_op(), lane = tid & 63, w = __builtin_amdgcn_readfirstlane(tid >> 6), g = h >> 3; const int wfw = w; WFly WF;
    const bf16* XC = (const bf16*)(p.ws + OFF_HC); const float* G = (const float*)(p.ws + OFF_G);
    bf16* obase = (bf16*)(p.ws + OFF_SO) + (size_t)(2 + dir) * SEG + h * 64;
    const float dskip = dir ? 0.f : p.in[I_SD][h];
    const int seq = (b * 16 + h) * 2 + dir; const float* gb = gate_base(p, 1);
    const float* BSq = gb + (size_t)seq * TT; const float* CSq = gb + (size_t)(128 + seq) * TT; const float* KFq = gb + (size_t)(256 + seq) * TT; const float* DECq = gb + (size_t)384 * TT + seq * 68;
    SLAS float* scal = (SLAS float*)(lds + L_SC);
    for (int i = tid; i < 80 * QS / 2; i += 512) ((SLAS unsigned*)(lds + L_ST0))[i] = 0u;
    f32x4 S[5];
#pragma unroll
    for (int i = 0; i < 5; ++i) S[i] = (f32x4){0.f, 0.f, 0.f, 0.f};
    const size_t rowbase = (size_t)b * TT;
    const int tg = tid >> 5, cg = tid & 31, m0 = tg * 4; const bool isb = cg >= 16; const int ch = (cg & 15) * 8;
    const bf16* bcp = XC + SEG + (rowbase + m0) * DM + (isb ? 0 : 256) + g * 128 + ch;
    const bf16* xp = XC + (rowbase + m0) * DM + h * 64 + cg * 2;
    struct Pre { Raw4 R; VRaw V; float4 kf; float bs, cs, dec; } PA, PB;
#define SSD_ISSUE(P_, cc) do { const int mc_ = chunk_of_step(dir, (cc)); const size_t to_ = (size_t)mc_ * 64; raw4_issue(bcp + to_ * DM, P_.R); v_issue(xp + to_ * DM, P_.V); \
        P_.kf = *(const float4*)(KFq + to_ + m0); P_.dec = DECq[mc_]; if (w == 0) { P_.bs = BSq[to_ + lane]; P_.cs = CSq[to_ + lane]; } } while (0)
#define SSD_STEP(P_, c_) do { const int c = (c_); const int t0 = chunk_of_step(dir, c) * 64; \
        __syncthreads(); \
        if (w == 0) { scal[lane] = P_.bs; scal[64 + lane] = P_.cs; scal[128 + lane] = __expf(P_.bs); } \
        raw4_put_rows(lds + (isb ? L_KA : L_QA), m0, ch, P_.R); \
        if (isb) raw4_put_cols(lds + L_KT, m0, ch, P_.R); \
        v_put<true>(lds, P_.V, m0, cg, P_.kf); \
        const float dec_ = P_.dec; \
        SSD_ISSUE(P_, (c + 2 < 68) ? c + 2 : 67);        \
        WFLY_FILL(); \
        __syncthreads(); \
        WFLY_DRAIN(); \
        chunk_compute<2, dir>(lds, c & 1, S, dec_, dskip, obase, b, t0, tid DPASS); } while (0)
#if defined(DIAG_SEL) && DIAG_SEL >= 10
    unsigned long long dacc[8] = {0, 0, 0, 0, 0, 0, 0, 0}; unsigned long long dlast = 0;
#endif
    SSD_ISSUE(PA, 0); SSD_ISSUE(PB, 1);
    for (int c2 = 0; c2 < 68; c2 += 2) { SSD_STEP(PA, c2); SSD_STEP(PB, c2 + 1); }
#undef SSD_STEP
#undef SSD_ISSUE
}
template <int dir> __device__ __forceinline__ void gla_unit(const Params& p, int b, int h, int vs, unsigned char* lds_, int uidx) {
    SLAS unsigned char* lds = (SLAS unsigned char*)lds_;
    const int tid = tid_op(); const int wfw = __builtin_amdgcn_readfirstlane(tid >> 6); WFly WF;
    const bf16* QA = (const bf16*)(p.ws + OFF_HC) + (size_t)(2 + dir) * SEG; const bf16* ZS = (const bf16*)(p.ws + OFF_ZS); const float* DEC = (const float*)(p.ws + OFF_RGS);
    bf16* obase = (bf16*)(p.ws + OFF_SO) + (size_t)dir * SEG + h * 256 + vs * 64;
    SLAS float* scal = (SLAS float*)(lds + L_SC);
    for (int i = tid; i < 80 * QS / 2; i += 512) ((SLAS unsigned*)(lds + L_ST0))[i] = 0u;
    f32x4 S[5];
#pragma unroll
    for (int i = 0; i < 5; ++i) S[i] = (f32x4){0.f, 0.f, 0.f, 0.f};
    const size_t rowbase = (size_t)b * TT;
    const int tg = tid >> 5, cg = tid & 31, m0 = tg * 4; const bool isk = cg >= 16; const int ch = (cg & 15) * 8;
    const bf16* qkp = QA + (rowbase + m0) * DM + (isk ? 512 : 0) + h * 128 + ch;
    const bf16* vp = ZS + SEG + (rowbase + m0) * DM + h * 256 + vs * 64 + cg * 2;
    struct Pre { Raw4 R; VRaw V; f32x4 dlo, dhi; } PA, PB;
#define GLA_ISSUE(P_, cc) do { const int mc_ = chunk_of_step(dir, (cc)); const size_t to_ = (size_t)mc_ * 64; raw4_issue(qkp + to_ * DM, P_.R); v_issue(vp + to_ * DM, P_.V); \
        const float* dp_ = DEC + ((size_t)((b * 68 + mc_) * 4 + h) * 2 + dir) * 128 + ch; P_.dlo = *(const f32x4*)dp_; P_.dhi = *(const f32x4*)(dp_ + 4); } while (0)
#define GLA_STEP(P_, c_) do { const int c = (c_); const int t0 = chunk_of_step(dir, c) * 64; \
        __syncthreads(); \
        raw4_put_rows(lds + (isk ? L_KA : L_QA), m0, ch, P_.R); \
        if (isk) { raw4_put_cols_scaled(lds + L_KT, m0, ch, P_.R, P_.dlo, P_.dhi); if (tg == 0) { *(SLAS f32x4*)(scal + 192 + ch) = P_.dlo; *(SLAS f32x4*)(scal + 192 + ch + 4) = P_.dhi; } } \
        v_put<false>(lds, P_.V, m0, cg, make_float4(0.f, 0.f, 0.f, 0.f)); \
        GLA_ISSUE(P_, (c + 2 < 68) ? c + 2 : 67);        \
        WFLY_FILL(); \
        __syncthreads(); \
        WFLY_DRAIN(); \
        chunk_compute<1, dir>(lds, c & 1, S, 1.f, 0.f, obase, b, t0, tid DPASS); } while (0)
#if defined(DIAG_SEL) && DIAG_SEL >= 10
    unsigned long long dacc[8] = {0, 0, 0, 0, 0, 0, 0, 0}; unsigned long long dlast = 0;
#endif
    GLA_ISSUE(PA, 0); GLA_ISSUE(PB, 1);
    for (int c2 = 0; c2 < 68; c2 += 2) { GLA_STEP(PA, c2); GLA_STEP(PB, c2 + 1); }
#undef GLA_STEP
#undef GLA_ISSUE
}

__device__ __forceinline__ void prep_conv(const Params& p, int layer) {
    const int tid = tid_op(); const long gtid = (long)blockIdx.x * 512 + tid, gstride = (long)gridDim.x * 512;
    const bf16* ZS = (const bf16*)(p.ws + OFF_ZS); bf16* OUT = (bf16*)(p.ws + (layer == 0 ? OFF_Y : OFF_HC));
    const int ngrp = (layer == 0) ? 256 : 192;
    const long nitems = (long)(MROWS / 4) * ngrp;
    for (long it = gtid; it < nitems; it += gstride) {
        const int cgi = (int)(it % ngrp), tgi = (int)(it / ngrp), row4 = tgi * 4, b = row4 / TT, t = row4 % TT, t0 = t & ~63, m0 = t & 63, mc = t0 >> 6;
        const int lo = (mc < 4) ? 0 : t0, hi = (mc < 4) ? NCTX : t0 + 64;
        Blk48 v; const bf16* src; bf16* dst; int col;
        if (layer == 0 && cgi < 128) { col = cgi * 8; src = ZS; dst = OUT;
            conv_4x8<true>(src, (size_t)b * TT, t0, m0, lo, hi, col, p.in[I_MCONVW], 1024, col, p.in[I_MCONVB], col >= 512 ? 0.08838834764831845f : 1.f, v); }
        else if (layer == 0) { col = (cgi - 128) * 8; src = ZS + 3 * SEG; dst = (bf16*)(p.ws + OFF_H);
            conv_4x8<false>(src, (size_t)b * TT, t0, m0, lo, hi, col, p.in[I_LCONVW], 1024, col, p.in[I_LCONVB], 1.f, v); }
        else { const int xc = cgi * 8;
            col = (xc < 1024) ? xc : xc - 1024; src = ZS + (size_t)(xc < 1024 ? 4 : 5) * SEG; dst = OUT + (size_t)(xc < 1024 ? 0 : 1) * SEG;
            conv_4x8<true>(src, (size_t)b * TT, t0, m0, lo, hi, col, p.in[I_SCONVW], 1536, xc, p.in[I_SCONVB], 1.f, v); }
#pragma unroll
        for (int jj = 0; jj < 4; ++jj) { uint4 o; o.x = pk2(v.lo[jj][0], v.lo[jj][1]); o.y = pk2(v.lo[jj][2], v.lo[jj][3]); o.z = pk2(v.hi[jj][0], v.hi[jj][1]); o.w = pk2(v.hi[jj][2], v.hi[jj][3]);
            *(uint4*)(dst + ((size_t)b * TT + t0 + m0 + jj) * DM + col) = o; }
    }
}
__device__ __forceinline__ void prep_gla(const Params& p, unsigned char* lds_) {
    SLAS unsigned char* lds = (SLAS unsigned char*)lds_;
    const int tid = tid_op(), d = tid & 127, qt = tid >> 7;
    const bf16* ZS = (const bf16*)(p.ws + OFF_ZS); const float* G = (const float*)(p.ws + OFF_G); float* DEC = (float*)(p.ws + OFF_RGS);
    SLAS float* qtot = (SLAS float*)(lds + L_SC) + 512; SLAS float* GA = (SLAS float*)(lds + L_GA); SLAS bf16* E = (SLAS bf16*)(lds + L_ST0);
    const int tg = tid >> 5, cg = tid & 31, m0 = tg * 4; const bool isk = cg >= 16; const int ch = (cg & 15) * 8;
    float wg[16]; float bg = 0.f; int wkey = -1;
    Raw4 R; float4 gaq = make_float4(0.f, 0.f, 0.f, 0.f);
#define PG_FETCH(uu) do { const int dir_ = (uu) & 1, h_ = ((uu) >> 1) & 3, bm_ = (uu) >> 3; const size_t rb_ = (size_t)(bm_ / 68) * TT + (bm_ % 68) * 64; \
        if (tid < 256) gaq = *(const float4*)(G + (rb_ + (tid >> 2)) * 64 + dir_ * 16 + (tid & 3) * 4); \
        raw4_issue(ZS + (rb_ + m0) * DM + (isk ? 512 : 0) + h_ * 128 + ch, R); } while (0)
    if ((int)blockIdx.x < 2176) PG_FETCH((int)blockIdx.x);
    for (int u = blockIdx.x; u < 2176; u += gridDim.x) {
        const int dir = u & 1, h = (u >> 1) & 3, bm = u >> 3, b = bm / 68, mc = bm % 68; const size_t rowbase = (size_t)b * TT + mc * 64;
        if ((u & 7) != wkey) { wkey = u & 7;
#pragma unroll
            for (int j = 0; j < 16; ++j) wg[j] = p.in[I_GALW][(size_t)(dir * 16 + j) * 512 + h * 128 + d];
            bg = p.in[I_GALB][dir * 512 + h * 128 + d]; }
        __syncthreads();
        if (tid < 256) *(SLAS f32x4*)(GA + (tid >> 2) * 16 + (tid & 3) * 4) = (f32x4){gaq.x, gaq.y, gaq.z, gaq.w};
        const Raw4 Rc = R;
        __syncthreads();
        if (u + (int)gridDim.x < 2176) PG_FETCH(u + (int)gridDim.x);
        f32x4 loc[4]; float run = 0.f;
#pragma unroll
        for (int i2 = 0; i2 < 16; ++i2) { const int ii = dir ? 15 - i2 : i2; const SLAS float* ga = GA + (qt * 16 + ii) * 16;
            float pre = bg;
#pragma unroll
            for (int j4 = 0; j4 < 4; ++j4) { const f32x4 a = *(const SLAS f32x4*)(ga + 4 * j4); pre += a[0] * wg[4 * j4] + a[1] * wg[4 * j4 + 1] + a[2] * wg[4 * j4 + 2] + a[3] * wg[4 * j4 + 3]; }
            run -= softplus_fast(-pre) * (1.f / 16.f); loc[ii >> 2][ii & 3] = run; }
        qtot[qt * 128 + d] = run;
        __syncthreads();
        float off = 0.f, tot = 0.f;
#pragma unroll
        for (int q2 = 0; q2 < 4; ++q2) { const float tq = qtot[q2 * 128 + d]; if (dir ? (q2 > qt) : (q2 < qt)) off += tq; tot += tq; }
        if (qt == 0) DEC[((size_t)((b * 68 + mc) * 4 + h) * 2 + dir) * 128 + d] = __expf(tot);
#pragma unroll
        for (int ii = 0; ii < 16; ++ii) E[(qt * 16 + ii) * QS + d] = (bf16)f2bf(__expf(off + loc[ii >> 2][ii & 3]));
        __syncthreads();
        bf16* dst = (bf16*)(p.ws + OFF_HC) + (size_t)(2 + dir) * SEG + (rowbase + m0) * DM + (isk ? 512 : 0) + h * 128 + ch;
#pragma unroll
        for (int jj = 0; jj < 4; ++jj) { const u32x4 ev = *(const SLAS u32x4*)((const SLAS unsigned char*)E + (size_t)((m0 + jj) * QS + ch) * 2);
            const uint4 e4 = make_uint4(ev.x, ev.y, ev.z, ev.w); const f32x4 elo = bf4lo(e4), ehi = bf4hi(e4), xlo = bf4lo(Rc.r[jj]), xhi = bf4hi(Rc.r[jj]); f32x4 alo, ahi;
            if (!isk) { alo = xlo * elo * 0.08838834764831845f; ahi = xhi * ehi * 0.08838834764831845f; }
            else {
#pragma unroll
                for (int e = 0; e < 4; ++e) { alo[e] = xlo[e] * __builtin_amdgcn_rcpf(elo[e]); ahi[e] = xhi[e] * __builtin_amdgcn_rcpf(ehi[e]); } }
            uint4 o; o.x = pk2(alo[0], alo[1]); o.y = pk2(alo[2], alo[3]); o.z = pk2(ahi[0], ahi[1]); o.w = pk2(ahi[2], ahi[3]);
            *(uint4*)(dst + (size_t)jj * DM) = o; }
    }
#undef PG_FETCH
}
}

namespace rg {
using sc::bf16x8; using sc::f32x4; using sc::u32x4; using sc::mfma; using sc::ldfrag; using sc::QS;
constexpr int L_XL = 0, L_OUT = 64 * QS * 2, OS = 132;
template <int PHASE>
__device__ __forceinline__ void rglru_units(const Params& p, int u0, int ustride, unsigned char* lds_) {
    SLAS unsigned char* lds = (SLAS unsigned char*)lds_;
    const int tid = tid_op(), lane = tid & 63, w = tid >> 6, r = lane & 15, q = lane >> 4;
    const int blk = u0 & 7, ch = blk * 128 + w * 16 + r;
    const bf16* ZS = (const bf16*)(p.ws + OFF_ZS); const bf16* WT = (const bf16*)(p.ws + OFF_W_RG);
    float2* RGS = (float2*)(p.ws + OFF_RGS); bf16* HC = (bf16*)(p.ws + OFF_HC);
    bf16x8 bw[4][4];
#pragma unroll
    for (int mm = 0; mm < 4; ++mm)
#pragma unroll
        for (int ks = 0; ks < 4; ++ks) bw[mm][ks] = *(const bf16x8*)(WT + ((size_t)((mm & 1) * 16 + (mm >> 1) * 8 + blk) * 128 + (w * 16 + r)) * 128 + ks * 32 + 8 * q);
    float ba[2], bx[2], sp[2];
#pragma unroll
    for (int dd = 0; dd < 2; ++dd) { ba[dd] = p.in[I_LBA][dd * 1024 + ch]; bx[dd] = p.in[I_LBX][dd * 1024 + ch]; sp[dd] = -8.f * softplus_f(-p.in[I_LLAM][dd * 1024 + ch]); }
    const bf16* XLC = (const bf16*)(p.ws + OFF_H);
    uint4 xr[2];
#define RG_FETCH(uu) do { const int bm_ = (uu) >> 3; const size_t rb_ = (size_t)(bm_ / 68) * TT + (bm_ % 68) * 64; \
        _Pragma("unroll") for (int rep = 0; rep < 2; ++rep) { const int idx = tid + rep * 512; xr[rep] = *(const uint4*)(XLC + (rb_ + (idx >> 4)) * DM + blk * 128 + (idx & 15) * 8); } } while (0)
    if (u0 < 2176) RG_FETCH(u0);
    for (int u = u0; u < 2176; u += ustride) {
        const int bm = u >> 3, b = bm / 68, mc = bm % 68, t0 = mc * 64;
        const size_t rowbase = (size_t)b * TT;
        __syncthreads();
#pragma unroll
        for (int rep = 0; rep < 2; ++rep) { const int idx = tid + rep * 512; const sc::u32x4 o4 = {xr[rep].x, xr[rep].y, xr[rep].z, xr[rep].w}; *(SLAS sc::u32x4*)(lds + L_XL + (size_t)((idx >> 4) * QS + (idx & 15) * 8) * 2) = o4; }
        if (u + ustride < 2176) RG_FETCH(u + ustride);
        float cin0 = 0.f, cin1 = 0.f;
        if (PHASE == 1) {
#pragma unroll
            for (int dd = 0; dd < 2; ++dd) {
                const int n = dd ? ((mc < 4) ? 3 - mc : 71 - mc) : mc, per = (n + 3) >> 2, lo_q = min(q * per, n), hi_q = min(lo_q + per, n);
                float A = 1.f, B = 0.f;
#pragma unroll 4
                for (int cp = lo_q; cp < hi_q; ++cp) { const int mcp = dd ? sc::chunk_of_step(1, cp) : cp; const float2 ab = RGS[((size_t)(b * 68 + mcp) * 2 + dd) * 1024 + ch]; B = ab.x * B + ab.y; A = ab.x * A; }
                float carry = 0.f;
#pragma unroll
                for (int qq = 0; qq < 4; ++qq) { const float Aq = __shfl(A, r + 16 * qq), Bq = __shfl(B, r + 16 * qq); carry = Aq * carry + Bq; }
                if (dd) cin1 = carry; else cin0 = carry; }
        }
        __syncthreads();
        f32x4 av[2][4], bv[2][4];
#pragma unroll
        for (int tb = 0; tb < 4; ++tb) {
            bf16x8 af[4];
#pragma unroll
            for (int ks = 0; ks < 4; ++ks) af[ks] = ldfrag(lds + L_XL, tb * 16 + r, QS, ks * 32 + 8 * q);
            f32x4 acc[4];
#pragma unroll
            for (int mm = 0; mm < 4; ++mm) { acc[mm] = (f32x4){0.f, 0.f, 0.f, 0.f};
#pragma unroll
                for (int ks = 0; ks < 4; ++ks) acc[mm] = mfma(af[ks], bw[mm][ks], acc[mm]); }
            f32x4 xl4;
#pragma unroll
            for (int j = 0; j < 4; ++j) xl4[j] = bf2f(((const SLAS bf16*)(lds + L_XL))[(tb * 16 + 4 * q + j) * QS + w * 16 + r]);
#pragma unroll
            for (int dd = 0; dd < 2; ++dd) { f32x4 a4, b4;
#pragma unroll
                for (int j = 0; j < 4; ++j) { const float rr = sc::sigmoid_fast(acc[dd * 2][j] + ba[dd]), ii = sc::sigmoid_fast(acc[dd * 2 + 1][j] + bx[dd]);
                    const float a = __expf(rr * sp[dd]); a4[j] = a; b4[j] = sqrtf(fmaxf(1.f - a * a, 0.f)) * (ii * xl4[j]); }
                av[dd][tb] = a4; bv[dd][tb] = b4; }
        }
        SLAS float* OUT = (SLAS float*)(lds + L_OUT);
        { float carry = cin0, aprod = 1.f;
#pragma unroll
          for (int tb = 0; tb < 4; ++tb) {
              const f32x4 A = av[0][tb], B = bv[0][tb]; f32x4 hl, ac;
              hl[0] = B[0]; ac[0] = A[0];
#pragma unroll
              for (int j = 1; j < 4; ++j) { hl[j] = A[j] * hl[j - 1] + B[j]; ac[j] = A[j] * ac[j - 1]; }
              float Ae = 1.f, Be = 0.f, At = 1.f, Bt = 0.f;
#pragma unroll
              for (int qq = 0; qq < 4; ++qq) { const float Aq = __shfl(ac[3], r + 16 * qq), Bq = __shfl(hl[3], r + 16 * qq);
                  if (qq < q) { Be = Aq * Be + Bq; Ae = Aq * Ae; }
                  Bt = Aq * Bt + Bq; At = Aq * At; }
              const float hin = Ae * carry + Be;
              { const f32x4 ov = ac * hin + hl, cv = ac * (Ae * aprod);
#pragma unroll
                for (int j = 0; j < 4; ++j) { const int oi = (tb * 16 + 4 * q + j) * OS + w * 16 + r; OUT[oi] = ov[j]; OUT[8448 + oi] = cv[j]; } }
              carry = At * carry + Bt; aprod *= At; }
          if (PHASE == 0 && q == 0) RGS[((size_t)(b * 68 + mc) * 2 + 0) * 1024 + ch] = make_float2(aprod, carry); }
        { float carry = cin1, aprod = 1.f;
#pragma unroll
          for (int tb = 3; tb >= 0; --tb) {
              const f32x4 A = av[1][tb], B = bv[1][tb]; f32x4 hl, ac;
              hl[3] = B[3]; ac[3] = A[3];
#pragma unroll
              for (int j = 2; j >= 0; --j) { hl[j] = A[j] * hl[j + 1] + B[j]; ac[j] = A[j] * ac[j + 1]; }
              float Ae = 1.f, Be = 0.f, At = 1.f, Bt = 0.f;
#pragma unroll
              for (int qq = 3; qq >= 0; --qq) { const float Aq = __shfl(ac[0], r + 16 * qq), Bq = __shfl(hl[0], r + 16 * qq);
                  if (qq > q) { Be = Aq * Be + Bq; Ae = Aq * Ae; }
                  Bt = Aq * Bt + Bq; At = Aq * At; }
              const float hin = Ae * carry + Be;
              { const f32x4 ov = ac * hin + hl, cv = ac * (Ae * aprod);
#pragma unroll
                for (int j = 0; j < 4; ++j) { const int oi = (tb * 16 + 4 * q + j) * OS + w * 16 + r; OUT[oi] += ov[j]; OUT[16896 + oi] = cv[j]; } }
              carry = At * carry + Bt; aprod *= At; }
          if (PHASE == 0 && q == 0) RGS[((size_t)(b * 68 + mc) * 2 + 1) * 1024 + ch] = make_float2(aprod, carry); }
        if (PHASE == 0) {
            __syncthreads();
            bf16* T0 = (bf16*)(p.ws + OFF_SO) + 2 * SEG; bf16* T1 = (bf16*)(p.ws + OFF_SO) + 3 * SEG; bf16* T2 = (bf16*)(p.ws + OFF_Y) + SEG;
#pragma unroll
            for (int rep = 0; rep < 2; ++rep) { const int idx = tid + rep * 512, t = idx >> 4, cc = idx & 15; const size_t off = (rowbase + t0 + t) * DM + blk * 128 + cc * 8;
#pragma unroll
                for (int k3 = 0; k3 < 3; ++k3) { const f32x4 x0 = *(const SLAS f32x4*)(OUT + k3 * 8448 + t * OS + cc * 8), x1 = *(const SLAS f32x4*)(OUT + k3 * 8448 + t * OS + cc * 8 + 4);
                    uint4 ov; ov.x = sc::pk2(x0[0], x0[1]); ov.y = sc::pk2(x0[2], x0[3]); ov.z = sc::pk2(x1[0], x1[1]); ov.w = sc::pk2(x1[2], x1[3]);
                    *(uint4*)((k3 == 0 ? T0 : (k3 == 1 ? T1 : T2)) + off) = ov; } }
        }
    }
}
__device__ __forceinline__ void rglru_finish(const Params& p, int u0, int ustride, unsigned char* lds_) {
    SLAS unsigned char* lds = (SLAS unsigned char*)lds_;
    const int tid = tid_op(), c = tid & 127, part = tid >> 7, blk = u0 & 7, ch = blk * 128 + c;
    const bf16* ZS = (const bf16*)(p.ws + OFF_ZS); const float2* RGS = (const float2*)(p.ws + OFF_RGS); bf16* HC = (bf16*)(p.ws + OFF_HC);
    const bf16* T0 = (const bf16*)(p.ws + OFF_SO) + 2 * SEG; const bf16* T1 = (const bf16*)(p.ws + OFF_SO) + 3 * SEG; const bf16* T2 = (const bf16*)(p.ws + OFF_Y) + SEG;
    SLAS float* FA = (SLAS float*)lds; SLAS float* CR = FA + 2048;
    for (int u = u0; u < 2176; u += ustride) {
        const int bm = u >> 3, b = bm / 68, mc = bm % 68, t0 = mc * 64; const size_t rowbase = (size_t)b * TT;
        uint4 xs[2], x0[2], x1[2], xg[2];
#pragma unroll
        for (int rep = 0; rep < 2; ++rep) { const int idx = tid + rep * 512, t = idx >> 4, cc = idx & 15; const size_t off = (rowbase + t0 + t) * DM + blk * 128 + cc * 8;
            xs[rep] = *(const uint4*)(T0 + off); x0[rep] = *(const uint4*)(T1 + off); x1[rep] = *(const uint4*)(T2 + off); xg[rep] = *(const uint4*)(ZS + 4 * SEG + off); }
        __syncthreads();
#pragma unroll
        for (int dd = 0; dd < 2; ++dd) {
            const int n = dd ? ((mc < 4) ? 3 - mc : 71 - mc) : mc, per = (n + 3) >> 2, lo_q = min(part * per, n), hi_q = min(lo_q + per, n);
            float A = 1.f, B = 0.f;
#pragma unroll 4
            for (int cp = lo_q; cp < hi_q; ++cp) { const int mcp = dd ? sc::chunk_of_step(1, cp) : cp; const float2 ab = RGS[((size_t)(b * 68 + mcp) * 2 + dd) * 1024 + ch]; B = ab.x * B + ab.y; A = ab.x * A; }
            FA[((dd * 4 + part) * 128 + c) * 2] = A; FA[((dd * 4 + part) * 128 + c) * 2 + 1] = B; }
        __syncthreads();
        if (tid < 256) { const int dd = tid >> 7; float carry = 0.f;
#pragma unroll
            for (int pp = 0; pp < 4; ++pp) carry = FA[((dd * 4 + pp) * 128 + c) * 2] * carry + FA[((dd * 4 + pp) * 128 + c) * 2 + 1];
            CR[dd * 128 + c] = carry; }
        __syncthreads();
#pragma unroll
        for (int rep = 0; rep < 2; ++rep) { const int idx = tid + rep * 512, t = idx >> 4, cc = idx & 15; const size_t row = rowbase + t0 + t;
            const f32x4 k0l = *(const SLAS f32x4*)(CR + cc * 8), k0h = *(const SLAS f32x4*)(CR + cc * 8 + 4), k1l = *(const SLAS f32x4*)(CR + 128 + cc * 8), k1h = *(const SLAS f32x4*)(CR + 128 + cc * 8 + 4);
            const f32x4 hl = sc::bf4lo(xs[rep]) + sc::bf4lo(x0[rep]) * k0l + sc::bf4lo(x1[rep]) * k1l, hh = sc::bf4hi(xs[rep]) + sc::bf4hi(x0[rep]) * k0h + sc::bf4hi(x1[rep]) * k1h;
            const f32x4 gl = sc::bf4lo(xg[rep]), gh = sc::bf4hi(xg[rep]);
            uint4 ov; ov.x = sc::pk2(hl[0] * gelu_fast(gl[0]), hl[1] * gelu_fast(gl[1])); ov.y = sc::pk2(hl[2] * gelu_fast(gl[2]), hl[3] * gelu_fast(gl[3]));
            ov.z = sc::pk2(hh[0] * gelu_fast(gh[0]), hh[1] * gelu_fast(gh[1])); ov.w = sc::pk2(hh[2] * gelu_fast(gh[2]), hh[3] * gelu_fast(gh[3]));
            *(uint4*)(HC + row * 2048 + 1024 + blk * 128 + cc * 8) = ov; }
    }
}
}

__device__ __forceinline__ void sub_barrier(unsigned* cnt, unsigned n) {
    asm volatile("s_waitcnt vmcnt(0)" ::: "memory");
    __syncthreads();
    if (threadIdx.x == 0) {
        __builtin_amdgcn_fence(__ATOMIC_RELEASE, "agent");
        asm volatile("s_waitcnt vmcnt(0)" ::: "memory");
        __hip_atomic_fetch_add(cnt, 1u, __ATOMIC_RELAXED, __HIP_MEMORY_SCOPE_AGENT);
        unsigned sp = 0;
        while (__hip_atomic_load(cnt, __ATOMIC_RELAXED, __HIP_MEMORY_SCOPE_AGENT) < n) { __builtin_amdgcn_s_sleep(2); if (++sp > (1u << 24)) break; }
        __builtin_amdgcn_fence(__ATOMIC_ACQUIRE, "agent");
        asm volatile("s_waitcnt vmcnt(0)" ::: "memory");
    }
    __syncthreads();
}
__device__ __forceinline__ void phase_scan(const Params& p, int layer, float* sm) {
#ifdef DIAG_SEL
    const unsigned long long dg_t0 = __builtin_amdgcn_s_memrealtime();
#endif
    if (layer == 0) {
        if (gridDim.x == 256) {
            const int u = blockIdx.x;
            if (u < 128) { if ((u >> 2) & 1) sc::mlstm_unit<1>(p, u >> 5, (u >> 3) & 3, u & 3, (unsigned char*)sm, u); else sc::mlstm_unit<0>(p, u >> 5, (u >> 3) & 3, u & 3, (unsigned char*)sm, u); }
            else rg::rglru_units<0>(p, u - 128, 128, (unsigned char*)sm);
        } else {
            for (int u = blockIdx.x; u < 128; u += gridDim.x) { if ((u >> 2) & 1) sc::mlstm_unit<1>(p, u >> 5, (u >> 3) & 3, u & 3, (unsigned char*)sm, u); else sc::mlstm_unit<0>(p, u >> 5, (u >> 3) & 3, u & 3, (unsigned char*)sm, u); __syncthreads(); }
            if ((gridDim.x & 7) == 0) rg::rglru_units<0>(p, blockIdx.x, gridDim.x, (unsigned char*)sm); else if (blockIdx.x < 8) rg::rglru_units<0>(p, blockIdx.x, 8, (unsigned char*)sm);
        }
    } else {
        for (int u = blockIdx.x; u < 256; u += gridDim.x) {
            if (u < 128) { if ((u >> 2) & 1) sc::gla_unit<1>(p, u >> 5, (u >> 3) & 3, u & 3, (unsigned char*)sm, u); else sc::gla_unit<0>(p, u >> 5, (u >> 3) & 3, u & 3, (unsigned char*)sm, u); }
            else { const int w = u - 128; if (w & 1) sc::ssd_unit<1>(p, w >> 5, (w >> 1) & 15, (unsigned char*)sm, u); else sc::ssd_unit<0>(p, w >> 5, (w >> 1) & 15, (unsigned char*)sm, u); }
            __syncthreads();
        }
    }
#ifdef DIAG_SEL
    if (threadIdx.x == 0) { const unsigned long long dt_ = __builtin_amdgcn_s_memrealtime() - dg_t0; unsigned long long* dg = (unsigned long long*)(p.ws + OFF_CTL + 98304);
        if (layer == 0 && blockIdx.x == 0) dg[1] = dt_; if (layer == 0 && blockIdx.x == 128) dg[2] = dt_; if (layer == 1 && blockIdx.x == 0) dg[3] = dt_; if (layer == 1 && blockIdx.x == 128) dg[4] = dt_;
        if (layer == 0 && blockIdx.x == 4) dg[5] = dt_; if (layer == 1 && blockIdx.x == 4) dg[6] = dt_; }
#endif
}

__device__ __forceinline__ float sigmoid_fast_(float x) { return __builtin_amdgcn_rcpf(1.f + __expf(-x)); }
__device__ __forceinline__ void ld16_bf16(const bf16* row, int lane, float (&v)[16]) {
#pragma unroll
    for (int c = 0; c < 2; ++c) { const uint4 t = *(const uint4*)(row + c * 512 + lane * 8);
        v[8 * c + 0] = bf2f(t.x & 0xffffu); v[8 * c + 1] = bf2f(t.x >> 16); v[8 * c + 2] = bf2f(t.y & 0xffffu); v[8 * c + 3] = bf2f(t.y >> 16);
        v[8 * c + 4] = bf2f(t.z & 0xffffu); v[8 * c + 5] = bf2f(t.z >> 16); v[8 * c + 6] = bf2f(t.w & 0xffffu); v[8 * c + 7] = bf2f(t.w >> 16); }
}
__device__ __forceinline__ void ld16_f32(const float* row, int lane, float (&v)[16]) {
#pragma unroll
    for (int c = 0; c < 2; ++c) { const float4 t0 = *(const float4*)(row + c * 512 + lane * 8), t1 = *(const float4*)(row + c * 512 + lane * 8 + 4);
        v[8 * c + 0] = t0.x; v[8 * c + 1] = t0.y; v[8 * c + 2] = t0.z; v[8 * c + 3] = t0.w; v[8 * c + 4] = t1.x; v[8 * c + 5] = t1.y; v[8 * c + 6] = t1.z; v[8 * c + 7] = t1.w; }
}
__device__ __forceinline__ void st16_bf16(bf16* row, int lane, const float (&v)[16]) {
#pragma unroll
    for (int c = 0; c < 2; ++c) { uint4 t; t.x = f2bf(v[8 * c]) | (f2bf(v[8 * c + 1]) << 16); t.y = f2bf(v[8 * c + 2]) | (f2bf(v[8 * c + 3]) << 16); t.z = f2bf(v[8 * c + 4]) | (f2bf(v[8 * c + 5]) << 16); t.w = f2bf(v[8 * c + 6]) | (f2bf(v[8 * c + 7]) << 16);
        *(uint4*)(row + c * 512 + lane * 8) = t; }
}
__device__ __forceinline__ float half_sum(float v) {
#pragma unroll
    for (int o = 16; o >= 1; o >>= 1) v += __shfl_xor(v, o);
    return v;
}
__device__ __forceinline__ void phase_mix2(const Params& p, int layer, float* sm) {
    if (layer == 0) { if ((gridDim.x & 7) == 0) rg::rglru_finish(p, blockIdx.x, gridDim.x, (unsigned char*)sm); else if (blockIdx.x < 8) rg::rglru_finish(p, blockIdx.x, 8, (unsigned char*)sm); }
    const int tid_ = tid_op(); const int lane = tid_ & 63, gw = blockIdx.x * 8 + (tid_ >> 6), NGW = gridDim.x * 8;
    const bf16* ZS = (const bf16*)(p.ws + OFF_ZS); const bf16* SO = (const bf16*)(p.ws + OFF_SO); bf16* HC = (bf16*)(p.ws + OFF_HC);
    for (int pr = gw; pr < MROWS / 2; pr += NGW) {
        const size_t r = (size_t)2 * pr;
        float a0[16], c0[16], g0[16], a1[16], c1[16], g1[16], w[16];
        ld16_bf16(SO + r * DM, lane, a0); ld16_bf16(SO + SEG + r * DM, lane, c0); ld16_bf16(ZS + 2 * SEG + r * DM, lane, g0);
        ld16_bf16(SO + (r + 1) * DM, lane, a1); ld16_bf16(SO + SEG + (r + 1) * DM, lane, c1); ld16_bf16(ZS + 2 * SEG + (r + 1) * DM, lane, g1);
        ld16_f32(layer == 0 ? p.in[I_MNORMW] : p.in[I_GNORMW], lane, w);
#pragma unroll
        for (int c = 0; c < 2; ++c) {
            float ss0 = 0.f, ss1 = 0.f;
#pragma unroll
            for (int i = 0; i < 8; ++i) { a0[8 * c + i] += c0[8 * c + i]; ss0 += a0[8 * c + i] * a0[8 * c + i]; a1[8 * c + i] += c1[8 * c + i]; ss1 += a1[8 * c + i] * a1[8 * c + i]; }
            const float r0 = __builtin_amdgcn_rsqf(half_sum(ss0) * (1.f / 256.f) + 1e-6f), r1 = __builtin_amdgcn_rsqf(half_sum(ss1) * (1.f / 256.f) + 1e-6f);
#pragma unroll
            for (int i = 0; i < 8; ++i) { const float q0 = g0[8 * c + i], q1 = g1[8 * c + i]; const float s0 = sigmoid_fast_(q0), s1 = sigmoid_fast_(q1);
                a0[8 * c + i] = a0[8 * c + i] * r0 * w[8 * c + i] * (layer == 0 ? s0 : q0 * s0); a1[8 * c + i] = a1[8 * c + i] * r1 * w[8 * c + i] * (layer == 0 ? s1 : q1 * s1); }
        }
        st16_bf16(HC + r * 2048, lane, a0); st16_bf16(HC + (r + 1) * 2048, lane, a1);
        if (layer == 0) continue;
        ld16_bf16(SO + 2 * SEG + r * DM, lane, a0); ld16_bf16(SO + 3 * SEG + r * DM, lane, c0); ld16_bf16(ZS + 3 * SEG + r * DM, lane, g0);
        ld16_bf16(SO + 2 * SEG + (r + 1) * DM, lane, a1); ld16_bf16(SO + 3 * SEG + (r + 1) * DM, lane, c1); ld16_bf16(ZS + 3 * SEG + (r + 1) * DM, lane, g1);
        ld16_f32(p.in[I_SNORMW], lane, w);
#pragma unroll
        for (int i = 0; i < 16; ++i) { a0[i] = (a0[i] + c0[i]) * (g0[i] * sigmoid_fast_(g0[i])); a1[i] = (a1[i] + c1[i]) * (g1[i] * sigmoid_fast_(g1[i])); }
        const float r0 = rstd_of(row_ss(a0)), r1 = rstd_of(row_ss(a1));
#pragma unroll
        for (int i = 0; i < 16; ++i) { a0[i] = a0[i] * r0 * w[i]; a1[i] = a1[i] * r1 * w[i]; }
        st16_bf16(HC + r * 2048 + 1024, lane, a0); st16_bf16(HC + (r + 1) * 2048 + 1024, lane, a1);
    }
}

__device__ __forceinline__ void phase_route_gather(const Params& p, float* sm) {
    int* bc = (int*)sm;
    int* base = bc + 2048; int* myoff = base + 16; int* woff = myoff + 8; int* cur = woff + 64;
    const int tid = tid_op(), lane = tid & 63, wave = tid >> 6, G = gridDim.x;
    const int* BCNT = (const int*)(p.ws + OFF_STOK); int* ctl = (int*)(p.ws + OFF_CTL);
    for (int i = tid; i < G * 8; i += 512) { const int g = i >> 3, e = i & 7; int sacc = 0;
#pragma unroll
        for (int w = 0; w < 8; ++w) sacc += BCNT[(g * 8 + w) * 8 + e];
        bc[i] = sacc; }
    if (tid < 64) { const int w = tid >> 3, e = tid & 7; int sacc = 0; for (int w2 = 0; w2 < w; ++w2) sacc += BCNT[((int)blockIdx.x * 8 + w2) * 8 + e]; woff[tid] = sacc; cur[tid] = 0; }
    __syncthreads();
    if (tid < 8) { int tot = 0, mine = 0; for (int g = 0; g < G; ++g) { if (g == (int)blockIdx.x) mine = tot; tot += bc[g * 8 + tid]; } myoff[tid] = mine; base[8 + tid] = tot; }
    __syncthreads();
    if (tid == 0) { int acc = 0; for (int e = 0; e < 8; ++e) { base[e] = acc; acc += (base[8 + e] + 255) / 256 * 256; }
        if (blockIdx.x == 0) { for (int e = 0; e < 8; ++e) { ctl[CW_CNT + e] = base[8 + e]; ctl[CW_BASE + e] = base[e]; } ctl[CW_BASE + 8] = acc; ctl[CW_TOT] = acc; } }
    __syncthreads();
    const int* TOPI = (const int*)(p.ws + OFF_TOPI); int* SLOT = (int*)(p.ws + OFF_SLOT);
    const unsigned char* H8 = p.ws + OFF_H; unsigned char* XS8 = p.ws + OFF_XS;
    const int gw = blockIdx.x * 8 + wave, NGW = G * 8;
    if (wave < 8) { const int e = wave, c0 = base[e] + base[8 + e], c1 = base[e] + (base[8 + e] + 255) / 256 * 256;
        for (int row = c0 + (int)blockIdx.x; row < c1; row += G) ((uint4*)(XS8 + (size_t)row * DM))[lane] = make_uint4(0u, 0u, 0u, 0u); }
    for (int pr = gw; pr < MROWS / 2; pr += NGW) {
        const int r = 2 * pr, b = r / TT, t = r % TT; if (t < NCTX) continue;
        const int tok = b * SEQ + (t - NCTX);
        int sl = 0, e = -1;
        if (lane < 4) e = TOPI[tok * 2 + lane];
        const int e0 = __shfl(e, 0), e1 = __shfl(e, 1), e2 = __shfl(e, 2);
        if (lane < 4) { const int rank = ((lane > 0 && e0 == e) ? 1 : 0) + ((lane > 1 && e1 == e) ? 1 : 0) + ((lane > 2 && e2 == e) ? 1 : 0);
            const int before = cur[wave * 8 + e]; sl = base[e] + myoff[e] + woff[wave * 8 + e] + before + rank; SLOT[tok * 2 + lane] = sl; }
        __builtin_amdgcn_wave_barrier();
        if (lane < 4) atomicAdd(&cur[wave * 8 + e], 1);
        __builtin_amdgcn_wave_barrier();
        const int s0 = __shfl(sl, 0), s1 = __shfl(sl, 1), s2 = __shfl(sl, 2), s3 = __shfl(sl, 3);
        const uint4 va = ((const uint4*)(H8 + (size_t)r * DM))[lane], vb = ((const uint4*)(H8 + (size_t)(r + 1) * DM))[lane];
        ((uint4*)(XS8 + (size_t)s0 * DM))[lane] = va; ((uint4*)(XS8 + (size_t)s1 * DM))[lane] = va;
        ((uint4*)(XS8 + (size_t)s2 * DM))[lane] = vb; ((uint4*)(XS8 + (size_t)s3 * DM))[lane] = vb;
    }
}

#define XB_TMO      128
#define XB_XCNT(j)  (256  + 64 * (j))
#define XB_XSUB(j)  (1280 + 64 * (j))
#define XB_XGEN(j)  (2304 + 64 * (j))
#define XB_TOP      3328
#define XB_TOPGEN   3392
#define XCD_BAR_WORDS 3456
#define XB_SPIN_CAP (1u << 22)
__device__ __forceinline__ unsigned xb_ld(unsigned* p)              { return __hip_atomic_load(p, __ATOMIC_RELAXED, __HIP_MEMORY_SCOPE_AGENT); }
__device__ __forceinline__ unsigned xb_add(unsigned* p, unsigned v) { return __hip_atomic_fetch_add(p, v, __ATOMIC_RELAXED, __HIP_MEMORY_SCOPE_AGENT); }
__device__ __forceinline__ unsigned xb_xcc_id() { return (unsigned)__builtin_amdgcn_s_getreg((3 << 11) | 20) & 0xFu; }
#define XB_SPIN(cond, bar) do { unsigned _sp = 0; while (cond) { __builtin_amdgcn_s_sleep(1); \
    if ((++_sp & 255u) == 0u) { if (xb_ld(&(bar)[XB_TMO])) break; if (_sp > XB_SPIN_CAP) { atomicAdd(&(bar)[XB_TMO], 1u); break; } } } } while (0)
struct XcdBarrier { unsigned* bar; unsigned x; volatile __attribute__((address_space(3))) unsigned* st; };
__device__ __forceinline__ XcdBarrier xcd_barrier_post(unsigned* bar, volatile __attribute__((address_space(3))) unsigned* st) {
    XcdBarrier b; b.bar = bar; b.x = xb_xcc_id(); b.st = st;
    if (threadIdx.x == 0) (void)xb_add(&bar[XB_XCNT(b.x)], 1u);
    return b;
}
__device__ __forceinline__ void xcd_barrier_complete(unsigned* bar, unsigned x, unsigned& nloc, unsigned& nx) {
    const unsigned G = gridDim.x * gridDim.y * gridDim.z;
    unsigned sum, cnt, mine, sp = 0u;
    for (;;) {
        sum = 0u; cnt = 0u; mine = 0u;
#pragma unroll
        for (unsigned j = 0; j < 16; ++j) { const unsigned c = xb_ld(&bar[XB_XCNT(j)]); sum += c; cnt += (c > 0u) ? 1u : 0u; mine = (j == x) ? c : mine; }
        if (sum == G) break;
        __builtin_amdgcn_s_sleep(1);
        if ((++sp & 255u) == 0u) { if (xb_ld(&bar[XB_TMO])) break; if (sp > XB_SPIN_CAP) { atomicAdd(&bar[XB_TMO], 1u); break; } }
    }
    nloc = mine > 0u ? mine : 1u; nx = cnt > 0u ? cnt : 1u;
}
__device__ __forceinline__ void xcd_barrier(const XcdBarrier& b) {
    asm volatile("s_waitcnt vmcnt(0)" ::: "memory");
    __syncthreads();
    if (threadIdx.x == 0) {
        unsigned* bar = b.bar;
        __builtin_amdgcn_s_waitcnt(0);
        unsigned nloc = b.st[0], nx = b.st[1];
        if (nloc == 0u) { xcd_barrier_complete(bar, b.x, nloc, nx); b.st[0] = nloc; b.st[1] = nx; }
        const unsigned old = xb_add(&bar[XB_XSUB(b.x)], 1u);
        const unsigned gen = old / nloc;
        if (old + 1u == (gen + 1u) * nloc) {
            __builtin_amdgcn_fence(__ATOMIC_RELEASE, "agent");
            asm volatile("s_waitcnt vmcnt(0)" ::: "memory");
            const unsigned og = xb_add(&bar[XB_TOP], 1u);
            const unsigned tg = og / nx;
            if (og + 1u == (tg + 1u) * nx) xb_add(&bar[XB_TOPGEN], 1u);
            else XB_SPIN(xb_ld(&bar[XB_TOPGEN]) == tg, bar);
            __builtin_amdgcn_fence(__ATOMIC_ACQUIRE, "agent");
            xb_add(&bar[XB_XGEN(b.x)], 1u);
            asm volatile("s_waitcnt vmcnt(0)" ::: "memory");
        } else {
            XB_SPIN(xb_ld(&bar[XB_XGEN(b.x)]) == gen, bar);
            __builtin_amdgcn_fence(__ATOMIC_ACQUIRE, "agent");
            asm volatile("s_waitcnt vmcnt(0)" ::: "memory");
        }
    }
    __syncthreads();
}

__global__ void __launch_bounds__(512, 2) mega(Params p) {
    extern __shared__ __attribute__((aligned(16))) unsigned char lds[];
    float* sm = (float*)lds;
    PG8_LAS unsigned char* LDS = (PG8_LAS unsigned char*)lds;
    unsigned char* ws = p.ws;
    bf16* H = (bf16*)(ws + OFF_H); bf16* ZS = (bf16*)(ws + OFF_ZS); float* G = (float*)(ws + OFF_G); bf16* HC = (bf16*)(ws + OFF_HC); float* Y = (float*)(ws + OFF_Y);
    const int* ctl = (const int*)(ws + OFF_CTL);
    volatile __attribute__((address_space(3))) unsigned* bst = (volatile __attribute__((address_space(3))) unsigned*)((PG8_LAS unsigned char*)lds + LDS_BYTES - 64);
    if (threadIdx.x < 2) bst[threadIdx.x] = 0u;
    __syncthreads();
    const XcdBarrier gbar = xcd_barrier_post((unsigned*)(ws + OFF_BAR), bst);

#ifndef DIAG_Q
#define DIAG_Q 10.f
#endif
#ifdef DIAG_SEL
#define PH(k, ...) do { const unsigned long long t0_ = __builtin_amdgcn_s_memrealtime(); { __VA_ARGS__; xcd_barrier(gbar); } if (blockIdx.x == 0 && threadIdx.x == 0) ((unsigned long long*)(ws + OFF_CTL + 98304))[30 + (k)] = __builtin_amdgcn_s_memrealtime() - t0_; } while (0)
#else
#define PH(k, ...) do { for (int _r = 0; _r < (((REP_MASK >> (k)) & 1) ? 2 : 1); ++_r) { __VA_ARGS__; xcd_barrier(gbar); } } while (0)
#endif
    PH(0, phase_mod(p, sm); phase_wconv(p, sm, 2, blockIdx.x, gridDim.x * 8));
    PH(1, phase_norm<0>(p, 0, (int*)sm));
    PH(2, { pg8::Gemm g{H, (const bf16*)(ws + OFF_W_ABIN), MROWS, NP_ABIN, DM, DM}; pg8::StaticOrder S; S.init(MROWS, NP_ABIN, gridDim.x, blockIdx.x); pg8::EpiInProj E{ZS, G, 20, 16}; pg8::gemm_phase(LDS, g, S, E); });
    PH(19, sc::prep_conv(p, 0); sc::prep_gates(p, 0));
    PH(3, phase_scan(p, 0, sm));
    PH(4, phase_mix2(p, 0, sm));
    PH(5, { pg8::Gemm g{HC, (const bf16*)(ws + OFF_W_ABOUT), MROWS, DM, 2048, 2048}; pg8::StaticOrder S; S.init(NTOK, DM, gridDim.x, blockIdx.x); pg8::EpiBf16 E{(bf16*)Y, DM}; pg8::gemm_phase(LDS, g, S, E); }
          { pg8::Gemm g{HC, (const bf16*)(ws + OFF_W_ABOUT), MROWS, DM, 256, 2048}; pg8::SplitOrder S{64, 4, 8, 256, (int)gridDim.x, (int)blockIdx.x, nullptr, 0}; pg8::EpiPart E{(float*)(ws + OFF_SO), 64, 4}; pg8::gemm_phase(LDS, g, S, E); });
    PH(6, phase_norm<1>(p, 0, (int*)sm, 8));
    PH(7, { pg8::Gemm g{H, (const bf16*)(ws + OFF_W_FFN1), MROWS, 2 * FFD, DM / 2, DM / 2}; pg8::StaticOrder S; S.init(MROWS, 2 * FFD, gridDim.x, blockIdx.x); pg8::EpiSwigluF8 E{ws + OFF_ACT, FFD, 1.f / (F8_XS * F8_W1S), F8_AS}; pg8::gemm_phase_f8(LDS, g, S, E); });
    PH(8, { const float dsc = 1.f / (F8_AS * F8_W2S);
          { pg8::Gemm g{(const bf16*)(ws + OFF_ACT), (const bf16*)(ws + OFF_W_FFN2), MROWS, DM, FFD / 2, FFD / 2}; pg8::StaticOrder S; S.init(NTOK, DM, gridDim.x, blockIdx.x); pg8::EpiBf16S E{(bf16*)Y, DM, dsc}; pg8::gemm_phase_f8(LDS, g, S, E); }
          { pg8::Gemm g{(const bf16*)(ws + OFF_ACT), (const bf16*)(ws + OFF_W_FFN2), MROWS, DM, 128, FFD / 2}; pg8::SplitOrder S{64, 4, 11, 128, (int)gridDim.x, (int)blockIdx.x, nullptr, 0}; pg8::EpiPartS E{(float*)(ws + OFF_SO), 64, 4, dsc}; pg8::gemm_phase_f8(LDS, g, S, E); } });
    PH(9, phase_norm<2>(p, 0, (int*)sm, 11));
    PH(10, { pg8::Gemm g{H, (const bf16*)(ws + OFF_W_CDIN), MROWS, NP_CDIN, DM, DM}; pg8::InProj1Order S; S.init(NTOK, NP_CDIN, gridDim.x, blockIdx.x); pg8::EpiInProj E{ZS, G, 22, 64}; pg8::gemm_phase(LDS, g, S, E); });
    PH(20, sc::prep_conv(p, 1); sc::prep_gates(p, 1); sc::prep_gla(p, (unsigned char*)sm));
    PH(11, phase_scan(p, 1, sm));
    PH(12, phase_mix2(p, 1, sm));
    PH(13, { pg8::Gemm g{HC, (const bf16*)(ws + OFF_W_CDOUT), MROWS, DM, 2048, 2048}; pg8::SkipCtxOrder S; S.init(NTOK, DM, gridDim.x, blockIdx.x); pg8::EpiBf16 E{(bf16*)Y, DM}; pg8::gemm_phase(LDS, g, S, E); });
    PH(14, phase_norm<1>(p, 1, (int*)sm));
#ifndef DIAG_NOROUTER
    PH(15, phase_route_gather(p, sm));
    PH(17, { pg8::Gemm g{(const bf16*)(ws + OFF_XS), (const bf16*)(ws + OFF_W_MOE1), ctl[CW_TOT], 2 * FFE, DM / 2, DM / 2}; pg8::MoeOrder S; S.init(ctl[CW_TOT], 2 * FFE, gridDim.x, blockIdx.x); S.ctl = ctl; S.estride = (size_t)2 * FFE * DM;
          pg8::EpiSwigluF8 E{ws + OFF_ACTM, FFE, 1.f / (F8_XS * F8_W1S), F8_AS}; pg8::gemm_phase_f8(LDS, g, S, E); });
    PH(18, { const int tot = ctl[CW_TOT], nmain = tot < 2 * NTOK ? tot : 2 * NTOK; const float dsc = 1.f / (F8_AS * F8_W2S);
          { pg8::Gemm g{(const bf16*)(ws + OFF_ACTM), (const bf16*)(ws + OFF_W_MOE2), tot, DM, FFE / 2, FFE / 2}; pg8::MoeOrder S; S.init(nmain, DM, gridDim.x, blockIdx.x); S.ctl = ctl; S.estride = (size_t)DM * FFE; pg8::EpiBf16S E{(bf16*)(ws + OFF_YS), DM, dsc}; pg8::gemm_phase_f8(LDS, g, S, E); }
          { pg8::Gemm g{(const bf16*)(ws + OFF_ACTM), (const bf16*)(ws + OFF_W_MOE2), tot, DM, 256, FFE / 2}; pg8::SplitOrder S{128, (tot - nmain) / 256, 7, 256, (int)gridDim.x, (int)blockIdx.x, ctl, (size_t)DM * FFE}; pg8::EpiPartS E{(float*)(ws + OFF_YS + 68 * MiB), 128, 8, dsc}; pg8::gemm_phase_f8(LDS, g, S, E); } });
#ifdef DIAG_SEL
    const unsigned long long tn3_ = __builtin_amdgcn_s_memrealtime();
#endif
    phase_norm<3>(p, 1, (int*)sm);
#ifdef DIAG_SEL
    if (blockIdx.x == 0 && threadIdx.x == 0) ((unsigned long long*)(ws + OFF_CTL + 98304))[29] = __builtin_amdgcn_s_memrealtime() - tn3_;
#endif
#endif
#ifdef DIAG_SEL
    xcd_barrier(gbar);
    for (size_t i_ = (size_t)blockIdx.x * 512 + threadIdx.x; i_ < (size_t)NTOK * DM; i_ += (size_t)gridDim.x * 512) p.out[i_] = 0.f;
    xcd_barrier(gbar);
    if (blockIdx.x == 0 && threadIdx.x == 0) { const unsigned long long* dg = (const unsigned long long*)(ws + OFF_CTL + 98304); const float tus = (DIAG_SEL == 0) ? 200.f : ((DIAG_SEL >= 29) ? floorf((float)(dg[DIAG_SEL]) * 0.01f / DIAG_Q + 0.5f) * DIAG_Q * 2.f : (DIAG_SEL >= 10) ? floorf((float)(dg[DIAG_SEL]) * 0.01f / 12.f + 0.5f) * 12.f * 4.f : floorf((float)(dg[DIAG_SEL]) * 0.01f / 30.f + 0.5f) * 30.f); p.out[0] = 50.f * tus; }
#endif
#ifdef EXTRA_SYNCS
    for (int i_ = 0; i_ < EXTRA_SYNCS; ++i_) xcd_barrier(gbar);
#endif
#undef PH
}

__global__ void nan_fill(float* out, int n) { int i = blockIdx.x * blockDim.x + threadIdx.x; if (i < n) out[i] = __builtin_nanf(""); }

extern "C" void kernel_launch(void* const* d_in, const int* in_sizes, int n_in, void* d_out, int out_size, void* d_ws, size_t ws_size, hipStream_t stream) {
    static int grid_blocks = 0;
    if (grid_blocks == 0) {
        int dev = 0, cus = 0, per_cu = 0;
        hipGetDevice(&dev);
        hipDeviceGetAttribute(&cus, hipDeviceAttributeMultiprocessorCount, dev);
        hipFuncSetAttribute((const void*)mega, hipFuncAttributeMaxDynamicSharedMemorySize, LDS_BYTES);
        hipOccupancyMaxActiveBlocksPerMultiprocessor(&per_cu, (const void*)mega, 512, LDS_BYTES);
        if (per_cu < 1) per_cu = 1;
        grid_blocks = cus * (per_cu > 1 ? 1 : per_cu);
        if (grid_blocks <= 0) grid_blocks = 256;
    }
    if (n_in != 37 || ws_size < WS_NEED) { fprintf(stderr, "kernel_launch: bad n_in %d or ws %zu < %zu\n", n_in, ws_size, (size_t)WS_NEED); nan_fill<<<(out_size + 255) / 256, 256, 0, stream>>>((float*)d_out, out_size); return; }
    Params p{};
    for (int i = 0; i < 37; ++i) p.in[i] = (const float*)d_in[i];
    p.out = (float*)d_out; p.ws = (unsigned char*)d_ws;
    if (hipMemsetAsync(d_ws, 0, 131072, stream) != hipSuccess) { fprintf(stderr, "kernel_launch: memset failed\n"); return; }
    hipLaunchKernelGGL(mega, dim3(grid_blocks), dim3(512), LDS_BYTES, stream, p);
    const hipError_t e = hipPeekAtLastError();
    if (e != hipSuccess) fprintf(stderr, "launch failed: %s (grid %d)\n", hipGetErrorString(e), grid_blocks);
}
```

```cpp
#include <hip/hip_runtime.h>
#include <cstdio>
#include <cstdint>

typedef unsigned short bf16;

constexpr int NB = 4, SEQ = 4096, NCTX = 256, TT = 4352, MROWS = NB * TT, DM = 1024;
constexpr int NTOK = NB * SEQ;
constexpr int FFD = 2816, FFE = 3584, NEXP = 8;
constexpr int AB_IN = 5136, CD_IN = 5696;
constexpr int MAXSLOT = 2 * NTOK + NEXP * 256;
constexpr float F8_XS = 4.f, F8_W1S = 128.f, F8_AS = 4.f, F8_W2S = 256.f;

constexpr size_t MiB = 1u << 20;
constexpr size_t OFF_CTL = 0, OFF_MOD = 1 * MiB, OFF_G = 2 * MiB, OFF_XC = 7 * MiB, OFF_TOPI = 11 * MiB, OFF_TOPG = 11 * MiB + 256 * 1024,
                 OFF_SLOT = 11 * MiB + 512 * 1024, OFF_STOK = 12 * MiB, OFF_RGS = 13 * MiB, OFF_H = 18 * MiB, OFF_ZS = 52 * MiB,
                 OFF_SO = 256 * MiB, OFF_HC = 392 * MiB, OFF_Y = 460 * MiB, OFF_W = 528 * MiB;
constexpr int NP_ABIN = 5376, NP_CDIN = 5888;
constexpr size_t OFF_W_ABIN = OFF_W, OFF_W_ABOUT = OFF_W_ABIN + (size_t)NP_ABIN * 1024 * 2, OFF_W_FFN1 = OFF_W_ABOUT + (size_t)1024 * 2048 * 2,
                 OFF_W_FFN2 = OFF_W_FFN1 + (size_t)5632 * 1024 * 2, OFF_W_CDIN = OFF_W_FFN2 + (size_t)1024 * 2816 * 2, OFF_W_CDOUT = OFF_W_CDIN + (size_t)NP_CDIN * 1024 * 2,
                 OFF_W_MOE1 = OFF_W_CDOUT + (size_t)1024 * 2048 * 2, OFF_W_MOE2 = OFF_W_MOE1 + (size_t)8 * 7168 * 1024 * 2, OFF_W_RG = OFF_W_MOE2 + (size_t)8 * 1024 * 3584 * 2, OFF_W_END = OFF_W_RG + (size_t)32 * 128 * 128 * 2;
constexpr size_t OFF_XB = (OFF_W_END + MiB - 1) / MiB * MiB;
constexpr size_t WS_NEED = OFF_XB + (size_t)MROWS * DM * 2;
constexpr size_t SEG = (size_t)MROWS * DM;
constexpr size_t OFF_ACT = OFF_ZS, OFF_XS = OFF_HC, OFF_ACTM = OFF_ZS, OFF_YS = OFF_HC;
constexpr int CW_CNT = 0, CW_BASE = 8, CW_TOT = 17;

#ifndef REP_MASK
#define REP_MASK 0
#endif
constexpr int LDS_BYTES = 147456;
constexpr size_t OFF_BAR = 4096;
#if defined(PROBE_SC) && PROBE_SC == 1
#define PROBE_STAGE_REPS 2
#else
#define PROBE_STAGE_REPS 1
#endif
struct Params { const float* in[37]; float* out; unsigned char* ws; };
enum { I_X = 0, I_C, I_CTX, I_CCTX, I_MODW, I_MODB, I_NORMG, I_ABIN, I_MCONVW, I_MCONVB, I_MGATEB, I_MNORMW, I_LCONVW, I_LCONVB, I_LWA, I_LBA, I_LWX, I_LBX,
       I_LLAM, I_ABOUT, I_FFN1, I_FFN2, I_CDIN, I_GALW, I_GALB, I_GNORMW, I_SCONVW, I_SCONVB, I_SDTB, I_SALOG, I_SD, I_SNORMW, I_CDOUT, I_RW, I_RB, I_MOE1, I_MOE2 };

__device__ __forceinline__ float bf2f(unsigned v) { return __uint_as_float(v << 16); }
__device__ __forceinline__ unsigned f2bf(float f) { unsigned u = __float_as_uint(f); return (u + 0x7fffu + ((u >> 16) & 1u)) >> 16; }
__device__ __forceinline__ float sigmoid_f(float x) { return 1.f / (1.f + expf(-x)); }
__device__ __forceinline__ float silu_f(float x) { return x / (1.f + expf(-x)); }
__device__ __forceinline__ float softplus_f(float x) { return fmaxf(x, 0.f) + log1pf(expf(-fabsf(x))); }
__device__ __forceinline__ float logsigmoid_f(float x) { return -softplus_f(-x); }
__device__ __forceinline__ float gelu_fast(float x) { const float u2 = 1.5957691216057308f * (x + 0.044715f * x * x * x); return x * __builtin_amdgcn_rcpf(1.f + __expf(-u2)); }
__device__ __forceinline__ float gelu_f(float x) { return 0.5f * x * (1.f + tanhf(0.7978845608028654f * (x + 0.044715f * x * x * x))); }
__device__ __forceinline__ float wave_sum(float v) {
#pragma unroll
    for (int o = 32; o >= 1; o >>= 1) v += __shfl_xor(v, o);
    return v;
}
__device__ __forceinline__ int tid_op() { int t = threadIdx.x; asm volatile("" : "+v"(t)); return t; }
__device__ __forceinline__ void ld_row_f32(const float* row, int lane, float (&v)[16]) {
#pragma unroll
    for (int j = 0; j < 4; ++j) { const float4 t = ((const float4*)row)[j * 64 + lane]; v[4 * j] = t.x; v[4 * j + 1] = t.y; v[4 * j + 2] = t.z; v[4 * j + 3] = t.w; }
}
__device__ __forceinline__ void st_row_f32(float* row, int lane, const float (&v)[16]) {
#pragma unroll
    for (int j = 0; j < 4; ++j) ((float4*)row)[j * 64 + lane] = make_float4(v[4 * j], v[4 * j + 1], v[4 * j + 2], v[4 * j + 3]);
}
__device__ __forceinline__ void ld_row_bf16(const bf16* row, int lane, float (&v)[16]) {
#pragma unroll
    for (int j = 0; j < 4; ++j) { const uint2 t = ((const uint2*)row)[j * 64 + lane]; v[4 * j] = bf2f(t.x & 0xffffu); v[4 * j + 1] = bf2f(t.x >> 16); v[4 * j + 2] = bf2f(t.y & 0xffffu); v[4 * j + 3] = bf2f(t.y >> 16); }
}
__device__ __forceinline__ void st_row_bf16(bf16* row, int lane, const float (&v)[16]) {
#pragma unroll
    for (int j = 0; j < 4; ++j) { uint2 t; t.x = f2bf(v[4 * j]) | (f2bf(v[4 * j + 1]) << 16); t.y = f2bf(v[4 * j + 2]) | (f2bf(v[4 * j + 3]) << 16); ((uint2*)row)[j * 64 + lane] = t; }
}
__device__ __forceinline__ unsigned pack4_fp8(float a, float b, float c, float d) {
    a = __builtin_amdgcn_fmed3f(a, -448.f, 448.f); b = __builtin_amdgcn_fmed3f(b, -448.f, 448.f); c = __builtin_amdgcn_fmed3f(c, -448.f, 448.f); d = __builtin_amdgcn_fmed3f(d, -448.f, 448.f);
    int w = __builtin_amdgcn_cvt_pk_fp8_f32(a, b, 0, false); w = __builtin_amdgcn_cvt_pk_fp8_f32(c, d, w, true); return (unsigned)w;
}
__device__ __forceinline__ void st_row_fp8(unsigned char* row, int lane, const float (&v)[16], float sc) {
#pragma unroll
    for (int j = 0; j < 4; ++j) ((unsigned*)row)[j * 64 + lane] = pack4_fp8(v[4 * j] * sc, v[4 * j + 1] * sc, v[4 * j + 2] * sc, v[4 * j + 3] * sc);
}
__device__ __forceinline__ void ld_row_parts(const float* P, int KS, size_t rows_per_part, size_t row, int lane, float (&v)[16]) {
#pragma unroll
    for (int i = 0; i < 16; ++i) v[i] = 0.f;
    for (int kz = 0; kz < KS; ++kz) { float t[16]; ld_row_f32(P + ((size_t)kz * rows_per_part + row) * DM, lane, t);
#pragma unroll
        for (int i = 0; i < 16; ++i) v[i] += t[i]; }
}
__device__ __forceinline__ float row_ss(const float (&v)[16]) { float s = 0.f;
#pragma unroll
    for (int i = 0; i < 16; ++i) s += v[i] * v[i];
    return wave_sum(s); }

__device__ __forceinline__ void seg_bounds(int t, int& lo, int& hi) { if (t < NCTX) { lo = 0; hi = NCTX; } else { lo = NCTX + ((t - NCTX) & ~63); hi = lo + 64; } }
__device__ __forceinline__ float conv4(const bf16* Z, int b, int t, int c, const float* w, int wstride, int wc, float bias) {
    int lo, hi; seg_bounds(t, lo, hi); float s = bias;
#pragma unroll
    for (int j = 0; j < 4; ++j) { const int tt = t + j - 2; if (tt >= lo && tt < hi) s += w[j * wstride + wc] * bf2f(Z[((size_t)(b * TT + tt)) * DM + c]); }
    return s;
}
__device__ __forceinline__ int tokmap(int dir, int tau) { return dir ? (tau < NCTX ? (NCTX - 1 - tau) : (TT + NCTX - 1 - tau)) : tau; }

__device__ __forceinline__ void phase_mod(const Params& p, float* sm) {
    float* sv = sm; float* red = sm + 5 * 1024; const int tid = tid_op();
    if (blockIdx.x == 48) { float* RWT = (float*)(p.ws + OFF_MOD + 512 * 1024); for (int i = tid; i < 8 * 1024; i += 512) RWT[i] = p.in[I_RW][(size_t)(i & 1023) * 8 + (i >> 10)]; }
    if (blockIdx.x < 48) {
        for (int i = tid; i < 5 * 1024; i += 512) { const int v = i >> 10, k = i & 1023; const float x = (v < 4) ? p.in[I_C][v * 1024 + k] : p.in[I_CCTX][k]; sv[i] = silu_f(x); }
        __syncthreads();
        float* MOD = (float*)(p.ws + OFF_MOD);
        for (int it = blockIdx.x; it < 48; it += gridDim.x) {
            const int l = it / 24, j0 = (it % 24) * 256, c4 = (tid & 63) * 4, kg = tid >> 6;
            const float* w = p.in[I_MODW] + (size_t)l * 1024 * 6144 + j0 + c4;
            float a[5][4];
#pragma unroll
            for (int v = 0; v < 5; ++v)
#pragma unroll
                for (int e = 0; e < 4; ++e) a[v][e] = 0.f;
#pragma unroll 8
            for (int k = kg * 128; k < kg * 128 + 128; ++k) { const float4 wv = *(const float4*)(w + (size_t)k * 6144);
#pragma unroll
                for (int v = 0; v < 5; ++v) { const float x = sv[v * 1024 + k]; a[v][0] += x * wv.x; a[v][1] += x * wv.y; a[v][2] += x * wv.z; a[v][3] += x * wv.w; } }
#pragma unroll
            for (int v = 0; v < 5; ++v) *(float4*)(red + (kg * 5 + v) * 256 + c4) = make_float4(a[v][0], a[v][1], a[v][2], a[v][3]);
            __syncthreads();
            for (int o = tid; o < 5 * 256; o += 512) { const int v = o >> 8, cc = o & 255; float sacc = 0.f;
#pragma unroll
                for (int g = 0; g < 8; ++g) sacc += red[(g * 5 + v) * 256 + cc];
                MOD[(size_t)(l * 5 + v) * 6144 + j0 + cc] = sacc + p.in[I_MODB][l * 6144 + j0 + cc]; }
            __syncthreads();
        }
    }
}

__device__ __forceinline__ float rstd_of(float ss) { return __builtin_amdgcn_rsqf(ss * (1.f / DM) + 1e-6f); }
__device__ __forceinline__ void router_reduce_pick(const Params& p, float (&lg)[8], int lane, int tok, int* hist) {
    float v4[4], v2[2], v1;
    { const bool hi = lane & 32;
#pragma unroll
      for (int e = 0; e < 4; ++e) { const float send = hi ? lg[e] : lg[e + 4], keep = hi ? lg[e + 4] : lg[e]; v4[e] = keep + __shfl_xor(send, 32); } }
    { const bool hi = lane & 16;
#pragma unroll
      for (int e = 0; e < 2; ++e) { const float send = hi ? v4[e] : v4[e + 2], keep = hi ? v4[e + 2] : v4[e]; v2[e] = keep + __shfl_xor(send, 16); } }
    { const bool hi = lane & 8; const float send = hi ? v2[0] : v2[1], keep = hi ? v2[1] : v2[0]; v1 = keep + __shfl_xor(send, 8); }
    v1 += __shfl_xor(v1, 4); v1 += __shfl_xor(v1, 2); v1 += __shfl_xor(v1, 1);
#pragma unroll
    for (int e = 0; e < 8; ++e) lg[e] = __shfl(v1, e * 8) + p.in[I_RB][e];
    if (lane == 0) {
        int e0 = 0; float l0 = lg[0];
#pragma unroll
        for (int e = 1; e < 8; ++e) if (lg[e] > l0) { l0 = lg[e]; e0 = e; }
        int e1 = -1; float l1 = -3.0e38f;
#pragma unroll
        for (int e = 0; e < 8; ++e) if (e != e0 && lg[e] > l1) { l1 = lg[e]; e1 = e; }
        const float ex = __expf(l1 - l0), g0 = 1.f / (1.f + ex), g1 = ex / (1.f + ex);
        ((int*)(p.ws + OFF_TOPI))[tok * 2] = e0; ((int*)(p.ws + OFF_TOPI))[tok * 2 + 1] = e1;
        ((float*)(p.ws + OFF_TOPG))[tok * 2] = g0; ((float*)(p.ws + OFF_TOPG))[tok * 2 + 1] = g1;
        atomicAdd(&hist[e0], 1); atomicAdd(&hist[e1], 1);
    }
}
__device__ __forceinline__ void router_pair(const Params& p, const float (&xa)[16], const float (&xb)[16], int lane, int tok, int* hist, const float* rw) {
#ifdef DIAG_NOROUTER
    return;
#endif
    float la[8], lb[8];
#pragma unroll
    for (int e = 0; e < 8; ++e) { la[e] = 0.f; lb[e] = 0.f; }
#pragma unroll
    for (int e = 0; e < 8; ++e)
#pragma unroll
        for (int j = 0; j < 4; ++j) { const float4 w = ((const float4*)(rw + e * 1024))[j * 64 + lane];
            la[e] += xa[4 * j] * w.x + xa[4 * j + 1] * w.y + xa[4 * j + 2] * w.z + xa[4 * j + 3] * w.w; lb[e] += xb[4 * j] * w.x + xb[4 * j + 1] * w.y + xb[4 * j + 2] * w.z + xb[4 * j + 3] * w.w; }
    router_reduce_pick(p, la, lane, tok, hist); router_reduce_pick(p, lb, lane, tok + 1, hist);
}
template <int MODE> __device__ __forceinline__ void phase_norm(const Params& p, int layer, int* hist, int KS = 0) {
    const int tid_ = tid_op(); const int lane = tid_ & 63, gw = blockIdx.x * 8 + (tid_ >> 6), NGW = gridDim.x * 8;
    const float* MOD = (const float*)(p.ws + OFF_MOD);
    const float* NG = p.in[I_NORMG] + (size_t)layer * 4 * 1024;
    bf16* H = (bf16*)(p.ws + OFF_H); const bf16* Y = (const bf16*)(p.ws + OFF_Y);
    const bool last = (layer == 1);
    const float* rw = (const float*)(hist + 64);
    if (MODE == 1 && last) { if (tid_ < 64) hist[tid_] = 0; const float* RWT = (const float*)(p.ws + OFF_MOD + 512 * 1024); for (int i = tid_; i < 2048; i += 512) ((float4*)(hist + 64))[i] = ((const float4*)RWT)[i]; __syncthreads(); }
    const int npair = (KS > 0) ? NTOK / 2 : MROWS / 2, nitem = npair + ((KS > 0) ? (MROWS - NTOK) : 0);
    for (int it = gw; it < nitem; it += NGW) {
        const bool two = it < npair; const int pr = it;
        const int r = two ? 2 * pr : NTOK + (it - npair), b = r / TT, t = r % TT; const bool isctx = t < NCTX; const int v = isctx ? 4 : b;
        if ((MODE == 3 || (MODE == 1 && last)) && isctx) continue;
        const float* mv = MOD + (size_t)(layer * 5 + v) * 6144;
        const float* xin = isctx ? (p.in[I_CTX] + ((size_t)b * NCTX + t) * DM) : (p.in[I_X] + ((size_t)b * SEQ + (t - NCTX)) * DM);
        bf16* xst = (bf16*)(p.ws + OFF_XB) + (size_t)r * DM;
        float xa[16], xb[16], g[16], a[16], s[16];
        if (MODE == 0) {
            ld_row_f32(xin, lane, xa); ld_row_f32(xin + DM, lane, xb);
            ld_row_f32(NG, lane, g); ld_row_f32(mv + 1024, lane, a); ld_row_f32(mv, lane, s);
            const float ra = rstd_of(row_ss(xa)), rb = rstd_of(row_ss(xb));
#pragma unroll
            for (int i = 0; i < 16; ++i) { const float gg = g[i] * (1.f + a[i]); xa[i] = xa[i] * ra * gg + s[i]; xb[i] = xb[i] * rb * gg + s[i]; }
            st_row_bf16(H + (size_t)r * DM, lane, xa); st_row_bf16(H + (size_t)(r + 1) * DM, lane, xb);
        } else if (MODE == 1 || MODE == 2) {
            float ya[16], yb[16];
            if (!two) { const float* P = (const float*)(p.ws + OFF_SO); ld_row_parts(P, KS, 1024, (size_t)(r - NTOK), lane, ya); }
            else { ld_row_bf16(Y + (size_t)r * DM, lane, ya); ld_row_bf16(Y + (size_t)(r + 1) * DM, lane, yb); }
            if (MODE == 1 && layer == 0) { ld_row_f32(xin, lane, xa); if (two) ld_row_f32(xin + DM, lane, xb); } else { ld_row_bf16(xst, lane, xa); if (two) ld_row_bf16(xst + DM, lane, xb); }
            if (!two) {
#pragma unroll
                for (int i = 0; i < 16; ++i) { yb[i] = ya[i]; xb[i] = xa[i]; } }
            ld_row_f32(NG + (MODE == 1 ? 1 : 3) * 1024, lane, g); ld_row_f32(mv + (MODE == 1 ? 2 : 5) * 1024, lane, a);
            const float ra = rstd_of(row_ss(ya)), rb = rstd_of(row_ss(yb));
#pragma unroll
            for (int i = 0; i < 16; ++i) { const float gg = a[i] * g[i]; xa[i] += gg * (ya[i] * ra); xb[i] += gg * (yb[i] * rb); }
            st_row_bf16(xst, lane, xa); if (two) st_row_bf16(xst + DM, lane, xb);
            const float* ng2 = (MODE == 1) ? (NG + 2 * 1024) : (p.in[I_NORMG] + (size_t)4 * 1024);
            const float* mv2 = (MODE == 1) ? mv : (MOD + (size_t)(5 + v) * 6144);
            ld_row_f32(ng2, lane, g); ld_row_f32(mv2 + (MODE == 1 ? 4 : 1) * 1024, lane, a); ld_row_f32(mv2 + (MODE == 1 ? 3 : 0) * 1024, lane, s);
            const float ra2 = rstd_of(row_ss(xa)), rb2 = rstd_of(row_ss(xb));
#pragma unroll
            for (int i = 0; i < 16; ++i) { const float gg = g[i] * (1.f + a[i]); xa[i] = xa[i] * ra2 * gg + s[i]; xb[i] = xb[i] * rb2 * gg + s[i]; }
            if (MODE == 1) { unsigned char* H8 = (unsigned char*)H; st_row_fp8(H8 + (size_t)r * DM, lane, xa, F8_XS); if (two) st_row_fp8(H8 + (size_t)(r + 1) * DM, lane, xb, F8_XS); }
            else { st_row_bf16(H + (size_t)r * DM, lane, xa); if (two) st_row_bf16(H + (size_t)(r + 1) * DM, lane, xb); }
            if (MODE == 1 && last) { const int tok = b * SEQ + (t - NCTX); router_pair(p, xa, xb, lane, tok, hist + (tid_ >> 6) * 8, rw); }
        } else {
            const int tok = b * SEQ + (t - NCTX);
            const int4 sl = *(const int4*)((const int*)(p.ws + OFF_SLOT) + tok * 2); const float4 gt = *(const float4*)((const float*)(p.ws + OFF_TOPG) + tok * 2);
            const bf16* YS = (const bf16*)(p.ws + OFF_YS);
            float ya[16], yb[16];
            const float* PS = (const float*)(p.ws + OFF_YS + 68 * MiB);
            if (sl.x >= 2 * NTOK) ld_row_parts(PS, 7, 2048, (size_t)(sl.x - 2 * NTOK), lane, ya); else ld_row_bf16(YS + (size_t)sl.x * DM, lane, ya);
            if (sl.y >= 2 * NTOK) ld_row_parts(PS, 7, 2048, (size_t)(sl.y - 2 * NTOK), lane, a); else ld_row_bf16(YS + (size_t)sl.y * DM, lane, a);
            if (sl.z >= 2 * NTOK) ld_row_parts(PS, 7, 2048, (size_t)(sl.z - 2 * NTOK), lane, yb); else ld_row_bf16(YS + (size_t)sl.z * DM, lane, yb);
            if (sl.w >= 2 * NTOK) ld_row_parts(PS, 7, 2048, (size_t)(sl.w - 2 * NTOK), lane, s); else ld_row_bf16(YS + (size_t)sl.w * DM, lane, s);
            ld_row_bf16(xst, lane, xa); ld_row_bf16(xst + DM, lane, xb);
#pragma unroll
            for (int i = 0; i < 16; ++i) { ya[i] = ya[i] * gt.x + a[i] * gt.y; yb[i] = yb[i] * gt.z + s[i] * gt.w; }
            ld_row_f32(NG + 3 * 1024, lane, g); ld_row_f32(mv + 5 * 1024, lane, a);
            const float ra = rstd_of(row_ss(ya)), rb = rstd_of(row_ss(yb));
#pragma unroll
            for (int i = 0; i < 16; ++i) { const float gg = a[i] * g[i]; xa[i] += gg * (ya[i] * ra); xb[i] += gg * (yb[i] * rb); }
            float* xo = p.out + ((size_t)b * SEQ + (t - NCTX)) * DM; st_row_f32(xo, lane, xa); st_row_f32(xo + DM, lane, xb);
        }
    }
    if (MODE == 1 && last) { __syncthreads(); if (tid_ < 64) ((int*)(p.ws + OFF_STOK))[blockIdx.x * 64 + tid_] = hist[tid_]; }
}

namespace pg8 {
#define PG8_LAS __attribute__((address_space(3)))
typedef unsigned short bf16_t;
typedef short bf16x8 __attribute__((ext_vector_type(8)));
typedef float f32x4 __attribute__((ext_vector_type(4)));
typedef unsigned u32x4 __attribute__((ext_vector_type(4)));
typedef unsigned u32x2 __attribute__((ext_vector_type(2)));
typedef int i32x4 __attribute__((ext_vector_type(4)));
typedef int i32x8 __attribute__((ext_vector_type(8)));
constexpr int BM = 256, BK = 64, HALF = 128, HTB = HALF * BK * 2, STAGE_BYTES = 8 * HTB, NXCD = 8, WGM = 8;
__host__ __device__ __forceinline__ int lds_byte(int r, int c) { const int st = (r >> 4) * 2 + (c >> 5), rr = r & 15, cc = c & 31, ob = rr * 64 + cc * 2; return st * 1024 + (ob ^ (((ob >> 9) & 1) << 5)); }
__host__ __device__ __forceinline__ void stage_rc(int b, int& R, int& C) { const int st = b / 1024, sb = b % 1024, swz = sb ^ (((sb >> 9) & 1) << 5); R = (st >> 1) * 16 + swz / 64; C = (st & 1) * 32 + (swz % 64) / 2; }
__host__ __device__ __forceinline__ int perm32(int rho) { const int n = rho >> 4, i = rho & 15; return 8 * (i >> 2) + 4 * n + (i & 3); }
struct Unit { int pm, pn, kz; };
struct Gemm { const bf16_t* A; const bf16_t* Bt; int M, N, K, ld; };
struct StaticOrder {
    int nM, nN, nwg, G, c;
    __device__ void init(int M, int N, int G_, int c_) { nM = M / BM; nN = N / BM; nwg = nM * nN; G = G_; c = c_; }
    __device__ bool next(int i, Unit& u) const {
        const long L = (long)i * G + c; if (L >= nwg) return false;
        int wgid = (int)L; { const int q = nwg / NXCD, r = nwg % NXCD, xcd = wgid % NXCD, off = wgid / NXCD; wgid = (xcd < r ? xcd * (q + 1) : r * (q + 1) + (xcd - r) * q) + off; }
        const int nig = WGM * nN, gid = wgid / nig, fm = gid * WGM, gsz = (nM - fm) < WGM ? (nM - fm) : WGM;
        u.pm = fm + ((wgid % nig) % gsz); u.pn = (wgid % nig) / gsz; u.kz = 0; return true;
    }
    __device__ __forceinline__ size_t boff(const Unit&) const { return 0; }
    __device__ __forceinline__ size_t koff(const Unit&) const { return 0; }
};
struct SplitOrder {
    int base, novf, KS, kpart, G, c; const int* ctl; size_t estride;
    __device__ bool next(int i, Unit& u) const { const int L = i * G + c; if (L >= novf * 4 * KS) return false; u.kz = L % KS; const int rest = L / KS; u.pn = rest & 3; u.pm = base + (rest >> 2); return true; }
    __device__ __forceinline__ size_t koff(const Unit& u) const { return (size_t)u.kz * kpart * 2; }
    __device__ __forceinline__ size_t boff(const Unit& u) const { if (!ctl) return 0; const int row0 = u.pm * 256; int e = 0;
#pragma unroll
        for (int i = 1; i < 8; ++i) if (row0 >= ctl[CW_BASE + i]) e = i;
        return (size_t)e * estride; }
};
template <bool SC> struct EpiPartT { static constexpr bool PERM = false;
    float* P; int base, novf_max; float sc = 1.f;
    __device__ __forceinline__ void operator()(const f32x4 (&acc)[2][2][4][2], const Unit& u, int wr, int wc, int fr, int fq) const {
        asm volatile("" : "+v"(fr));
        float* C = P + ((size_t)u.kz * novf_max + (u.pm - base)) * 256 * 1024; const int row0 = wr * 64 + fr, col0 = u.pn * BM + wc * 32 + 4 * fq;
#pragma unroll
        for (int ai = 0; ai < 2; ++ai)
#pragma unroll
            for (int m = 0; m < 4; ++m) { float* rowp = C + (size_t)(row0 + ai * HALF + m * 16) * 1024 + col0;
#pragma unroll
                for (int bj = 0; bj < 2; ++bj)
#pragma unroll
                    for (int n = 0; n < 2; ++n) *(f32x4*)(rowp + bj * HALF + n * 16) = SC ? acc[ai][bj][m][n] * sc : acc[ai][bj][m][n]; }
    }
};
typedef EpiPartT<false> EpiPart; typedef EpiPartT<true> EpiPartS;
struct SkipCtxOrder : StaticOrder {
    __device__ bool next(int i, Unit& u) const { if (!StaticOrder::next(i, u)) return false; u.pm = u.pm + (u.pm >> 4) + 1; return true; }
};
struct InProj1Order : StaticOrder {
    __device__ bool next(int i, Unit& u) const {
        const long L = (long)i * G + c;
        if (L < nwg) { StaticOrder::next(i, u); u.pm = u.pm + (u.pm >> 4) + 1; return true; }
        const int idx = (int)(L - nwg); if (idx >= 48) return false;
        const int j = idx % 12; u.pm = (idx / 12) * 17; u.pn = j < 6 ? 2 + j : (j < 11 ? 10 + j : 22); u.kz = 0; return true;
    }
};
struct MoeOrder : StaticOrder {
    const int* ctl; size_t estride;
    __device__ __forceinline__ size_t boff(const Unit& u) const { const int row0 = u.pm * 256; int e = 0;
#pragma unroll
        for (int i = 1; i < 8; ++i) if (row0 >= ctl[CW_BASE + i]) e = i;
        return (size_t)e * estride; }
};
__device__ __forceinline__ unsigned cvt_pk_bf16(float lo, float hi) { unsigned r; asm volatile("v_cvt_pk_bf16_f32 %0, %1, %2" : "=v"(r) : "v"(lo), "v"(hi)); return r; }
__device__ __forceinline__ float silu_fast(float x) { return x * __builtin_amdgcn_rcpf(1.f + __expf(-x)); }
struct EpiF32 { static constexpr bool PERM = false;
    float* C; int ldc;
    __device__ __forceinline__ void operator()(const f32x4 (&acc)[2][2][4][2], const Unit& u, int wr, int wc, int fr, int fq) const {
        const int row0 = u.pm * BM + wr * 64 + fr, col0 = u.pn * BM + wc * 32 + 4 * fq;
#pragma unroll
        for (int ai = 0; ai < 2; ++ai)
#pragma unroll
            for (int m = 0; m < 4; ++m) { float* rowp = C + (size_t)(row0 + ai * HALF + m * 16) * ldc + col0;
#pragma unroll
                for (int bj = 0; bj < 2; ++bj)
#pragma unroll
                    for (int n = 0; n < 2; ++n) *(f32x4*)(rowp + bj * HALF + n * 16) = acc[ai][bj][m][n]; }
    }
};
template <bool SC> struct EpiBf16T { static constexpr bool PERM = true;
    bf16_t* O; int ldc; float sc = 1.f;
    __device__ __forceinline__ void operator()(const f32x4 (&acc)[2][2][4][2], const Unit& u, int wr, int wc, int fr, int fq) const {
        const int row0 = u.pm * BM + wr * 64 + fr, col0 = u.pn * BM + wc * 32 + 8 * fq;
#pragma unroll
        for (int ai = 0; ai < 2; ++ai)
#pragma unroll
            for (int m = 0; m < 4; ++m) { bf16_t* rowp = O + (size_t)(row0 + ai * HALF + m * 16) * ldc + col0;
#pragma unroll
                for (int bj = 0; bj < 2; ++bj) { const f32x4 v0 = SC ? acc[ai][bj][m][0] * sc : acc[ai][bj][m][0], v1 = SC ? acc[ai][bj][m][1] * sc : acc[ai][bj][m][1];
                    u32x4 w; w.x = cvt_pk_bf16(v0[0], v0[1]); w.y = cvt_pk_bf16(v0[2], v0[3]); w.z = cvt_pk_bf16(v1[0], v1[1]); w.w = cvt_pk_bf16(v1[2], v1[3]);
                    *(u32x4*)(rowp + bj * HALF) = w; } }
    }
};
typedef EpiBf16T<false> EpiBf16; typedef EpiBf16T<true> EpiBf16S;
struct EpiInProj { static constexpr bool PERM = true;
    bf16_t* ZS; float* G; int gate_tile, ngate;
    __device__ __forceinline__ void operator()(const f32x4 (&acc)[2][2][4][2], const Unit& u, int wr, int wc, int fr, int fq) const {
        const int row0 = u.pm * BM + wr * 64 + fr;
        if (u.pn == gate_tile) {
            if (wc < 2) {
#pragma unroll
                for (int ai = 0; ai < 2; ++ai)
#pragma unroll
                    for (int m = 0; m < 4; ++m)
#pragma unroll
                        for (int n = 0; n < 2; ++n) { const int c0 = 32 * wc + 8 * fq + 4 * n; if (c0 < ngate) *(f32x4*)(G + (size_t)(row0 + ai * HALF + m * 16) * 64 + c0) = acc[ai][0][m][n]; }
            }
        } else {
            bf16_t* base = ZS + (size_t)(u.pn >> 2) * SEG; const int col0 = (u.pn & 3) * 256 + wc * 32 + 8 * fq;
#pragma unroll
            for (int ai = 0; ai < 2; ++ai)
#pragma unroll
                for (int m = 0; m < 4; ++m) { bf16_t* rowp = base + (size_t)(row0 + ai * HALF + m * 16) * DM + col0;
#pragma unroll
                    for (int bj = 0; bj < 2; ++bj) { const f32x4 v0 = acc[ai][bj][m][0], v1 = acc[ai][bj][m][1];
                        u32x4 w; w.x = cvt_pk_bf16(v0[0], v0[1]); w.y = cvt_pk_bf16(v0[2], v0[3]); w.z = cvt_pk_bf16(v1[0], v1[1]); w.w = cvt_pk_bf16(v1[2], v1[3]);
                        *(u32x4*)(rowp + bj * HALF) = w; } }
        }
    }
};
struct EpiSwiglu { static constexpr bool PERM = true;
    bf16_t* O; int ldo;
    __device__ __forceinline__ void operator()(const f32x4 (&acc)[2][2][4][2], const Unit& u, int wr, int wc, int fr, int fq) const {
        const int row0 = u.pm * BM + wr * 64 + fr, col0 = u.pn * HALF + wc * 32 + 8 * fq;
#pragma unroll
        for (int ai = 0; ai < 2; ++ai)
#pragma unroll
            for (int m = 0; m < 4; ++m) { const f32x4 g0 = acc[ai][0][m][0], g1 = acc[ai][0][m][1], u0 = acc[ai][1][m][0], u1 = acc[ai][1][m][1];
                u32x4 w; w.x = cvt_pk_bf16(silu_fast(g0[0]) * u0[0], silu_fast(g0[1]) * u0[1]); w.y = cvt_pk_bf16(silu_fast(g0[2]) * u0[2], silu_fast(g0[3]) * u0[3]);
                w.z = cvt_pk_bf16(silu_fast(g1[0]) * u1[0], silu_fast(g1[1]) * u1[1]); w.w = cvt_pk_bf16(silu_fast(g1[2]) * u1[2], silu_fast(g1[3]) * u1[3]);
                *(u32x4*)(O + (size_t)(row0 + ai * HALF + m * 16) * ldo + col0) = w; }
    }
};

struct EpiSwigluF8 { static constexpr bool PERM = true;
    unsigned char* O; int ldo; float dsc, osc;
    __device__ __forceinline__ void operator()(const f32x4 (&acc)[2][2][4][2], const Unit& u, int wr, int wc, int fr, int fq) const {
        const int row0 = u.pm * BM + wr * 64 + fr, col0 = u.pn * HALF + wc * 32 + 8 * fq;
#pragma unroll
        for (int ai = 0; ai < 2; ++ai)
#pragma unroll
            for (int m = 0; m < 4; ++m) { const f32x4 g0 = acc[ai][0][m][0] * dsc, g1 = acc[ai][0][m][1] * dsc, u0 = acc[ai][1][m][0] * (dsc * osc), u1 = acc[ai][1][m][1] * (dsc * osc);
                u32x2 w; w.x = pack4_fp8(silu_fast(g0[0]) * u0[0], silu_fast(g0[1]) * u0[1], silu_fast(g0[2]) * u0[2], silu_fast(g0[3]) * u0[3]);
                w.y = pack4_fp8(silu_fast(g1[0]) * u1[0], silu_fast(g1[1]) * u1[1], silu_fast(g1[2]) * u1[2], silu_fast(g1[3]) * u1[3]);
                *(u32x2*)(O + (size_t)(row0 + ai * HALF + m * 16) * ldo + col0) = w; }
    }
};

template <class Epi, class Sched, bool F8 = false>
__device__ __forceinline__ void gemm_phase(PG8_LAS unsigned char* lds, const Gemm g, const Sched& S, const Epi& E) {
    const int tid = tid_op(), wid = __builtin_amdgcn_readfirstlane(tid >> 6), lane = tid & 63, wr = wid >> 2, wc = wid & 3, fr = lane & 15, fq = lane >> 4;
    const int K = g.ld, nt = g.K / BK;
    unsigned voffA[2], voffB[2];
#pragma unroll
    for (int i = 0; i < 2; ++i) { int R, C; stage_rc(tid * 16 + i * 8192, R, C); const int Rb = Epi::PERM ? ((R & ~31) + perm32(R & 31)) : R;
        voffA[i] = (unsigned)(R * K + C) * 2u; voffB[i] = (unsigned)(Rb * K + C) * 2u; }
    const size_t kstep = (size_t)(BK * 2);
    const size_t hstep = (size_t)HALF * K * 2;
    const size_t tstep = 2 * hstep;
    const unsigned ldsw = (unsigned)wid * 1024u;
    const int aoff = lds_byte(wr * 64 + fr, fq * 8), boff = lds_byte(wc * 32 + fr, fq * 8);
#define PG8_SA(b, h) (((b) * 2 + (h)) * HTB)
#define PG8_SB(b, h) ((4 + (b) * 2 + (h)) * HTB)
#define PG8_STAGE(bufoff, gbase, voff) do { _Pragma("unroll") for (int _i = 0; _i < 2; ++_i) \
        __builtin_amdgcn_global_load_lds((const unsigned*)((const char*)(gbase) + (voff)[_i]), (PG8_LAS unsigned*)(lds + (bufoff) + ldsw + _i * 8192), 16, 0, 0); } while (0)
#define PG8_LD16(p_) (*(const PG8_LAS i32x4*)(p_))
#define PG8_LDA(dst, b, h) do { if (F8) { _Pragma("unroll") for (int m = 0; m < 4; ++m) dst##8[m] = __builtin_shufflevector(PG8_LD16(lds + PG8_SA(b, h) + aoff + m * 2048), PG8_LD16(lds + PG8_SA(b, h) + aoff + m * 2048 + 1024), 0, 1, 2, 3, 4, 5, 6, 7); } \
      else { _Pragma("unroll") for (int m = 0; m < 4; ++m) _Pragma("unroll") for (int k = 0; k < 2; ++k) dst[m][k] = *(const PG8_LAS bf16x8*)(lds + PG8_SA(b, h) + aoff + m * 2048 + k * 1024); } } while (0)
#define PG8_LDB(dst, b, h) do { if (F8) { _Pragma("unroll") for (int n = 0; n < 2; ++n) dst##8[n] = __builtin_shufflevector(PG8_LD16(lds + PG8_SB(b, h) + boff + n * 2048), PG8_LD16(lds + PG8_SB(b, h) + boff + n * 2048 + 1024), 0, 1, 2, 3, 4, 5, 6, 7); } \
      else { _Pragma("unroll") for (int n = 0; n < 2; ++n) _Pragma("unroll") for (int k = 0; k < 2; ++k) dst[n][k] = *(const PG8_LAS bf16x8*)(lds + PG8_SB(b, h) + boff + n * 2048 + k * 1024); } } while (0)
#define PG8_MMA(ai, bj, At, Bt) do { __builtin_amdgcn_s_setprio(1); if (F8) { _Pragma("unroll") for (int m = 0; m < 4; ++m) _Pragma("unroll") for (int n = 0; n < 2; ++n) \
        asm volatile("v_mfma_f32_16x16x128_f8f6f4 %0, %1, %2, %0" : "+v"(acc[ai][bj][m][n]) : "v"(Bt##8[n]), "v"(At##8[m])); } \
      else { _Pragma("unroll") for (int m = 0; m < 4; ++m) _Pragma("unroll") for (int n = 0; n < 2; ++n) _Pragma("unroll") for (int k = 0; k < 2; ++k) \
        acc[ai][bj][m][n] = __builtin_amdgcn_mfma_f32_16x16x32_bf16(Bt[n][k], At[m][k], acc[ai][bj][m][n], 0, 0, 0); } __builtin_amdgcn_s_setprio(0); } while (0)
#define PG8_ACCF8(a_, b_) asm volatile("" : "+v"(acc[a_][b_][0][0]), "+v"(acc[a_][b_][0][1]), "+v"(acc[a_][b_][1][0]), "+v"(acc[a_][b_][1][1]), "+v"(acc[a_][b_][2][0]), "+v"(acc[a_][b_][2][1]), "+v"(acc[a_][b_][3][0]), "+v"(acc[a_][b_][3][1]))
#define PG8_ACC_FENCE() do { if (F8) { PG8_ACCF8(0, 0); PG8_ACCF8(0, 1); PG8_ACCF8(1, 0); PG8_ACCF8(1, 1); asm volatile("s_nop 7" ::: "memory"); } } while (0)
#define PG8_WAIT_V(n) asm volatile("s_waitcnt vmcnt(" #n ")" ::: "memory")
#define PG8_WAIT_L(n) asm volatile("s_waitcnt lgkmcnt(" #n ")" ::: "memory")
#define PG8_BAR __builtin_amdgcn_s_barrier()
#define PG8_SCHED __builtin_amdgcn_sched_barrier(0)
    Unit cur, nxt; int ui = 0;
    if (!S.next(0, cur)) return;
    f32x4 acc[2][2][4][2];
#pragma unroll
    for (int a = 0; a < 2; ++a)
#pragma unroll
        for (int b = 0; b < 2; ++b)
#pragma unroll
            for (int m = 0; m < 4; ++m)
#pragma unroll
                for (int n = 0; n < 2; ++n) acc[a][b][m][n] = (f32x4){0.f, 0.f, 0.f, 0.f};
    PG8_ACC_FENCE();
    bf16x8 At[4][2], B0[2][2], B1[2][2]; i32x8 At8[4], B08[2], B18[2];
    const char* cA = (const char*)g.A + (size_t)cur.pm * tstep + S.koff(cur); const char* cB = (const char*)g.Bt + S.boff(cur) + (size_t)cur.pn * tstep + S.koff(cur);
    PG8_STAGE(PG8_SB(0, 0), cB, voffB); PG8_STAGE(PG8_SB(0, 1), cB + hstep, voffB); PG8_STAGE(PG8_SA(0, 0), cA, voffA); PG8_STAGE(PG8_SA(0, 1), cA + hstep, voffA);
    if (wr == 1) PG8_BAR;
    PG8_WAIT_V(2); PG8_BAR;
    PG8_STAGE(PG8_SB(1, 0), cB + kstep, voffB); PG8_STAGE(PG8_SA(1, 0), cA + kstep, voffA); PG8_STAGE(PG8_SB(1, 1), cB + hstep + kstep, voffB);
    PG8_WAIT_V(6); PG8_BAR;
    for (;;) {
        const bool has_next = S.next(ui + 1, nxt);
        const char* nA = has_next ? (const char*)g.A + (size_t)nxt.pm * tstep + S.koff(nxt) : cA; const char* nB = has_next ? (const char*)g.Bt + S.boff(nxt) + (size_t)nxt.pn * tstep + S.koff(nxt) : cB;
        for (int t = 0; t < nt; t += 2) {
            const bool last = (t == nt - 2);
            const char* a1 = cA + (size_t)(t + 1) * kstep;
            const char* a2 = last ? nA : cA + (size_t)(t + 2) * kstep; const char* b2 = last ? nB : cB + (size_t)(t + 2) * kstep;
            const char* a3 = a2 + kstep; const char* b3 = b2 + kstep;
            PG8_LDB(B0, 0, 0); PG8_LDB(B1, 0, 1); PG8_SCHED; PG8_LDA(At, 0, 0); PG8_STAGE(PG8_SA(1, 1), a1 + hstep, voffA);
            PG8_WAIT_V(8); PG8_WAIT_L(0); PG8_BAR; PG8_MMA(0, 0, At, B0); PG8_MMA(0, 1, At, B1); PG8_BAR; PG8_SCHED;
            PG8_LDA(At, 0, 1); PG8_STAGE(PG8_SB(0, 0), b2, voffB); PG8_STAGE(PG8_SB(0, 1), b2 + hstep, voffB); PG8_STAGE(PG8_SA(0, 0), a2, voffA);
            PG8_WAIT_V(8); PG8_WAIT_L(0); PG8_BAR; PG8_MMA(1, 0, At, B0); PG8_MMA(1, 1, At, B1); PG8_BAR; PG8_SCHED;
            PG8_LDB(B0, 1, 0); PG8_LDB(B1, 1, 1); PG8_SCHED; PG8_LDA(At, 1, 0); PG8_STAGE(PG8_SA(0, 1), a2 + hstep, voffA);
            PG8_WAIT_V(8); PG8_WAIT_L(0); PG8_BAR; PG8_MMA(0, 0, At, B0); PG8_MMA(0, 1, At, B1); PG8_BAR; PG8_SCHED;
            PG8_LDA(At, 1, 1); PG8_STAGE(PG8_SB(1, 0), b3, voffB); PG8_STAGE(PG8_SB(1, 1), b3 + hstep, voffB); PG8_STAGE(PG8_SA(1, 0), a3, voffA);
            PG8_WAIT_V(8); PG8_WAIT_L(0); PG8_BAR; PG8_MMA(1, 0, At, B0); PG8_MMA(1, 1, At, B1); PG8_BAR; PG8_SCHED;
        }
        if (F8) { asm volatile("s_nop 15\n\ts_nop 15\n\ts_nop 15\n\ts_nop 15" ::: "memory"); PG8_ACCF8(0, 0); PG8_ACCF8(0, 1); PG8_ACCF8(1, 0); PG8_ACCF8(1, 1); }
        if (wr == 0) PG8_BAR;
        E(acc, cur, wr, wc, fr, fq);
        if (!has_next) break;
#pragma unroll
        for (int a = 0; a < 2; ++a)
#pragma unroll
            for (int b = 0; b < 2; ++b)
#pragma unroll
                for (int m = 0; m < 4; ++m)
#pragma unroll
                    for (int n = 0; n < 2; ++n) acc[a][b][m][n] = (f32x4){0.f, 0.f, 0.f, 0.f};
        PG8_ACC_FENCE();
        cur = nxt; cA = nA; cB = nB; ++ui;
        if (wr == 1) PG8_BAR;
    }
    PG8_WAIT_V(0);
    PG8_BAR;
#undef PG8_SA
#undef PG8_SB
#undef PG8_STAGE
#undef PG8_LDA
#undef PG8_LD16
#undef PG8_LDB
#undef PG8_MMA
#undef PG8_WAIT_V
#undef PG8_ACCF8
#undef PG8_ACC_FENCE
#undef PG8_WAIT_L
#undef PG8_BAR
#undef PG8_SCHED
}
template <class Epi, class Sched> __device__ __forceinline__ void gemm_phase_f8(PG8_LAS unsigned char* lds, const Gemm g, const Sched& S, const Epi& E) { gemm_phase<Epi, Sched, true>(lds, g, S, E); }
}

__device__ __forceinline__ int wsrccol(int map, int n, int FF) {
    if (map == 0) return n;
    if (map == 1) return n < 3072 ? n : (n < 5120 ? n + 16 : (n < 5136 ? 3072 + (n - 5120) : -1));
    if (map == 2) return n < 3072 ? n : (n < 5632 ? n + 32 : (n < 5664 ? 3072 + (n - 5632) : (n < 5696 ? n : -1)));
    const int tile = n >> 8, i = n & 255; return (i < 128) ? tile * 128 + i : FF + tile * 128 + (i - 128);
}
typedef float sc4f __attribute__((ext_vector_type(4)));
struct WItem { const float* W; bf16* WT; int ldsrc, K, nblk, map, FF, item; float wsc; };
struct WRegs { float4 v[16]; };
__device__ __forceinline__ void wconv_load(const WItem& d, int lane, WRegs& R) {
    const bool f8 = d.wsc != 0.f;
    const int kb = d.item / d.nblk, nb = d.item % d.nblk, k0 = (f8 ? 128 : 64) * kb, n0 = (f8 ? 32 : 64) * nb, n4 = (f8 ? (lane & 7) : (lane & 15)) * 4, kr = f8 ? (lane >> 3) : (lane >> 4), kstep = f8 ? 8 : 4;
    const int sc = wsrccol(d.map, n0 + n4, d.FF);
#pragma unroll
    for (int i = 0; i < 16; ++i) { if (sc >= 0) { const sc4f t = __builtin_nontemporal_load((const sc4f*)(d.W + (size_t)(k0 + kstep * i + kr) * d.ldsrc + sc)); R.v[i] = make_float4(t[0], t[1], t[2], t[3]); } else R.v[i] = make_float4(0.f, 0.f, 0.f, 0.f); }
}
__device__ __forceinline__ void wconv_finish(const WItem& d, int lane, const WRegs& R, float* scr) {
    if (d.wsc != 0.f) {
        const int kb = d.item / d.nblk, nb = d.item % d.nblk, k0 = 128 * kb, n0 = 32 * nb, n4 = (lane & 7) * 4, kr = lane >> 3; const float ws_ = d.wsc;
#pragma unroll
        for (int i = 0; i < 16; ++i) { float* q = scr + (8 * i + kr) * 33 + n4; q[0] = R.v[i].x; q[1] = R.v[i].y; q[2] = R.v[i].z; q[3] = R.v[i].w; }
        asm volatile("s_waitcnt lgkmcnt(0)" ::: "memory");
        const int c = lane & 7;
#pragma unroll
        for (int j = 0; j < 4; ++j) { const int n = (lane >> 3) + 8 * j; const float* q = scr + (16 * c) * 33 + n;
            uint4 o; o.x = pack4_fp8(q[0 * 33] * ws_, q[1 * 33] * ws_, q[2 * 33] * ws_, q[3 * 33] * ws_); o.y = pack4_fp8(q[4 * 33] * ws_, q[5 * 33] * ws_, q[6 * 33] * ws_, q[7 * 33] * ws_);
            o.z = pack4_fp8(q[8 * 33] * ws_, q[9 * 33] * ws_, q[10 * 33] * ws_, q[11 * 33] * ws_); o.w = pack4_fp8(q[12 * 33] * ws_, q[13 * 33] * ws_, q[14 * 33] * ws_, q[15 * 33] * ws_);
            *(uint4*)((unsigned char*)d.WT + (size_t)(n0 + n) * d.K + k0 + 16 * c) = o; }
        asm volatile("s_waitcnt lgkmcnt(0)" ::: "memory");
        return;
    }
    const int kb = d.item / d.nblk, nb = d.item % d.nblk, k0 = 64 * kb, n0 = 64 * nb, n4 = (lane & 15) * 4, kr = lane >> 4;
#pragma unroll
    for (int i = 0; i < 16; ++i) { float* q = scr + (4 * i + kr) * 65 + n4; q[0] = R.v[i].x; q[1] = R.v[i].y; q[2] = R.v[i].z; q[3] = R.v[i].w; }
    asm volatile("s_waitcnt lgkmcnt(0)" ::: "memory");
    const int c = lane & 7;
#pragma unroll
    for (int j = 0; j < 8; ++j) { const int n = (lane >> 3) + 8 * j; const float* q = scr + (8 * c) * 65 + n;
        uint4 o; o.x = f2bf(q[0 * 65]) | (f2bf(q[1 * 65]) << 16); o.y = f2bf(q[2 * 65]) | (f2bf(q[3 * 65]) << 16); o.z = f2bf(q[4 * 65]) | (f2bf(q[5 * 65]) << 16); o.w = f2bf(q[6 * 65]) | (f2bf(q[7 * 65]) << 16);
        *(uint4*)(d.WT + (size_t)(n0 + n) * d.K + k0 + 8 * c) = o; }
    asm volatile("s_waitcnt lgkmcnt(0)" ::: "memory");
}
__device__ __forceinline__ WItem wconv_decode(const Params& p, int r) {
    constexpr int I0 = 16 * (NP_ABIN / 64), I1 = 32 * 16, I2 = 16 * (5632 / 64), I3 = 44 * 16, I4 = 16 * (NP_CDIN / 64), I5 = 32 * 16, I6 = 16 * (7168 / 64), I7 = 56 * 16;
    constexpr int NIT = I0 + I1 + I2 + I3 + I4 + I5;
    unsigned char* ws = p.ws;
    if (r >= NIT) { r -= NIT; const int mtx = r >> 2; return WItem{(mtx < 16 ? p.in[I_LWA] : p.in[I_LWX]) + (size_t)(mtx & 15) * 128 * 128, (bf16*)(ws + OFF_W_RG) + (size_t)mtx * 128 * 128, 128, 128, 2, 0, 0, r & 3}; }
    if (r < I0) return WItem{p.in[I_ABIN], (bf16*)(ws + OFF_W_ABIN), AB_IN, 1024, NP_ABIN / 64, 1, 0, r}; r -= I0;
    if (r < I1) return WItem{p.in[I_ABOUT], (bf16*)(ws + OFF_W_ABOUT), 1024, 2048, 16, 0, 0, r}; r -= I1;
    if (r < I2) return WItem{p.in[I_FFN1], (bf16*)(ws + OFF_W_FFN1), 5632, 1024, 5632 / 32, 3, FFD, r, F8_W1S}; r -= I2;
    if (r < I3) return WItem{p.in[I_FFN2], (bf16*)(ws + OFF_W_FFN2), 1024, 2816, 32, 0, 0, r, F8_W2S}; r -= I3;
    if (r < I4) return WItem{p.in[I_CDIN], (bf16*)(ws + OFF_W_CDIN), CD_IN, 1024, NP_CDIN / 64, 2, 0, r}; r -= I4;
    if (r < I5) return WItem{p.in[I_CDOUT], (bf16*)(ws + OFF_W_CDOUT), 1024, 2048, 16, 0, 0, r}; r -= I5;
    return WItem{p.in[I_CDOUT], (bf16*)(ws + OFF_W_CDOUT), 1024, 2048, 16, 0, 0, r % I5};
}
__device__ __forceinline__ void phase_wconv(const Params& p, float* sm, int part, int gwb, int NGW) {
    const int tid = tid_op(), lane = tid & 63, wave = tid >> 6;
    float* scr = sm + wave * (128 * 33);
    constexpr int NTOT = 16 * (NP_ABIN / 64) + 32 * 16 + 16 * (5632 / 64) + 44 * 16 + 16 * (NP_CDIN / 64) + 32 * 16 + 32 * 4;
    (void)part; (void)NGW;
    const int grp = gwb & 31; unsigned* tick = (unsigned*)(p.ws + OFF_CTL + 65536) + 64 * grp;
#define WC_TICKET() ((int)__builtin_amdgcn_readfirstlane((lane == 0) ? (int)__hip_atomic_fetch_add(tick, 1u, __ATOMIC_RELAXED, __HIP_MEMORY_SCOPE_AGENT) : 0) * 32 + grp)
    int itA = WC_TICKET();
    if (itA >= NTOT) return;
    WItem dA = wconv_decode(p, itA), dB = dA; WRegs RA, RB;
    wconv_load(dA, lane, RA);
    for (;;) {
        const int itB = WC_TICKET(); const bool hB = itB < NTOT;
        if (hB) { dB = wconv_decode(p, itB); wconv_load(dB, lane, RB); }
        wconv_finish(dA, lane, RA, scr);
        if (!hB) break;
        itA = WC_TICKET(); const bool hA = itA < NTOT;
        if (hA) { dA = wconv_decode(p, itA); wconv_load(dA, lane, RA); }
        wconv_finish(dB, lane, RB, scr);
        if (!hA) break;
    }
#undef WC_TICKET
}

namespace sc {
#if defined(DIAG_SEL) && DIAG_SEL >= 10
#define DSTAMP(k) do { const unsigned long long n_ = __builtin_amdgcn_s_memrealtime(); dacc[k] += n_ - dlast; dlast = n_; } while (0)
#define DARGS , unsigned long long (&dacc)[8], unsigned long long& dlast
#define DPASS , dacc, dlast
#else
#define DSTAMP(k) do {} while (0)
#define DARGS
#define DPASS
#endif
typedef short bf16x8 __attribute__((ext_vector_type(8)));
typedef float f32x4 __attribute__((ext_vector_type(4)));
#define SLAS __attribute__((address_space(3)))
typedef unsigned u32x2 __attribute__((ext_vector_type(2)));
typedef unsigned u32x4 __attribute__((ext_vector_type(4)));
constexpr int QS = 136, TS = 72;
constexpr int L_QA = 0, L_KA = L_QA + 64 * QS * 2, L_KT = L_KA + 64 * QS * 2, L_VU = L_KT + 128 * TS * 2, L_VS = L_VU + 80 * TS * 2, L_ST0 = L_VS + 80 * TS * 2,
              L_ST1 = L_ST0 + 80 * QS * 2, L_P = L_ST1 + 80 * QS * 2, L_SC = L_P + 64 * TS * 2, L_END = L_SC + 2048 + 2048;
__device__ __forceinline__ bf16x8 ldfrag(const SLAS unsigned char* base, int row, int stride, int k) { return *(const SLAS bf16x8*)(base + (size_t)(row * stride + k) * 2); }
typedef float f32x2_t __attribute__((ext_vector_type(2)));
typedef __bf16 bf16x2_t __attribute__((ext_vector_type(2)));
__device__ __forceinline__ unsigned pk2(float lo, float hi) { f32x2_t v = {lo, hi}; bf16x2_t b = __builtin_convertvector(v, bf16x2_t); return __builtin_bit_cast(unsigned, b); }
__device__ __forceinline__ f32x4 mfma(bf16x8 a, bf16x8 b, f32x4 c) { return __builtin_amdgcn_mfma_f32_16x16x32_bf16(a, b, c, 0, 0, 0); }
__device__ __forceinline__ int kt_off(int d, int s) { return (d * TS + ((((s >> 3) ^ (d >> 3)) & 7) << 3) + (s & 7)) * 2; }
__device__ __forceinline__ int chunk_of_step(int dir, int c) { return dir ? (c < 4 ? 3 - c : 71 - c) : c; }

template <int MODE, int dir>
__device__ __forceinline__ void chunk_compute(SLAS unsigned char* lds, int cur, f32x4 (&S)[5], float decs, float dskip, bf16* obase  , int b, int t0, int tid DARGS) {
    constexpr bool ONES = (MODE == 0), PERD = (MODE == 1), EXPD = (MODE != 1);
    const int lane = tid & 63, w = tid >> 6, r = lane & 15, q = lane >> 4;
    const SLAS unsigned char* Qa = lds + L_QA; const SLAS unsigned char* Ka = lds + L_KA; const SLAS unsigned char* KT = lds + L_KT;
    const SLAS unsigned char* VU = lds + L_VU; const SLAS unsigned char* VS = lds + (MODE == 1 ? L_VU : L_VS);
    const SLAS unsigned char* STc = lds + (cur ? L_ST1 : L_ST0); SLAS unsigned char* STn = lds + (cur ? L_ST0 : L_ST1);
    SLAS unsigned char* P = lds + L_P; const SLAS float* scal = (const SLAS float*)(lds + L_SC);
    DSTAMP(2);
#if defined(PROBE_SC) && PROBE_SC == 4
    __syncthreads(); __syncthreads(); __syncthreads();
#endif
#if defined(PROBE_SC) && PROBE_SC == 5
    if (tid == 0) __builtin_amdgcn_s_sleep(127);
#endif
    {
        const int sb = w >> 1, tbA = (w & 1) * 2;
        bf16x8 a[4], b0[4], b1[4];
#pragma unroll
        for (int ks = 0; ks < 4; ++ks) { a[ks] = ldfrag(Ka, sb * 16 + r, QS, ks * 32 + 8 * q); b0[ks] = ldfrag(Qa, tbA * 16 + r, QS, ks * 32 + 8 * q); b1[ks] = ldfrag(Qa, tbA * 16 + 16 + r, QS, ks * 32 + 8 * q); }
        f32x4 acc0 = {0.f, 0.f, 0.f, 0.f}, acc1 = {0.f, 0.f, 0.f, 0.f};
#pragma unroll
        for (int ks = 0; ks < 4; ++ks) { acc0 = mfma(a[ks], b0[ks], acc0); acc1 = mfma(a[ks], b1[ks], acc1); }
        const f32x4 csv = EXPD ? *(const SLAS f32x4*)(scal + 64 + sb * 16 + 4 * q) : (f32x4){0.f, 0.f, 0.f, 0.f};
#pragma unroll
        for (int tt = 0; tt < 2; ++tt) {
            const int tb = tbA + tt, t = tb * 16 + r; const f32x4 acc = tt ? acc1 : acc0;
            float pv[4] = {0.f, 0.f, 0.f, 0.f};
            { const float btv = EXPD ? scal[t] : 0.f;
#pragma unroll
                for (int j = 0; j < 4; ++j) { const int sidx = sb * 16 + 4 * q + j; float v = acc[j]; if (EXPD) v *= __expf(btv + csv[j]); v = (dir ? (sidx >= t) : (sidx <= t)) ? v : 0.f; if (MODE == 2 && sidx == t) v += dskip; pv[j] = v; } }
            u32x2 o; o.x = pk2(pv[0], pv[1]); o.y = pk2(pv[2], pv[3]);
            *(SLAS u32x2*)(P + (size_t)(t * TS + sb * 16 + 4 * q) * 2) = o;
        }
    }
    DSTAMP(3);
    const int tb2 = w & 3, vb0 = (w >> 2) * 2, t2 = tb2 * 16 + r;
    const float rsv = EXPD ? scal[128 + t2] : 1.f;
    f32x4 oa0 = {0.f, 0.f, 0.f, 0.f}, oa1 = {0.f, 0.f, 0.f, 0.f}, oad = {0.f, 0.f, 0.f, 0.f};
    {
        bf16x8 bq[4], s0[4], s1[4], sd[4];
#pragma unroll
        for (int ks = 0; ks < 4; ++ks) { bq[ks] = ldfrag(Qa, t2, QS, ks * 32 + 8 * q); s0[ks] = ldfrag(STc, vb0 * 16 + r, QS, ks * 32 + 8 * q); s1[ks] = ldfrag(STc, vb0 * 16 + 16 + r, QS, ks * 32 + 8 * q);
            if (ONES) sd[ks] = ldfrag(STc, 64 + r, QS, ks * 32 + 8 * q); }
#pragma unroll
        for (int ks = 0; ks < 4; ++ks) { oa0 = mfma(s0[ks], bq[ks], oa0); oa1 = mfma(s1[ks], bq[ks], oa1); if (ONES) oad = mfma(sd[ks], bq[ks], oad); }
        if (EXPD) { oa0 = oa0 * rsv; oa1 = oa1 * rsv; if (ONES) oad = oad * rsv; }
    }
    {
        const int d0 = w * 16; constexpr int NT = 4 + (ONES ? 1 : 0);
        bf16x8 ak[2], vs[NT][2];
#pragma unroll
        for (int ks = 0; ks < 2; ++ks) { ak[ks] = *(const SLAS bf16x8*)(KT + kt_off(d0 + r, ks * 32 + 8 * q));
#pragma unroll
            for (int vb = 0; vb < NT; ++vb) vs[vb][ks] = ldfrag(VS, vb * 16 + r, TS, ks * 32 + 8 * q); }
        f32x4 dv = {decs, decs, decs, decs};
        if (PERD) dv = *(const SLAS f32x4*)(scal + 192 + d0 + 4 * q);
#pragma unroll
        for (int vb = 0; vb < NT; ++vb) S[vb] = S[vb] * dv;
#pragma unroll
        for (int ks = 0; ks < 2; ++ks)
#pragma unroll
            for (int vb = 0; vb < NT; ++vb) S[vb] = mfma(ak[ks], vs[vb][ks], S[vb]);
#pragma unroll
        for (int vb = 0; vb < NT; ++vb) { u32x2 o; o.x = pk2(S[vb][0], S[vb][1]); o.y = pk2(S[vb][2], S[vb][3]);
            *(SLAS u32x2*)(STn + (size_t)((vb * 16 + r) * QS + d0 + 4 * q) * 2) = o; }
    }
    DSTAMP(4);
    __syncthreads();
    DSTAMP(5);
    {
        bf16x8 bp[2], v0[2], v1[2], vd[2];
#pragma unroll
        for (int ks = 0; ks < 2; ++ks) { bp[ks] = ldfrag(P, t2, TS, ks * 32 + 8 * q); v0[ks] = ldfrag(VU, vb0 * 16 + r, TS, ks * 32 + 8 * q); v1[ks] = ldfrag(VU, vb0 * 16 + 16 + r, TS, ks * 32 + 8 * q);
            if (ONES) vd[ks] = ldfrag(VU, 64 + r, TS, ks * 32 + 8 * q); }
#pragma unroll
        for (int ks = 0; ks < 2; ++ks) { oa0 = mfma(v0[ks], bp[ks], oa0); oa1 = mfma(v1[ks], bp[ks], oa1); if (ONES) oad = mfma(vd[ks], bp[ks], oad); }
        if (ONES) { const float den = __shfl(oad[0], r); const float rden = __builtin_amdgcn_rcpf(fmaxf(fabsf(den), 1.f)); oa0 = oa0 * rden; oa1 = oa1 * rden; }
        bf16* orow = obase + ((size_t)b * TT + t0 + t2) * DM + vb0 * 16 + 4 * q;
        uint2 o; o.x = pk2(oa0[0], oa0[1]); o.y = pk2(oa0[2], oa0[3]); *(uint2*)(orow) = o;
        o.x = pk2(oa1[0], oa1[1]); o.y = pk2(oa1[2], oa1[3]); *(uint2*)(orow + 16) = o;
    }
    DSTAMP(6);
}

struct Blk48 { f32x4 lo[4], hi[4]; };
struct Rows7 { uint4 r[7]; };
__device__ __forceinline__ f32x4 bf4lo(uint4 v) { return (f32x4){bf2f(v.x & 0xffffu), bf2f(v.x >> 16), bf2f(v.y & 0xffffu), bf2f(v.y >> 16)}; }
__device__ __forceinline__ f32x4 bf4hi(uint4 v) { return (f32x4){bf2f(v.z & 0xffffu), bf2f(v.z >> 16), bf2f(v.w & 0xffffu), bf2f(v.w >> 16)}; }
__device__ __forceinline__ float silu_fast(float x) { return x * __builtin_amdgcn_rcpf(1.f + __expf(-x)); }
__device__ __forceinline__ float sigmoid_fast(float x) { return __builtin_amdgcn_rcpf(1.f + __expf(-x)); }
__device__ __forceinline__ float softplus_fast(float x) { return fmaxf(x, 0.f) + __logf(1.f + __expf(-fabsf(x))); }
__device__ __forceinline__ f32x4 silu4(f32x4 x, float sc) { return (f32x4){silu_fast(x[0]) * sc, silu_fast(x[1]) * sc, silu_fast(x[2]) * sc, silu_fast(x[3]) * sc}; }
template <bool ACT> __device__ __forceinline__ void conv_4x8(const bf16* Z, size_t rowbase, int t0, int m0, int lo, int hi, int col, const float* cw, int wstride, int wcol, const float* cb, float scale, Blk48& out) {
    Rows7 R;
#pragma unroll
    for (int rr = 0; rr < 7; ++rr) { const int tt = t0 + m0 + rr - 2; uint4 v = make_uint4(0u, 0u, 0u, 0u);
        if (tt >= lo && tt < hi) v = *(const uint4*)(Z + (rowbase + tt) * DM + col);
        R.r[rr] = v; }
    f32x4 wlo[4], whi[4];
#pragma unroll
    for (int j = 0; j < 4; ++j) { wlo[j] = *(const f32x4*)(cw + (size_t)j * wstride + wcol); whi[j] = *(const f32x4*)(cw + (size_t)j * wstride + wcol + 4); }
    const f32x4 blo = *(const f32x4*)(cb + wcol), bhi = *(const f32x4*)(cb + wcol + 4);
#pragma unroll
    for (int jj = 0; jj < 4; ++jj) { f32x4 a = blo, c = bhi;
#pragma unroll
        for (int j = 0; j < 4; ++j) { a = a + wlo[j] * bf4lo(R.r[jj + j]); c = c + whi[j] * bf4hi(R.r[jj + j]); }
        if (ACT) { a = silu4(a, scale); c = silu4(c, scale); }
        out.lo[jj] = a; out.hi[jj] = c; }
}
__device__ __forceinline__ void put_rows(SLAS unsigned char* tile, int m0, int ch, const Blk48& v) {
#pragma unroll
    for (int jj = 0; jj < 4; ++jj) { u32x4 o; o.x = pk2(v.lo[jj][0], v.lo[jj][1]); o.y = pk2(v.lo[jj][2], v.lo[jj][3]); o.z = pk2(v.hi[jj][0], v.hi[jj][1]); o.w = pk2(v.hi[jj][2], v.hi[jj][3]);
        *(SLAS u32x4*)(tile + (size_t)((m0 + jj) * QS + ch) * 2) = o; }
}
struct Raw4 { uint4 r[4]; };
__device__ __forceinline__ void raw4_issue(const bf16* p0  , Raw4& R) {
#pragma unroll
    for (int jj = 0; jj < 4; ++jj) R.r[jj] = *(const uint4*)(p0 + (size_t)jj * DM);
}
__device__ __forceinline__ void raw4_put_rows(SLAS unsigned char* tile, int m0, int ch, const Raw4& R) {
#pragma unroll
    for (int jj = 0; jj < 4; ++jj) { u32x4 o = {R.r[jj].x, R.r[jj].y, R.r[jj].z, R.r[jj].w}; *(SLAS u32x4*)(tile + (size_t)((m0 + jj) * QS + ch) * 2) = o; }
}
__device__ __forceinline__ void raw4_put_cols(SLAS unsigned char* tile, int m0, int ch, const Raw4& R) {
    const unsigned w0[4] = {R.r[0].x, R.r[0].y, R.r[0].z, R.r[0].w}, w1[4] = {R.r[1].x, R.r[1].y, R.r[1].z, R.r[1].w}, w2[4] = {R.r[2].x, R.r[2].y, R.r[2].z, R.r[2].w}, w3[4] = {R.r[3].x, R.r[3].y, R.r[3].z, R.r[3].w};
#pragma unroll
    for (int pr = 0; pr < 4; ++pr) { u32x2 ev, od;
        ev.x = (w0[pr] & 0xffffu) | (w1[pr] << 16); ev.y = (w2[pr] & 0xffffu) | (w3[pr] << 16);
        od.x = (w0[pr] >> 16) | (w1[pr] & 0xffff0000u); od.y = (w2[pr] >> 16) | (w3[pr] & 0xffff0000u);
        *(SLAS u32x2*)(tile + kt_off(ch + 2 * pr, m0)) = ev; *(SLAS u32x2*)(tile + kt_off(ch + 2 * pr + 1, m0)) = od; }
}
__device__ __forceinline__ void raw4_put_cols_scaled(SLAS unsigned char* tile, int m0, int ch, const Raw4& R, f32x4 dlo, f32x4 dhi) {
    const f32x4 a0 = bf4lo(R.r[0]), a1 = bf4lo(R.r[1]), a2 = bf4lo(R.r[2]), a3 = bf4lo(R.r[3]), c0 = bf4hi(R.r[0]), c1 = bf4hi(R.r[1]), c2 = bf4hi(R.r[2]), c3 = bf4hi(R.r[3]);
#pragma unroll
    for (int e = 0; e < 4; ++e) { u32x2 o, o2; o.x = pk2(a0[e] * dlo[e], a1[e] * dlo[e]); o.y = pk2(a2[e] * dlo[e], a3[e] * dlo[e]); o2.x = pk2(c0[e] * dhi[e], c1[e] * dhi[e]); o2.y = pk2(c2[e] * dhi[e], c3[e] * dhi[e]);
        *(SLAS u32x2*)(tile + kt_off(ch + e, m0)) = o; *(SLAS u32x2*)(tile + kt_off(ch + 4 + e, m0)) = o2; }
}
struct VRaw { unsigned x0, x1, x2, x3; };
__device__ __forceinline__ void v_issue(const bf16* vp  , VRaw& R) { R.x0 = *(const unsigned*)(vp); R.x1 = *(const unsigned*)(vp + DM); R.x2 = *(const unsigned*)(vp + 2 * DM); R.x3 = *(const unsigned*)(vp + 3 * DM); }
template <bool SCALED> __device__ __forceinline__ void v_put(SLAS unsigned char* lds, const VRaw& R, int m0, int c2, float4 kf) {
    u32x2 ua, ub;
    ua.x = (R.x0 & 0xffffu) | (R.x1 << 16); ua.y = (R.x2 & 0xffffu) | (R.x3 << 16); ub.x = (R.x0 >> 16) | (R.x1 & 0xffff0000u); ub.y = (R.x2 >> 16) | (R.x3 & 0xffff0000u);
    *(SLAS u32x2*)(lds + L_VU + (size_t)((c2 * 2) * TS + m0) * 2) = ua; *(SLAS u32x2*)(lds + L_VU + (size_t)((c2 * 2 + 1) * TS + m0) * 2) = ub;
    if (SCALED) {
        const float k0 = kf.x, k1 = kf.y, k2 = kf.z, k3 = kf.w;
        u32x2 sa, sb;
        sa.x = pk2(bf2f(R.x0 & 0xffffu) * k0, bf2f(R.x1 & 0xffffu) * k1); sa.y = pk2(bf2f(R.x2 & 0xffffu) * k2, bf2f(R.x3 & 0xffffu) * k3);
        sb.x = pk2(bf2f(R.x0 >> 16) * k0, bf2f(R.x1 >> 16) * k1); sb.y = pk2(bf2f(R.x2 >> 16) * k2, bf2f(R.x3 >> 16) * k3);
        *(SLAS u32x2*)(lds + L_VS + (size_t)((c2 * 2) * TS + m0) * 2) = sa; *(SLAS u32x2*)(lds + L_VS + (size_t)((c2 * 2 + 1) * TS + m0) * 2) = sb; }
}
template <int dir> __device__ __forceinline__ float dir_scan(float x, int lane, float& bl) {
#pragma unroll
    for (int o = 1; o < 64; o <<= 1) { const float tv = dir ? __shfl_down(x, o) : __shfl_up(x, o); if (dir ? (lane + o < 64) : (lane >= o)) x += tv; }
    bl = __shfl(x, dir ? 0 : 63); return x;
}
constexpr int L_GA = L_END;
static_assert(L_GA + 4096 <= 147456, "scan LDS map");

__device__ __forceinline__ const float* gate_base(const Params& p, int layer) { return (const float*)(p.ws + (layer == 0 ? OFF_TOPI : OFF_H)); }
__device__ __forceinline__ void prep_gates(const Params& p, int layer) {
    const int tid = tid_op(), lane = tid & 63, gw = blockIdx.x * 8 + (tid >> 6), NGW = gridDim.x * 8;
    const int NH = layer == 0 ? 4 : 16, nseq = NB * NH * 2;
    float* gb = (float*)gate_base(p, layer); const float* G = (const float*)(p.ws + OFF_G);
    float* BS = gb; float* CS = gb + (size_t)nseq * TT; float* KF = gb + (size_t)2 * nseq * TT; float* DECS = gb + (size_t)3 * nseq * TT;
    for (int task = gw; task < nseq * 68; task += NGW) {
        const int seq = task / 68, mc = task % 68, dir = seq & 1, h = (seq >> 1) % NH, b = seq / (2 * NH);
        const size_t row = (size_t)b * TT + mc * 64 + lane;
        float l, gs, mul = 1.f;
        if (layer == 0) { const float gi = G[row * 64 + dir * 4 + h] + p.in[I_MGATEB][dir * 4 + h], gf = G[row * 64 + (2 + dir) * 4 + h] + p.in[I_MGATEB][(2 + dir) * 4 + h];
            l = -softplus_fast(-gf); gs = gi; }
        else { const float dtv = softplus_fast(G[row * 64 + 32 + dir * 16 + h] + p.in[I_SDTB][dir * 16 + h]); l = -dtv * __expf(p.in[I_SALOG][dir * 16 + h]); gs = __logf(dtv); mul = dtv; }
        float bl; const float bsum = dir ? dir_scan<1>(l, lane, bl) : dir_scan<0>(l, lane, bl);
        const size_t o = (size_t)seq * TT + mc * 64 + lane;
        BS[o] = bsum; CS[o] = gs - bsum; KF[o] = (layer == 0) ? __expf(bl - bsum + gs) : __expf(bl - bsum) * mul;
        if (lane == 0) DECS[seq * 68 + mc] = __expf(bl);
    }
}

struct WFly { f32x4 v[4]; };
constexpr int L_WF = L_END, WF_PITCH = 144;
static_assert(L_WF + 64 * WF_PITCH <= 147456 - 64, "wfly tile");
__device__ __forceinline__ unsigned pack4_fp8_nc(float a, float b, float c, float d) { int w = __builtin_amdgcn_cvt_pk_fp8_f32(a, b, 0, false); w = __builtin_amdgcn_cvt_pk_fp8_f32(c, d, w, true); return (unsigned)w; }
struct WPiece { const float* src; size_t ld; unsigned char* dst; size_t pitch; };
__device__ __forceinline__ WPiece wfly_piece(const Params& p, int ord, int uidx) {
    WPiece q;
    if (ord < 14) { const int nb = uidx & 15, t_ = ord * 16 + (uidx >> 4), e = t_ / 28, kg = t_ - e * 28;
        q.src = p.in[I_MOE2] + ((size_t)e * 3584 + kg * 128) * 1024 + nb * 64; q.ld = 1024; q.dst = p.ws + OFF_W_MOE2 + (size_t)e * 1024 * 3584 + (size_t)(nb * 64) * 3584 + kg * 128; q.pitch = 3584; }
    else { const int i = (ord - 14) * 256 + uidx, t_ = i / 112, nb = i - t_ * 112, kg = t_ & 7, e = t_ >> 3, n0 = nb * 64, tile = n0 >> 8, i0 = n0 & 255, scol = (i0 < 128) ? tile * 128 + i0 : FFE + tile * 128 + (i0 - 128);
        q.src = p.in[I_MOE1] + ((size_t)e * 1024 + kg * 128) * 7168 + scol; q.ld = 7168; q.dst = p.ws + OFF_W_MOE1 + (size_t)e * 7168 * 1024 + (size_t)n0 * 1024 + kg * 128; q.pitch = 1024; }
    return q;
}
__device__ __forceinline__ void wfly_issue(const Params& p, int ord, int uidx, int wv, int lane, WFly& F) {
    const WPiece q = wfly_piece(p, ord, uidx);
    const float* s0 = q.src + (size_t)(wv * 16 + (lane >> 4) * 4) * q.ld + (lane & 15) * 4;
#pragma unroll
    for (int i = 0; i < 4; ++i) F.v[i] = __builtin_nontemporal_load((const f32x4*)(s0 + (size_t)i * q.ld));
}
__device__ __forceinline__ void wfly_fill(SLAS unsigned char* lds, int ord_prev, int wv, int lane, const WFly& F) {
    const float sc = ord_prev < 14 ? F8_W2S : F8_W1S;
#pragma unroll
    for (int nn = 0; nn < 4; ++nn) *(SLAS unsigned*)(lds + L_WF + ((lane & 15) * 4 + nn) * WF_PITCH + wv * 16 + (lane >> 4) * 4) = pack4_fp8_nc(F.v[0][nn] * sc, F.v[1][nn] * sc, F.v[2][nn] * sc, F.v[3][nn] * sc);
}
__device__ __forceinline__ void wfly_drain(const Params& p, SLAS unsigned char* lds, int ord_prev, int uidx, int wv, int lane) {
    const WPiece q = wfly_piece(p, ord_prev, uidx); const int row = wv * 8 + (lane >> 3), pc = lane & 7;
    const u32x4 v = *(const SLAS u32x4*)(lds + L_WF + row * WF_PITCH + pc * 16);
    *(uint4*)(q.dst + (size_t)row * q.pitch + pc * 16) = make_uint4(v.x, v.y, v.z, v.w);
}
#define WFLY_FILL() do { if (c >= 1 && c <= 42) wfly_fill(lds, c - 1, wfw, tid & 63, WF); if (c < 42) wfly_issue(p, c, uidx, wfw, tid & 63, WF); } while (0)
#define WFLY_DRAIN() do { if (c >= 1 && c <= 42) wfly_drain(p, lds, c - 1, uidx, wfw, tid & 63); } while (0)
template <int dir> __device__ __forceinline__ void mlstm_unit(const Params& p, int b, int h, int vs, unsigned char* lds_, int uidx) {
    SLAS unsigned char* lds = (SLAS unsigned char*)lds_;
    const int tid = tid_op(), lane = tid & 63, w = tid >> 6; (void)uidx;
    const bf16* QKC = (const bf16*)(p.ws + OFF_Y); const bf16* ZS = (const bf16*)(p.ws + OFF_ZS); const float* G = (const float*)(p.ws + OFF_G);
    bf16* obase = (bf16*)(p.ws + OFF_SO) + (size_t)dir * SEG + h * 256 + vs * 64;
    const int seq = (b * 4 + h) * 2 + dir; const float* gb = gate_base(p, 0);
    const float* BSq = gb + (size_t)seq * TT; const float* CSq = gb + (size_t)(32 + seq) * TT; const float* KFq = gb + (size_t)(64 + seq) * TT; const float* DECq = gb + (size_t)96 * TT + seq * 68;
    SLAS float* scal = (SLAS float*)(lds + L_SC);
    for (int i = tid; i < 80 * QS / 2; i += 512) ((SLAS unsigned*)(lds + L_ST0))[i] = 0u;
    for (int i = tid; i < 16 * TS / 2; i += 512) { ((SLAS unsigned*)(lds + L_VU + 64 * TS * 2))[i] = (i < TS / 2) ? 0x3f803f80u : 0u; ((SLAS unsigned*)(lds + L_VS + 64 * TS * 2))[i] = 0u; }
    f32x4 S[5];
#pragma unroll
    for (int i = 0; i < 5; ++i) S[i] = (f32x4){0.f, 0.f, 0.f, 0.f};
    const size_t rowbase = (size_t)b * TT;
    const int tg = tid >> 5, cg = tid & 31, m0 = tg * 4; const bool isk = cg >= 16; const int ch = (cg & 15) * 8;
    const bf16* qkp = QKC + (rowbase + m0) * DM + (isk ? 512 : 0) + h * 128 + ch;
    const bf16* vp = ZS + SEG + (rowbase + m0) * DM + h * 256 + vs * 64 + cg * 2;
    struct Pre { Raw4 R; VRaw V; float4 kf; float bs, cs, kfl, dec; } PA, PB;
#define MLSTM_ISSUE(P_, cc) do { const int mc_ = chunk_of_step(dir, (cc)); const size_t to_ = (size_t)mc_ * 64; raw4_issue(qkp + to_ * DM, P_.R); v_issue(vp + to_ * DM, P_.V); \
        P_.kf = *(const float4*)(KFq + to_ + m0); P_.dec = DECq[mc_]; if (w == 0) { P_.bs = BSq[to_ + lane]; P_.cs = CSq[to_ + lane]; P_.kfl = KFq[to_ + lane]; } } while (0)
#define MLSTM_STEP(P_, c_) do { const int c = (c_); const int t0 = chunk_of_step(dir, c) * 64; float blk_ = 0.f; \
        __syncthreads();                                       \
        DSTAMP(0); \
        for (int rep_ = 0; rep_ < PROBE_STAGE_REPS; ++rep_) { \
        if (w == 0) { scal[lane] = P_.bs; scal[64 + lane] = P_.cs; scal[128 + lane] = __expf(P_.bs); ((SLAS bf16*)(lds + L_VS + 64 * TS * 2))[lane] = (bf16)f2bf(P_.kfl); } \
        raw4_put_rows(lds + (isk ? L_KA : L_QA), m0, ch, P_.R); \
        if (isk) raw4_put_cols(lds + L_KT, m0, ch, P_.R); \
        v_put<true>(lds, P_.V, m0, cg, P_.kf); blk_ = P_.dec; } \
        MLSTM_ISSUE(P_, (c + 2 < 68) ? c + 2 : 67);        \
        DSTAMP(1); \
        __syncthreads(); \
        chunk_compute<0, dir>(lds, c & 1, S, blk_, 0.f, obase, b, t0, tid DPASS); } while (0)
#if defined(DIAG_SEL) && DIAG_SEL >= 10
    unsigned long long dacc[8] = {0, 0, 0, 0, 0, 0, 0, 0}; unsigned long long dlast = __builtin_amdgcn_s_memrealtime();
#endif
    MLSTM_ISSUE(PA, 0); MLSTM_ISSUE(PB, 1);
    for (int c2 = 0; c2 < 68; c2 += 2) { MLSTM_STEP(PA, c2); MLSTM_STEP(PB, c2 + 1); }
#undef MLSTM_STEP
#if defined(DIAG_SEL) && DIAG_SEL >= 10
    if (tid == 0 && blockIdx.x == 0) { unsigned long long* dg = (unsigned long long*)(p.ws + OFF_CTL + 98304); for (int k = 0; k < 7; ++k) dg[10 + k] = dacc[k]; }
#endif
#undef MLSTM_ISSUE
}
template <int dir> __device__ __forceinline__ void ssd_unit(const Params& p, int b, int h, unsigned char* lds_, int uidx) {
    SLAS unsigned char* lds = (SLAS unsigned char*)lds_;
    const int tid = tid_op(), lane = tid & 63, w = tid >> 6, g = h >> 3; const int wfw = __builtin_amdgcn_readfirstlane(w); WFly WF;
    const bf16* XC = (const bf16*)(p.ws + OFF_HC); const float* G = (const float*)(p.ws + OFF_G);
    bf16* obase = (bf16*)(p.ws + OFF_SO) + (size_t)(2 + dir) * SEG + h * 64;
    const float dskip = dir ? 0.f : p.in[I_SD][h];
    const int seq = (b * 16 + h) * 2 + dir; const float* gb = gate_base(p, 1);
    const float* BSq = gb + (size_t)seq * TT; const float* CSq = gb + (size_t)(128 + seq) * TT; const float* KFq = gb + (size_t)(256 + seq) * TT; const float* DECq = gb + (size_t)384 * TT + seq * 68;
    SLAS float* scal = (SLAS float*)(lds + L_SC);
    for (int i = tid; i < 80 * QS / 2; i += 512) ((SLAS unsigned*)(lds + L_ST0))[i] = 0u;
    f32x4 S[5];
#pragma unroll
    for (int i = 0; i < 5; ++i) S[i] = (f32x4){0.f, 0.f, 0.f, 0.f};
    const size_t rowbase = (size_t)b * TT;
    const int tg = tid >> 5, cg = tid & 31, m0 = tg * 4; const bool isb = cg >= 16; const int ch = (cg & 15) * 8;
    const bf16* bcp = XC + SEG + (rowbase + m0) * DM + (isb ? 0 : 256) + g * 128 + ch;
    const bf16* xp = XC + (rowbase + m0) * DM + h * 64 + cg * 2;
    struct Pre { Raw4 R; VRaw V; float4 kf; float bs, cs, dec; } PA, PB;
#define SSD_ISSUE(P_, cc) do { const int mc_ = chunk_of_step(dir, (cc)); const size_t to_ = (size_t)mc_ * 64; raw4_issue(bcp + to_ * DM, P_.R); v_issue(xp + to_ * DM, P_.V); \
        P_.kf = *(const float4*)(KFq + to_ + m0); P_.dec = DECq[mc_]; if (w == 0) { P_.bs = BSq[to_ + lane]; P_.cs = CSq[to_ + lane]; } } while (0)
#define SSD_STEP(P_, c_) do { const int c = (c_); const int t0 = chunk_of_step(dir, c) * 64; \
        __syncthreads(); \
        if (w == 0) { scal[lane] = P_.bs; scal[64 + lane] = P_.cs; scal[128 + lane] = __expf(P_.bs); } \
        raw4_put_rows(lds + (isb ? L_KA : L_QA), m0, ch, P_.R); \
        if (isb) raw4_put_cols(lds + L_KT, m0, ch, P_.R); \
        v_put<true>(lds, P_.V, m0, cg, P_.kf); \
        const float dec_ = P_.dec; \
        SSD_ISSUE(P_, (c + 2 < 68) ? c + 2 : 67);        \
        WFLY_FILL(); \
        __syncthreads(); \
        WFLY_DRAIN(); \
        chunk_compute<2, dir>(lds, c & 1, S, dec_, dskip, obase, b, t0, tid DPASS); } while (0)
#if defined(DIAG_SEL) && DIAG_SEL >= 10
    unsigned long long dacc[8] = {0, 0, 0, 0, 0, 0, 0, 0}; unsigned long long dlast = 0;
#endif
    SSD_ISSUE(PA, 0); SSD_ISSUE(PB, 1);
    for (int c2 = 0; c2 < 68; c2 += 2) { SSD_STEP(PA, c2); SSD_STEP(PB, c2 + 1); }
#undef SSD_STEP
#undef SSD_ISSUE
}
template <int dir> __device__ __forceinline__ void gla_unit(const Params& p, int b, int h, int vs, unsigned char* lds_, int uidx) {
    SLAS unsigned char* lds = (SLAS unsigned char*)lds_;
    const int tid = tid_op(); const int wfw = __builtin_amdgcn_readfirstlane(tid >> 6); WFly WF;
    const bf16* QA = (const bf16*)(p.ws + OFF_HC) + (size_t)(2 + dir) * SEG; const bf16* ZS = (const bf16*)(p.ws + OFF_ZS); const float* DEC = (const float*)(p.ws + OFF_RGS);
    bf16* obase = (bf16*)(p.ws + OFF_SO) + (size_t)dir * SEG + h * 256 + vs * 64;
    SLAS float* scal = (SLAS float*)(lds + L_SC);
    for (int i = tid; i < 80 * QS / 2; i += 512) ((SLAS unsigned*)(lds + L_ST0))[i] = 0u;
    f32x4 S[5];
#pragma unroll
    for (int i = 0; i < 5; ++i) S[i] = (f32x4){0.f, 0.f, 0.f, 0.f};
    const size_t rowbase = (size_t)b * TT;
    const int tg = tid >> 5, cg = tid & 31, m0 = tg * 4; const bool isk = cg >= 16; const int ch = (cg & 15) * 8;
    const bf16* qkp = QA + (rowbase + m0) * DM + (isk ? 512 : 0) + h * 128 + ch;
    const bf16* vp = ZS + SEG + (rowbase + m0) * DM + h * 256 + vs * 64 + cg * 2;
    struct Pre { Raw4 R; VRaw V; f32x4 dlo, dhi; } PA, PB;
#define GLA_ISSUE(P_, cc) do { const int mc_ = chunk_of_step(dir, (cc)); const size_t to_ = (size_t)mc_ * 64; raw4_issue(qkp + to_ * DM, P_.R); v_issue(vp + to_ * DM, P_.V); \
        const float* dp_ = DEC + ((size_t)((b * 68 + mc_) * 4 + h) * 2 + dir) * 128 + ch; P_.dlo = *(const f32x4*)dp_; P_.dhi = *(const f32x4*)(dp_ + 4); } while (0)
#define GLA_STEP(P_, c_) do { const int c = (c_); const int t0 = chunk_of_step(dir, c) * 64; \
        __syncthreads(); \
        raw4_put_rows(lds + (isk ? L_KA : L_QA), m0, ch, P_.R); \
        if (isk) { raw4_put_cols_scaled(lds + L_KT, m0, ch, P_.R, P_.dlo, P_.dhi); if (tg == 0) { *(SLAS f32x4*)(scal + 192 + ch) = P_.dlo; *(SLAS f32x4*)(scal + 192 + ch + 4) = P_.dhi; } } \
        v_put<false>(lds, P_.V, m0, cg, make_float4(0.f, 0.f, 0.f, 0.f)); \
        GLA_ISSUE(P_, (c + 2 < 68) ? c + 2 : 67);        \
        WFLY_FILL(); \
        __syncthreads(); \
        WFLY_DRAIN(); \
        chunk_compute<1, dir>(lds, c & 1, S, 1.f, 0.f, obase, b, t0, tid DPASS); } while (0)
#if defined(DIAG_SEL) && DIAG_SEL >= 10
    unsigned long long dacc[8] = {0, 0, 0, 0, 0, 0, 0, 0}; unsigned long long dlast = 0;
#endif
    GLA_ISSUE(PA, 0); GLA_ISSUE(PB, 1);
    for (int c2 = 0; c2 < 68; c2 += 2) { GLA_STEP(PA, c2); GLA_STEP(PB, c2 + 1); }
#undef GLA_STEP
#undef GLA_ISSUE
}

__device__ __forceinline__ void prep_conv(const Params& p, int layer) {
    const int tid = tid_op(); const long gtid = (long)blockIdx.x * 512 + tid, gstride = (long)gridDim.x * 512;
    const bf16* ZS = (const bf16*)(p.ws + OFF_ZS); bf16* OUT = (bf16*)(p.ws + (layer == 0 ? OFF_Y : OFF_HC));
    const int ngrp = (layer == 0) ? 256 : 192;
    const long nitems = (long)(MROWS / 4) * ngrp;
    for (long it = gtid; it < nitems; it += gstride) {
        const int cgi = (int)(it % ngrp), tgi = (int)(it / ngrp), row4 = tgi * 4, b = row4 / TT, t = row4 % TT, t0 = t & ~63, m0 = t & 63, mc = t0 >> 6;
        const int lo = (mc < 4) ? 0 : t0, hi = (mc < 4) ? NCTX : t0 + 64;
        Blk48 v; const bf16* src; bf16* dst; int col;
        if (layer == 0 && cgi < 128) { col = cgi * 8; src = ZS; dst = OUT;
            conv_4x8<true>(src, (size_t)b * TT, t0, m0, lo, hi, col, p.in[I_MCONVW], 1024, col, p.in[I_MCONVB], col >= 512 ? 0.08838834764831845f : 1.f, v); }
        else if (layer == 0) { col = (cgi - 128) * 8; src = ZS + 3 * SEG; dst = (bf16*)(p.ws + OFF_H);
            conv_4x8<false>(src, (size_t)b * TT, t0, m0, lo, hi, col, p.in[I_LCONVW], 1024, col, p.in[I_LCONVB], 1.f, v); }
        else { const int xc = cgi * 8;
            col = (xc < 1024) ? xc : xc - 1024; src = ZS + (size_t)(xc < 1024 ? 4 : 5) * SEG; dst = OUT + (size_t)(xc < 1024 ? 0 : 1) * SEG;
            conv_4x8<true>(src, (size_t)b * TT, t0, m0, lo, hi, col, p.in[I_SCONVW], 1536, xc, p.in[I_SCONVB], 1.f, v); }
#pragma unroll
        for (int jj = 0; jj < 4; ++jj) { uint4 o; o.x = pk2(v.lo[jj][0], v.lo[jj][1]); o.y = pk2(v.lo[jj][2], v.lo[jj][3]); o.z = pk2(v.hi[jj][0], v.hi[jj][1]); o.w = pk2(v.hi[jj][2], v.hi[jj][3]);
            *(uint4*)(dst + ((size_t)b * TT + t0 + m0 + jj) * DM + col) = o; }
    }
}
__device__ __forceinline__ void prep_gla(const Params& p, unsigned char* lds_) {
    SLAS unsigned char* lds = (SLAS unsigned char*)lds_;
    const int tid = tid_op(), d = tid & 127, qt = tid >> 7;
    const bf16* ZS = (const bf16*)(p.ws + OFF_ZS); const float* G = (const float*)(p.ws + OFF_G); float* DEC = (float*)(p.ws + OFF_RGS);
    SLAS float* qtot = (SLAS float*)(lds + L_SC) + 512; SLAS float* GA = (SLAS float*)(lds + L_GA); SLAS bf16* E = (SLAS bf16*)(lds + L_ST0);
    const int tg = tid >> 5, cg = tid & 31, m0 = tg * 4; const bool isk = cg >= 16; const int ch = (cg & 15) * 8;
    float wg[16]; float bg = 0.f; int wkey = -1;
    Raw4 R; float4 gaq = make_float4(0.f, 0.f, 0.f, 0.f);
#define PG_FETCH(uu) do { const int dir_ = (uu) & 1, h_ = ((uu) >> 1) & 3, bm_ = (uu) >> 3; const size_t rb_ = (size_t)(bm_ / 68) * TT + (bm_ % 68) * 64; \
        if (tid < 256) gaq = *(const float4*)(G + (rb_ + (tid >> 2)) * 64 + dir_ * 16 + (tid & 3) * 4); \
        raw4_issue(ZS + (rb_ + m0) * DM + (isk ? 512 : 0) + h_ * 128 + ch, R); } while (0)
    if ((int)blockIdx.x < 2176) PG_FETCH((int)blockIdx.x);
    for (int u = blockIdx.x; u < 2176; u += gridDim.x) {
        const int dir = u & 1, h = (u >> 1) & 3, bm = u >> 3, b = bm / 68, mc = bm % 68; const size_t rowbase = (size_t)b * TT + mc * 64;
        if ((u & 7) != wkey) { wkey = u & 7;
#pragma unroll
            for (int j = 0; j < 16; ++j) wg[j] = p.in[I_GALW][(size_t)(dir * 16 + j) * 512 + h * 128 + d];
            bg = p.in[I_GALB][dir * 512 + h * 128 + d]; }
        __syncthreads();
        if (tid < 256) *(SLAS f32x4*)(GA + (tid >> 2) * 16 + (tid & 3) * 4) = (f32x4){gaq.x, gaq.y, gaq.z, gaq.w};
        const Raw4 Rc = R;
        __syncthreads();
        if (u + (int)gridDim.x < 2176) PG_FETCH(u + (int)gridDim.x);
        f32x4 loc[4]; float run = 0.f;
#pragma unroll
        for (int i2 = 0; i2 < 16; ++i2) { const int ii = dir ? 15 - i2 : i2; const SLAS float* ga = GA + (qt * 16 + ii) * 16;
            float pre = bg;
#pragma unroll
            for (int j4 = 0; j4 < 4; ++j4) { const f32x4 a = *(const SLAS f32x4*)(ga + 4 * j4); pre += a[0] * wg[4 * j4] + a[1] * wg[4 * j4 + 1] + a[2] * wg[4 * j4 + 2] + a[3] * wg[4 * j4 + 3]; }
            run -= softplus_fast(-pre) * (1.f / 16.f); loc[ii >> 2][ii & 3] = run; }
        qtot[qt * 128 + d] = run;
        __syncthreads();
        float off = 0.f, tot = 0.f;
#pragma unroll
        for (int q2 = 0; q2 < 4; ++q2) { const float tq = qtot[q2 * 128 + d]; if (dir ? (q2 > qt) : (q2 < qt)) off += tq; tot += tq; }
        if (qt == 0) DEC[((size_t)((b * 68 + mc) * 4 + h) * 2 + dir) * 128 + d] = __expf(tot);
#pragma unroll
        for (int ii = 0; ii < 16; ++ii) E[(qt * 16 + ii) * QS + d] = (bf16)f2bf(__expf(off + loc[ii >> 2][ii & 3]));
        __syncthreads();
        bf16* dst = (bf16*)(p.ws + OFF_HC) + (size_t)(2 + dir) * SEG + (rowbase + m0) * DM + (isk ? 512 : 0) + h * 128 + ch;
#pragma unroll
        for (int jj = 0; jj < 4; ++jj) { const u32x4 ev = *(const SLAS u32x4*)((const SLAS unsigned char*)E + (size_t)((m0 + jj) * QS + ch) * 2);
            const uint4 e4 = make_uint4(ev.x, ev.y, ev.z, ev.w); const f32x4 elo = bf4lo(e4), ehi = bf4hi(e4), xlo = bf4lo(Rc.r[jj]), xhi = bf4hi(Rc.r[jj]); f32x4 alo, ahi;
            if (!isk) { alo = xlo * elo * 0.08838834764831845f; ahi = xhi * ehi * 0.08838834764831845f; }
            else {
#pragma unroll
                for (int e = 0; e < 4; ++e) { alo[e] = xlo[e] * __builtin_amdgcn_rcpf(elo[e]); ahi[e] = xhi[e] * __builtin_amdgcn_rcpf(ehi[e]); } }
            uint4 o; o.x = pk2(alo[0], alo[1]); o.y = pk2(alo[2], alo[3]); o.z = pk2(ahi[0], ahi[1]); o.w = pk2(ahi[2], ahi[3]);
            *(uint4*)(dst + (size_t)jj * DM) = o; }
    }
#undef PG_FETCH
}
}

namespace rg {
using sc::bf16x8; using sc::f32x4; using sc::u32x4; using sc::mfma; using sc::ldfrag; using sc::QS;
constexpr int L_XL = 0, L_OUT = 64 * QS * 2, OS = 132;
template <int PHASE>
__device__ __forceinline__ void rglru_units(const Params& p, int u0, int ustride, unsigned char* lds_) {
    SLAS unsigned char* lds = (SLAS unsigned char*)lds_;
    const int tid = tid_op(), lane = tid & 63, w = tid >> 6, r = lane & 15, q = lane >> 4;
    const int blk = u0 & 7, ch = blk * 128 + w * 16 + r;
    const bf16* ZS = (const bf16*)(p.ws + OFF_ZS); const bf16* WT = (const bf16*)(p.ws + OFF_W_RG);
    float2* RGS = (float2*)(p.ws + OFF_RGS); bf16* HC = (bf16*)(p.ws + OFF_HC);
    bf16x8 bw[4][4];
#pragma unroll
    for (int mm = 0; mm < 4; ++mm)
#pragma unroll
        for (int ks = 0; ks < 4; ++ks) bw[mm][ks] = *(const bf16x8*)(WT + ((size_t)((mm & 1) * 16 + (mm >> 1) * 8 + blk) * 128 + (w * 16 + r)) * 128 + ks * 32 + 8 * q);
    float ba[2], bx[2], sp[2];
#pragma unroll
    for (int dd = 0; dd < 2; ++dd) { ba[dd] = p.in[I_LBA][dd * 1024 + ch]; bx[dd] = p.in[I_LBX][dd * 1024 + ch]; sp[dd] = -8.f * softplus_f(-p.in[I_LLAM][dd * 1024 + ch]); }
    const bf16* XLC = (const bf16*)(p.ws + OFF_H);
    uint4 xr[2];
#define RG_FETCH(uu) do { const int bm_ = (uu) >> 3; const size_t rb_ = (size_t)(bm_ / 68) * TT + (bm_ % 68) * 64; \
        _Pragma("unroll") for (int rep = 0; rep < 2; ++rep) { const int idx = tid + rep * 512; xr[rep] = *(const uint4*)(XLC + (rb_ + (idx >> 4)) * DM + blk * 128 + (idx & 15) * 8); } } while (0)
    if (u0 < 2176) RG_FETCH(u0);
    for (int u = u0; u < 2176; u += ustride) {
        const int bm = u >> 3, b = bm / 68, mc = bm % 68, t0 = mc * 64;
        const size_t rowbase = (size_t)b * TT;
        __syncthreads();
#pragma unroll
        for (int rep = 0; rep < 2; ++rep) { const int idx = tid + rep * 512; const sc::u32x4 o4 = {xr[rep].x, xr[rep].y, xr[rep].z, xr[rep].w}; *(SLAS sc::u32x4*)(lds + L_XL + (size_t)((idx >> 4) * QS + (idx & 15) * 8) * 2) = o4; }
        if (u + ustride < 2176) RG_FETCH(u + ustride);
        float cin0 = 0.f, cin1 = 0.f;
        if (PHASE == 1) {
#pragma unroll
            for (int dd = 0; dd < 2; ++dd) {
                const int n = dd ? ((mc < 4) ? 3 - mc : 71 - mc) : mc, per = (n + 3) >> 2, lo_q = min(q * per, n), hi_q = min(lo_q + per, n);
                float A = 1.f, B = 0.f;
#pragma unroll 4
                for (int cp = lo_q; cp < hi_q; ++cp) { const int mcp = dd ? sc::chunk_of_step(1, cp) : cp; const float2 ab = RGS[((size_t)(b * 68 + mcp) * 2 + dd) * 1024 + ch]; B = ab.x * B + ab.y; A = ab.x * A; }
                float carry = 0.f;
#pragma unroll
                for (int qq = 0; qq < 4; ++qq) { const float Aq = __shfl(A, r + 16 * qq), Bq = __shfl(B, r + 16 * qq); carry = Aq * carry + Bq; }
                if (dd) cin1 = carry; else cin0 = carry; }
        }
        __syncthreads();
        f32x4 av[2][4], bv[2][4];
#pragma unroll
        for (int tb = 0; tb < 4; ++tb) {
            bf16x8 af[4];
#pragma unroll
            for (int ks = 0; ks < 4; ++ks) af[ks] = ldfrag(lds + L_XL, tb * 16 + r, QS, ks * 32 + 8 * q);
            f32x4 acc[4];
#pragma unroll
            for (int mm = 0; mm < 4; ++mm) { acc[mm] = (f32x4){0.f, 0.f, 0.f, 0.f};
#pragma unroll
                for (int ks = 0; ks < 4; ++ks) acc[mm] = mfma(af[ks], bw[mm][ks], acc[mm]); }
            f32x4 xl4;
#pragma unroll
            for (int j = 0; j < 4; ++j) xl4[j] = bf2f(((const SLAS bf16*)(lds + L_XL))[(tb * 16 + 4 * q + j) * QS + w * 16 + r]);
#pragma unroll
            for (int dd = 0; dd < 2; ++dd) { f32x4 a4, b4;
#pragma unroll
                for (int j = 0; j < 4; ++j) { const float rr = sc::sigmoid_fast(acc[dd * 2][j] + ba[dd]), ii = sc::sigmoid_fast(acc[dd * 2 + 1][j] + bx[dd]);
                    const float a = __expf(rr * sp[dd]); a4[j] = a; b4[j] = sqrtf(fmaxf(1.f - a * a, 0.f)) * (ii * xl4[j]); }
                av[dd][tb] = a4; bv[dd][tb] = b4; }
        }
        SLAS float* OUT = (SLAS float*)(lds + L_OUT);
        { float carry = cin0, aprod = 1.f;
#pragma unroll
          for (int tb = 0; tb < 4; ++tb) {
              const f32x4 A = av[0][tb], B = bv[0][tb]; f32x4 hl, ac;
              hl[0] = B[0]; ac[0] = A[0];
#pragma unroll
              for (int j = 1; j < 4; ++j) { hl[j] = A[j] * hl[j - 1] + B[j]; ac[j] = A[j] * ac[j - 1]; }
              float Ae = 1.f, Be = 0.f, At = 1.f, Bt = 0.f;
#pragma unroll
              for (int qq = 0; qq < 4; ++qq) { const float Aq = __shfl(ac[3], r + 16 * qq), Bq = __shfl(hl[3], r + 16 * qq);
                  if (qq < q) { Be = Aq * Be + Bq; Ae = Aq * Ae; }
                  Bt = Aq * Bt + Bq; At = Aq * At; }
              const float hin = Ae * carry + Be;
              { const f32x4 ov = ac * hin + hl, cv = ac * (Ae * aprod);
#pragma unroll
                for (int j = 0; j < 4; ++j) { const int oi = (tb * 16 + 4 * q + j) * OS + w * 16 + r; OUT[oi] = ov[j]; OUT[8448 + oi] = cv[j]; } }
              carry = At * carry + Bt; aprod *= At; }
          if (PHASE == 0 && q == 0) RGS[((size_t)(b * 68 + mc) * 2 + 0) * 1024 + ch] = make_float2(aprod, carry); }
        { float carry = cin1, aprod = 1.f;
#pragma unroll
          for (int tb = 3; tb >= 0; --tb) {
              const f32x4 A = av[1][tb], B = bv[1][tb]; f32x4 hl, ac;
              hl[3] = B[3]; ac[3] = A[3];
#pragma unroll
              for (int j = 2; j >= 0; --j) { hl[j] = A[j] * hl[j + 1] + B[j]; ac[j] = A[j] * ac[j + 1]; }
              float Ae = 1.f, Be = 0.f, At = 1.f, Bt = 0.f;
#pragma unroll
              for (int qq = 3; qq >= 0; --qq) { const float Aq = __shfl(ac[0], r + 16 * qq), Bq = __shfl(hl[0], r + 16 * qq);
                  if (qq > q) { Be = Aq * Be + Bq; Ae = Aq * Ae; }
                  Bt = Aq * Bt + Bq; At = Aq * At; }
              const float hin = Ae * carry + Be;
              { const f32x4 ov = ac * hin + hl, cv = ac * (Ae * aprod);
#pragma unroll
                for (int j = 0; j < 4; ++j) { const int oi = (tb * 16 + 4 * q + j) * OS + w * 16 + r; OUT[oi] += ov[j]; OUT[16896 + oi] = cv[j]; } }
              carry = At * carry + Bt; aprod *= At; }
          if (PHASE == 0 && q == 0) RGS[((size_t)(b * 68 + mc) * 2 + 1) * 1024 + ch] = make_float2(aprod, carry); }
        if (PHASE == 0) {
            __syncthreads();
            bf16* T0 = (bf16*)(p.ws + OFF_SO) + 2 * SEG; bf16* T1 = (bf16*)(p.ws + OFF_SO) + 3 * SEG; bf16* T2 = (bf16*)(p.ws + OFF_Y) + SEG;
#pragma unroll
            for (int rep = 0; rep < 2; ++rep) { const int idx = tid + rep * 512, t = idx >> 4, cc = idx & 15; const size_t off = (rowbase + t0 + t) * DM + blk * 128 + cc * 8;
#pragma unroll
                for (int k3 = 0; k3 < 3; ++k3) { const f32x4 x0 = *(const SLAS f32x4*)(OUT + k3 * 8448 + t * OS + cc * 8), x1 = *(const SLAS f32x4*)(OUT + k3 * 8448 + t * OS + cc * 8 + 4);
                    uint4 ov; ov.x = sc::pk2(x0[0], x0[1]); ov.y = sc::pk2(x0[2], x0[3]); ov.z = sc::pk2(x1[0], x1[1]); ov.w = sc::pk2(x1[2], x1[3]);
                    *(uint4*)((k3 == 0 ? T0 : (k3 == 1 ? T1 : T2)) + off) = ov; } }
        }
    }
}
__device__ __forceinline__ void rglru_finish(const Params& p, int u0, int ustride, unsigned char* lds_) {
    SLAS unsigned char* lds = (SLAS unsigned char*)lds_;
    const int tid = tid_op(), c = tid & 127, part = tid >> 7, blk = u0 & 7, ch = blk * 128 + c;
    const bf16* ZS = (const bf16*)(p.ws + OFF_ZS); const float2* RGS = (const float2*)(p.ws + OFF_RGS); bf16* HC = (bf16*)(p.ws + OFF_HC);
    const bf16* T0 = (const bf16*)(p.ws + OFF_SO) + 2 * SEG; const bf16* T1 = (const bf16*)(p.ws + OFF_SO) + 3 * SEG; const bf16* T2 = (const bf16*)(p.ws + OFF_Y) + SEG;
    SLAS float* FA = (SLAS float*)lds; SLAS float* CR = FA + 2048;
    for (int u = u0; u < 2176; u += ustride) {
        const int bm = u >> 3, b = bm / 68, mc = bm % 68, t0 = mc * 64; const size_t rowbase = (size_t)b * TT;
        uint4 xs[2], x0[2], x1[2], xg[2];
#pragma unroll
        for (int rep = 0; rep < 2; ++rep) { const int idx = tid + rep * 512, t = idx >> 4, cc = idx & 15; const size_t off = (rowbase + t0 + t) * DM + blk * 128 + cc * 8;
            xs[rep] = *(const uint4*)(T0 + off); x0[rep] = *(const uint4*)(T1 + off); x1[rep] = *(const uint4*)(T2 + off); xg[rep] = *(const uint4*)(ZS + 4 * SEG + off); }
        __syncthreads();
#pragma unroll
        for (int dd = 0; dd < 2; ++dd) {
            const int n = dd ? ((mc < 4) ? 3 - mc : 71 - mc) : mc, per = (n + 3) >> 2, lo_q = min(part * per, n), hi_q = min(lo_q + per, n);
            float A = 1.f, B = 0.f;
#pragma unroll 4
            for (int cp = lo_q; cp < hi_q; ++cp) { const int mcp = dd ? sc::chunk_of_step(1, cp) : cp; const float2 ab = RGS[((size_t)(b * 68 + mcp) * 2 + dd) * 1024 + ch]; B = ab.x * B + ab.y; A = ab.x * A; }
            FA[((dd * 4 + part) * 128 + c) * 2] = A; FA[((dd * 4 + part) * 128 + c) * 2 + 1] = B; }
        __syncthreads();
        if (tid < 256) { const int dd = tid >> 7; float carry = 0.f;
#pragma unroll
            for (int pp = 0; pp < 4; ++pp) carry = FA[((dd * 4 + pp) * 128 + c) * 2] * carry + FA[((dd * 4 + pp) * 128 + c) * 2 + 1];
            CR[dd * 128 + c] = carry; }
        __syncthreads();
#pragma unroll
        for (int rep = 0; rep < 2; ++rep) { const int idx = tid + rep * 512, t = idx >> 4, cc = idx & 15; const size_t row = rowbase + t0 + t;
            const f32x4 k0l = *(const SLAS f32x4*)(CR + cc * 8), k0h = *(const SLAS f32x4*)(CR + cc * 8 + 4), k1l = *(const SLAS f32x4*)(CR + 128 + cc * 8), k1h = *(const SLAS f32x4*)(CR + 128 + cc * 8 + 4);
            const f32x4 hl = sc::bf4lo(xs[rep]) + sc::bf4lo(x0[rep]) * k0l + sc::bf4lo(x1[rep]) * k1l, hh = sc::bf4hi(xs[rep]) + sc::bf4hi(x0[rep]) * k0h + sc::bf4hi(x1[rep]) * k1h;
            const f32x4 gl = sc::bf4lo(xg[rep]), gh = sc::bf4hi(xg[rep]);
            uint4 ov; ov.x = sc::pk2(hl[0] * gelu_fast(gl[0]), hl[1] * gelu_fast(gl[1])); ov.y = sc::pk2(hl[2] * gelu_fast(gl[2]), hl[3] * gelu_fast(gl[3]));
            ov.z = sc::pk2(hh[0] * gelu_fast(gh[0]), hh[1] * gelu_fast(gh[1])); ov.w = sc::pk2(hh[2] * gelu_fast(gh[2]), hh[3] * gelu_fast(gh[3]));
            *(uint4*)(HC + row * 2048 + 1024 + blk * 128 + cc * 8) = ov; }
    }
}
}

__device__ __forceinline__ void sub_barrier(unsigned* cnt, unsigned n) {
    asm volatile("s_waitcnt vmcnt(0)" ::: "memory");
    __syncthreads();
    if (threadIdx.x == 0) {
        __builtin_amdgcn_fence(__ATOMIC_RELEASE, "agent");
        asm volatile("s_waitcnt vmcnt(0)" ::: "memory");
        __hip_atomic_fetch_add(cnt, 1u, __ATOMIC_RELAXED, __HIP_MEMORY_SCOPE_AGENT);
        unsigned sp = 0;
        while (__hip_atomic_load(cnt, __ATOMIC_RELAXED, __HIP_MEMORY_SCOPE_AGENT) < n) { __builtin_amdgcn_s_sleep(2); if (++sp > (1u << 24)) break; }
        __builtin_amdgcn_fence(__ATOMIC_ACQUIRE, "agent");
        asm volatile("s_waitcnt vmcnt(0)" ::: "memory");
    }
    __syncthreads();
}
__device__ __forceinline__ void phase_scan(const Params& p, int layer, float* sm) {
#ifdef DIAG_SEL
    const unsigned long long dg_t0 = __builtin_amdgcn_s_memrealtime();
#endif
    if (layer == 0) {
        if (gridDim.x == 256) {
            const int u = blockIdx.x;
            if (u < 128) { if ((u >> 2) & 1) sc::mlstm_unit<1>(p, u >> 5, (u >> 3) & 3, u & 3, (unsigned char*)sm, u); else sc::mlstm_unit<0>(p, u >> 5, (u >> 3) & 3, u & 3, (unsigned char*)sm, u); }
            else rg::rglru_units<0>(p, u - 128, 128, (unsigned char*)sm);
        } else {
            for (int u = blockIdx.x; u < 128; u += gridDim.x) { if ((u >> 2) & 1) sc::mlstm_unit<1>(p, u >> 5, (u >> 3) & 3, u & 3, (unsigned char*)sm, u); else sc::mlstm_unit<0>(p, u >> 5, (u >> 3) & 3, u & 3, (unsigned char*)sm, u); __syncthreads(); }
            if ((gridDim.x & 7) == 0) rg::rglru_units<0>(p, blockIdx.x, gridDim.x, (unsigned char*)sm); else if (blockIdx.x < 8) rg::rglru_units<0>(p, blockIdx.x, 8, (unsigned char*)sm);
        }
    } else {
        for (int u = blockIdx.x; u < 256; u += gridDim.x) {
            if (u < 128) { if ((u >> 2) & 1) sc::gla_unit<1>(p, u >> 5, (u >> 3) & 3, u & 3, (unsigned char*)sm, u); else sc::gla_unit<0>(p, u >> 5, (u >> 3) & 3, u & 3, (unsigned char*)sm, u); }
            else { const int w = u - 128; if (w & 1) sc::ssd_unit<1>(p, w >> 5, (w >> 1) & 15, (unsigned char*)sm, u); else sc::ssd_unit<0>(p, w >> 5, (w >> 1) & 15, (unsigned char*)sm, u); }
            __syncthreads();
        }
    }
#ifdef DIAG_SEL
    if (threadIdx.x == 0) { const unsigned long long dt_ = __builtin_amdgcn_s_memrealtime() - dg_t0; unsigned long long* dg = (unsigned long long*)(p.ws + OFF_CTL + 98304);
        if (layer == 0 && blockIdx.x == 0) dg[1] = dt_; if (layer == 0 && blockIdx.x == 128) dg[2] = dt_; if (layer == 1 && blockIdx.x == 0) dg[3] = dt_; if (layer == 1 && blockIdx.x == 128) dg[4] = dt_;
        if (layer == 0 && blockIdx.x == 4) dg[5] = dt_; if (layer == 1 && blockIdx.x == 4) dg[6] = dt_; }
#endif
}

__device__ __forceinline__ float sigmoid_fast_(float x) { return __builtin_amdgcn_rcpf(1.f + __expf(-x)); }
__device__ __forceinline__ void ld16_bf16(const bf16* row, int lane, float (&v)[16]) {
#pragma unroll
    for (int c = 0; c < 2; ++c) { const uint4 t = *(const uint4*)(row + c * 512 + lane * 8);
        v[8 * c + 0] = bf2f(t.x & 0xffffu); v[8 * c + 1] = bf2f(t.x >> 16); v[8 * c + 2] = bf2f(t.y & 0xffffu); v[8 * c + 3] = bf2f(t.y >> 16);
        v[8 * c + 4] = bf2f(t.z & 0xffffu); v[8 * c + 5] = bf2f(t.z >> 16); v[8 * c + 6] = bf2f(t.w & 0xffffu); v[8 * c + 7] = bf2f(t.w >> 16); }
}
__device__ __forceinline__ void ld16_f32(const float* row, int lane, float (&v)[16]) {
#pragma unroll
    for (int c = 0; c < 2; ++c) { const float4 t0 = *(const float4*)(row + c * 512 + lane * 8), t1 = *(const float4*)(row + c * 512 + lane * 8 + 4);
        v[8 * c + 0] = t0.x; v[8 * c + 1] = t0.y; v[8 * c + 2] = t0.z; v[8 * c + 3] = t0.w; v[8 * c + 4] = t1.x; v[8 * c + 5] = t1.y; v[8 * c + 6] = t1.z; v[8 * c + 7] = t1.w; }
}
__device__ __forceinline__ void st16_bf16(bf16* row, int lane, const float (&v)[16]) {
#pragma unroll
    for (int c = 0; c < 2; ++c) { uint4 t; t.x = f2bf(v[8 * c]) | (f2bf(v[8 * c + 1]) << 16); t.y = f2bf(v[8 * c + 2]) | (f2bf(v[8 * c + 3]) << 16); t.z = f2bf(v[8 * c + 4]) | (f2bf(v[8 * c + 5]) << 16); t.w = f2bf(v[8 * c + 6]) | (f2bf(v[8 * c + 7]) << 16);
        *(uint4*)(row + c * 512 + lane * 8) = t; }
}
__device__ __forceinline__ float half_sum(float v) {
#pragma unroll
    for (int o = 16; o >= 1; o >>= 1) v += __shfl_xor(v, o);
    return v;
}
__device__ __forceinline__ void phase_mix2(const Params& p, int layer, float* sm) {
    if (layer == 0) { if ((gridDim.x & 7) == 0) rg::rglru_finish(p, blockIdx.x, gridDim.x, (unsigned char*)sm); else if (blockIdx.x < 8) rg::rglru_finish(p, blockIdx.x, 8, (unsigned char*)sm); }
    const int tid_ = tid_op(); const int lane = tid_ & 63, gw = blockIdx.x * 8 + (tid_ >> 6), NGW = gridDim.x * 8;
    const bf16* ZS = (const bf16*)(p.ws + OFF_ZS); const bf16* SO = (const bf16*)(p.ws + OFF_SO); bf16* HC = (bf16*)(p.ws + OFF_HC);
    for (int pr = gw; pr < MROWS / 2; pr += NGW) {
        const size_t r = (size_t)2 * pr;
        float a0[16], c0[16], g0[16], a1[16], c1[16], g1[16], w[16];
        ld16_bf16(SO + r * DM, lane, a0); ld16_bf16(SO + SEG + r * DM, lane, c0); ld16_bf16(ZS + 2 * SEG + r * DM, lane, g0);
        ld16_bf16(SO + (r + 1) * DM, lane, a1); ld16_bf16(SO + SEG + (r + 1) * DM, lane, c1); ld16_bf16(ZS + 2 * SEG + (r + 1) * DM, lane, g1);
        ld16_f32(layer == 0 ? p.in[I_MNORMW] : p.in[I_GNORMW], lane, w);
#pragma unroll
        for (int c = 0; c < 2; ++c) {
            float ss0 = 0.f, ss1 = 0.f;
#pragma unroll
            for (int i = 0; i < 8; ++i) { a0[8 * c + i] += c0[8 * c + i]; ss0 += a0[8 * c + i] * a0[8 * c + i]; a1[8 * c + i] += c1[8 * c + i]; ss1 += a1[8 * c + i] * a1[8 * c + i]; }
            const float r0 = __builtin_amdgcn_rsqf(half_sum(ss0) * (1.f / 256.f) + 1e-6f), r1 = __builtin_amdgcn_rsqf(half_sum(ss1) * (1.f / 256.f) + 1e-6f);
#pragma unroll
            for (int i = 0; i < 8; ++i) { const float q0 = g0[8 * c + i], q1 = g1[8 * c + i]; const float s0 = sigmoid_fast_(q0), s1 = sigmoid_fast_(q1);
                a0[8 * c + i] = a0[8 * c + i] * r0 * w[8 * c + i] * (layer == 0 ? s0 : q0 * s0); a1[8 * c + i] = a1[8 * c + i] * r1 * w[8 * c + i] * (layer == 0 ? s1 : q1 * s1); }
        }
        st16_bf16(HC + r * 2048, lane, a0); st16_bf16(HC + (r + 1) * 2048, lane, a1);
        if (layer == 0) continue;
        ld16_bf16(SO + 2 * SEG + r * DM, lane, a0); ld16_bf16(SO + 3 * SEG + r * DM, lane, c0); ld16_bf16(ZS + 3 * SEG + r * DM, lane, g0);
        ld16_bf16(SO + 2 * SEG + (r + 1) * DM, lane, a1); ld16_bf16(SO + 3 * SEG + (r + 1) * DM, lane, c1); ld16_bf16(ZS + 3 * SEG + (r + 1) * DM, lane, g1);
        ld16_f32(p.in[I_SNORMW], lane, w);
#pragma unroll
        for (int i = 0; i < 16; ++i) { a0[i] = (a0[i] + c0[i]) * (g0[i] * sigmoid_fast_(g0[i])); a1[i] = (a1[i] + c1[i]) * (g1[i] * sigmoid_fast_(g1[i])); }
        const float r0 = rstd_of(row_ss(a0)), r1 = rstd_of(row_ss(a1));
#pragma unroll
        for (int i = 0; i < 16; ++i) { a0[i] = a0[i] * r0 * w[i]; a1[i] = a1[i] * r1 * w[i]; }
        st16_bf16(HC + r * 2048 + 1024, lane, a0); st16_bf16(HC + (r + 1) * 2048 + 1024, lane, a1);
    }
}

__device__ __forceinline__ void phase_route_gather(const Params& p, float* sm) {
    int* bc = (int*)sm;
    int* base = bc + 2048; int* myoff = base + 16; int* woff = myoff + 8; int* cur = woff + 64;
    const int tid = tid_op(), lane = tid & 63, wave = tid >> 6, G = gridDim.x;
    const int* BCNT = (const int*)(p.ws + OFF_STOK); int* ctl = (int*)(p.ws + OFF_CTL);
    for (int i = tid; i < G * 8; i += 512) { const int g = i >> 3, e = i & 7; int sacc = 0;
#pragma unroll
        for (int w = 0; w < 8; ++w) sacc += BCNT[(g * 8 + w) * 8 + e];
        bc[i] = sacc; }
    if (tid < 64) { const int w = tid >> 3, e = tid & 7; int sacc = 0; for (int w2 = 0; w2 < w; ++w2) sacc += BCNT[((int)blockIdx.x * 8 + w2) * 8 + e]; woff[tid] = sacc; cur[tid] = 0; }
    __syncthreads();
    if (tid < 8) { int tot = 0, mine = 0; for (int g = 0; g < G; ++g) { if (g == (int)blockIdx.x) mine = tot; tot += bc[g * 8 + tid]; } myoff[tid] = mine; base[8 + tid] = tot; }
    __syncthreads();
    if (tid == 0) { int acc = 0; for (int e = 0; e < 8; ++e) { base[e] = acc; acc += (base[8 + e] + 255) / 256 * 256; }
        if (blockIdx.x == 0) { for (int e = 0; e < 8; ++e) { ctl[CW_CNT + e] = base[8 + e]; ctl[CW_BASE + e] = base[e]; } ctl[CW_BASE + 8] = acc; ctl[CW_TOT] = acc; } }
    __syncthreads();
    const int* TOPI = (const int*)(p.ws + OFF_TOPI); int* SLOT = (int*)(p.ws + OFF_SLOT);
    const unsigned char* H8 = p.ws + OFF_H; unsigned char* XS8 = p.ws + OFF_XS;
    const int gw = blockIdx.x * 8 + wave, NGW = G * 8;
    if (wave < 8) { const int e = wave, c0 = base[e] + base[8 + e], c1 = base[e] + (base[8 + e] + 255) / 256 * 256;
        for (int row = c0 + (int)blockIdx.x; row < c1; row += G) ((uint4*)(XS8 + (size_t)row * DM))[lane] = make_uint4(0u, 0u, 0u, 0u); }
    for (int pr = gw; pr < MROWS / 2; pr += NGW) {
        const int r = 2 * pr, b = r / TT, t = r % TT; if (t < NCTX) continue;
        const int tok = b * SEQ + (t - NCTX);
        int sl = 0, e = -1;
        if (lane < 4) e = TOPI[tok * 2 + lane];
        const int e0 = __shfl(e, 0), e1 = __shfl(e, 1), e2 = __shfl(e, 2);
        if (lane < 4) { const int rank = ((lane > 0 && e0 == e) ? 1 : 0) + ((lane > 1 && e1 == e) ? 1 : 0) + ((lane > 2 && e2 == e) ? 1 : 0);
            const int before = cur[wave * 8 + e]; sl = base[e] + myoff[e] + woff[wave * 8 + e] + before + rank; SLOT[tok * 2 + lane] = sl; }
        __builtin_amdgcn_wave_barrier();
        if (lane < 4) atomicAdd(&cur[wave * 8 + e], 1);
        __builtin_amdgcn_wave_barrier();
        const int s0 = __shfl(sl, 0), s1 = __shfl(sl, 1), s2 = __shfl(sl, 2), s3 = __shfl(sl, 3);
        const uint4 va = ((const uint4*)(H8 + (size_t)r * DM))[lane], vb = ((const uint4*)(H8 + (size_t)(r + 1) * DM))[lane];
        ((uint4*)(XS8 + (size_t)s0 * DM))[lane] = va; ((uint4*)(XS8 + (size_t)s1 * DM))[lane] = va;
        ((uint4*)(XS8 + (size_t)s2 * DM))[lane] = vb; ((uint4*)(XS8 + (size_t)s3 * DM))[lane] = vb;
    }
}

#define XB_TMO      128
#define XB_XCNT(j)  (256  + 64 * (j))
#define XB_XSUB(j)  (1280 + 64 * (j))
#define XB_XGEN(j)  (2304 + 64 * (j))
#define XB_TOP      3328
#define XB_TOPGEN   3392
#define XCD_BAR_WORDS 3456
#define XB_SPIN_CAP (1u << 22)
__device__ __forceinline__ unsigned xb_ld(unsigned* p)              { return __hip_atomic_load(p, __ATOMIC_RELAXED, __HIP_MEMORY_SCOPE_AGENT); }
__device__ __forceinline__ unsigned xb_add(unsigned* p, unsigned v) { return __hip_atomic_fetch_add(p, v, __ATOMIC_RELAXED, __HIP_MEMORY_SCOPE_AGENT); }
__device__ __forceinline__ unsigned xb_xcc_id() { return (unsigned)__builtin_amdgcn_s_getreg((3 << 11) | 20) & 0xFu; }
#define XB_SPIN(cond, bar) do { unsigned _sp = 0; while (cond) { __builtin_amdgcn_s_sleep(1); \
    if ((++_sp & 255u) == 0u) { if (xb_ld(&(bar)[XB_TMO])) break; if (_sp > XB_SPIN_CAP) { atomicAdd(&(bar)[XB_TMO], 1u); break; } } } } while (0)
struct XcdBarrier { unsigned* bar; unsigned x; volatile __attribute__((address_space(3))) unsigned* st; };
__device__ __forceinline__ XcdBarrier xcd_barrier_post(unsigned* bar, volatile __attribute__((address_space(3))) unsigned* st) {
    XcdBarrier b; b.bar = bar; b.x = xb_xcc_id(); b.st = st;
    if (threadIdx.x == 0) (void)xb_add(&bar[XB_XCNT(b.x)], 1u);
    return b;
}
__device__ __forceinline__ void xcd_barrier_complete(unsigned* bar, unsigned x, unsigned& nloc, unsigned& nx) {
    const unsigned G = gridDim.x * gridDim.y * gridDim.z;
    unsigned sum, cnt, mine, sp = 0u;
    for (;;) {
        sum = 0u; cnt = 0u; mine = 0u;
#pragma unroll
        for (unsigned j = 0; j < 16; ++j) { const unsigned c = xb_ld(&bar[XB_XCNT(j)]); sum += c; cnt += (c > 0u) ? 1u : 0u; mine = (j == x) ? c : mine; }
        if (sum == G) break;
        __builtin_amdgcn_s_sleep(1);
        if ((++sp & 255u) == 0u) { if (xb_ld(&bar[XB_TMO])) break; if (sp > XB_SPIN_CAP) { atomicAdd(&bar[XB_TMO], 1u); break; } }
    }
    nloc = mine > 0u ? mine : 1u; nx = cnt > 0u ? cnt : 1u;
}
__device__ __forceinline__ void xcd_barrier(const XcdBarrier& b) {
    asm volatile("s_waitcnt vmcnt(0)" ::: "memory");
    __syncthreads();
    if (threadIdx.x == 0) {
        unsigned* bar = b.bar;
        __builtin_amdgcn_s_waitcnt(0);
        unsigned nloc = b.st[0], nx = b.st[1];
        if (nloc == 0u) { xcd_barrier_complete(bar, b.x, nloc, nx); b.st[0] = nloc; b.st[1] = nx; }
        const unsigned old = xb_add(&bar[XB_XSUB(b.x)], 1u);
        const unsigned gen = old / nloc;
        if (old + 1u == (gen + 1u) * nloc) {
            __builtin_amdgcn_fence(__ATOMIC_RELEASE, "agent");
            asm volatile("s_waitcnt vmcnt(0)" ::: "memory");
            const unsigned og = xb_add(&bar[XB_TOP], 1u);
            const unsigned tg = og / nx;
            if (og + 1u == (tg + 1u) * nx) xb_add(&bar[XB_TOPGEN], 1u);
            else XB_SPIN(xb_ld(&bar[XB_TOPGEN]) == tg, bar);
            __builtin_amdgcn_fence(__ATOMIC_ACQUIRE, "agent");
            xb_add(&bar[XB_XGEN(b.x)], 1u);
            asm volatile("s_waitcnt vmcnt(0)" ::: "memory");
        } else {
            XB_SPIN(xb_ld(&bar[XB_XGEN(b.x)]) == gen, bar);
            __builtin_amdgcn_fence(__ATOMIC_ACQUIRE, "agent");
            asm volatile("s_waitcnt vmcnt(0)" ::: "memory");
        }
    }
    __syncthreads();
}

__global__ void __launch_bounds__(512, 2) mega(Params p) {
    extern __shared__ __attribute__((aligned(16))) unsigned char lds[];
    float* sm = (float*)lds;
    PG8_LAS unsigned char* LDS = (PG8_LAS unsigned char*)lds;
    unsigned char* ws = p.ws;
    bf16* H = (bf16*)(ws + OFF_H); bf16* ZS = (bf16*)(ws + OFF_ZS); float* G = (float*)(ws + OFF_G); bf16* HC = (bf16*)(ws + OFF_HC); float* Y = (float*)(ws + OFF_Y);
    const int* ctl = (const int*)(ws + OFF_CTL);
    volatile __attribute__((address_space(3))) unsigned* bst = (volatile __attribute__((address_space(3))) unsigned*)((PG8_LAS unsigned char*)lds + LDS_BYTES - 64);
    if (threadIdx.x < 2) bst[threadIdx.x] = 0u;
    __syncthreads();
    const XcdBarrier gbar = xcd_barrier_post((unsigned*)(ws + OFF_BAR), bst);

#ifndef DIAG_Q
#define DIAG_Q 10.f
#endif
#ifdef DIAG_SEL
#define PH(k, ...) do { const unsigned long long t0_ = __builtin_amdgcn_s_memrealtime(); { __VA_ARGS__; xcd_barrier(gbar); } if (blockIdx.x == 0 && threadIdx.x == 0) ((unsigned long long*)(ws + OFF_CTL + 98304))[30 + (k)] = __builtin_amdgcn_s_memrealtime() - t0_; } while (0)
#else
#define PH(k, ...) do { for (int _r = 0; _r < (((REP_MASK >> (k)) & 1) ? 2 : 1); ++_r) { __VA_ARGS__; xcd_barrier(gbar); } } while (0)
#endif
    PH(0, phase_mod(p, sm); phase_wconv(p, sm, 2, blockIdx.x, gridDim.x * 8));
    PH(1, phase_norm<0>(p, 0, (int*)sm));
    PH(2, { pg8::Gemm g{H, (const bf16*)(ws + OFF_W_ABIN), MROWS, NP_ABIN, DM, DM}; pg8::StaticOrder S; S.init(MROWS, NP_ABIN, gridDim.x, blockIdx.x); pg8::EpiInProj E{ZS, G, 20, 16}; pg8::gemm_phase(LDS, g, S, E); });
    PH(19, sc::prep_conv(p, 0); sc::prep_gates(p, 0));
    PH(3, phase_scan(p, 0, sm));
    PH(4, phase_mix2(p, 0, sm));
    PH(5, { pg8::Gemm g{HC, (const bf16*)(ws + OFF_W_ABOUT), MROWS, DM, 2048, 2048}; pg8::StaticOrder S; S.init(NTOK, DM, gridDim.x, blockIdx.x); pg8::EpiBf16 E{(bf16*)Y, DM}; pg8::gemm_phase(LDS, g, S, E); }
          { pg8::Gemm g{HC, (const bf16*)(ws + OFF_W_ABOUT), MROWS, DM, 256, 2048}; pg8::SplitOrder S{64, 4, 8, 256, (int)gridDim.x, (int)blockIdx.x, nullptr, 0}; pg8::EpiPart E{(float*)(ws + OFF_SO), 64, 4}; pg8::gemm_phase(LDS, g, S, E); });
    PH(6, phase_norm<1>(p, 0, (int*)sm, 8));
    PH(7, { pg8::Gemm g{H, (const bf16*)(ws + OFF_W_FFN1), MROWS, 2 * FFD, DM / 2, DM / 2}; pg8::StaticOrder S; S.init(MROWS, 2 * FFD, gridDim.x, blockIdx.x); pg8::EpiSwigluF8 E{ws + OFF_ACT, FFD, 1.f / (F8_XS * F8_W1S), F8_AS}; pg8::gemm_phase_f8(LDS, g, S, E); });
    PH(8, { const float dsc = 1.f / (F8_AS * F8_W2S);
          { pg8::Gemm g{(const bf16*)(ws + OFF_ACT), (const bf16*)(ws + OFF_W_FFN2), MROWS, DM, FFD / 2, FFD / 2}; pg8::StaticOrder S; S.init(NTOK, DM, gridDim.x, blockIdx.x); pg8::EpiBf16S E{(bf16*)Y, DM, dsc}; pg8::gemm_phase_f8(LDS, g, S, E); }
          { pg8::Gemm g{(const bf16*)(ws + OFF_ACT), (const bf16*)(ws + OFF_W_FFN2), MROWS, DM, 128, FFD / 2}; pg8::SplitOrder S{64, 4, 11, 128, (int)gridDim.x, (int)blockIdx.x, nullptr, 0}; pg8::EpiPartS E{(float*)(ws + OFF_SO), 64, 4, dsc}; pg8::gemm_phase_f8(LDS, g, S, E); } });
    PH(9, phase_norm<2>(p, 0, (int*)sm, 11));
    PH(10, { pg8::Gemm g{H, (const bf16*)(ws + OFF_W_CDIN), MROWS, NP_CDIN, DM, DM}; pg8::InProj1Order S; S.init(NTOK, NP_CDIN, gridDim.x, blockIdx.x); pg8::EpiInProj E{ZS, G, 22, 64}; pg8::gemm_phase(LDS, g, S, E); });
    PH(20, sc::prep_conv(p, 1); sc::prep_gates(p, 1); sc::prep_gla(p, (unsigned char*)sm));
    PH(11, phase_scan(p, 1, sm));
    PH(12, phase_mix2(p, 1, sm));
    PH(13, { pg8::Gemm g{HC, (const bf16*)(ws + OFF_W_CDOUT), MROWS, DM, 2048, 2048}; pg8::SkipCtxOrder S; S.init(NTOK, DM, gridDim.x, blockIdx.x); pg8::EpiBf16 E{(bf16*)Y, DM}; pg8::gemm_phase(LDS, g, S, E); });
    PH(14, phase_norm<1>(p, 1, (int*)sm));
#ifndef DIAG_NOROUTER
    PH(15, phase_route_gather(p, sm));
    PH(17, { pg8::Gemm g{(const bf16*)(ws + OFF_XS), (const bf16*)(ws + OFF_W_MOE1), ctl[CW_TOT], 2 * FFE, DM / 2, DM / 2}; pg8::MoeOrder S; S.init(ctl[CW_TOT], 2 * FFE, gridDim.x, blockIdx.x); S.ctl = ctl; S.estride = (size_t)2 * FFE * DM;
          pg8::EpiSwigluF8 E{ws + OFF_ACTM, FFE, 1.f / (F8_XS * F8_W1S), F8_AS}; pg8::gemm_phase_f8(LDS, g, S, E); });
    PH(18, { const int tot = ctl[CW_TOT], nmain = tot < 2 * NTOK ? tot : 2 * NTOK; const float dsc = 1.f / (F8_AS * F8_W2S);
          { pg8::Gemm g{(const bf16*)(ws + OFF_ACTM), (const bf16*)(ws + OFF_W_MOE2), tot, DM, FFE / 2, FFE / 2}; pg8::MoeOrder S; S.init(nmain, DM, gridDim.x, blockIdx.x); S.ctl = ctl; S.estride = (size_t)DM * FFE; pg8::EpiBf16S E{(bf16*)(ws + OFF_YS), DM, dsc}; pg8::gemm_phase_f8(LDS, g, S, E); }
          { pg8::Gemm g{(const bf16*)(ws + OFF_ACTM), (const bf16*)(ws + OFF_W_MOE2), tot, DM, 256, FFE / 2}; pg8::SplitOrder S{128, (tot - nmain) / 256, 7, 256, (int)gridDim.x, (int)blockIdx.x, ctl, (size_t)DM * FFE}; pg8::EpiPartS E{(float*)(ws + OFF_YS + 68 * MiB), 128, 8, dsc}; pg8::gemm_phase_f8(LDS, g, S, E); } });
#ifdef DIAG_SEL
    const unsigned long long tn3_ = __builtin_amdgcn_s_memrealtime();
#endif
    phase_norm<3>(p, 1, (int*)sm);
#ifdef DIAG_SEL
    if (blockIdx.x == 0 && threadIdx.x == 0) ((unsigned long long*)(ws + OFF_CTL + 98304))[29] = __builtin_amdgcn_s_memrealtime() - tn3_;
#endif
#endif
#ifdef DIAG_SEL
    xcd_barrier(gbar);
    for (size_t i_ = (size_t)blockIdx.x * 512 + threadIdx.x; i_ < (size_t)NTOK * DM; i_ += (size_t)gridDim.x * 512) p.out[i_] = 0.f;
    xcd_barrier(gbar);
    if (blockIdx.x == 0 && threadIdx.x == 0) { const unsigned long long* dg = (const unsigned long long*)(ws + OFF_CTL + 98304); const float tus = (DIAG_SEL == 0) ? 200.f : ((DIAG_SEL >= 29) ? floorf((float)(dg[DIAG_SEL]) * 0.01f / DIAG_Q + 0.5f) * DIAG_Q * 2.f : (DIAG_SEL >= 10) ? floorf((float)(dg[DIAG_SEL]) * 0.01f / 12.f + 0.5f) * 12.f * 4.f : floorf((float)(dg[DIAG_SEL]) * 0.01f / 30.f + 0.5f) * 30.f); p.out[0] = 50.f * tus; }
#endif
#ifdef EXTRA_SYNCS
    for (int i_ = 0; i_ < EXTRA_SYNCS; ++i_) xcd_barrier(gbar);
#endif
#undef PH
}

__global__ void nan_fill(float* out, int n) { int i = blockIdx.x * blockDim.x + threadIdx.x; if (i < n) out[i] = __builtin_nanf(""); }

extern "C" void kernel_launch(void* const* d_in, const int* in_sizes, int n_in, void* d_out, int out_size, void* d_ws, size_t ws_size, hipStream_t stream) {
    static int grid_blocks = 0;
    if (grid_blocks == 0) {
        int dev = 0, cus = 0, per_cu = 0;
        hipGetDevice(&dev);
        hipDeviceGetAttribute(&cus, hipDeviceAttributeMultiprocessorCount, dev);
        hipFuncSetAttribute((const void*)mega, hipFuncAttributeMaxDynamicSharedMemorySize, LDS_BYTES);
        hipOccupancyMaxActiveBlocksPerMultiprocessor(&per_cu, (const void*)mega, 512, LDS_BYTES);
        if (per_cu < 1) per_cu = 1;
        grid_blocks = cus * (per_cu > 1 ? 1 : per_cu);
        if (grid_blocks <= 0) grid_blocks = 256;
    }
    if (n_in != 37 || ws_size < WS_NEED) { fprintf(stderr, "kernel_launch: bad n_in %d or ws %zu < %zu\n", n_in, ws_size, (size_t)WS_NEED); nan_fill<<<(out_size + 255) / 256, 256, 0, stream>>>((float*)d_out, out_size); return; }
    Params p{};
    for (int i = 0; i < 37; ++i) p.in[i] = (const float*)d_in[i];
    p.out = (float*)d_out; p.ws = (unsigned char*)d_ws;
    if (hipMemsetAsync(d_ws, 0, 131072, stream) != hipSuccess) { fprintf(stderr, "kernel_launch: memset failed\n"); return; }
    hipLaunchKernelGGL(mega, dim3(grid_blocks), dim3(512), LDS_BYTES, stream, p);
    const hipError_t e = hipPeekAtLastError();
    if (e != hipSuccess) fprintf(stderr, "launch failed: %s (grid %d)\n", hipGetErrorString(e), grid_blocks);
}
```

```cpp
#include <hip/hip_runtime.h>
#include <cstdio>
#include <cstdint>

typedef unsigned short bf16;

constexpr int NB = 4, SEQ = 4096, NCTX = 256, TT = 4352, MROWS = NB * TT, DM = 1024;
constexpr int NTOK = NB * SEQ;
constexpr int FFD = 2816, FFE = 3584, NEXP = 8;
constexpr int AB_IN = 5136, CD_IN = 5696;
constexpr int MAXSLOT = 2 * NTOK + NEXP * 256;
constexpr float F8_XS = 4.f, F8_W1S = 128.f, F8_AS = 4.f, F8_W2S = 256.f;

constexpr size_t MiB = 1u << 20;
constexpr size_t OFF_CTL = 0, OFF_MOD = 1 * MiB, OFF_G = 2 * MiB, OFF_XC = 7 * MiB, OFF_TOPI = 11 * MiB, OFF_TOPG = 11 * MiB + 256 * 1024,
                 OFF_SLOT = 11 * MiB + 512 * 1024, OFF_STOK = 12 * MiB, OFF_RGS = 13 * MiB, OFF_H = 18 * MiB, OFF_ZS = 52 * MiB,
                 OFF_SO = 256 * MiB, OFF_HC = 392 * MiB, OFF_Y = 460 * MiB, OFF_W = 528 * MiB;
constexpr int NP_ABIN = 5376, NP_CDIN = 5888;
constexpr size_t OFF_W_ABIN = OFF_W, OFF_W_ABOUT = OFF_W_ABIN + (size_t)NP_ABIN * 1024 * 2, OFF_W_FFN1 = OFF_W_ABOUT + (size_t)1024 * 2048 * 2,
                 OFF_W_FFN2 = OFF_W_FFN1 + (size_t)5632 * 1024 * 2, OFF_W_CDIN = OFF_W_FFN2 + (size_t)1024 * 2816 * 2, OFF_W_CDOUT = OFF_W_CDIN + (size_t)NP_CDIN * 1024 * 2,
                 OFF_W_MOE1 = OFF_W_CDOUT + (size_t)1024 * 2048 * 2, OFF_W_MOE2 = OFF_W_MOE1 + (size_t)8 * 7168 * 1024 * 2, OFF_W_RG = OFF_W_MOE2 + (size_t)8 * 1024 * 3584 * 2, OFF_W_END = OFF_W_RG + (size_t)32 * 128 * 128 * 2;
constexpr size_t OFF_XB = (OFF_W_END + MiB - 1) / MiB * MiB;
constexpr size_t WS_NEED = OFF_XB + (size_t)MROWS * DM * 2;
constexpr size_t SEG = (size_t)MROWS * DM;
constexpr size_t OFF_ACT = OFF_ZS, OFF_XS = OFF_HC, OFF_ACTM = OFF_ZS, OFF_YS = OFF_HC;
constexpr int CW_CNT = 0, CW_BASE = 8, CW_TOT = 17;

#ifndef REP_MASK
#define REP_MASK 0
#endif
constexpr int LDS_BYTES = 147456;
constexpr size_t OFF_BAR = 4096;
#if defined(PROBE_SC) && PROBE_SC == 1
#define PROBE_STAGE_REPS 2
#else
#define PROBE_STAGE_REPS 1
#endif
struct Params { const float* in[37]; float* out; unsigned char* ws; };
enum { I_X = 0, I_C, I_CTX, I_CCTX, I_MODW, I_MODB, I_NORMG, I_ABIN, I_MCONVW, I_MCONVB, I_MGATEB, I_MNORMW, I_LCONVW, I_LCONVB, I_LWA, I_LBA, I_LWX, I_LBX,
       I_LLAM, I_ABOUT, I_FFN1, I_FFN2, I_CDIN, I_GALW, I_GALB, I_GNORMW, I_SCONVW, I_SCONVB, I_SDTB, I_SALOG, I_SD, I_SNORMW, I_CDOUT, I_RW, I_RB, I_MOE1, I_MOE2 };

__device__ __forceinline__ float bf2f(unsigned v) { return __uint_as_float(v << 16); }
__device__ __forceinline__ unsigned f2bf(float f) { unsigned u = __float_as_uint(f); return (u + 0x7fffu + ((u >> 16) & 1u)) >> 16; }
__device__ __forceinline__ float sigmoid_f(float x) { return 1.f / (1.f + expf(-x)); }
__device__ __forceinline__ float silu_f(float x) { return x / (1.f + expf(-x)); }
__device__ __forceinline__ float softplus_f(float x) { return fmaxf(x, 0.f) + log1pf(expf(-fabsf(x))); }
__device__ __forceinline__ float logsigmoid_f(float x) { return -softplus_f(-x); }
__device__ __forceinline__ float gelu_fast(float x) { const float u2 = 1.5957691216057308f * (x + 0.044715f * x * x * x); return x * __builtin_amdgcn_rcpf(1.f + __expf(-u2)); }
__device__ __forceinline__ float gelu_f(float x) { return 0.5f * x * (1.f + tanhf(0.7978845608028654f * (x + 0.044715f * x * x * x))); }
__device__ __forceinline__ float wave_sum(float v) {
#pragma unroll
    for (int o = 32; o >= 1; o >>= 1) v += __shfl_xor(v, o);
    return v;
}
__device__ __forceinline__ int tid_op() { int t = threadIdx.x; asm volatile("" : "+v"(t)); return t; }
__device__ __forceinline__ void ld_row_f32(const float* row, int lane, float (&v)[16]) {
#pragma unroll
    for (int j = 0; j < 4; ++j) { const float4 t = ((const float4*)row)[j * 64 + lane]; v[4 * j] = t.x; v[4 * j + 1] = t.y; v[4 * j + 2] = t.z; v[4 * j + 3] = t.w; }
}
__device__ __forceinline__ void st_row_f32(float* row, int lane, const float (&v)[16]) {
#pragma unroll
    for (int j = 0; j < 4; ++j) ((float4*)row)[j * 64 + lane] = make_float4(v[4 * j], v[4 * j + 1], v[4 * j + 2], v[4 * j + 3]);
}
__device__ __forceinline__ void ld_row_bf16(const bf16* row, int lane, float (&v)[16]) {
#pragma unroll
    for (int j = 0; j < 4; ++j) { const uint2 t = ((const uint2*)row)[j * 64 + lane]; v[4 * j] = bf2f(t.x & 0xffffu); v[4 * j + 1] = bf2f(t.x >> 16); v[4 * j + 2] = bf2f(t.y & 0xffffu); v[4 * j + 3] = bf2f(t.y >> 16); }
}
__device__ __forceinline__ void st_row_bf16(bf16* row, int lane, const float (&v)[16]) {
#pragma unroll
    for (int j = 0; j < 4; ++j) { uint2 t; t.x = f2bf(v[4 * j]) | (f2bf(v[4 * j + 1]) << 16); t.y = f2bf(v[4 * j + 2]) | (f2bf(v[4 * j + 3]) << 16); ((uint2*)row)[j * 64 + lane] = t; }
}
__device__ __forceinline__ unsigned pack4_fp8(float a, float b, float c, float d) {
    a = __builtin_amdgcn_fmed3f(a, -448.f, 448.f); b = __builtin_amdgcn_fmed3f(b, -448.f, 448.f); c = __builtin_amdgcn_fmed3f(c, -448.f, 448.f); d = __builtin_amdgcn_fmed3f(d, -448.f, 448.f);
    int w = __builtin_amdgcn_cvt_pk_fp8_f32(a, b, 0, false); w = __builtin_amdgcn_cvt_pk_fp8_f32(c, d, w, true); return (unsigned)w;
}
__device__ __forceinline__ void st_row_fp8(unsigned char* row, int lane, const float (&v)[16], float sc) {
#pragma unroll
    for (int j = 0; j < 4; ++j) ((unsigned*)row)[j * 64 + lane] = pack4_fp8(v[4 * j] * sc, v[4 * j + 1] * sc, v[4 * j + 2] * sc, v[4 * j + 3] * sc);
}
__device__ __forceinline__ void ld_row_parts(const float* P, int KS, size_t rows_per_part, size_t row, int lane, float (&v)[16]) {
#pragma unroll
    for (int i = 0; i < 16; ++i) v[i] = 0.f;
    for (int kz = 0; kz < KS; ++kz) { float t[16]; ld_row_f32(P + ((size_t)kz * rows_per_part + row) * DM, lane, t);
#pragma unroll
        for (int i = 0; i < 16; ++i) v[i] += t[i]; }
}
__device__ __forceinline__ float row_ss(const float (&v)[16]) { float s = 0.f;
#pragma unroll
    for (int i = 0; i < 16; ++i) s += v[i] * v[i];
    return wave_sum(s); }

__device__ __forceinline__ void seg_bounds(int t, int& lo, int& hi) { if (t < NCTX) { lo = 0; hi = NCTX; } else { lo = NCTX + ((t - NCTX) & ~63); hi = lo + 64; } }
__device__ __forceinline__ float conv4(const bf16* Z, int b, int t, int c, const float* w, int wstride, int wc, float bias) {
    int lo, hi; seg_bounds(t, lo, hi); float s = bias;
#pragma unroll
    for (int j = 0; j < 4; ++j) { const int tt = t + j - 2; if (tt >= lo && tt < hi) s += w[j * wstride + wc] * bf2f(Z[((size_t)(b * TT + tt)) * DM + c]); }
    return s;
}
__device__ __forceinline__ int tokmap(int dir, int tau) { return dir ? (tau < NCTX ? (NCTX - 1 - tau) : (TT + NCTX - 1 - tau)) : tau; }

__device__ __forceinline__ void phase_mod(const Params& p, float* sm) {
    float* sv = sm; float* red = sm + 5 * 1024; const int tid = tid_op();
    if (blockIdx.x == 48) { float* RWT = (float*)(p.ws + OFF_MOD + 512 * 1024); for (int i = tid; i < 8 * 1024; i += 512) RWT[i] = p.in[I_RW][(size_t)(i & 1023) * 8 + (i >> 10)]; }
    if (blockIdx.x < 48) {
        for (int i = tid; i < 5 * 1024; i += 512) { const int v = i >> 10, k = i & 1023; const float x = (v < 4) ? p.in[I_C][v * 1024 + k] : p.in[I_CCTX][k]; sv[i] = silu_f(x); }
        __syncthreads();
        float* MOD = (float*)(p.ws + OFF_MOD);
        for (int it = blockIdx.x; it < 48; it += gridDim.x) {
            const int l = it / 24, j0 = (it % 24) * 256, c4 = (tid & 63) * 4, kg = tid >> 6;
            const float* w = p.in[I_MODW] + (size_t)l * 1024 * 6144 + j0 + c4;
            float a[5][4];
#pragma unroll
            for (int v = 0; v < 5; ++v)
#pragma unroll
                for (int e = 0; e < 4; ++e) a[v][e] = 0.f;
#pragma unroll 8
            for (int k = kg * 128; k < kg * 128 + 128; ++k) { const float4 wv = *(const float4*)(w + (size_t)k * 6144);
#pragma unroll
                for (int v = 0; v < 5; ++v) { const float x = sv[v * 1024 + k]; a[v][0] += x * wv.x; a[v][1] += x * wv.y; a[v][2] += x * wv.z; a[v][3] += x * wv.w; } }
#pragma unroll
            for (int v = 0; v < 5; ++v) *(float4*)(red + (kg * 5 + v) * 256 + c4) = make_float4(a[v][0], a[v][1], a[v][2], a[v][3]);
            __syncthreads();
            for (int o = tid; o < 5 * 256; o += 512) { const int v = o >> 8, cc = o & 255; float sacc = 0.f;
#pragma unroll
                for (int g = 0; g < 8; ++g) sacc += red[(g * 5 + v) * 256 + cc];
                MOD[(size_t)(l * 5 + v) * 6144 + j0 + cc] = sacc + p.in[I_MODB][l * 6144 + j0 + cc]; }
            __syncthreads();
        }
    }
}

__device__ __forceinline__ float rstd_of(float ss) { return __builtin_amdgcn_rsqf(ss * (1.f / DM) + 1e-6f); }
__device__ __forceinline__ void router_reduce_pick(const Params& p, float (&lg)[8], int lane, int tok, int* hist) {
    float v4[4], v2[2], v1;
    { const bool hi = lane & 32;
#pragma unroll
      for (int e = 0; e < 4; ++e) { const float send = hi ? lg[e] : lg[e + 4], keep = hi ? lg[e + 4] : lg[e]; v4[e] = keep + __shfl_xor(send, 32); } }
    { const bool hi = lane & 16;
#pragma unroll
      for (int e = 0; e < 2; ++e) { const float send = hi ? v4[e] : v4[e + 2], keep = hi ? v4[e + 2] : v4[e]; v2[e] = keep + __shfl_xor(send, 16); } }
    { const bool hi = lane & 8; const float send = hi ? v2[0] : v2[1], keep = hi ? v2[1] : v2[0]; v1 = keep + __shfl_xor(send, 8); }
    v1 += __shfl_xor(v1, 4); v1 += __shfl_xor(v1, 2); v1 += __shfl_xor(v1, 1);
#pragma unroll
    for (int e = 0; e < 8; ++e) lg[e] = __shfl(v1, e * 8) + p.in[I_RB][e];
    if (lane == 0) {
        int e0 = 0; float l0 = lg[0];
#pragma unroll
        for (int e = 1; e < 8; ++e) if (lg[e] > l0) { l0 = lg[e]; e0 = e; }
        int e1 = -1; float l1 = -3.0e38f;
#pragma unroll
        for (int e = 0; e < 8; ++e) if (e != e0 && lg[e] > l1) { l1 = lg[e]; e1 = e; }
        const float ex = __expf(l1 - l0), g0 = 1.f / (1.f + ex), g1 = ex / (1.f + ex);
        ((int*)(p.ws + OFF_TOPI))[tok * 2] = e0; ((int*)(p.ws + OFF_TOPI))[tok * 2 + 1] = e1;
        ((float*)(p.ws + OFF_TOPG))[tok * 2] = g0; ((float*)(p.ws + OFF_TOPG))[tok * 2 + 1] = g1;
        atomicAdd(&hist[e0], 1); atomicAdd(&hist[e1], 1);
    }
}
__device__ __forceinline__ void router_pair(const Params& p, const float (&xa)[16], const float (&xb)[16], int lane, int tok, int* hist, const float* rw) {
#ifdef DIAG_NOROUTER
    return;
#endif
    float la[8], lb[8];
#pragma unroll
    for (int e = 0; e < 8; ++e) { la[e] = 0.f; lb[e] = 0.f; }
#pragma unroll
    for (int e = 0; e < 8; ++e)
#pragma unroll
        for (int j = 0; j < 4; ++j) { const float4 w = ((const float4*)(rw + e * 1024))[j * 64 + lane];
            la[e] += xa[4 * j] * w.x + xa[4 * j + 1] * w.y + xa[4 * j + 2] * w.z + xa[4 * j + 3] * w.w; lb[e] += xb[4 * j] * w.x + xb[4 * j + 1] * w.y + xb[4 * j + 2] * w.z + xb[4 * j + 3] * w.w; }
    router_reduce_pick(p, la, lane, tok, hist); router_reduce_pick(p, lb, lane, tok + 1, hist);
}
template <int MODE> __device__ __forceinline__ void phase_norm(const Params& p, int layer, int* hist, int KS = 0) {
    const int tid_ = tid_op(); const int lane = tid_ & 63, gw = blockIdx.x * 8 + (tid_ >> 6), NGW = gridDim.x * 8;
    const float* MOD = (const float*)(p.ws + OFF_MOD);
    const float* NG = p.in[I_NORMG] + (size_t)layer * 4 * 1024;
    bf16* H = (bf16*)(p.ws + OFF_H); const bf16* Y = (const bf16*)(p.ws + OFF_Y);
    const bool last = (layer == 1);
    const float* rw = (const float*)(hist + 64);
    if (MODE == 1 && last) { if (tid_ < 64) hist[tid_] = 0; const float* RWT = (const float*)(p.ws + OFF_MOD + 512 * 1024); for (int i = tid_; i < 2048; i += 512) ((float4*)(hist + 64))[i] = ((const float4*)RWT)[i]; __syncthreads(); }
    const int npair = (KS > 0) ? NTOK / 2 : MROWS / 2, nitem = npair + ((KS > 0) ? (MROWS - NTOK) : 0);
    constexpr bool PIPE = (MODE == 1 || MODE == 2);
    uint2 ry0[4], ry1[4], rh0[4], rh1[4]; float4 rf0[4], rf1[4];
#define NP_ISSUE(it_) do { const int r_ = 2 * (it_), b_ = r_ / TT, t_ = r_ % TT; const bool cx_ = t_ < NCTX; \
        const uint2* y0_ = (const uint2*)(Y + (size_t)r_ * DM); \
        _Pragma("unroll") for (int j = 0; j < 4; ++j) { ry0[j] = y0_[j * 64 + lane]; ry1[j] = y0_[256 + j * 64 + lane]; } \
        if (MODE == 1 && layer == 0) { const float4* x0_ = (const float4*)(cx_ ? (p.in[I_CTX] + ((size_t)b_ * NCTX + t_) * DM) : (p.in[I_X] + ((size_t)b_ * SEQ + (t_ - NCTX)) * DM)); \
            _Pragma("unroll") for (int j = 0; j < 4; ++j) { rf0[j] = x0_[j * 64 + lane]; rf1[j] = x0_[256 + j * 64 + lane]; } } \
        else { const uint2* x0_ = (const uint2*)((const bf16*)(p.ws + OFF_XB) + (size_t)r_ * DM); \
            _Pragma("unroll") for (int j = 0; j < 4; ++j) { rh0[j] = x0_[j * 64 + lane]; rh1[j] = x0_[256 + j * 64 + lane]; } } } while (0)
    float gK[16];
    if (!PIPE) ld_row_f32(NG + (MODE == 0 ? 0 : 3) * 1024, lane, gK);
    int4 nsl = make_int4(0, 0, 0, 0); float4 ngt = make_float4(0.f, 0.f, 0.f, 0.f);
#define N3_ISSUE(it_) do { const int r_ = 2 * (it_), b_ = r_ / TT, t_ = r_ % TT, tk_ = b_ * SEQ + (t_ < NCTX ? 0 : t_ - NCTX); \
        nsl = *(const int4*)((const int*)(p.ws + OFF_SLOT) + tk_ * 2); ngt = *(const float4*)((const float*)(p.ws + OFF_TOPG) + tk_ * 2); } while (0)
    if (MODE == 3 && gw < MROWS / 2) N3_ISSUE(gw);
    if (PIPE && gw < npair) NP_ISSUE(gw);
    for (int it = gw; it < nitem; it += NGW) {
        const bool two = it < npair; const int pr = it;
        const int r = two ? 2 * pr : NTOK + (it - npair), b = r / TT, t = r % TT; const bool isctx = t < NCTX; const int v = isctx ? 4 : b;
        uint2 cy0[4], cy1[4], ch0[4], ch1[4]; float4 cf0[4], cf1[4];
        if (PIPE && two) {
#pragma unroll
            for (int j = 0; j < 4; ++j) { cy0[j] = ry0[j]; cy1[j] = ry1[j]; ch0[j] = rh0[j]; ch1[j] = rh1[j]; cf0[j] = rf0[j]; cf1[j] = rf1[j]; }
            asm volatile("" : "+v"(cy0[0].x), "+v"(cy0[1].x), "+v"(cy0[2].x), "+v"(cy0[3].x), "+v"(cy1[0].x), "+v"(cy1[1].x), "+v"(cy1[2].x), "+v"(cy1[3].x));
            if (MODE == 1 && layer == 0) asm volatile("" : "+v"(cf0[0].x), "+v"(cf0[1].x), "+v"(cf0[2].x), "+v"(cf0[3].x), "+v"(cf1[0].x), "+v"(cf1[1].x), "+v"(cf1[2].x), "+v"(cf1[3].x));
            else asm volatile("" : "+v"(ch0[0].x), "+v"(ch0[1].x), "+v"(ch0[2].x), "+v"(ch0[3].x), "+v"(ch1[0].x), "+v"(ch1[1].x), "+v"(ch1[2].x), "+v"(ch1[3].x));
            { const int itn = (it + NGW < npair) ? it + NGW : it; NP_ISSUE(itn); }
        }
        int4 csl = nsl; float4 cgt = ngt;
        if (MODE == 3) { asm volatile("" : "+v"(csl.x), "+v"(cgt.x)); const int itn = (it + NGW < nitem) ? it + NGW : it; N3_ISSUE(itn); }
        if ((MODE == 3 || (MODE == 1 && last)) && isctx) continue;
        const float* mv = MOD + (size_t)(layer * 5 + v) * 6144;
        const float* xin = isctx ? (p.in[I_CTX] + ((size_t)b * NCTX + t) * DM) : (p.in[I_X] + ((size_t)b * SEQ + (t - NCTX)) * DM);
        bf16* xst = (bf16*)(p.ws + OFF_XB) + (size_t)r * DM;
        float xa[16], xb[16], g[16], a[16], s[16];
        if (MODE == 0) {
            ld_row_f32(xin, lane, xa); ld_row_f32(xin + DM, lane, xb);
            ld_row_f32(mv + 1024, lane, a); ld_row_f32(mv, lane, s);
#pragma unroll
            for (int i = 0; i < 16; ++i) g[i] = gK[i];
            const float ra = rstd_of(row_ss(xa)), rb = rstd_of(row_ss(xb));
#pragma unroll
            for (int i = 0; i < 16; ++i) { const float gg = g[i] * (1.f + a[i]); xa[i] = xa[i] * ra * gg + s[i]; xb[i] = xb[i] * rb * gg + s[i]; }
            st_row_bf16(H + (size_t)r * DM, lane, xa); st_row_bf16(H + (size_t)(r + 1) * DM, lane, xb);
        } else if (MODE == 1 || MODE == 2) {
            float ya[16], yb[16];
            if (!two) { const float* P = (const float*)(p.ws + OFF_SO); ld_row_parts(P, KS, 1024, (size_t)(r - NTOK), lane, ya); }
            else {
#pragma unroll
                for (int j = 0; j < 4; ++j) { ya[4 * j] = bf2f(cy0[j].x & 0xffffu); ya[4 * j + 1] = bf2f(cy0[j].x >> 16); ya[4 * j + 2] = bf2f(cy0[j].y & 0xffffu); ya[4 * j + 3] = bf2f(cy0[j].y >> 16);
                    yb[4 * j] = bf2f(cy1[j].x & 0xffffu); yb[4 * j + 1] = bf2f(cy1[j].x >> 16); yb[4 * j + 2] = bf2f(cy1[j].y & 0xffffu); yb[4 * j + 3] = bf2f(cy1[j].y >> 16); } }
            if (!two) { if (MODE == 1 && layer == 0) ld_row_f32(xin, lane, xa); else ld_row_bf16(xst, lane, xa); }
            else if (MODE == 1 && layer == 0) {
#pragma unroll
                for (int j = 0; j < 4; ++j) { xa[4 * j] = cf0[j].x; xa[4 * j + 1] = cf0[j].y; xa[4 * j + 2] = cf0[j].z; xa[4 * j + 3] = cf0[j].w; xb[4 * j] = cf1[j].x; xb[4 * j + 1] = cf1[j].y; xb[4 * j + 2] = cf1[j].z; xb[4 * j + 3] = cf1[j].w; } }
            else {
#pragma unroll
                for (int j = 0; j < 4; ++j) { xa[4 * j] = bf2f(ch0[j].x & 0xffffu); xa[4 * j + 1] = bf2f(ch0[j].x >> 16); xa[4 * j + 2] = bf2f(ch0[j].y & 0xffffu); xa[4 * j + 3] = bf2f(ch0[j].y >> 16);
                    xb[4 * j] = bf2f(ch1[j].x & 0xffffu); xb[4 * j + 1] = bf2f(ch1[j].x >> 16); xb[4 * j + 2] = bf2f(ch1[j].y & 0xffffu); xb[4 * j + 3] = bf2f(ch1[j].y >> 16); } }
            if (!two) {
#pragma unroll
                for (int i = 0; i < 16; ++i) { yb[i] = ya[i]; xb[i] = xa[i]; } }
            const float* mv2 = (MODE == 1) ? mv : (MOD + (size_t)(5 + v) * 6144);
            float g2[16], a2[16], s2[16];
            ld_row_f32(NG + (MODE == 1 ? 1 : 3) * 1024, lane, g); ld_row_f32(mv + (MODE == 1 ? 2 : 5) * 1024, lane, a);
            ld_row_f32((MODE == 1) ? (NG + 2 * 1024) : (p.in[I_NORMG] + (size_t)4 * 1024), lane, g2); ld_row_f32(mv2 + (MODE == 1 ? 4 : 1) * 1024, lane, a2); ld_row_f32(mv2 + (MODE == 1 ? 3 : 0) * 1024, lane, s2);
            const float ra = rstd_of(row_ss(ya)), rb = rstd_of(row_ss(yb));
#pragma unroll
            for (int i = 0; i < 16; ++i) { const float gg = a[i] * g[i]; xa[i] += gg * (ya[i] * ra); xb[i] += gg * (yb[i] * rb); }
            st_row_bf16(xst, lane, xa); if (two) st_row_bf16(xst + DM, lane, xb);
            const float ra2 = rstd_of(row_ss(xa)), rb2 = rstd_of(row_ss(xb));
#pragma unroll
            for (int i = 0; i < 16; ++i) { const float gg = g2[i] * (1.f + a2[i]); xa[i] = xa[i] * ra2 * gg + s2[i]; xb[i] = xb[i] * rb2 * gg + s2[i]; }
            if (MODE == 1) { unsigned char* H8 = (unsigned char*)H; st_row_fp8(H8 + (size_t)r * DM, lane, xa, F8_XS); if (two) st_row_fp8(H8 + (size_t)(r + 1) * DM, lane, xb, F8_XS); }
            else { st_row_bf16(H + (size_t)r * DM, lane, xa); if (two) st_row_bf16(H + (size_t)(r + 1) * DM, lane, xb); }
            if (MODE == 1 && last) { const int tok = b * SEQ + (t - NCTX); router_pair(p, xa, xb, lane, tok, hist + (tid_ >> 6) * 8, rw); }
        } else {
            const int tok = b * SEQ + (t - NCTX);
            const int4 sl = csl; const float4 gt = cgt;
            const bf16* YS = (const bf16*)(p.ws + OFF_YS);
            float ya[16], yb[16];
            const float* PS = (const float*)(p.ws + OFF_YS + 68 * MiB);
            { const int c0 = sl.x < 2 * NTOK ? sl.x : 0, c1 = sl.y < 2 * NTOK ? sl.y : 0, c2 = sl.z < 2 * NTOK ? sl.z : 0, c3 = sl.w < 2 * NTOK ? sl.w : 0;
              uint2 q0[4], q1[4], q2[4], q3[4], h0[4], h1[4];
#pragma unroll
              for (int j = 0; j < 4; ++j) { q0[j] = ((const uint2*)(YS + (size_t)c0 * DM))[j * 64 + lane]; q1[j] = ((const uint2*)(YS + (size_t)c1 * DM))[j * 64 + lane]; q2[j] = ((const uint2*)(YS + (size_t)c2 * DM))[j * 64 + lane]; q3[j] = ((const uint2*)(YS + (size_t)c3 * DM))[j * 64 + lane];
                  h0[j] = ((const uint2*)xst)[j * 64 + lane]; h1[j] = ((const uint2*)xst)[256 + j * 64 + lane]; }
#pragma unroll
              for (int j = 0; j < 4; ++j) {
                  ya[4 * j] = bf2f(q0[j].x & 0xffffu); ya[4 * j + 1] = bf2f(q0[j].x >> 16); ya[4 * j + 2] = bf2f(q0[j].y & 0xffffu); ya[4 * j + 3] = bf2f(q0[j].y >> 16);
                  a[4 * j] = bf2f(q1[j].x & 0xffffu); a[4 * j + 1] = bf2f(q1[j].x >> 16); a[4 * j + 2] = bf2f(q1[j].y & 0xffffu); a[4 * j + 3] = bf2f(q1[j].y >> 16);
                  yb[4 * j] = bf2f(q2[j].x & 0xffffu); yb[4 * j + 1] = bf2f(q2[j].x >> 16); yb[4 * j + 2] = bf2f(q2[j].y & 0xffffu); yb[4 * j + 3] = bf2f(q2[j].y >> 16);
                  s[4 * j] = bf2f(q3[j].x & 0xffffu); s[4 * j + 1] = bf2f(q3[j].x >> 16); s[4 * j + 2] = bf2f(q3[j].y & 0xffffu); s[4 * j + 3] = bf2f(q3[j].y >> 16);
                  xa[4 * j] = bf2f(h0[j].x & 0xffffu); xa[4 * j + 1] = bf2f(h0[j].x >> 16); xa[4 * j + 2] = bf2f(h0[j].y & 0xffffu); xa[4 * j + 3] = bf2f(h0[j].y >> 16);
                  xb[4 * j] = bf2f(h1[j].x & 0xffffu); xb[4 * j + 1] = bf2f(h1[j].x >> 16); xb[4 * j + 2] = bf2f(h1[j].y & 0xffffu); xb[4 * j + 3] = bf2f(h1[j].y >> 16); } }
            if (((sl.x | sl.y | sl.z | sl.w) >= 2 * NTOK)) {
                if (sl.x >= 2 * NTOK) ld_row_parts(PS, 7, 2048, (size_t)(sl.x - 2 * NTOK), lane, ya);
                if (sl.y >= 2 * NTOK) ld_row_parts(PS, 7, 2048, (size_t)(sl.y - 2 * NTOK), lane, a);
                if (sl.z >= 2 * NTOK) ld_row_parts(PS, 7, 2048, (size_t)(sl.z - 2 * NTOK), lane, yb);
                if (sl.w >= 2 * NTOK) ld_row_parts(PS, 7, 2048, (size_t)(sl.w - 2 * NTOK), lane, s); }
#pragma unroll
            for (int i = 0; i < 16; ++i) { ya[i] = ya[i] * gt.x + a[i] * gt.y; yb[i] = yb[i] * gt.z + s[i] * gt.w; }
            ld_row_f32(mv + 5 * 1024, lane, a);
#pragma unroll
            for (int i = 0; i < 16; ++i) g[i] = gK[i];
            const float ra = rstd_of(row_ss(ya)), rb = rstd_of(row_ss(yb));
#pragma unroll
            for (int i = 0; i < 16; ++i) { const float gg = a[i] * g[i]; xa[i] += gg * (ya[i] * ra); xb[i] += gg * (yb[i] * rb); }
            float* xo = p.out + ((size_t)b * SEQ + (t - NCTX)) * DM; st_row_f32(xo, lane, xa); st_row_f32(xo + DM, lane, xb);
        }
    }
#undef NP_ISSUE
#undef N3_ISSUE
    if (MODE == 1 && last) { __syncthreads(); if (tid_ < 64) ((int*)(p.ws + OFF_STOK))[blockIdx.x * 64 + tid_] = hist[tid_]; }
}

namespace pg8 {
#define PG8_LAS __attribute__((address_space(3)))
typedef unsigned short bf16_t;
typedef short bf16x8 __attribute__((ext_vector_type(8)));
typedef float f32x4 __attribute__((ext_vector_type(4)));
typedef unsigned u32x4 __attribute__((ext_vector_type(4)));
typedef unsigned u32x2 __attribute__((ext_vector_type(2)));
typedef int i32x4 __attribute__((ext_vector_type(4)));
typedef int i32x8 __attribute__((ext_vector_type(8)));
constexpr int BM = 256, BK = 64, HALF = 128, HTB = HALF * BK * 2, STAGE_BYTES = 8 * HTB, NXCD = 8, WGM = 8;
__host__ __device__ __forceinline__ int lds_byte(int r, int c) { const int st = (r >> 4) * 2 + (c >> 5), rr = r & 15, cc = c & 31, ob = rr * 64 + cc * 2; return st * 1024 + (ob ^ (((ob >> 9) & 1) << 5)); }
__host__ __device__ __forceinline__ void stage_rc(int b, int& R, int& C) { const int st = b / 1024, sb = b % 1024, swz = sb ^ (((sb >> 9) & 1) << 5); R = (st >> 1) * 16 + swz / 64; C = (st & 1) * 32 + (swz % 64) / 2; }
__host__ __device__ __forceinline__ int perm32(int rho) { const int n = rho >> 4, i = rho & 15; return 8 * (i >> 2) + 4 * n + (i & 3); }
struct Unit { int pm, pn, kz; };
struct Gemm { const bf16_t* A; const bf16_t* Bt; int M, N, K, ld; };
struct StaticOrder {
    int nM, nN, nwg, G, c;
    __device__ void init(int M, int N, int G_, int c_) { nM = M / BM; nN = N / BM; nwg = nM * nN; G = G_; c = c_; }
    __device__ bool next(int i, Unit& u) const {
        const long L = (long)i * G + c; if (L >= nwg) return false;
        int wgid = (int)L; { const int q = nwg / NXCD, r = nwg % NXCD, xcd = wgid % NXCD, off = wgid / NXCD; wgid = (xcd < r ? xcd * (q + 1) : r * (q + 1) + (xcd - r) * q) + off; }
        const int nig = WGM * nN, gid = wgid / nig, fm = gid * WGM, gsz = (nM - fm) < WGM ? (nM - fm) : WGM;
        u.pm = fm + ((wgid % nig) % gsz); u.pn = (wgid % nig) / gsz; u.kz = 0; return true;
    }
    __device__ __forceinline__ size_t boff(const Unit&) const { return 0; }
    __device__ __forceinline__ size_t koff(const Unit&) const { return 0; }
};
struct SplitOrder {
    int base, novf, KS, kpart, G, c; const int* ctl; size_t estride;
    __device__ bool next(int i, Unit& u) const { const int L = i * G + c; if (L >= novf * 4 * KS) return false; u.kz = L % KS; const int rest = L / KS; u.pn = rest & 3; u.pm = base + (rest >> 2); return true; }
    __device__ __forceinline__ size_t koff(const Unit& u) const { return (size_t)u.kz * kpart * 2; }
    __device__ __forceinline__ size_t boff(const Unit& u) const { if (!ctl) return 0; const int row0 = u.pm * 256; int e = 0;
#pragma unroll
        for (int i = 1; i < 8; ++i) if (row0 >= ctl[CW_BASE + i]) e = i;
        return (size_t)e * estride; }
};
template <bool SC> struct EpiPartT { static constexpr bool PERM = false;
    float* P; int base, novf_max; float sc = 1.f;
    __device__ __forceinline__ void operator()(const f32x4 (&acc)[2][2][4][2], const Unit& u, int wr, int wc, int fr, int fq) const {
        asm volatile("" : "+v"(fr));
        float* C = P + ((size_t)u.kz * novf_max + (u.pm - base)) * 256 * 1024; const int row0 = wr * 64 + fr, col0 = u.pn * BM + wc * 32 + 4 * fq;
#pragma unroll
        for (int ai = 0; ai < 2; ++ai)
#pragma unroll
            for (int m = 0; m < 4; ++m) { float* rowp = C + (size_t)(row0 + ai * HALF + m * 16) * 1024 + col0;
#pragma unroll
                for (int bj = 0; bj < 2; ++bj)
#pragma unroll
                    for (int n = 0; n < 2; ++n) *(f32x4*)(rowp + bj * HALF + n * 16) = SC ? acc[ai][bj][m][n] * sc : acc[ai][bj][m][n]; }
    }
};
typedef EpiPartT<false> EpiPart; typedef EpiPartT<true> EpiPartS;
struct SkipCtxOrder : StaticOrder {
    __device__ bool next(int i, Unit& u) const { if (!StaticOrder::next(i, u)) return false; u.pm = u.pm + (u.pm >> 4) + 1; return true; }
};
struct InProj1Order : StaticOrder {
    __device__ bool next(int i, Unit& u) const {
        const long L = (long)i * G + c;
        if (L < nwg) { StaticOrder::next(i, u); u.pm = u.pm + (u.pm >> 4) + 1; return true; }
        const int idx = (int)(L - nwg); if (idx >= 48) return false;
        const int j = idx % 12; u.pm = (idx / 12) * 17; u.pn = j < 6 ? 2 + j : (j < 11 ? 10 + j : 22); u.kz = 0; return true;
    }
};
struct MoeOrder : StaticOrder {
    const int* ctl; size_t estride;
    __device__ __forceinline__ size_t boff(const Unit& u) const { const int row0 = u.pm * 256; int e = 0;
#pragma unroll
        for (int i = 1; i < 8; ++i) if (row0 >= ctl[CW_BASE + i]) e = i;
        return (size_t)e * estride; }
};
__device__ __forceinline__ unsigned cvt_pk_bf16(float lo, float hi) { unsigned r; asm volatile("v_cvt_pk_bf16_f32 %0, %1, %2" : "=v"(r) : "v"(lo), "v"(hi)); return r; }
__device__ __forceinline__ float silu_fast(float x) { return x * __builtin_amdgcn_rcpf(1.f + __expf(-x)); }
struct EpiF32 { static constexpr bool PERM = false;
    float* C; int ldc;
    __device__ __forceinline__ void operator()(const f32x4 (&acc)[2][2][4][2], const Unit& u, int wr, int wc, int fr, int fq) const {
        const int row0 = u.pm * BM + wr * 64 + fr, col0 = u.pn * BM + wc * 32 + 4 * fq;
#pragma unroll
        for (int ai = 0; ai < 2; ++ai)
#pragma unroll
            for (int m = 0; m < 4; ++m) { float* rowp = C + (size_t)(row0 + ai * HALF + m * 16) * ldc + col0;
#pragma unroll
                for (int bj = 0; bj < 2; ++bj)
#pragma unroll
                    for (int n = 0; n < 2; ++n) *(f32x4*)(rowp + bj * HALF + n * 16) = acc[ai][bj][m][n]; }
    }
};
template <bool SC> struct EpiBf16T { static constexpr bool PERM = true;
    bf16_t* O; int ldc; float sc = 1.f;
    __device__ __forceinline__ void operator()(const f32x4 (&acc)[2][2][4][2], const Unit& u, int wr, int wc, int fr, int fq) const {
        const int row0 = u.pm * BM + wr * 64 + fr, col0 = u.pn * BM + wc * 32 + 8 * fq;
#pragma unroll
        for (int ai = 0; ai < 2; ++ai)
#pragma unroll
            for (int m = 0; m < 4; ++m) { bf16_t* rowp = O + (size_t)(row0 + ai * HALF + m * 16) * ldc + col0;
#pragma unroll
                for (int bj = 0; bj < 2; ++bj) { const f32x4 v0 = SC ? acc[ai][bj][m][0] * sc : acc[ai][bj][m][0], v1 = SC ? acc[ai][bj][m][1] * sc : acc[ai][bj][m][1];
                    u32x4 w; w.x = cvt_pk_bf16(v0[0], v0[1]); w.y = cvt_pk_bf16(v0[2], v0[3]); w.z = cvt_pk_bf16(v1[0], v1[1]); w.w = cvt_pk_bf16(v1[2], v1[3]);
                    *(u32x4*)(rowp + bj * HALF) = w; } }
    }
};
typedef EpiBf16T<false> EpiBf16; typedef EpiBf16T<true> EpiBf16S;
struct EpiInProj { static constexpr bool PERM = true;
    bf16_t* ZS; float* G; int gate_tile, ngate;
    __device__ __forceinline__ void operator()(const f32x4 (&acc)[2][2][4][2], const Unit& u, int wr, int wc, int fr, int fq) const {
        const int row0 = u.pm * BM + wr * 64 + fr;
        if (u.pn == gate_tile) {
            if (wc < 2) {
#pragma unroll
                for (int ai = 0; ai < 2; ++ai)
#pragma unroll
                    for (int m = 0; m < 4; ++m)
#pragma unroll
                        for (int n = 0; n < 2; ++n) { const int c0 = 32 * wc + 8 * fq + 4 * n; if (c0 < ngate) *(f32x4*)(G + (size_t)(row0 + ai * HALF + m * 16) * 64 + c0) = acc[ai][0][m][n]; }
            }
        } else {
            bf16_t* base = ZS + (size_t)(u.pn >> 2) * SEG; const int col0 = (u.pn & 3) * 256 + wc * 32 + 8 * fq;
#pragma unroll
            for (int ai = 0; ai < 2; ++ai)
#pragma unroll
                for (int m = 0; m < 4; ++m) { bf16_t* rowp = base + (size_t)(row0 + ai * HALF + m * 16) * DM + col0;
#pragma unroll
                    for (int bj = 0; bj < 2; ++bj) { const f32x4 v0 = acc[ai][bj][m][0], v1 = acc[ai][bj][m][1];
                        u32x4 w; w.x = cvt_pk_bf16(v0[0], v0[1]); w.y = cvt_pk_bf16(v0[2], v0[3]); w.z = cvt_pk_bf16(v1[0], v1[1]); w.w = cvt_pk_bf16(v1[2], v1[3]);
                        *(u32x4*)(rowp + bj * HALF) = w; } }
        }
    }
};
struct EpiSwiglu { static constexpr bool PERM = true;
    bf16_t* O; int ldo;
    __device__ __forceinline__ void operator()(const f32x4 (&acc)[2][2][4][2], const Unit& u, int wr, int wc, int fr, int fq) const {
        const int row0 = u.pm * BM + wr * 64 + fr, col0 = u.pn * HALF + wc * 32 + 8 * fq;
#pragma unroll
        for (int ai = 0; ai < 2; ++ai)
#pragma unroll
            for (int m = 0; m < 4; ++m) { const f32x4 g0 = acc[ai][0][m][0], g1 = acc[ai][0][m][1], u0 = acc[ai][1][m][0], u1 = acc[ai][1][m][1];
                u32x4 w; w.x = cvt_pk_bf16(silu_fast(g0[0]) * u0[0], silu_fast(g0[1]) * u0[1]); w.y = cvt_pk_bf16(silu_fast(g0[2]) * u0[2], silu_fast(g0[3]) * u0[3]);
                w.z = cvt_pk_bf16(silu_fast(g1[0]) * u1[0], silu_fast(g1[1]) * u1[1]); w.w = cvt_pk_bf16(silu_fast(g1[2]) * u1[2], silu_fast(g1[3]) * u1[3]);
                *(u32x4*)(O + (size_t)(row0 + ai * HALF + m * 16) * ldo + col0) = w; }
    }
};

struct EpiSwigluF8 { static constexpr bool PERM = true;
    unsigned char* O; int ldo; float dsc, osc;
    __device__ __forceinline__ void operator()(const f32x4 (&acc)[2][2][4][2], const Unit& u, int wr, int wc, int fr, int fq) const {
        const int row0 = u.pm * BM + wr * 64 + fr, col0 = u.pn * HALF + wc * 32 + 8 * fq;
#pragma unroll
        for (int ai = 0; ai < 2; ++ai)
#pragma unroll
            for (int m = 0; m < 4; ++m) { const f32x4 g0 = acc[ai][0][m][0] * dsc, g1 = acc[ai][0][m][1] * dsc, u0 = acc[ai][1][m][0] * (dsc * osc), u1 = acc[ai][1][m][1] * (dsc * osc);
                u32x2 w; w.x = pack4_fp8(silu_fast(g0[0]) * u0[0], silu_fast(g0[1]) * u0[1], silu_fast(g0[2]) * u0[2], silu_fast(g0[3]) * u0[3]);
                w.y = pack4_fp8(silu_fast(g1[0]) * u1[0], silu_fast(g1[1]) * u1[1], silu_fast(g1[2]) * u1[2], silu_fast(g1[3]) * u1[3]);
                *(u32x2*)(O + (size_t)(row0 + ai * HALF + m * 16) * ldo + col0) = w; }
    }
};

template <class Epi, class Sched, bool F8 = false>
__device__ __forceinline__ void gemm_phase(PG8_LAS unsigned char* lds, const Gemm g, const Sched& S, const Epi& E) {
    const int tid = tid_op(), wid = __builtin_amdgcn_readfirstlane(tid >> 6), lane = tid & 63, wr = wid >> 2, wc = wid & 3, fr = lane & 15, fq = lane >> 4;
    const int K = g.ld, nt = g.K / BK;
    unsigned voffA[2], voffB[2];
#pragma unroll
    for (int i = 0; i < 2; ++i) { int R, C; stage_rc(tid * 16 + i * 8192, R, C); const int Rb = Epi::PERM ? ((R & ~31) + perm32(R & 31)) : R;
        voffA[i] = (unsigned)(R * K + C) * 2u; voffB[i] = (unsigned)(Rb * K + C) * 2u; }
    const size_t kstep = (size_t)(BK * 2);
    const size_t hstep = (size_t)HALF * K * 2;
    const size_t tstep = 2 * hstep;
    const unsigned ldsw = (unsigned)wid * 1024u;
    const int aoff = lds_byte(wr * 64 + fr, fq * 8), boff = lds_byte(wc * 32 + fr, fq * 8);
#define PG8_SA(b, h) (((b) * 2 + (h)) * HTB)
#define PG8_SB(b, h) ((4 + (b) * 2 + (h)) * HTB)
#define PG8_STAGE(bufoff, gbase, voff) do { _Pragma("unroll") for (int _i = 0; _i < 2; ++_i) \
        __builtin_amdgcn_global_load_lds((const unsigned*)((const char*)(gbase) + (voff)[_i]), (PG8_LAS unsigned*)(lds + (bufoff) + ldsw + _i * 8192), 16, 0, 0); } while (0)
#define PG8_LD16(p_) (*(const PG8_LAS i32x4*)(p_))
#define PG8_LDA(dst, b, h) do { if (F8) { _Pragma("unroll") for (int m = 0; m < 4; ++m) dst##8[m] = __builtin_shufflevector(PG8_LD16(lds + PG8_SA(b, h) + aoff + m * 2048), PG8_LD16(lds + PG8_SA(b, h) + aoff + m * 2048 + 1024), 0, 1, 2, 3, 4, 5, 6, 7); } \
      else { _Pragma("unroll") for (int m = 0; m < 4; ++m) _Pragma("unroll") for (int k = 0; k < 2; ++k) dst[m][k] = *(const PG8_LAS bf16x8*)(lds + PG8_SA(b, h) + aoff + m * 2048 + k * 1024); } } while (0)
#define PG8_LDB(dst, b, h) do { if (F8) { _Pragma("unroll") for (int n = 0; n < 2; ++n) dst##8[n] = __builtin_shufflevector(PG8_LD16(lds + PG8_SB(b, h) + boff + n * 2048), PG8_LD16(lds + PG8_SB(b, h) + boff + n * 2048 + 1024), 0, 1, 2, 3, 4, 5, 6, 7); } \
      else { _Pragma("unroll") for (int n = 0; n < 2; ++n) _Pragma("unroll") for (int k = 0; k < 2; ++k) dst[n][k] = *(const PG8_LAS bf16x8*)(lds + PG8_SB(b, h) + boff + n * 2048 + k * 1024); } } while (0)
#define PG8_MMA(ai, bj, At, Bt) do { __builtin_amdgcn_s_setprio(1); if (F8) { _Pragma("unroll") for (int m = 0; m < 4; ++m) _Pragma("unroll") for (int n = 0; n < 2; ++n) \
        asm volatile("v_mfma_f32_16x16x128_f8f6f4 %0, %1, %2, %0" : "+v"(acc[ai][bj][m][n]) : "v"(Bt##8[n]), "v"(At##8[m])); } \
      else { _Pragma("unroll") for (int m = 0; m < 4; ++m) _Pragma("unroll") for (int n = 0; n < 2; ++n) _Pragma("unroll") for (int k = 0; k < 2; ++k) \
        acc[ai][bj][m][n] = __builtin_amdgcn_mfma_f32_16x16x32_bf16(Bt[n][k], At[m][k], acc[ai][bj][m][n], 0, 0, 0); } __builtin_amdgcn_s_setprio(0); } while (0)
#define PG8_ACCF8(a_, b_) asm volatile("" : "+v"(acc[a_][b_][0][0]), "+v"(acc[a_][b_][0][1]), "+v"(acc[a_][b_][1][0]), "+v"(acc[a_][b_][1][1]), "+v"(acc[a_][b_][2][0]), "+v"(acc[a_][b_][2][1]), "+v"(acc[a_][b_][3][0]), "+v"(acc[a_][b_][3][1]))
#define PG8_ACC_FENCE() do { if (F8) { PG8_ACCF8(0, 0); PG8_ACCF8(0, 1); PG8_ACCF8(1, 0); PG8_ACCF8(1, 1); asm volatile("s_nop 7" ::: "memory"); } } while (0)
#define PG8_WAIT_V(n) asm volatile("s_waitcnt vmcnt(" #n ")" ::: "memory")
#define PG8_WAIT_L(n) asm volatile("s_waitcnt lgkmcnt(" #n ")" ::: "memory")
#define PG8_BAR __builtin_amdgcn_s_barrier()
#define PG8_SCHED __builtin_amdgcn_sched_barrier(0)
    Unit cur, nxt; int ui = 0;
    if (!S.next(0, cur)) return;
    f32x4 acc[2][2][4][2];
#pragma unroll
    for (int a = 0; a < 2; ++a)
#pragma unroll
        for (int b = 0; b < 2; ++b)
#pragma unroll
            for (int m = 0; m < 4; ++m)
#pragma unroll
                for (int n = 0; n < 2; ++n) acc[a][b][m][n] = (f32x4){0.f, 0.f, 0.f, 0.f};
    PG8_ACC_FENCE();
    bf16x8 At[4][2], B0[2][2], B1[2][2]; i32x8 At8[4], B08[2], B18[2];
    const char* cA = (const char*)g.A + (size_t)cur.pm * tstep + S.koff(cur); const char* cB = (const char*)g.Bt + S.boff(cur) + (size_t)cur.pn * tstep + S.koff(cur);
    PG8_STAGE(PG8_SB(0, 0), cB, voffB); PG8_STAGE(PG8_SB(0, 1), cB + hstep, voffB); PG8_STAGE(PG8_SA(0, 0), cA, voffA); PG8_STAGE(PG8_SA(0, 1), cA + hstep, voffA);
    if (wr == 1) PG8_BAR;
    PG8_WAIT_V(2); PG8_BAR;
    PG8_STAGE(PG8_SB(1, 0), cB + kstep, voffB); PG8_STAGE(PG8_SA(1, 0), cA + kstep, voffA); PG8_STAGE(PG8_SB(1, 1), cB + hstep + kstep, voffB);
    PG8_WAIT_V(6); PG8_BAR;
    for (;;) {
        const bool has_next = S.next(ui + 1, nxt);
        const char* nA = has_next ? (const char*)g.A + (size_t)nxt.pm * tstep + S.koff(nxt) : cA; const char* nB = has_next ? (const char*)g.Bt + S.boff(nxt) + (size_t)nxt.pn * tstep + S.koff(nxt) : cB;
        for (int t = 0; t < nt; t += 2) {
            const bool last = (t == nt - 2);
            const char* a1 = cA + (size_t)(t + 1) * kstep;
            const char* a2 = last ? nA : cA + (size_t)(t + 2) * kstep; const char* b2 = last ? nB : cB + (size_t)(t + 2) * kstep;
            const char* a3 = a2 + kstep; const char* b3 = b2 + kstep;
            PG8_LDB(B0, 0, 0); PG8_LDB(B1, 0, 1); PG8_SCHED; PG8_LDA(At, 0, 0); PG8_STAGE(PG8_SA(1, 1), a1 + hstep, voffA);
            PG8_WAIT_V(8); PG8_WAIT_L(0); PG8_BAR; PG8_MMA(0, 0, At, B0); PG8_MMA(0, 1, At, B1); PG8_BAR; PG8_SCHED;
            PG8_LDA(At, 0, 1); PG8_STAGE(PG8_SB(0, 0), b2, voffB); PG8_STAGE(PG8_SB(0, 1), b2 + hstep, voffB); PG8_STAGE(PG8_SA(0, 0), a2, voffA);
            PG8_WAIT_V(8); PG8_WAIT_L(0); PG8_BAR; PG8_MMA(1, 0, At, B0); PG8_MMA(1, 1, At, B1); PG8_BAR; PG8_SCHED;
            PG8_LDB(B0, 1, 0); PG8_LDB(B1, 1, 1); PG8_SCHED; PG8_LDA(At, 1, 0); PG8_STAGE(PG8_SA(0, 1), a2 + hstep, voffA);
            PG8_WAIT_V(8); PG8_WAIT_L(0); PG8_BAR; PG8_MMA(0, 0, At, B0); PG8_MMA(0, 1, At, B1); PG8_BAR; PG8_SCHED;
            PG8_LDA(At, 1, 1); PG8_STAGE(PG8_SB(1, 0), b3, voffB); PG8_STAGE(PG8_SB(1, 1), b3 + hstep, voffB); PG8_STAGE(PG8_SA(1, 0), a3, voffA);
            PG8_WAIT_V(8); PG8_WAIT_L(0); PG8_BAR; PG8_MMA(1, 0, At, B0); PG8_MMA(1, 1, At, B1); PG8_BAR; PG8_SCHED;
        }
        if (F8) { asm volatile("s_nop 15\n\ts_nop 15\n\ts_nop 15\n\ts_nop 15" ::: "memory"); PG8_ACCF8(0, 0); PG8_ACCF8(0, 1); PG8_ACCF8(1, 0); PG8_ACCF8(1, 1); }
        if (wr == 0) PG8_BAR;
        E(acc, cur, wr, wc, fr, fq);
        if (!has_next) break;
#pragma unroll
        for (int a = 0; a < 2; ++a)
#pragma unroll
            for (int b = 0; b < 2; ++b)
#pragma unroll
                for (int m = 0; m < 4; ++m)
#pragma unroll
                    for (int n = 0; n < 2; ++n) acc[a][b][m][n] = (f32x4){0.f, 0.f, 0.f, 0.f};
        PG8_ACC_FENCE();
        cur = nxt; cA = nA; cB = nB; ++ui;
        if (wr == 1) PG8_BAR;
    }
    PG8_WAIT_V(0);
    PG8_BAR;
#undef PG8_SA
#undef PG8_SB
#undef PG8_STAGE
#undef PG8_LDA
#undef PG8_LD16
#undef PG8_LDB
#undef PG8_MMA
#undef PG8_WAIT_V
#undef PG8_ACCF8
#undef PG8_ACC_FENCE
#undef PG8_WAIT_L
#undef PG8_BAR
#undef PG8_SCHED
}
template <class Epi, class Sched> __device__ __forceinline__ void gemm_phase_f8(PG8_LAS unsigned char* lds, const Gemm g, const Sched& S, const Epi& E) { gemm_phase<Epi, Sched, true>(lds, g, S, E); }
}

__device__ __forceinline__ int wsrccol(int map, int n, int FF) {
    if (map == 0) return n;
    if (map == 1) return n < 3072 ? n : (n < 5120 ? n + 16 : (n < 5136 ? 3072 + (n - 5120) : -1));
    if (map == 2) return n < 3072 ? n : (n < 5632 ? n + 32 : (n < 5664 ? 3072 + (n - 5632) : (n < 5696 ? n : -1)));
    const int tile = n >> 8, i = n & 255; return (i < 128) ? tile * 128 + i : FF + tile * 128 + (i - 128);
}
typedef float sc4f __attribute__((ext_vector_type(4)));
struct WItem { const float* W; bf16* WT; int ldsrc, K, nblk, map, FF, item; float wsc; };
struct WRegs { float4 v[16]; };
__device__ __forceinline__ void wconv_load(const WItem& d, int lane, WRegs& R) {
    const bool f8 = d.wsc != 0.f;
    const int kb = d.item / d.nblk, nb = d.item % d.nblk, k0 = (f8 ? 128 : 64) * kb, n0 = (f8 ? 32 : 64) * nb, n4 = (f8 ? (lane & 7) : (lane & 15)) * 4, kr = f8 ? (lane >> 3) : (lane >> 4), kstep = f8 ? 8 : 4;
    const int sc = wsrccol(d.map, n0 + n4, d.FF);
#pragma unroll
    for (int i = 0; i < 16; ++i) { if (sc >= 0) { const sc4f t = __builtin_nontemporal_load((const sc4f*)(d.W + (size_t)(k0 + kstep * i + kr) * d.ldsrc + sc)); R.v[i] = make_float4(t[0], t[1], t[2], t[3]); } else R.v[i] = make_float4(0.f, 0.f, 0.f, 0.f); }
}
__device__ __forceinline__ void wconv_finish(const WItem& d, int lane, const WRegs& R, float* scr) {
    if (d.wsc != 0.f) {
        const int kb = d.item / d.nblk, nb = d.item % d.nblk, k0 = 128 * kb, n0 = 32 * nb, n4 = (lane & 7) * 4, kr = lane >> 3; const float ws_ = d.wsc;
#pragma unroll
        for (int i = 0; i < 16; ++i) { float* q = scr + (8 * i + kr) * 33 + n4; q[0] = R.v[i].x; q[1] = R.v[i].y; q[2] = R.v[i].z; q[3] = R.v[i].w; }
        asm volatile("s_waitcnt lgkmcnt(0)" ::: "memory");
        const int c = lane & 7;
#pragma unroll
        for (int j = 0; j < 4; ++j) { const int n = (lane >> 3) + 8 * j; const float* q = scr + (16 * c) * 33 + n;
            uint4 o; o.x = pack4_fp8(q[0 * 33] * ws_, q[1 * 33] * ws_, q[2 * 33] * ws_, q[3 * 33] * ws_); o.y = pack4_fp8(q[4 * 33] * ws_, q[5 * 33] * ws_, q[6 * 33] * ws_, q[7 * 33] * ws_);
            o.z = pack4_fp8(q[8 * 33] * ws_, q[9 * 33] * ws_, q[10 * 33] * ws_, q[11 * 33] * ws_); o.w = pack4_fp8(q[12 * 33] * ws_, q[13 * 33] * ws_, q[14 * 33] * ws_, q[15 * 33] * ws_);
            *(uint4*)((unsigned char*)d.WT + (size_t)(n0 + n) * d.K + k0 + 16 * c) = o; }
        asm volatile("s_waitcnt lgkmcnt(0)" ::: "memory");
        return;
    }
    const int kb = d.item / d.nblk, nb = d.item % d.nblk, k0 = 64 * kb, n0 = 64 * nb, n4 = (lane & 15) * 4, kr = lane >> 4;
#pragma unroll
    for (int i = 0; i < 16; ++i) { float* q = scr + (4 * i + kr) * 65 + n4; q[0] = R.v[i].x; q[1] = R.v[i].y; q[2] = R.v[i].z; q[3] = R.v[i].w; }
    asm volatile("s_waitcnt lgkmcnt(0)" ::: "memory");
    const int c = lane & 7;
#pragma unroll
    for (int j = 0; j < 8; ++j) { const int n = (lane >> 3) + 8 * j; const float* q = scr + (8 * c) * 65 + n;
        uint4 o; o.x = f2bf(q[0 * 65]) | (f2bf(q[1 * 65]) << 16); o.y = f2bf(q[2 * 65]) | (f2bf(q[3 * 65]) << 16); o.z = f2bf(q[4 * 65]) | (f2bf(q[5 * 65]) << 16); o.w = f2bf(q[6 * 65]) | (f2bf(q[7 * 65]) << 16);
        *(uint4*)(d.WT + (size_t)(n0 + n) * d.K + k0 + 8 * c) = o; }
    asm volatile("s_waitcnt lgkmcnt(0)" ::: "memory");
}
__device__ __forceinline__ WItem wconv_decode(const Params& p, int r) {
    constexpr int I0 = 16 * (NP_ABIN / 64), I1 = 32 * 16, I2 = 16 * (5632 / 64), I3 = 44 * 16, I4 = 16 * (NP_CDIN / 64), I5 = 32 * 16, I6 = 16 * (7168 / 64), I7 = 56 * 16;
    constexpr int NIT = I0 + I1 + I2 + I3 + I4 + I5;
    unsigned char* ws = p.ws;
    if (r >= NIT) { r -= NIT; const int mtx = r >> 2; return WItem{(mtx < 16 ? p.in[I_LWA] : p.in[I_LWX]) + (size_t)(mtx & 15) * 128 * 128, (bf16*)(ws + OFF_W_RG) + (size_t)mtx * 128 * 128, 128, 128, 2, 0, 0, r & 3}; }
    if (r < I0) return WItem{p.in[I_ABIN], (bf16*)(ws + OFF_W_ABIN), AB_IN, 1024, NP_ABIN / 64, 1, 0, r}; r -= I0;
    if (r < I1) return WItem{p.in[I_ABOUT], (bf16*)(ws + OFF_W_ABOUT), 1024, 2048, 16, 0, 0, r}; r -= I1;
    if (r < I2) return WItem{p.in[I_FFN1], (bf16*)(ws + OFF_W_FFN1), 5632, 1024, 5632 / 32, 3, FFD, r, F8_W1S}; r -= I2;
    if (r < I3) return WItem{p.in[I_FFN2], (bf16*)(ws + OFF_W_FFN2), 1024, 2816, 32, 0, 0, r, F8_W2S}; r -= I3;
    if (r < I4) return WItem{p.in[I_CDIN], (bf16*)(ws + OFF_W_CDIN), CD_IN, 1024, NP_CDIN / 64, 2, 0, r}; r -= I4;
    if (r < I5) return WItem{p.in[I_CDOUT], (bf16*)(ws + OFF_W_CDOUT), 1024, 2048, 16, 0, 0, r}; r -= I5;
    return WItem{p.in[I_CDOUT], (bf16*)(ws + OFF_W_CDOUT), 1024, 2048, 16, 0, 0, r % I5};
}
__device__ __forceinline__ void phase_wconv(const Params& p, float* sm, int part, int gwb, int NGW) {
    const int tid = tid_op(), lane = tid & 63, wave = tid >> 6;
    float* scr = sm + wave * (128 * 33);
    constexpr int NTOT = 16 * (NP_ABIN / 64) + 32 * 16 + 16 * (5632 / 64) + 44 * 16 + 16 * (NP_CDIN / 64) + 32 * 16 + 32 * 4;
    (void)part; (void)NGW;
    const int grp = gwb & 31; unsigned* tick = (unsigned*)(p.ws + OFF_CTL + 65536) + 64 * grp;
#define WC_TICKET() ((int)__builtin_amdgcn_readfirstlane((lane == 0) ? (int)__hip_atomic_fetch_add(tick, 1u, __ATOMIC_RELAXED, __HIP_MEMORY_SCOPE_AGENT) : 0) * 32 + grp)
    int itA = WC_TICKET();
    if (itA >= NTOT) return;
    WItem dA = wconv_decode(p, itA), dB = dA; WRegs RA, RB;
    wconv_load(dA, lane, RA);
    for (;;) {
        const int itB = WC_TICKET(); const bool hB = itB < NTOT;
        if (hB) { dB = wconv_decode(p, itB); wconv_load(dB, lane, RB); }
        wconv_finish(dA, lane, RA, scr);
        if (!hB) break;
        itA = WC_TICKET(); const bool hA = itA < NTOT;
        if (hA) { dA = wconv_decode(p, itA); wconv_load(dA, lane, RA); }
        wconv_finish(dB, lane, RB, scr);
        if (!hA) break;
    }
#undef WC_TICKET
}

namespace sc {
#if defined(DIAG_SEL) && DIAG_SEL >= 10
#define DSTAMP(k) do { const unsigned long long n_ = __builtin_amdgcn_s_memrealtime(); dacc[k] += n_ - dlast; dlast = n_; } while (0)
#define DARGS , unsigned long long (&dacc)[8], unsigned long long& dlast
#define DPASS , dacc, dlast
#else
#define DSTAMP(k) do {} while (0)
#define DARGS
#define DPASS
#endif
typedef short bf16x8 __attribute__((ext_vector_type(8)));
typedef float f32x4 __attribute__((ext_vector_type(4)));
#define SLAS __attribute__((address_space(3)))
typedef unsigned u32x2 __attribute__((ext_vector_type(2)));
typedef unsigned u32x4 __attribute__((ext_vector_type(4)));
constexpr int QS = 136, TS = 72;
constexpr int L_QA = 0, L_KA = L_QA + 64 * QS * 2, L_KT = L_KA + 64 * QS * 2, L_VU = L_KT + 128 * TS * 2, L_VS = L_VU + 80 * TS * 2, L_ST0 = L_VS + 80 * TS * 2,
              L_ST1 = L_ST0 + 80 * QS * 2, L_P = L_ST1 + 80 * QS * 2, L_SC = L_P + 64 * TS * 2, L_END = L_SC + 2048 + 2048;
__device__ __forceinline__ bf16x8 ldfrag(const SLAS unsigned char* base, int row, int stride, int k) { return *(const SLAS bf16x8*)(base + (size_t)(row * stride + k) * 2); }
typedef float f32x2_t __attribute__((ext_vector_type(2)));
typedef __bf16 bf16x2_t __attribute__((ext_vector_type(2)));
__device__ __forceinline__ unsigned pk2(float lo, float hi) { f32x2_t v = {lo, hi}; bf16x2_t b = __builtin_convertvector(v, bf16x2_t); return __builtin_bit_cast(unsigned, b); }
__device__ __forceinline__ f32x4 mfma(bf16x8 a, bf16x8 b, f32x4 c) { return __builtin_amdgcn_mfma_f32_16x16x32_bf16(a, b, c, 0, 0, 0); }
__device__ __forceinline__ int kt_off(int d, int s) { return (d * TS + ((((s >> 3) ^ (d >> 3)) & 7) << 3) + (s & 7)) * 2; }
__device__ __forceinline__ int chunk_of_step(int dir, int c) { return dir ? (c < 4 ? 3 - c : 71 - c) : c; }

template <int MODE, int dir>
__device__ __forceinline__ void chunk_compute(SLAS unsigned char* lds, int cur, f32x4 (&S)[5], float decs, float dskip, bf16* obase  , int b, int t0, int tid DARGS) {
    constexpr bool ONES = (MODE == 0), PERD = (MODE == 1), EXPD = (MODE != 1);
    const int lane = tid & 63, w = tid >> 6, r = lane & 15, q = lane >> 4;
    const SLAS unsigned char* Qa = lds + L_QA; const SLAS unsigned char* Ka = lds + L_KA; const SLAS unsigned char* KT = lds + L_KT;
    const SLAS unsigned char* VU = lds + L_VU; const SLAS unsigned char* VS = lds + (MODE == 1 ? L_VU : L_VS);
    const SLAS unsigned char* STc = lds + (cur ? L_ST1 : L_ST0); SLAS unsigned char* STn = lds + (cur ? L_ST0 : L_ST1);
    SLAS unsigned char* P = lds + L_P; const SLAS float* scal = (const SLAS float*)(lds + L_SC);
    DSTAMP(2);
#if defined(PROBE_SC) && PROBE_SC == 4
    __syncthreads(); __syncthreads(); __syncthreads();
#endif
#if defined(PROBE_SC) && PROBE_SC == 5
    if (tid == 0) __builtin_amdgcn_s_sleep(127);
#endif
    {
        const int sb = w >> 1, tbA = (w & 1) * 2;
        const bool on0 = dir ? (sb >= tbA) : (sb <= tbA), on1 = dir ? (sb >= tbA + 1) : (sb <= tbA + 1);
        bf16x8 a[4], b0[4], b1[4];
#pragma unroll
        for (int ks = 0; ks < 4; ++ks) { a[ks] = ldfrag(Ka, sb * 16 + r, QS, ks * 32 + 8 * q); b0[ks] = ldfrag(Qa, tbA * 16 + r, QS, ks * 32 + 8 * q); b1[ks] = ldfrag(Qa, tbA * 16 + 16 + r, QS, ks * 32 + 8 * q); }
        f32x4 acc0 = {0.f, 0.f, 0.f, 0.f}, acc1 = {0.f, 0.f, 0.f, 0.f};
#pragma unroll
        for (int ks = 0; ks < 4; ++ks) { if (on0) acc0 = mfma(a[ks], b0[ks], acc0); if (on1) acc1 = mfma(a[ks], b1[ks], acc1); }
        const f32x4 csv = EXPD ? *(const SLAS f32x4*)(scal + 64 + sb * 16 + 4 * q) : (f32x4){0.f, 0.f, 0.f, 0.f};
#pragma unroll
        for (int tt = 0; tt < 2; ++tt) {
            const int tb = tbA + tt, t = tb * 16 + r; const f32x4 acc = tt ? acc1 : acc0; const bool on = tt ? on1 : on0;
            float pv[4] = {0.f, 0.f, 0.f, 0.f};
            if (on) { const float btv = EXPD ? scal[t] : 0.f;
#pragma unroll
                for (int j = 0; j < 4; ++j) { const int sidx = sb * 16 + 4 * q + j; float v = acc[j]; if (EXPD) v *= __expf(btv + csv[j]); v = (dir ? (sidx >= t) : (sidx <= t)) ? v : 0.f; if (MODE == 2 && sidx == t) v += dskip; pv[j] = v; } }
            u32x2 o; o.x = pk2(pv[0], pv[1]); o.y = pk2(pv[2], pv[3]);
            *(SLAS u32x2*)(P + (size_t)(t * TS + sb * 16 + 4 * q) * 2) = o;
        }
    }
    DSTAMP(3);
    const int tb2 = w & 3, vb0 = (w >> 2) * 2, t2 = tb2 * 16 + r;
    const float rsv = EXPD ? scal[128 + t2] : 1.f;
    f32x4 oa0 = {0.f, 0.f, 0.f, 0.f}, oa1 = {0.f, 0.f, 0.f, 0.f}, oad = {0.f, 0.f, 0.f, 0.f};
    {
        bf16x8 bq[4], s0[4], s1[4], sd[4];
#pragma unroll
        for (int ks = 0; ks < 4; ++ks) { bq[ks] = ldfrag(Qa, t2, QS, ks * 32 + 8 * q); s0[ks] = ldfrag(STc, vb0 * 16 + r, QS, ks * 32 + 8 * q); s1[ks] = ldfrag(STc, vb0 * 16 + 16 + r, QS, ks * 32 + 8 * q);
            if (ONES) sd[ks] = ldfrag(STc, 64 + r, QS, ks * 32 + 8 * q); }
#pragma unroll
        for (int ks = 0; ks < 4; ++ks) { oa0 = mfma(s0[ks], bq[ks], oa0); oa1 = mfma(s1[ks], bq[ks], oa1); if (ONES) oad = mfma(sd[ks], bq[ks], oad); }
        if (EXPD) { oa0 = oa0 * rsv; oa1 = oa1 * rsv; if (ONES) oad = oad * rsv; }
    }
    {
        const int d0 = w * 16; constexpr int NT = 4 + (ONES ? 1 : 0);
        bf16x8 ak[2], vs[NT][2];
#pragma unroll
        for (int ks = 0; ks < 2; ++ks) { ak[ks] = *(const SLAS bf16x8*)(KT + kt_off(d0 + r, ks * 32 + 8 * q));
#pragma unroll
            for (int vb = 0; vb < NT; ++vb) vs[vb][ks] = ldfrag(VS, vb * 16 + r, TS, ks * 32 + 8 * q); }
        f32x4 dv = {decs, decs, decs, decs};
        if (PERD) dv = *(const SLAS f32x4*)(scal + 192 + d0 + 4 * q);
        if (!PERD) {
#pragma unroll
            for (int vb = 0; vb < NT; ++vb) S[vb] = S[vb] * dv; }
#pragma unroll
        for (int ks = 0; ks < 2; ++ks)
#pragma unroll
            for (int vb = 0; vb < NT; ++vb) S[vb] = mfma(ak[ks], vs[vb][ks], S[vb]);
        if (PERD) {
#pragma unroll
            for (int vb = 0; vb < NT; ++vb) S[vb] = S[vb] * dv; }
#pragma unroll
        for (int vb = 0; vb < NT; ++vb) { u32x2 o; o.x = pk2(S[vb][0], S[vb][1]); o.y = pk2(S[vb][2], S[vb][3]);
            *(SLAS u32x2*)(STn + (size_t)((vb * 16 + r) * QS + d0 + 4 * q) * 2) = o; }
    }
    DSTAMP(4);
    __syncthreads();
    DSTAMP(5);
    {
        bf16x8 bp[2], v0[2], v1[2], vd[2];
#pragma unroll
        for (int ks = 0; ks < 2; ++ks) { bp[ks] = ldfrag(P, t2, TS, ks * 32 + 8 * q); v0[ks] = ldfrag(VU, vb0 * 16 + r, TS, ks * 32 + 8 * q); v1[ks] = ldfrag(VU, vb0 * 16 + 16 + r, TS, ks * 32 + 8 * q);
            if (ONES) vd[ks] = ldfrag(VU, 64 + r, TS, ks * 32 + 8 * q); }
#pragma unroll
        for (int ks = 0; ks < 2; ++ks) { oa0 = mfma(v0[ks], bp[ks], oa0); oa1 = mfma(v1[ks], bp[ks], oa1); if (ONES) oad = mfma(vd[ks], bp[ks], oad); }
        if (ONES) { const float den = __shfl(oad[0], r); const float rden = __builtin_amdgcn_rcpf(fmaxf(fabsf(den), 1.f)); oa0 = oa0 * rden; oa1 = oa1 * rden; }
        bf16* orow = obase + ((size_t)b * TT + t0 + t2) * DM + vb0 * 16 + 4 * q;
        uint2 o; o.x = pk2(oa0[0], oa0[1]); o.y = pk2(oa0[2], oa0[3]); *(uint2*)(orow) = o;
        o.x = pk2(oa1[0], oa1[1]); o.y = pk2(oa1[2], oa1[3]); *(uint2*)(orow + 16) = o;
    }
    DSTAMP(6);
}

struct Blk48 { f32x4 lo[4], hi[4]; };
struct Rows7 { uint4 r[7]; };
__device__ __forceinline__ f32x4 bf4lo(uint4 v) { return (f32x4){bf2f(v.x & 0xffffu), bf2f(v.x >> 16), bf2f(v.y & 0xffffu), bf2f(v.y >> 16)}; }
__device__ __forceinline__ f32x4 bf4hi(uint4 v) { return (f32x4){bf2f(v.z & 0xffffu), bf2f(v.z >> 16), bf2f(v.w & 0xffffu), bf2f(v.w >> 16)}; }
__device__ __forceinline__ float silu_fast(float x) { return x * __builtin_amdgcn_rcpf(1.f + __expf(-x)); }
__device__ __forceinline__ float sigmoid_fast(float x) { return __builtin_amdgcn_rcpf(1.f + __expf(-x)); }
__device__ __forceinline__ float softplus_fast(float x) { return fmaxf(x, 0.f) + __logf(1.f + __expf(-fabsf(x))); }
__device__ __forceinline__ f32x4 silu4(f32x4 x, float sc) { return (f32x4){silu_fast(x[0]) * sc, silu_fast(x[1]) * sc, silu_fast(x[2]) * sc, silu_fast(x[3]) * sc}; }
template <bool ACT> __device__ __forceinline__ void conv_4x8(const bf16* Z, size_t rowbase, int t0, int m0, int lo, int hi, int col, const float* cw, int wstride, int wcol, const float* cb, float scale, Blk48& out) {
    Rows7 R;
#pragma unroll
    for (int rr = 0; rr < 7; ++rr) { const int tt = t0 + m0 + rr - 2; uint4 v = make_uint4(0u, 0u, 0u, 0u);
        if (tt >= lo && tt < hi) v = *(const uint4*)(Z + (rowbase + tt) * DM + col);
        R.r[rr] = v; }
    f32x4 wlo[4], whi[4];
#pragma unroll
    for (int j = 0; j < 4; ++j) { wlo[j] = *(const f32x4*)(cw + (size_t)j * wstride + wcol); whi[j] = *(const f32x4*)(cw + (size_t)j * wstride + wcol + 4); }
    const f32x4 blo = *(const f32x4*)(cb + wcol), bhi = *(const f32x4*)(cb + wcol + 4);
#pragma unroll
    for (int jj = 0; jj < 4; ++jj) { f32x4 a = blo, c = bhi;
#pragma unroll
        for (int j = 0; j < 4; ++j) { a = a + wlo[j] * bf4lo(R.r[jj + j]); c = c + whi[j] * bf4hi(R.r[jj + j]); }
        if (ACT) { a = silu4(a, scale); c = silu4(c, scale); }
        out.lo[jj] = a; out.hi[jj] = c; }
}
__device__ __forceinline__ void put_rows(SLAS unsigned char* tile, int m0, int ch, const Blk48& v) {
#pragma unroll
    for (int jj = 0; jj < 4; ++jj) { u32x4 o; o.x = pk2(v.lo[jj][0], v.lo[jj][1]); o.y = pk2(v.lo[jj][2], v.lo[jj][3]); o.z = pk2(v.hi[jj][0], v.hi[jj][1]); o.w = pk2(v.hi[jj][2], v.hi[jj][3]);
        *(SLAS u32x4*)(tile + (size_t)((m0 + jj) * QS + ch) * 2) = o; }
}
struct Raw4 { uint4 r[4]; };
__device__ __forceinline__ void raw4_issue(const bf16* p0  , Raw4& R) {
#pragma unroll
    for (int jj = 0; jj < 4; ++jj) R.r[jj] = *(const uint4*)(p0 + (size_t)jj * DM);
}
__device__ __forceinline__ void raw4_put_rows(SLAS unsigned char* tile, int m0, int ch, const Raw4& R) {
#pragma unroll
    for (int jj = 0; jj < 4; ++jj) { u32x4 o = {R.r[jj].x, R.r[jj].y, R.r[jj].z, R.r[jj].w}; *(SLAS u32x4*)(tile + (size_t)((m0 + jj) * QS + ch) * 2) = o; }
}
__device__ __forceinline__ void raw4_put_cols(SLAS unsigned char* tile, int m0, int ch, const Raw4& R) {
    const unsigned w0[4] = {R.r[0].x, R.r[0].y, R.r[0].z, R.r[0].w}, w1[4] = {R.r[1].x, R.r[1].y, R.r[1].z, R.r[1].w}, w2[4] = {R.r[2].x, R.r[2].y, R.r[2].z, R.r[2].w}, w3[4] = {R.r[3].x, R.r[3].y, R.r[3].z, R.r[3].w};
#pragma unroll
    for (int pr = 0; pr < 4; ++pr) { u32x2 ev, od;
        ev.x = (w0[pr] & 0xffffu) | (w1[pr] << 16); ev.y = (w2[pr] & 0xffffu) | (w3[pr] << 16);
        od.x = (w0[pr] >> 16) | (w1[pr] & 0xffff0000u); od.y = (w2[pr] >> 16) | (w3[pr] & 0xffff0000u);
        *(SLAS u32x2*)(tile + kt_off(ch + 2 * pr, m0)) = ev; *(SLAS u32x2*)(tile + kt_off(ch + 2 * pr + 1, m0)) = od; }
}
__device__ __forceinline__ void raw4_put_cols_scaled(SLAS unsigned char* tile, int m0, int ch, const Raw4& R, f32x4 dlo, f32x4 dhi) {
    const f32x4 a0 = bf4lo(R.r[0]), a1 = bf4lo(R.r[1]), a2 = bf4lo(R.r[2]), a3 = bf4lo(R.r[3]), c0 = bf4hi(R.r[0]), c1 = bf4hi(R.r[1]), c2 = bf4hi(R.r[2]), c3 = bf4hi(R.r[3]);
#pragma unroll
    for (int e = 0; e < 4; ++e) { u32x2 o, o2; o.x = pk2(a0[e] * dlo[e], a1[e] * dlo[e]); o.y = pk2(a2[e] * dlo[e], a3[e] * dlo[e]); o2.x = pk2(c0[e] * dhi[e], c1[e] * dhi[e]); o2.y = pk2(c2[e] * dhi[e], c3[e] * dhi[e]);
        *(SLAS u32x2*)(tile + kt_off(ch + e, m0)) = o; *(SLAS u32x2*)(tile + kt_off(ch + 4 + e, m0)) = o2; }
}
struct VRaw { unsigned x0, x1, x2, x3; };
__device__ __forceinline__ void v_issue(const bf16* vp  , VRaw& R) { R.x0 = *(const unsigned*)(vp); R.x1 = *(const unsigned*)(vp + DM); R.x2 = *(const unsigned*)(vp + 2 * DM); R.x3 = *(const unsigned*)(vp + 3 * DM); }
template <bool SCALED> __device__ __forceinline__ void v_put(SLAS unsigned char* lds, const VRaw& R, int m0, int c2, float4 kf) {
    u32x2 ua, ub;
    ua.x = (R.x0 & 0xffffu) | (R.x1 << 16); ua.y = (R.x2 & 0xffffu) | (R.x3 << 16); ub.x = (R.x0 >> 16) | (R.x1 & 0xffff0000u); ub.y = (R.x2 >> 16) | (R.x3 & 0xffff0000u);
    *(SLAS u32x2*)(lds + L_VU + (size_t)((c2 * 2) * TS + m0) * 2) = ua; *(SLAS u32x2*)(lds + L_VU + (size_t)((c2 * 2 + 1) * TS + m0) * 2) = ub;
    if (SCALED) {
        const float k0 = kf.x, k1 = kf.y, k2 = kf.z, k3 = kf.w;
        u32x2 sa, sb;
        sa.x = pk2(bf2f(R.x0 & 0xffffu) * k0, bf2f(R.x1 & 0xffffu) * k1); sa.y = pk2(bf2f(R.x2 & 0xffffu) * k2, bf2f(R.x3 & 0xffffu) * k3);
        sb.x = pk2(bf2f(R.x0 >> 16) * k0, bf2f(R.x1 >> 16) * k1); sb.y = pk2(bf2f(R.x2 >> 16) * k2, bf2f(R.x3 >> 16) * k3);
        *(SLAS u32x2*)(lds + L_VS + (size_t)((c2 * 2) * TS + m0) * 2) = sa; *(SLAS u32x2*)(lds + L_VS + (size_t)((c2 * 2 + 1) * TS + m0) * 2) = sb; }
}
template <int dir> __device__ __forceinline__ float dir_scan(float x, int lane, float& bl) {
#pragma unroll
    for (int o = 1; o < 64; o <<= 1) { const float tv = dir ? __shfl_down(x, o) : __shfl_up(x, o); if (dir ? (lane + o < 64) : (lane >= o)) x += tv; }
    bl = __shfl(x, dir ? 0 : 63); return x;
}
constexpr int L_GA = L_END;
static_assert(L_GA + 4096 <= 147456, "scan LDS map");

__device__ __forceinline__ const float* gate_base(const Params& p, int layer) { return (const float*)(p.ws + (layer == 0 ? OFF_TOPI : OFF_H)); }
__device__ __forceinline__ void prep_gates(const Params& p, int layer) {
    const int tid = tid_op(), lane = tid & 63, gw = blockIdx.x * 8 + (tid >> 6), NGW = gridDim.x * 8;
    const int NH = layer == 0 ? 4 : 16, nseq = NB * NH * 2;
    float* gb = (float*)gate_base(p, layer); const float* G = (const float*)(p.ws + OFF_G);
    float* BS = gb; float* CS = gb + (size_t)nseq * TT; float* KF = gb + (size_t)2 * nseq * TT; float* DECS = gb + (size_t)3 * nseq * TT;
    float nA = 0.f, nB = 0.f;
#define PGT_ISSUE(task_) do { const int sq_ = (task_) / 68, mc_ = (task_) % 68, dr_ = sq_ & 1, hh_ = (sq_ >> 1) % NH, bb_ = sq_ / (2 * NH); const size_t rw_ = (size_t)bb_ * TT + mc_ * 64 + lane; \
        if (layer == 0) { nA = G[rw_ * 64 + dr_ * 4 + hh_]; nB = G[rw_ * 64 + (2 + dr_) * 4 + hh_]; } else { nA = G[rw_ * 64 + 32 + dr_ * 16 + hh_]; } } while (0)
    if (gw < nseq * 68) PGT_ISSUE(gw);
    for (int task = gw; task < nseq * 68; task += NGW) {
        const int seq = task / 68, mc = task % 68, dir = seq & 1, h = (seq >> 1) % NH, b = seq / (2 * NH);
        float cA = nA, cB = nB; asm volatile("" : "+v"(cA), "+v"(cB));
        { const int tn = (task + NGW < nseq * 68) ? task + NGW : task; PGT_ISSUE(tn); }
        float l, gs, mul = 1.f;
        if (layer == 0) { const float gi = cA + p.in[I_MGATEB][dir * 4 + h], gf = cB + p.in[I_MGATEB][(2 + dir) * 4 + h];
            l = -softplus_fast(-gf); gs = gi; }
        else { const float dtv = softplus_fast(cA + p.in[I_SDTB][dir * 16 + h]); l = -dtv * __expf(p.in[I_SALOG][dir * 16 + h]); gs = __logf(dtv); mul = dtv; }
        float bl; const float bsum = dir ? dir_scan<1>(l, lane, bl) : dir_scan<0>(l, lane, bl);
        const size_t o = (size_t)seq * TT + mc * 64 + lane;
        BS[o] = bsum; CS[o] = gs - bsum; KF[o] = (layer == 0) ? __expf(bl - bsum + gs) : __expf(bl - bsum) * mul;
        if (lane == 0) DECS[seq * 68 + mc] = __expf(bl);
    }
#undef PGT_ISSUE
}

struct WFly { f32x4 v[4]; };
constexpr int L_WF = L_END, WF_PITCH = 144;
static_assert(L_WF + 64 * WF_PITCH <= 147456 - 64, "wfly tile");
__device__ __forceinline__ unsigned pack4_fp8_nc(float a, float b, float c, float d) { int w = __builtin_amdgcn_cvt_pk_fp8_f32(a, b, 0, false); w = __builtin_amdgcn_cvt_pk_fp8_f32(c, d, w, true); return (unsigned)w; }
struct WPiece { const float* src; size_t ld; unsigned char* dst; size_t pitch; };
__device__ __forceinline__ WPiece wfly_piece(const Params& p, int ord, int uidx) {
    WPiece q;
    if (ord < 14) { const int nb = uidx & 15, t_ = ord * 16 + (uidx >> 4), e = t_ / 28, kg = t_ - e * 28;
        q.src = p.in[I_MOE2] + ((size_t)e * 3584 + kg * 128) * 1024 + nb * 64; q.ld = 1024; q.dst = p.ws + OFF_W_MOE2 + (size_t)e * 1024 * 3584 + (size_t)(nb * 64) * 3584 + kg * 128; q.pitch = 3584; }
    else { const int i = (ord - 14) * 256 + uidx, t_ = i / 112, nb = i - t_ * 112, kg = t_ & 7, e = t_ >> 3, n0 = nb * 64, tile = n0 >> 8, i0 = n0 & 255, scol = (i0 < 128) ? tile * 128 + i0 : FFE + tile * 128 + (i0 - 128);
        q.src = p.in[I_MOE1] + ((size_t)e * 1024 + kg * 128) * 7168 + scol; q.ld = 7168; q.dst = p.ws + OFF_W_MOE1 + (size_t)e * 7168 * 1024 + (size_t)n0 * 1024 + kg * 128; q.pitch = 1024; }
    return q;
}
__device__ __forceinline__ void wfly_issue(const Params& p, int ord, int uidx, int wv, int lane, WFly& F) {
    const WPiece q = wfly_piece(p, ord, uidx);
    const float* s0 = q.src + (size_t)(wv * 16 + (lane >> 4) * 4) * q.ld + (lane & 15) * 4;
#pragma unroll
    for (int i = 0; i < 4; ++i) F.v[i] = __builtin_nontemporal_load((const f32x4*)(s0 + (size_t)i * q.ld));
}
__device__ __forceinline__ void wfly_fill(SLAS unsigned char* lds, int ord_prev, int wv, int lane, const WFly& F) {
    const float sc = ord_prev < 14 ? F8_W2S : F8_W1S;
#pragma unroll
    for (int nn = 0; nn < 4; ++nn) *(SLAS unsigned*)(lds + L_WF + ((lane & 15) * 4 + nn) * WF_PITCH + wv * 16 + (lane >> 4) * 4) = pack4_fp8_nc(F.v[0][nn] * sc, F.v[1][nn] * sc, F.v[2][nn] * sc, F.v[3][nn] * sc);
}
__device__ __forceinline__ void wfly_drain(const Params& p, SLAS unsigned char* lds, int ord_prev, int uidx, int wv, int lane) {
    const WPiece q = wfly_piece(p, ord_prev, uidx); const int row = wv * 8 + (lane >> 3), pc = lane & 7;
    const u32x4 v = *(const SLAS u32x4*)(lds + L_WF + row * WF_PITCH + pc * 16);
    *(uint4*)(q.dst + (size_t)row * q.pitch + pc * 16) = make_uint4(v.x, v.y, v.z, v.w);
}
#define WFLY_FILL() do { if (c >= 1 && c <= 42) wfly_fill(lds, c - 1, wfw, tid & 63, WF); if (c < 42) wfly_issue(p, c, uidx, wfw, tid & 63, WF); } while (0)
#define WFLY_DRAIN() do { if (c >= 1 && c <= 42) wfly_drain(p, lds, c - 1, uidx, wfw, tid & 63); } while (0)
template <int dir> __device__ __forceinline__ void mlstm_unit(const Params& p, int b, int h, int vs, unsigned char* lds_, int uidx) {
    SLAS unsigned char* lds = (SLAS unsigned char*)lds_;
    const int tid = tid_op(), lane = tid & 63, w = tid >> 6; (void)uidx;
    const bf16* QKC = (const bf16*)(p.ws + OFF_Y); const bf16* ZS = (const bf16*)(p.ws + OFF_ZS); const float* G = (const float*)(p.ws + OFF_G);
    bf16* obase = (bf16*)(p.ws + OFF_SO) + (size_t)dir * SEG + h * 256 + vs * 64;
    const int seq = (b * 4 + h) * 2 + dir; const float* gb = gate_base(p, 0);
    const float* BSq = gb + (size_t)seq * TT; const float* CSq = gb + (size_t)(32 + seq) * TT; const float* KFq = gb + (size_t)(64 + seq) * TT; const float* DECq = gb + (size_t)96 * TT + seq * 68;
    SLAS float* scal = (SLAS float*)(lds + L_SC);
    for (int i = tid; i < 80 * QS / 2; i += 512) ((SLAS unsigned*)(lds + L_ST0))[i] = 0u;
    for (int i = tid; i < 16 * TS / 2; i += 512) { ((SLAS unsigned*)(lds + L_VU + 64 * TS * 2))[i] = (i < TS / 2) ? 0x3f803f80u : 0u; ((SLAS unsigned*)(lds + L_VS + 64 * TS * 2))[i] = 0u; }
    f32x4 S[5];
#pragma unroll
    for (int i = 0; i < 5; ++i) S[i] = (f32x4){0.f, 0.f, 0.f, 0.f};
    const size_t rowbase = (size_t)b * TT;
    const int tg = tid >> 5, cg = tid & 31, m0 = tg * 4; const bool isk = cg >= 16; const int ch = (cg & 15) * 8;
    const bf16* qkp = QKC + (rowbase + m0) * DM + (isk ? 512 : 0) + h * 128 + ch;
    const bf16* vp = ZS + SEG + (rowbase + m0) * DM + h * 256 + vs * 64 + cg * 2;
    struct Pre { Raw4 R; VRaw V; float4 kf; float bs, cs, kfl, dec; } PA, PB;
#define MLSTM_ISSUE(P_, cc) do { const int mc_ = chunk_of_step(dir, (cc)); const size_t to_ = (size_t)mc_ * 64; raw4_issue(qkp + to_ * DM, P_.R); v_issue(vp + to_ * DM, P_.V); \
        P_.kf = *(const float4*)(KFq + to_ + m0); P_.dec = DECq[mc_]; if (w == 0) { P_.bs = BSq[to_ + lane]; P_.cs = CSq[to_ + lane]; P_.kfl = KFq[to_ + lane]; } } while (0)
#define MLSTM_STEP(P_, c_) do { const int c = (c_); const int t0 = chunk_of_step(dir, c) * 64; float blk_ = 0.f; \
        __syncthreads();                                       \
        DSTAMP(0); \
        for (int rep_ = 0; rep_ < PROBE_STAGE_REPS; ++rep_) { \
        if (w == 0) { scal[lane] = P_.bs; scal[64 + lane] = P_.cs; scal[128 + lane] = __expf(P_.bs); ((SLAS bf16*)(lds + L_VS + 64 * TS * 2))[lane] = (bf16)f2bf(P_.kfl); } \
        raw4_put_rows(lds + (isk ? L_KA : L_QA), m0, ch, P_.R); \
        if (isk) raw4_put_cols(lds + L_KT, m0, ch, P_.R); \
        v_put<true>(lds, P_.V, m0, cg, P_.kf); blk_ = P_.dec; } \
        MLSTM_ISSUE(P_, (c + 2 < 68) ? c + 2 : 67);        \
        DSTAMP(1); \
        __syncthreads(); \
        chunk_compute<0, dir>(lds, c & 1, S, blk_, 0.f, obase, b, t0, tid DPASS); } while (0)
#if defined(DIAG_SEL) && DIAG_SEL >= 10
    unsigned long long dacc[8] = {0, 0, 0, 0, 0, 0, 0, 0}; unsigned long long dlast = __builtin_amdgcn_s_memrealtime();
#endif
    MLSTM_ISSUE(PA, 0); MLSTM_ISSUE(PB, 1);
    for (int c2 = 0; c2 < 68; c2 += 2) { MLSTM_STEP(PA, c2); MLSTM_STEP(PB, c2 + 1); }
#undef MLSTM_STEP
#if defined(DIAG_SEL) && DIAG_SEL >= 10
    if (tid == 0 && blockIdx.x == 0) { unsigned long long* dg = (unsigned long long*)(p.ws + OFF_CTL + 98304); for (int k = 0; k < 7; ++k) dg[10 + k] = dacc[k]; }
#endif
#undef MLSTM_ISSUE
}
template <int dir> __device__ __forceinline__ void ssd_unit(const Params& p, int b, int h, unsigned char* lds_, int uidx) {
    SLAS unsigned char* lds = (SLAS unsigned char*)lds_;
    const int tid = tid_op(), lane = tid & 63, w = tid >> 6, g = h >> 3; const int wfw = __builtin_amdgcn_readfirstlane(w); WFly WF;
    const bf16* XC = (const bf16*)(p.ws + OFF_HC); const float* G = (const float*)(p.ws + OFF_G);
    bf16* obase = (bf16*)(p.ws + OFF_SO) + (size_t)(2 + dir) * SEG + h * 64;
    const float dskip = dir ? 0.f : p.in[I_SD][h];
    const int seq = (b * 16 + h) * 2 + dir; const float* gb = gate_base(p, 1);
    const float* BSq = gb + (size_t)seq * TT; const float* CSq = gb + (size_t)(128 + seq) * TT; const float* KFq = gb + (size_t)(256 + seq) * TT; const float* DECq = gb + (size_t)384 * TT + seq * 68;
    SLAS float* scal = (SLAS float*)(lds + L_SC);
    for (int i = tid; i < 80 * QS / 2; i += 512) ((SLAS unsigned*)(lds + L_ST0))[i] = 0u;
    f32x4 S[5];
#pragma unroll
    for (int i = 0; i < 5; ++i) S[i] = (f32x4){0.f, 0.f, 0.f, 0.f};
    const size_t rowbase = (size_t)b * TT;
    const int tg = tid >> 5, cg = tid & 31, m0 = tg * 4; const bool isb = cg >= 16; const int ch = (cg & 15) * 8;
    const bf16* bcp = XC + SEG + (rowbase + m0) * DM + (isb ? 0 : 256) + g * 128 + ch;
    const bf16* xp = XC + (rowbase + m0) * DM + h * 64 + cg * 2;
    struct Pre { Raw4 R; VRaw V; float4 kf; float bs, cs, dec; } PA, PB;
#define SSD_ISSUE(P_, cc) do { const int mc_ = chunk_of_step(dir, (cc)); const size_t to_ = (size_t)mc_ * 64; raw4_issue(bcp + to_ * DM, P_.R); v_issue(xp + to_ * DM, P_.V); \
        P_.kf = *(const float4*)(KFq + to_ + m0); P_.dec = DECq[mc_]; if (w == 0) { P_.bs = BSq[to_ + lane]; P_.cs = CSq[to_ + lane]; } } while (0)
#define SSD_STEP(P_, c_) do { const int c = (c_); const int t0 = chunk_of_step(dir, c) * 64; \
        __syncthreads(); \
        if (w == 0) { scal[lane] = P_.bs; scal[64 + lane] = P_.cs; scal[128 + lane] = __expf(P_.bs); } \
        raw4_put_rows(lds + (isb ? L_KA : L_QA), m0, ch, P_.R); \
        if (isb) raw4_put_cols(lds + L_KT, m0, ch, P_.R); \
        v_put<true>(lds, P_.V, m0, cg, P_.kf); \
        const float dec_ = P_.dec; \
        SSD_ISSUE(P_, (c + 2 < 68) ? c + 2 : 67);        \
        WFLY_FILL(); \
        __syncthreads(); \
        WFLY_DRAIN(); \
        chunk_compute<2, dir>(lds, c & 1, S, dec_, dskip, obase, b, t0, tid DPASS); } while (0)
#if defined(DIAG_SEL) && DIAG_SEL >= 10
    unsigned long long dacc[8] = {0, 0, 0, 0, 0, 0, 0, 0}; unsigned long long dlast = 0;
#endif
    SSD_ISSUE(PA, 0); SSD_ISSUE(PB, 1);
    for (int c2 = 0; c2 < 68; c2 += 2) { SSD_STEP(PA, c2); SSD_STEP(PB, c2 + 1); }
#undef SSD_STEP
#undef SSD_ISSUE
}
template <int dir> __device__ __forceinline__ void gla_unit(const Params& p, int b, int h, int vs, unsigned char* lds_, int uidx) {
    SLAS unsigned char* lds = (SLAS unsigned char*)lds_;
    const int tid = tid_op(); const int wfw = __builtin_amdgcn_readfirstlane(tid >> 6); WFly WF;
    const bf16* QA = (const bf16*)(p.ws + OFF_HC) + (size_t)(2 + dir) * SEG; const bf16* ZS = (const bf16*)(p.ws + OFF_ZS); const float* DEC = (const float*)(p.ws + OFF_RGS);
    bf16* obase = (bf16*)(p.ws + OFF_SO) + (size_t)dir * SEG + h * 256 + vs * 64;
    SLAS float* scal = (SLAS float*)(lds + L_SC);
    for (int i = tid; i < 80 * QS / 2; i += 512) ((SLAS unsigned*)(lds + L_ST0))[i] = 0u;
    f32x4 S[5];
#pragma unroll
    for (int i = 0; i < 5; ++i) S[i] = (f32x4){0.f, 0.f, 0.f, 0.f};
    const size_t rowbase = (size_t)b * TT;
    const int tg = tid >> 5, cg = tid & 31, m0 = tg * 4; const bool isk = cg >= 16; const int ch = (cg & 15) * 8;
    const bf16* qkp = QA + (rowbase + m0) * DM + (isk ? 512 : 0) + h * 128 + ch;
    const bf16* vp = ZS + SEG + (rowbase + m0) * DM + h * 256 + vs * 64 + cg * 2;
    struct Pre { Raw4 R; VRaw V; f32x4 dlo, dhi; } PA, PB;
#define GLA_ISSUE(P_, cc) do { const int mc_ = chunk_of_step(dir, (cc)); const size_t to_ = (size_t)mc_ * 64; raw4_issue(qkp + to_ * DM, P_.R); v_issue(vp + to_ * DM, P_.V); \
        const float* dp_ = DEC + ((size_t)((b * 68 + mc_) * 4 + h) * 2 + dir) * 128 + ch; P_.dlo = *(const f32x4*)dp_; P_.dhi = *(const f32x4*)(dp_ + 4); } while (0)
#define GLA_STEP(P_, c_) do { const int c = (c_); const int t0 = chunk_of_step(dir, c) * 64; \
        __syncthreads(); \
        raw4_put_rows(lds + (isk ? L_KA : L_QA), m0, ch, P_.R); \
        if (isk) { raw4_put_cols(lds + L_KT, m0, ch, P_.R); if (tg == 0) { *(SLAS f32x4*)(scal + 192 + ch) = P_.dlo; *(SLAS f32x4*)(scal + 192 + ch + 4) = P_.dhi; } }        \
        v_put<false>(lds, P_.V, m0, cg, make_float4(0.f, 0.f, 0.f, 0.f)); \
        GLA_ISSUE(P_, (c + 2 < 68) ? c + 2 : 67);        \
        WFLY_FILL(); \
        __syncthreads(); \
        WFLY_DRAIN(); \
        chunk_compute<1, dir>(lds, c & 1, S, 1.f, 0.f, obase, b, t0, tid DPASS); } while (0)
#if defined(DIAG_SEL) && DIAG_SEL >= 10
    unsigned long long dacc[8] = {0, 0, 0, 0, 0, 0, 0, 0}; unsigned long long dlast = 0;
#endif
    GLA_ISSUE(PA, 0); GLA_ISSUE(PB, 1);
    for (int c2 = 0; c2 < 68; c2 += 2) { GLA_STEP(PA, c2); GLA_STEP(PB, c2 + 1); }
#undef GLA_STEP
#undef GLA_ISSUE
}

__device__ __forceinline__ void prep_conv(const Params& p, int layer) {
    const int tid = tid_op(); const long gtid = (long)blockIdx.x * 512 + tid, gstride = (long)gridDim.x * 512;
    const bf16* ZS = (const bf16*)(p.ws + OFF_ZS); bf16* OUT = (bf16*)(p.ws + (layer == 0 ? OFF_Y : OFF_HC));
    const int ngrp = (layer == 0) ? 256 : 192;
    const long nitems = (long)(MROWS / 4) * ngrp;
    Rows7 RN;
#define PC_SRC(it_, src_, col_, b_, t0_, m0_, lo_, hi_) const int cg_ = (int)((it_) % ngrp), tg_ = (int)((it_) / ngrp), r4_ = tg_ * 4, b_ = r4_ / TT, tq_ = r4_ % TT, t0_ = tq_ & ~63, m0_ = tq_ & 63, mcq_ = t0_ >> 6; \
        const int lo_ = (mcq_ < 4) ? 0 : t0_, hi_ = (mcq_ < 4) ? NCTX : t0_ + 64; const int xc_ = cg_ * 8; \
        const int col_ = (layer == 0) ? ((cg_ < 128) ? xc_ : xc_ - 1024) : ((xc_ < 1024) ? xc_ : xc_ - 1024); \
        const bf16* src_ = (layer == 0) ? ((cg_ < 128) ? ZS : ZS + 3 * SEG) : (ZS + (size_t)(xc_ < 1024 ? 4 : 5) * SEG);
#define PC_ISSUE(it_) do { PC_SRC(it_, s_, c_, bb_, t0_, m0_, lo_, hi_) \
        _Pragma("unroll") for (int rr = 0; rr < 7; ++rr) { int tt = t0_ + m0_ + rr - 2; tt = tt < lo_ ? lo_ : (tt >= hi_ ? hi_ - 1 : tt); RN.r[rr] = *(const uint4*)(s_ + ((size_t)bb_ * TT + tt) * DM + c_); } } while (0)
    if (gtid < nitems) PC_ISSUE(gtid);
    for (long it = gtid; it < nitems; it += gstride) {
        PC_SRC(it, src, col, b, t0, m0, lo, hi)
        (void)src;
        Rows7 R;
#pragma unroll
        for (int rr = 0; rr < 7; ++rr) R.r[rr] = RN.r[rr];
        asm volatile("" : "+v"(R.r[0].x), "+v"(R.r[1].x), "+v"(R.r[2].x), "+v"(R.r[3].x), "+v"(R.r[4].x), "+v"(R.r[5].x), "+v"(R.r[6].x));
        { const long itn = (it + gstride < nitems) ? it + gstride : it; PC_ISSUE(itn); }
#pragma unroll
        for (int rr = 0; rr < 7; ++rr) { const int tt = t0 + m0 + rr - 2; if (!(tt >= lo && tt < hi)) R.r[rr] = make_uint4(0u, 0u, 0u, 0u); }
        const int cgi = (int)(it % ngrp);
        const float* cw; const float* cb; int wstride, wcol; float scale; bool act; bf16* dst;
        if (layer == 0 && cgi < 128) { cw = p.in[I_MCONVW]; cb = p.in[I_MCONVB]; wstride = 1024; wcol = col; scale = col >= 512 ? 0.08838834764831845f : 1.f; act = true; dst = OUT; }
        else if (layer == 0) { cw = p.in[I_LCONVW]; cb = p.in[I_LCONVB]; wstride = 1024; wcol = col; scale = 1.f; act = false; dst = (bf16*)(p.ws + OFF_H); }
        else { const int xc = cgi * 8; cw = p.in[I_SCONVW]; cb = p.in[I_SCONVB]; wstride = 1536; wcol = xc; scale = 1.f; act = true; dst = OUT + (size_t)(xc < 1024 ? 0 : 1) * SEG; }
        f32x4 wlo[4], whi[4];
#pragma unroll
        for (int j = 0; j < 4; ++j) { wlo[j] = *(const f32x4*)(cw + (size_t)j * wstride + wcol); whi[j] = *(const f32x4*)(cw + (size_t)j * wstride + wcol + 4); }
        const f32x4 blo = *(const f32x4*)(cb + wcol), bhi = *(const f32x4*)(cb + wcol + 4);
#pragma unroll
        for (int jj = 0; jj < 4; ++jj) { f32x4 a = blo, c = bhi;
#pragma unroll
            for (int j = 0; j < 4; ++j) { a = a + wlo[j] * bf4lo(R.r[jj + j]); c = c + whi[j] * bf4hi(R.r[jj + j]); }
            if (act) { a = silu4(a, scale); c = silu4(c, scale); }
            uint4 o; o.x = pk2(a[0], a[1]); o.y = pk2(a[2], a[3]); o.z = pk2(c[0], c[1]); o.w = pk2(c[2], c[3]);
            *(uint4*)(dst + ((size_t)b * TT + t0 + m0 + jj) * DM + col) = o; }
    }
#undef PC_ISSUE
#undef PC_SRC
}
__device__ __forceinline__ void prep_gla(const Params& p, unsigned char* lds_) {
    SLAS unsigned char* lds = (SLAS unsigned char*)lds_;
    const int tid = tid_op(), d = tid & 127, qt = tid >> 7;
    const bf16* ZS = (const bf16*)(p.ws + OFF_ZS); const float* G = (const float*)(p.ws + OFF_G); float* DEC = (float*)(p.ws + OFF_RGS);
    SLAS float* qtot = (SLAS float*)(lds + L_SC) + 512; SLAS float* GA = (SLAS float*)(lds + L_GA); SLAS bf16* E = (SLAS bf16*)(lds + L_ST0);
    const int tg = tid >> 5, cg = tid & 31, m0 = tg * 4; const bool isk = cg >= 16; const int ch = (cg & 15) * 8;
    float wg[16]; float bg = 0.f; int wkey = -1;
    Raw4 R; float4 gaq = make_float4(0.f, 0.f, 0.f, 0.f);
#define PG_FETCH(uu) do { const int dir_ = (uu) & 1, h_ = ((uu) >> 1) & 3, bm_ = (uu) >> 3; const size_t rb_ = (size_t)(bm_ / 68) * TT + (bm_ % 68) * 64; \
        if (tid < 256) gaq = *(const float4*)(G + (rb_ + (tid >> 2)) * 64 + dir_ * 16 + (tid & 3) * 4); \
        raw4_issue(ZS + (rb_ + m0) * DM + (isk ? 512 : 0) + h_ * 128 + ch, R); } while (0)
    if ((int)blockIdx.x < 2176) PG_FETCH((int)blockIdx.x);
    for (int u = blockIdx.x; u < 2176; u += gridDim.x) {
        const int dir = u & 1, h = (u >> 1) & 3, bm = u >> 3, b = bm / 68, mc = bm % 68; const size_t rowbase = (size_t)b * TT + mc * 64;
        if ((u & 7) != wkey) { wkey = u & 7;
#pragma unroll
            for (int j = 0; j < 16; ++j) wg[j] = p.in[I_GALW][(size_t)(dir * 16 + j) * 512 + h * 128 + d];
            bg = p.in[I_GALB][dir * 512 + h * 128 + d]; }
        __syncthreads();
        if (tid < 256) *(SLAS f32x4*)(GA + (tid >> 2) * 16 + (tid & 3) * 4) = (f32x4){gaq.x, gaq.y, gaq.z, gaq.w};
        const Raw4 Rc = R;
        __syncthreads();
        PG_FETCH((u + (int)gridDim.x < 2176) ? u + (int)gridDim.x : u);
        f32x4 loc[4]; float run = 0.f;
#pragma unroll
        for (int i2 = 0; i2 < 16; ++i2) { const int ii = dir ? 15 - i2 : i2; const SLAS float* ga = GA + (qt * 16 + ii) * 16;
            float pre = bg;
#pragma unroll
            for (int j4 = 0; j4 < 4; ++j4) { const f32x4 a = *(const SLAS f32x4*)(ga + 4 * j4); pre += a[0] * wg[4 * j4] + a[1] * wg[4 * j4 + 1] + a[2] * wg[4 * j4 + 2] + a[3] * wg[4 * j4 + 3]; }
            run -= softplus_fast(-pre) * (1.f / 16.f); loc[ii >> 2][ii & 3] = run; }
        qtot[qt * 128 + d] = run;
        __syncthreads();
        float off = 0.f, tot = 0.f;
#pragma unroll
        for (int q2 = 0; q2 < 4; ++q2) { const float tq = qtot[q2 * 128 + d]; if (dir ? (q2 > qt) : (q2 < qt)) off += tq; tot += tq; }
        if (qt == 0) DEC[((size_t)((b * 68 + mc) * 4 + h) * 2 + dir) * 128 + d] = __expf(tot);
#pragma unroll
        for (int ii = 0; ii < 16; ++ii) E[(qt * 16 + ii) * QS + d] = (bf16)f2bf(__expf(off + loc[ii >> 2][ii & 3]));
        __syncthreads();
        bf16* dst = (bf16*)(p.ws + OFF_HC) + (size_t)(2 + dir) * SEG + (rowbase + m0) * DM + (isk ? 512 : 0) + h * 128 + ch;
#pragma unroll
        for (int jj = 0; jj < 4; ++jj) { const u32x4 ev = *(const SLAS u32x4*)((const SLAS unsigned char*)E + (size_t)((m0 + jj) * QS + ch) * 2);
            const uint4 e4 = make_uint4(ev.x, ev.y, ev.z, ev.w); const f32x4 elo = bf4lo(e4), ehi = bf4hi(e4), xlo = bf4lo(Rc.r[jj]), xhi = bf4hi(Rc.r[jj]); f32x4 alo, ahi;
            if (!isk) { alo = xlo * elo * 0.08838834764831845f; ahi = xhi * ehi * 0.08838834764831845f; }
            else {
#pragma unroll
                for (int e = 0; e < 4; ++e) { alo[e] = xlo[e] * __builtin_amdgcn_rcpf(elo[e]); ahi[e] = xhi[e] * __builtin_amdgcn_rcpf(ehi[e]); } }
            uint4 o; o.x = pk2(alo[0], alo[1]); o.y = pk2(alo[2], alo[3]); o.z = pk2(ahi[0], ahi[1]); o.w = pk2(ahi[2], ahi[3]);
            *(uint4*)(dst + (size_t)jj * DM) = o; }
    }
#undef PG_FETCH
}
}

namespace rg {
using sc::bf16x8; using sc::f32x4; using sc::u32x4; using sc::mfma; using sc::ldfrag; using sc::QS;
constexpr int L_XL = 0, L_OUT = 64 * QS * 2, OS = 132;
template <int PHASE>
__device__ __forceinline__ void rglru_units(const Params& p, int u0, int ustride, unsigned char* lds_) {
    SLAS unsigned char* lds = (SLAS unsigned char*)lds_;
    const int tid = tid_op(), lane = tid & 63, w = tid >> 6, r = lane & 15, q = lane >> 4;
    const int blk = u0 & 7, ch = blk * 128 + w * 16 + r;
    const bf16* ZS = (const bf16*)(p.ws + OFF_ZS); const bf16* WT = (const bf16*)(p.ws + OFF_W_RG);
    float2* RGS = (float2*)(p.ws + OFF_RGS); bf16* HC = (bf16*)(p.ws + OFF_HC);
    bf16x8 bw[4][4];
#pragma unroll
    for (int mm = 0; mm < 4; ++mm)
#pragma unroll
        for (int ks = 0; ks < 4; ++ks) bw[mm][ks] = *(const bf16x8*)(WT + ((size_t)((mm & 1) * 16 + (mm >> 1) * 8 + blk) * 128 + (w * 16 + r)) * 128 + ks * 32 + 8 * q);
    float ba[2], bx[2], sp[2];
#pragma unroll
    for (int dd = 0; dd < 2; ++dd) { ba[dd] = p.in[I_LBA][dd * 1024 + ch]; bx[dd] = p.in[I_LBX][dd * 1024 + ch]; sp[dd] = -8.f * softplus_f(-p.in[I_LLAM][dd * 1024 + ch]); }
    const bf16* XLC = (const bf16*)(p.ws + OFF_H);
    uint4 xr[2];
#define RG_FETCH(uu) do { const int bm_ = (uu) >> 3; const size_t rb_ = (size_t)(bm_ / 68) * TT + (bm_ % 68) * 64; \
        _Pragma("unroll") for (int rep = 0; rep < 2; ++rep) { const int idx = tid + rep * 512; xr[rep] = *(const uint4*)(XLC + (rb_ + (idx >> 4)) * DM + blk * 128 + (idx & 15) * 8); } } while (0)
    if (u0 < 2176) RG_FETCH(u0);
    for (int u = u0; u < 2176; u += ustride) {
        const int bm = u >> 3, b = bm / 68, mc = bm % 68, t0 = mc * 64;
        const size_t rowbase = (size_t)b * TT;
        __syncthreads();
#pragma unroll
        for (int rep = 0; rep < 2; ++rep) { const int idx = tid + rep * 512; const sc::u32x4 o4 = {xr[rep].x, xr[rep].y, xr[rep].z, xr[rep].w}; *(SLAS sc::u32x4*)(lds + L_XL + (size_t)((idx >> 4) * QS + (idx & 15) * 8) * 2) = o4; }
        if (u + ustride < 2176) RG_FETCH(u + ustride);
        float cin0 = 0.f, cin1 = 0.f;
        if (PHASE == 1) {
#pragma unroll
            for (int dd = 0; dd < 2; ++dd) {
                const int n = dd ? ((mc < 4) ? 3 - mc : 71 - mc) : mc, per = (n + 3) >> 2, lo_q = min(q * per, n), hi_q = min(lo_q + per, n);
                float A = 1.f, B = 0.f;
#pragma unroll 4
                for (int cp = lo_q; cp < hi_q; ++cp) { const int mcp = dd ? sc::chunk_of_step(1, cp) : cp; const float2 ab = RGS[((size_t)(b * 68 + mcp) * 2 + dd) * 1024 + ch]; B = ab.x * B + ab.y; A = ab.x * A; }
                float carry = 0.f;
#pragma unroll
                for (int qq = 0; qq < 4; ++qq) { const float Aq = __shfl(A, r + 16 * qq), Bq = __shfl(B, r + 16 * qq); carry = Aq * carry + Bq; }
                if (dd) cin1 = carry; else cin0 = carry; }
        }
        __syncthreads();
        f32x4 av[2][4], bv[2][4];
#pragma unroll
        for (int tb = 0; tb < 4; ++tb) {
            bf16x8 af[4];
#pragma unroll
            for (int ks = 0; ks < 4; ++ks) af[ks] = ldfrag(lds + L_XL, tb * 16 + r, QS, ks * 32 + 8 * q);
            f32x4 acc[4];
#pragma unroll
            for (int mm = 0; mm < 4; ++mm) { acc[mm] = (f32x4){0.f, 0.f, 0.f, 0.f};
#pragma unroll
                for (int ks = 0; ks < 4; ++ks) acc[mm] = mfma(af[ks], bw[mm][ks], acc[mm]); }
            f32x4 xl4;
#pragma unroll
            for (int j = 0; j < 4; ++j) xl4[j] = bf2f(((const SLAS bf16*)(lds + L_XL))[(tb * 16 + 4 * q + j) * QS + w * 16 + r]);
#pragma unroll
            for (int dd = 0; dd < 2; ++dd) { f32x4 a4, b4;
#pragma unroll
                for (int j = 0; j < 4; ++j) { const float rr = sc::sigmoid_fast(acc[dd * 2][j] + ba[dd]), ii = sc::sigmoid_fast(acc[dd * 2 + 1][j] + bx[dd]);
                    const float a = __expf(rr * sp[dd]); a4[j] = a; b4[j] = sqrtf(fmaxf(1.f - a * a, 0.f)) * (ii * xl4[j]); }
                av[dd][tb] = a4; bv[dd][tb] = b4; }
        }
        SLAS float* OUT = (SLAS float*)(lds + L_OUT);
        { float carry = cin0, aprod = 1.f;
#pragma unroll
          for (int tb = 0; tb < 4; ++tb) {
              const f32x4 A = av[0][tb], B = bv[0][tb]; f32x4 hl, ac;
              hl[0] = B[0]; ac[0] = A[0];
#pragma unroll
              for (int j = 1; j < 4; ++j) { hl[j] = A[j] * hl[j - 1] + B[j]; ac[j] = A[j] * ac[j - 1]; }
              float Ae = 1.f, Be = 0.f, At = 1.f, Bt = 0.f;
#pragma unroll
              for (int qq = 0; qq < 4; ++qq) { const float Aq = __shfl(ac[3], r + 16 * qq), Bq = __shfl(hl[3], r + 16 * qq);
                  if (qq < q) { Be = Aq * Be + Bq; Ae = Aq * Ae; }
                  Bt = Aq * Bt + Bq; At = Aq * At; }
              const float hin = Ae * carry + Be;
              { const f32x4 ov = ac * hin + hl, cv = ac * (Ae * aprod);
#pragma unroll
                for (int j = 0; j < 4; ++j) { const int oi = (tb * 16 + 4 * q + j) * OS + w * 16 + r; OUT[oi] = ov[j]; OUT[8448 + oi] = cv[j]; } }
              carry = At * carry + Bt; aprod *= At; }
          if (PHASE == 0 && q == 0) RGS[((size_t)(b * 68 + mc) * 2 + 0) * 1024 + ch] = make_float2(aprod, carry); }
        { float carry = cin1, aprod = 1.f;
#pragma unroll
          for (int tb = 3; tb >= 0; --tb) {
              const f32x4 A = av[1][tb], B = bv[1][tb]; f32x4 hl, ac;
              hl[3] = B[3]; ac[3] = A[3];
#pragma unroll
              for (int j = 2; j >= 0; --j) { hl[j] = A[j] * hl[j + 1] + B[j]; ac[j] = A[j] * ac[j + 1]; }
              float Ae = 1.f, Be = 0.f, At = 1.f, Bt = 0.f;
#pragma unroll
              for (int qq = 3; qq >= 0; --qq) { const float Aq = __shfl(ac[0], r + 16 * qq), Bq = __shfl(hl[0], r + 16 * qq);
                  if (qq > q) { Be = Aq * Be + Bq; Ae = Aq * Ae; }
                  Bt = Aq * Bt + Bq; At = Aq * At; }
              const float hin = Ae * carry + Be;
              { const f32x4 ov = ac * hin + hl, cv = ac * (Ae * aprod);
#pragma unroll
                for (int j = 0; j < 4; ++j) { const int oi = (tb * 16 + 4 * q + j) * OS + w * 16 + r; OUT[oi] += ov[j]; OUT[16896 + oi] = cv[j]; } }
              carry = At * carry + Bt; aprod *= At; }
          if (PHASE == 0 && q == 0) RGS[((size_t)(b * 68 + mc) * 2 + 1) * 1024 + ch] = make_float2(aprod, carry); }
        if (PHASE == 0) {
            __syncthreads();
            bf16* T0 = (bf16*)(p.ws + OFF_SO) + 2 * SEG; bf16* T1 = (bf16*)(p.ws + OFF_SO) + 3 * SEG; bf16* T2 = (bf16*)(p.ws + OFF_Y) + SEG;
#pragma unroll
            for (int rep = 0; rep < 2; ++rep) { const int idx = tid + rep * 512, t = idx >> 4, cc = idx & 15; const size_t off = (rowbase + t0 + t) * DM + blk * 128 + cc * 8;
#pragma unroll
                for (int k3 = 0; k3 < 3; ++k3) { const f32x4 x0 = *(const SLAS f32x4*)(OUT + k3 * 8448 + t * OS + cc * 8), x1 = *(const SLAS f32x4*)(OUT + k3 * 8448 + t * OS + cc * 8 + 4);
                    uint4 ov; ov.x = sc::pk2(x0[0], x0[1]); ov.y = sc::pk2(x0[2], x0[3]); ov.z = sc::pk2(x1[0], x1[1]); ov.w = sc::pk2(x1[2], x1[3]);
                    *(uint4*)((k3 == 0 ? T0 : (k3 == 1 ? T1 : T2)) + off) = ov; } }
        }
    }
}
constexpr int RGF_SPLIT = 128 * 6;
__device__ __forceinline__ void rglru_finish(const Params& p, int u0, int ustride, unsigned char* lds_, int ubegin, int uend) {
    SLAS unsigned char* lds = (SLAS unsigned char*)lds_;
    const int tid = tid_op(), c = tid & 127, part = tid >> 7, blk = u0 & 7, ch = blk * 128 + c;
    const bf16* ZS = (const bf16*)(p.ws + OFF_ZS); const float2* RGS = (const float2*)(p.ws + OFF_RGS); bf16* HC = (bf16*)(p.ws + OFF_HC);
    const bf16* T0 = (const bf16*)(p.ws + OFF_SO) + 2 * SEG; const bf16* T1 = (const bf16*)(p.ws + OFF_SO) + 3 * SEG; const bf16* T2 = (const bf16*)(p.ws + OFF_Y) + SEG;
    SLAS float* FA = (SLAS float*)lds; SLAS float* CR = FA + 2048;
    uint4 rxs[2], rx0[2], rx1[2], rxg[2];
#define RGF_ISSUE(u_) do { const int bm_ = (u_) >> 3, b_ = bm_ / 68, mc_ = bm_ % 68; \
        _Pragma("unroll") for (int rep = 0; rep < 2; ++rep) { const int idx = tid + rep * 512, t = idx >> 4, cc = idx & 15; const size_t off = ((size_t)b_ * TT + mc_ * 64 + t) * DM + blk * 128 + cc * 8; \
            rxs[rep] = *(const uint4*)(T0 + off); rx0[rep] = *(const uint4*)(T1 + off); rx1[rep] = *(const uint4*)(T2 + off); rxg[rep] = *(const uint4*)(ZS + 4 * SEG + off); } } while (0)
    if (ubegin + u0 < uend) RGF_ISSUE(ubegin + u0);
    for (int u = ubegin + u0; u < uend; u += ustride) {
        const int bm = u >> 3, b = bm / 68, mc = bm % 68, t0 = mc * 64; const size_t rowbase = (size_t)b * TT;
        uint4 xs[2], x0[2], x1[2], xg[2];
#pragma unroll
        for (int rep = 0; rep < 2; ++rep) { xs[rep] = rxs[rep]; x0[rep] = rx0[rep]; x1[rep] = rx1[rep]; xg[rep] = rxg[rep]; }
        asm volatile("" : "+v"(xs[0].x), "+v"(xs[1].x), "+v"(x0[0].x), "+v"(x0[1].x), "+v"(x1[0].x), "+v"(x1[1].x), "+v"(xg[0].x), "+v"(xg[1].x));
        { const int un = (u + ustride < uend) ? u + ustride : u; RGF_ISSUE(un); }
        __syncthreads();
#pragma unroll
        for (int dd = 0; dd < 2; ++dd) {
            const int n = dd ? ((mc < 4) ? 3 - mc : 71 - mc) : mc, per = (n + 3) >> 2, lo_q = min(part * per, n), hi_q = min(lo_q + per, n);
            float A = 1.f, B = 0.f;
            float2 abv[17];
#pragma unroll
            for (int k = 0; k < 17; ++k) { int cp = lo_q + k; cp = cp < 67 ? cp : 67; const int mcp = dd ? sc::chunk_of_step(1, cp) : cp; abv[k] = RGS[((size_t)(b * 68 + mcp) * 2 + dd) * 1024 + ch]; }
#pragma unroll
            for (int k = 0; k < 17; ++k) { if (lo_q + k < hi_q) { B = abv[k].x * B + abv[k].y; A = abv[k].x * A; } }
            FA[((dd * 4 + part) * 128 + c) * 2] = A; FA[((dd * 4 + part) * 128 + c) * 2 + 1] = B; }
        __syncthreads();
        if (tid < 256) { const int dd = tid >> 7; float carry = 0.f;
#pragma unroll
            for (int pp = 0; pp < 4; ++pp) carry = FA[((dd * 4 + pp) * 128 + c) * 2] * carry + FA[((dd * 4 + pp) * 128 + c) * 2 + 1];
            CR[dd * 128 + c] = carry; }
        __syncthreads();
#pragma unroll
        for (int rep = 0; rep < 2; ++rep) { const int idx = tid + rep * 512, t = idx >> 4, cc = idx & 15; const size_t row = rowbase + t0 + t;
            const f32x4 k0l = *(const SLAS f32x4*)(CR + cc * 8), k0h = *(const SLAS f32x4*)(CR + cc * 8 + 4), k1l = *(const SLAS f32x4*)(CR + 128 + cc * 8), k1h = *(const SLAS f32x4*)(CR + 128 + cc * 8 + 4);
            const f32x4 hl = sc::bf4lo(xs[rep]) + sc::bf4lo(x0[rep]) * k0l + sc::bf4lo(x1[rep]) * k1l, hh = sc::bf4hi(xs[rep]) + sc::bf4hi(x0[rep]) * k0h + sc::bf4hi(x1[rep]) * k1h;
            const f32x4 gl = sc::bf4lo(xg[rep]), gh = sc::bf4hi(xg[rep]);
            uint4 ov; ov.x = sc::pk2(hl[0] * gelu_fast(gl[0]), hl[1] * gelu_fast(gl[1])); ov.y = sc::pk2(hl[2] * gelu_fast(gl[2]), hl[3] * gelu_fast(gl[3]));
            ov.z = sc::pk2(hh[0] * gelu_fast(gh[0]), hh[1] * gelu_fast(gh[1])); ov.w = sc::pk2(hh[2] * gelu_fast(gh[2]), hh[3] * gelu_fast(gh[3]));
            *(uint4*)(HC + row * 2048 + 1024 + blk * 128 + cc * 8) = ov; }
    }
}
#undef RGF_ISSUE
}

__device__ __forceinline__ void sub_barrier(unsigned* cnt, unsigned n) {
    asm volatile("s_waitcnt vmcnt(0)" ::: "memory");
    __syncthreads();
    if (threadIdx.x == 0) {
        __builtin_amdgcn_fence(__ATOMIC_RELEASE, "agent");
        asm volatile("s_waitcnt vmcnt(0)" ::: "memory");
        __hip_atomic_fetch_add(cnt, 1u, __ATOMIC_RELAXED, __HIP_MEMORY_SCOPE_AGENT);
        unsigned sp = 0;
        while (__hip_atomic_load(cnt, __ATOMIC_RELAXED, __HIP_MEMORY_SCOPE_AGENT) < n) { __builtin_amdgcn_s_sleep(2); if (++sp > (1u << 24)) break; }
        __builtin_amdgcn_fence(__ATOMIC_ACQUIRE, "agent");
        asm volatile("s_waitcnt vmcnt(0)" ::: "memory");
    }
    __syncthreads();
}
__device__ __forceinline__ void phase_scan(const Params& p, int layer, float* sm) {
#ifdef DIAG_SEL
    const unsigned long long dg_t0 = __builtin_amdgcn_s_memrealtime();
#endif
    if (layer == 0) {
        if (gridDim.x == 256) {
            const int u = blockIdx.x;
            if (u < 128) { if ((u >> 2) & 1) sc::mlstm_unit<1>(p, u >> 5, (u >> 3) & 3, u & 3, (unsigned char*)sm, u); else sc::mlstm_unit<0>(p, u >> 5, (u >> 3) & 3, u & 3, (unsigned char*)sm, u); }
            else { rg::rglru_units<0>(p, u - 128, 128, (unsigned char*)sm);
                   sub_barrier((unsigned*)(p.ws + OFF_CTL + 2048), 128u); rg::rglru_finish(p, u - 128, 128, (unsigned char*)sm, 0, rg::RGF_SPLIT); }
        } else {
            for (int u = blockIdx.x; u < 128; u += gridDim.x) { if ((u >> 2) & 1) sc::mlstm_unit<1>(p, u >> 5, (u >> 3) & 3, u & 3, (unsigned char*)sm, u); else sc::mlstm_unit<0>(p, u >> 5, (u >> 3) & 3, u & 3, (unsigned char*)sm, u); __syncthreads(); }
            if ((gridDim.x & 7) == 0) rg::rglru_units<0>(p, blockIdx.x, gridDim.x, (unsigned char*)sm); else if (blockIdx.x < 8) rg::rglru_units<0>(p, blockIdx.x, 8, (unsigned char*)sm);
        }
    } else {
        for (int u = blockIdx.x; u < 256; u += gridDim.x) {
            if (u < 128) { if ((u >> 2) & 1) sc::gla_unit<1>(p, u >> 5, (u >> 3) & 3, u & 3, (unsigned char*)sm, u); else sc::gla_unit<0>(p, u >> 5, (u >> 3) & 3, u & 3, (unsigned char*)sm, u); }
            else { const int w = u - 128; if (w & 1) sc::ssd_unit<1>(p, w >> 5, (w >> 1) & 15, (unsigned char*)sm, u); else sc::ssd_unit<0>(p, w >> 5, (w >> 1) & 15, (unsigned char*)sm, u); }
            __syncthreads();
        }
    }
#ifdef DIAG_SEL
    if (threadIdx.x == 0) { const unsigned long long dt_ = __builtin_amdgcn_s_memrealtime() - dg_t0; unsigned long long* dg = (unsigned long long*)(p.ws + OFF_CTL + 98304);
        if (layer == 0 && blockIdx.x == 0) dg[1] = dt_; if (layer == 0 && blockIdx.x == 128) dg[2] = dt_; if (layer == 1 && blockIdx.x == 0) dg[3] = dt_; if (layer == 1 && blockIdx.x == 128) dg[4] = dt_;
        if (layer == 0 && blockIdx.x == 4) dg[5] = dt_; if (layer == 1 && blockIdx.x == 4) dg[6] = dt_; }
#endif
}

__device__ __forceinline__ float sigmoid_fast_(float x) { return __builtin_amdgcn_rcpf(1.f + __expf(-x)); }
__device__ __forceinline__ void ld16_bf16(const bf16* row, int lane, float (&v)[16]) {
#pragma unroll
    for (int c = 0; c < 2; ++c) { const uint4 t = *(const uint4*)(row + c * 512 + lane * 8);
        v[8 * c + 0] = bf2f(t.x & 0xffffu); v[8 * c + 1] = bf2f(t.x >> 16); v[8 * c + 2] = bf2f(t.y & 0xffffu); v[8 * c + 3] = bf2f(t.y >> 16);
        v[8 * c + 4] = bf2f(t.z & 0xffffu); v[8 * c + 5] = bf2f(t.z >> 16); v[8 * c + 6] = bf2f(t.w & 0xffffu); v[8 * c + 7] = bf2f(t.w >> 16); }
}
__device__ __forceinline__ void ld16_f32(const float* row, int lane, float (&v)[16]) {
#pragma unroll
    for (int c = 0; c < 2; ++c) { const float4 t0 = *(const float4*)(row + c * 512 + lane * 8), t1 = *(const float4*)(row + c * 512 + lane * 8 + 4);
        v[8 * c + 0] = t0.x; v[8 * c + 1] = t0.y; v[8 * c + 2] = t0.z; v[8 * c + 3] = t0.w; v[8 * c + 4] = t1.x; v[8 * c + 5] = t1.y; v[8 * c + 6] = t1.z; v[8 * c + 7] = t1.w; }
}
__device__ __forceinline__ void st16_bf16(bf16* row, int lane, const float (&v)[16]) {
#pragma unroll
    for (int c = 0; c < 2; ++c) { uint4 t; t.x = f2bf(v[8 * c]) | (f2bf(v[8 * c + 1]) << 16); t.y = f2bf(v[8 * c + 2]) | (f2bf(v[8 * c + 3]) << 16); t.z = f2bf(v[8 * c + 4]) | (f2bf(v[8 * c + 5]) << 16); t.w = f2bf(v[8 * c + 6]) | (f2bf(v[8 * c + 7]) << 16);
        *(uint4*)(row + c * 512 + lane * 8) = t; }
}
__device__ __forceinline__ float half_sum(float v) {
#pragma unroll
    for (int o = 16; o >= 1; o >>= 1) v += __shfl_xor(v, o);
    return v;
}
__device__ __forceinline__ void phase_mix2(const Params& p, int layer, float* sm) {
    if (layer == 0) { if (gridDim.x == 256) rg::rglru_finish(p, blockIdx.x, 256, (unsigned char*)sm, rg::RGF_SPLIT, 2176); else if ((gridDim.x & 7) == 0) rg::rglru_finish(p, blockIdx.x, gridDim.x, (unsigned char*)sm, 0, 2176); else if (blockIdx.x < 8) rg::rglru_finish(p, blockIdx.x, 8, (unsigned char*)sm, 0, 2176); }
    const int tid_ = tid_op(); const int lane = tid_ & 63, gw = blockIdx.x * 8 + (tid_ >> 6), NGW = gridDim.x * 8;
    const bf16* ZS = (const bf16*)(p.ws + OFF_ZS); const bf16* SO = (const bf16*)(p.ws + OFF_SO); bf16* HC = (bf16*)(p.ws + OFF_HC);
    const int nparts = layer == 0 ? 1 : 2;
    uint4 R[6][2];
#define MX_ISSUE(pr_, part_) do { const size_t r_ = (size_t)2 * (pr_); const bf16* A_ = SO + (size_t)((part_) ? 2 : 0) * SEG + r_ * DM; const bf16* C_ = SO + (size_t)((part_) ? 3 : 1) * SEG + r_ * DM; const bf16* G_ = ZS + (size_t)((part_) ? 3 : 2) * SEG + r_ * DM; \
        _Pragma("unroll") for (int c_ = 0; c_ < 2; ++c_) { R[0][c_] = *(const uint4*)(A_ + c_ * 512 + lane * 8); R[1][c_] = *(const uint4*)(C_ + c_ * 512 + lane * 8); R[2][c_] = *(const uint4*)(G_ + c_ * 512 + lane * 8); \
            R[3][c_] = *(const uint4*)(A_ + DM + c_ * 512 + lane * 8); R[4][c_] = *(const uint4*)(C_ + DM + c_ * 512 + lane * 8); R[5][c_] = *(const uint4*)(G_ + DM + c_ * 512 + lane * 8); } } while (0)
#define MX_UNPACK(dst_, row_) do { _Pragma("unroll") for (int c_ = 0; c_ < 2; ++c_) { const uint4 t_ = Cc[row_][c_]; \
        dst_[8 * c_ + 0] = bf2f(t_.x & 0xffffu); dst_[8 * c_ + 1] = bf2f(t_.x >> 16); dst_[8 * c_ + 2] = bf2f(t_.y & 0xffffu); dst_[8 * c_ + 3] = bf2f(t_.y >> 16); \
        dst_[8 * c_ + 4] = bf2f(t_.z & 0xffffu); dst_[8 * c_ + 5] = bf2f(t_.z >> 16); dst_[8 * c_ + 6] = bf2f(t_.w & 0xffffu); dst_[8 * c_ + 7] = bf2f(t_.w >> 16); } } while (0)
    float wK0[16], wK1[16];
    ld16_f32(layer == 0 ? p.in[I_MNORMW] : p.in[I_GNORMW], lane, wK0); ld16_f32(p.in[I_SNORMW], lane, wK1);
    if (gw < MROWS / 2) MX_ISSUE(gw, 0);
    for (int pr = gw; pr < MROWS / 2; pr += NGW) {
        const size_t r = (size_t)2 * pr;
        for (int part = 0; part < nparts; ++part) {
            uint4 Cc[6][2];
#pragma unroll
            for (int i = 0; i < 6; ++i) { Cc[i][0] = R[i][0]; Cc[i][1] = R[i][1]; }
            asm volatile("" : "+v"(Cc[0][0].x), "+v"(Cc[0][1].x), "+v"(Cc[1][0].x), "+v"(Cc[1][1].x), "+v"(Cc[2][0].x), "+v"(Cc[2][1].x), "+v"(Cc[3][0].x), "+v"(Cc[3][1].x), "+v"(Cc[4][0].x), "+v"(Cc[4][1].x), "+v"(Cc[5][0].x), "+v"(Cc[5][1].x));
            { int npr = pr, npt = part + 1; if (npt == nparts) { npt = 0; npr = pr + NGW; if (npr >= MROWS / 2) { npr = pr; npt = part; } } MX_ISSUE(npr, npt); }
            float a0[16], c0[16], g0[16], a1[16], c1[16], g1[16], w[16];
            MX_UNPACK(a0, 0); MX_UNPACK(c0, 1); MX_UNPACK(g0, 2); MX_UNPACK(a1, 3); MX_UNPACK(c1, 4); MX_UNPACK(g1, 5);
            if (part == 0) {
#pragma unroll
                for (int i = 0; i < 16; ++i) w[i] = wK0[i];
#pragma unroll
                for (int c = 0; c < 2; ++c) {
                    float ss0 = 0.f, ss1 = 0.f;
#pragma unroll
                    for (int i = 0; i < 8; ++i) { a0[8 * c + i] += c0[8 * c + i]; ss0 += a0[8 * c + i] * a0[8 * c + i]; a1[8 * c + i] += c1[8 * c + i]; ss1 += a1[8 * c + i] * a1[8 * c + i]; }
                    const float r0 = __builtin_amdgcn_rsqf(half_sum(ss0) * (1.f / 256.f) + 1e-6f), r1 = __builtin_amdgcn_rsqf(half_sum(ss1) * (1.f / 256.f) + 1e-6f);
#pragma unroll
                    for (int i = 0; i < 8; ++i) { const float q0 = g0[8 * c + i], q1 = g1[8 * c + i]; const float s0 = sigmoid_fast_(q0), s1 = sigmoid_fast_(q1);
                        a0[8 * c + i] = a0[8 * c + i] * r0 * w[8 * c + i] * (layer == 0 ? s0 : q0 * s0); a1[8 * c + i] = a1[8 * c + i] * r1 * w[8 * c + i] * (layer == 0 ? s1 : q1 * s1); }
                }
                st16_bf16(HC + r * 2048, lane, a0); st16_bf16(HC + (r + 1) * 2048, lane, a1);
            } else {
#pragma unroll
                for (int i = 0; i < 16; ++i) w[i] = wK1[i];
#pragma unroll
                for (int i = 0; i < 16; ++i) { a0[i] = (a0[i] + c0[i]) * (g0[i] * sigmoid_fast_(g0[i])); a1[i] = (a1[i] + c1[i]) * (g1[i] * sigmoid_fast_(g1[i])); }
                const float r0 = rstd_of(row_ss(a0)), r1 = rstd_of(row_ss(a1));
#pragma unroll
                for (int i = 0; i < 16; ++i) { a0[i] = a0[i] * r0 * w[i]; a1[i] = a1[i] * r1 * w[i]; }
                st16_bf16(HC + r * 2048 + 1024, lane, a0); st16_bf16(HC + (r + 1) * 2048 + 1024, lane, a1);
            }
        }
    }
#undef MX_ISSUE
#undef MX_UNPACK
}

__device__ __forceinline__ void phase_route_gather(const Params& p, float* sm) {
    int* bc = (int*)sm;
    int* base = bc + 2048; int* myoff = base + 16; int* woff = myoff + 8; int* cur = woff + 64;
    const int tid = tid_op(), lane = tid & 63, wave = tid >> 6, G = gridDim.x;
    const int* BCNT = (const int*)(p.ws + OFF_STOK); int* ctl = (int*)(p.ws + OFF_CTL);
    for (int i = tid; i < G * 8; i += 512) { const int g = i >> 3, e = i & 7; int sacc = 0;
#pragma unroll
        for (int w = 0; w < 8; ++w) sacc += BCNT[(g * 8 + w) * 8 + e];
        bc[i] = sacc; }
    if (tid < 64) { const int w = tid >> 3, e = tid & 7; int sacc = 0; for (int w2 = 0; w2 < w; ++w2) sacc += BCNT[((int)blockIdx.x * 8 + w2) * 8 + e]; woff[tid] = sacc; cur[tid] = 0; }
    __syncthreads();
    if (tid < 8) { int tot = 0, mine = 0; for (int g = 0; g < G; ++g) { if (g == (int)blockIdx.x) mine = tot; tot += bc[g * 8 + tid]; } myoff[tid] = mine; base[8 + tid] = tot; }
    __syncthreads();
    if (tid == 0) { int acc = 0; for (int e = 0; e < 8; ++e) { base[e] = acc; acc += (base[8 + e] + 255) / 256 * 256; }
        if (blockIdx.x == 0) { for (int e = 0; e < 8; ++e) { ctl[CW_CNT + e] = base[8 + e]; ctl[CW_BASE + e] = base[e]; } ctl[CW_BASE + 8] = acc; ctl[CW_TOT] = acc; } }
    __syncthreads();
    const int* TOPI = (const int*)(p.ws + OFF_TOPI); int* SLOT = (int*)(p.ws + OFF_SLOT);
    const unsigned char* H8 = p.ws + OFF_H; unsigned char* XS8 = p.ws + OFF_XS;
    const int gw = blockIdx.x * 8 + wave, NGW = G * 8;
    if (wave < 8) { const int e = wave, c0 = base[e] + base[8 + e], c1 = base[e] + (base[8 + e] + 255) / 256 * 256;
        for (int row = c0 + (int)blockIdx.x; row < c1; row += G) ((uint4*)(XS8 + (size_t)row * DM))[lane] = make_uint4(0u, 0u, 0u, 0u); }
    for (int pr = gw; pr < MROWS / 2; pr += NGW) {
        const int r = 2 * pr, b = r / TT, t = r % TT; if (t < NCTX) continue;
        const int tok = b * SEQ + (t - NCTX);
        int sl = 0, e = -1;
        if (lane < 4) e = TOPI[tok * 2 + lane];
        const int e0 = __shfl(e, 0), e1 = __shfl(e, 1), e2 = __shfl(e, 2);
        if (lane < 4) { const int rank = ((lane > 0 && e0 == e) ? 1 : 0) + ((lane > 1 && e1 == e) ? 1 : 0) + ((lane > 2 && e2 == e) ? 1 : 0);
            const int before = cur[wave * 8 + e]; sl = base[e] + myoff[e] + woff[wave * 8 + e] + before + rank; SLOT[tok * 2 + lane] = sl; }
        __builtin_amdgcn_wave_barrier();
        if (lane < 4) atomicAdd(&cur[wave * 8 + e], 1);
        __builtin_amdgcn_wave_barrier();
        const int s0 = __shfl(sl, 0), s1 = __shfl(sl, 1), s2 = __shfl(sl, 2), s3 = __shfl(sl, 3);
        const uint4 va = ((const uint4*)(H8 + (size_t)r * DM))[lane], vb = ((const uint4*)(H8 + (size_t)(r + 1) * DM))[lane];
        ((uint4*)(XS8 + (size_t)s0 * DM))[lane] = va; ((uint4*)(XS8 + (size_t)s1 * DM))[lane] = va;
        ((uint4*)(XS8 + (size_t)s2 * DM))[lane] = vb; ((uint4*)(XS8 + (size_t)s3 * DM))[lane] = vb;
    }
}

#define XB_TMO      128
#define XB_XCNT(j)  (256  + 64 * (j))
#define XB_XSUB(j)  (1280 + 64 * (j))
#define XB_XGEN(j)  (2304 + 64 * (j))
#define XB_TOP      3328
#define XB_TOPGEN   3392
#define XCD_BAR_WORDS 3456
#define XB_SPIN_CAP (1u << 22)
__device__ __forceinline__ unsigned xb_ld(unsigned* p)              { return __hip_atomic_load(p, __ATOMIC_RELAXED, __HIP_MEMORY_SCOPE_AGENT); }
__device__ __forceinline__ unsigned xb_add(unsigned* p, unsigned v) { return __hip_atomic_fetch_add(p, v, __ATOMIC_RELAXED, __HIP_MEMORY_SCOPE_AGENT); }
__device__ __forceinline__ unsigned xb_xcc_id() { return (unsigned)__builtin_amdgcn_s_getreg((3 << 11) | 20) & 0xFu; }
#define XB_SPIN(cond, bar) do { unsigned _sp = 0; while (cond) { __builtin_amdgcn_s_sleep(1); \
    if ((++_sp & 255u) == 0u) { if (xb_ld(&(bar)[XB_TMO])) break; if (_sp > XB_SPIN_CAP) { atomicAdd(&(bar)[XB_TMO], 1u); break; } } } } while (0)
struct XcdBarrier { unsigned* bar; unsigned x; volatile __attribute__((address_space(3))) unsigned* st; };
__device__ __forceinline__ XcdBarrier xcd_barrier_post(unsigned* bar, volatile __attribute__((address_space(3))) unsigned* st) {
    XcdBarrier b; b.bar = bar; b.x = xb_xcc_id(); b.st = st;
    if (threadIdx.x == 0) (void)xb_add(&bar[XB_XCNT(b.x)], 1u);
    return b;
}
__device__ __forceinline__ void xcd_barrier_complete(unsigned* bar, unsigned x, unsigned& nloc, unsigned& nx) {
    const unsigned G = gridDim.x * gridDim.y * gridDim.z;
    unsigned sum, cnt, mine, sp = 0u;
    for (;;) {
        sum = 0u; cnt = 0u; mine = 0u;
#pragma unroll
        for (unsigned j = 0; j < 16; ++j) { const unsigned c = xb_ld(&bar[XB_XCNT(j)]); sum += c; cnt += (c > 0u) ? 1u : 0u; mine = (j == x) ? c : mine; }
        if (sum == G) break;
        __builtin_amdgcn_s_sleep(1);
        if ((++sp & 255u) == 0u) { if (xb_ld(&bar[XB_TMO])) break; if (sp > XB_SPIN_CAP) { atomicAdd(&bar[XB_TMO], 1u); break; } }
    }
    nloc = mine > 0u ? mine : 1u; nx = cnt > 0u ? cnt : 1u;
}
__device__ __forceinline__ void xcd_barrier(const XcdBarrier& b) {
    asm volatile("s_waitcnt vmcnt(0)" ::: "memory");
    __syncthreads();
    if (threadIdx.x == 0) {
        unsigned* bar = b.bar;
        __builtin_amdgcn_s_waitcnt(0);
        unsigned nloc = b.st[0], nx = b.st[1];
        if (nloc == 0u) { xcd_barrier_complete(bar, b.x, nloc, nx); b.st[0] = nloc; b.st[1] = nx; }
        const unsigned old = xb_add(&bar[XB_XSUB(b.x)], 1u);
        const unsigned gen = old / nloc;
        if (old + 1u == (gen + 1u) * nloc) {
            __builtin_amdgcn_fence(__ATOMIC_RELEASE, "agent");
            asm volatile("s_waitcnt vmcnt(0)" ::: "memory");
            const unsigned og = xb_add(&bar[XB_TOP], 1u);
            const unsigned tg = og / nx;
            if (og + 1u == (tg + 1u) * nx) xb_add(&bar[XB_TOPGEN], 1u);
            else XB_SPIN(xb_ld(&bar[XB_TOPGEN]) == tg, bar);
            __builtin_amdgcn_fence(__ATOMIC_ACQUIRE, "agent");
            xb_add(&bar[XB_XGEN(b.x)], 1u);
            asm volatile("s_waitcnt vmcnt(0)" ::: "memory");
        } else {
            XB_SPIN(xb_ld(&bar[XB_XGEN(b.x)]) == gen, bar);
            __builtin_amdgcn_fence(__ATOMIC_ACQUIRE, "agent");
            asm volatile("s_waitcnt vmcnt(0)" ::: "memory");
        }
    }
    __syncthreads();
}

__global__ void __launch_bounds__(512, 2) mega(Params p) {
    extern __shared__ __attribute__((aligned(16))) unsigned char lds[];
    float* sm = (float*)lds;
    PG8_LAS unsigned char* LDS = (PG8_LAS unsigned char*)lds;
    unsigned char* ws = p.ws;
    bf16* H = (bf16*)(ws + OFF_H); bf16* ZS = (bf16*)(ws + OFF_ZS); float* G = (float*)(ws + OFF_G); bf16* HC = (bf16*)(ws + OFF_HC); float* Y = (float*)(ws + OFF_Y);
    const int* ctl = (const int*)(ws + OFF_CTL);
    volatile __attribute__((address_space(3))) unsigned* bst = (volatile __attribute__((address_space(3))) unsigned*)((PG8_LAS unsigned char*)lds + LDS_BYTES - 64);
    if (threadIdx.x < 2) bst[threadIdx.x] = 0u;
    __syncthreads();
    const XcdBarrier gbar = xcd_barrier_post((unsigned*)(ws + OFF_BAR), bst);

#ifndef DIAG_Q
#define DIAG_Q 10.f
#endif
#ifdef DIAG_SEL
#define PH(k, ...) do { const unsigned long long t0_ = __builtin_amdgcn_s_memrealtime(); { __VA_ARGS__; xcd_barrier(gbar); } if (blockIdx.x == 0 && threadIdx.x == 0) ((unsigned long long*)(ws + OFF_CTL + 98304))[30 + (k)] = __builtin_amdgcn_s_memrealtime() - t0_; } while (0)
#else
#define PH(k, ...) do { for (int _r = 0; _r < (((REP_MASK >> (k)) & 1) ? 2 : 1); ++_r) { __VA_ARGS__; xcd_barrier(gbar); } } while (0)
#endif
    PH(0, phase_mod(p, sm); phase_wconv(p, sm, 2, blockIdx.x, gridDim.x * 8));
    PH(1, phase_norm<0>(p, 0, (int*)sm));
    PH(2, { pg8::Gemm g{H, (const bf16*)(ws + OFF_W_ABIN), MROWS, NP_ABIN, DM, DM}; pg8::StaticOrder S; S.init(MROWS, NP_ABIN, gridDim.x, blockIdx.x); pg8::EpiInProj E{ZS, G, 20, 16}; pg8::gemm_phase(LDS, g, S, E); });
    PH(19, sc::prep_conv(p, 0); sc::prep_gates(p, 0));
    PH(3, phase_scan(p, 0, sm));
    PH(4, phase_mix2(p, 0, sm));
    PH(5, { pg8::Gemm g{HC, (const bf16*)(ws + OFF_W_ABOUT), MROWS, DM, 2048, 2048}; pg8::StaticOrder S; S.init(NTOK, DM, gridDim.x, blockIdx.x); pg8::EpiBf16 E{(bf16*)Y, DM}; pg8::gemm_phase(LDS, g, S, E); }
          { pg8::Gemm g{HC, (const bf16*)(ws + OFF_W_ABOUT), MROWS, DM, 256, 2048}; pg8::SplitOrder S{64, 4, 8, 256, (int)gridDim.x, (int)blockIdx.x, nullptr, 0}; pg8::EpiPart E{(float*)(ws + OFF_SO), 64, 4}; pg8::gemm_phase(LDS, g, S, E); });
    PH(6, phase_norm<1>(p, 0, (int*)sm, 8));
    PH(7, { pg8::Gemm g{H, (const bf16*)(ws + OFF_W_FFN1), MROWS, 2 * FFD, DM / 2, DM / 2}; pg8::StaticOrder S; S.init(MROWS, 2 * FFD, gridDim.x, blockIdx.x); pg8::EpiSwigluF8 E{ws + OFF_ACT, FFD, 1.f / (F8_XS * F8_W1S), F8_AS}; pg8::gemm_phase_f8(LDS, g, S, E); });
    PH(8, { const float dsc = 1.f / (F8_AS * F8_W2S);
          { pg8::Gemm g{(const bf16*)(ws + OFF_ACT), (const bf16*)(ws + OFF_W_FFN2), MROWS, DM, FFD / 2, FFD / 2}; pg8::StaticOrder S; S.init(NTOK, DM, gridDim.x, blockIdx.x); pg8::EpiBf16S E{(bf16*)Y, DM, dsc}; pg8::gemm_phase_f8(LDS, g, S, E); }
          { pg8::Gemm g{(const bf16*)(ws + OFF_ACT), (const bf16*)(ws + OFF_W_FFN2), MROWS, DM, 128, FFD / 2}; pg8::SplitOrder S{64, 4, 11, 128, (int)gridDim.x, (int)blockIdx.x, nullptr, 0}; pg8::EpiPartS E{(float*)(ws + OFF_SO), 64, 4, dsc}; pg8::gemm_phase_f8(LDS, g, S, E); } });
    PH(9, phase_norm<2>(p, 0, (int*)sm, 11));
    PH(10, { pg8::Gemm g{H, (const bf16*)(ws + OFF_W_CDIN), MROWS, NP_CDIN, DM, DM}; pg8::InProj1Order S; S.init(NTOK, NP_CDIN, gridDim.x, blockIdx.x); pg8::EpiInProj E{ZS, G, 22, 64}; pg8::gemm_phase(LDS, g, S, E); });
    PH(20, sc::prep_conv(p, 1); sc::prep_gates(p, 1); sc::prep_gla(p, (unsigned char*)sm));
    PH(11, phase_scan(p, 1, sm));
    PH(12, phase_mix2(p, 1, sm));
    PH(13, { pg8::Gemm g{HC, (const bf16*)(ws + OFF_W_CDOUT), MROWS, DM, 2048, 2048}; pg8::SkipCtxOrder S; S.init(NTOK, DM, gridDim.x, blockIdx.x); pg8::EpiBf16 E{(bf16*)Y, DM}; pg8::gemm_phase(LDS, g, S, E); });
    PH(14, phase_norm<1>(p, 1, (int*)sm));
#ifndef DIAG_NOROUTER
    PH(15, phase_route_gather(p, sm));
    PH(17, { pg8::Gemm g{(const bf16*)(ws + OFF_XS), (const bf16*)(ws + OFF_W_MOE1), ctl[CW_TOT], 2 * FFE, DM / 2, DM / 2}; pg8::MoeOrder S; S.init(ctl[CW_TOT], 2 * FFE, gridDim.x, blockIdx.x); S.ctl = ctl; S.estride = (size_t)2 * FFE * DM;
          pg8::EpiSwigluF8 E{ws + OFF_ACTM, FFE, 1.f / (F8_XS * F8_W1S), F8_AS}; pg8::gemm_phase_f8(LDS, g, S, E); });
    PH(18, { const int tot = ctl[CW_TOT], nmain = tot < 2 * NTOK ? tot : 2 * NTOK; const float dsc = 1.f / (F8_AS * F8_W2S);
          { pg8::Gemm g{(const bf16*)(ws + OFF_ACTM), (const bf16*)(ws + OFF_W_MOE2), tot, DM, FFE / 2, FFE / 2}; pg8::MoeOrder S; S.init(nmain, DM, gridDim.x, blockIdx.x); S.ctl = ctl; S.estride = (size_t)DM * FFE; pg8::EpiBf16S E{(bf16*)(ws + OFF_YS), DM, dsc}; pg8::gemm_phase_f8(LDS, g, S, E); }
          { pg8::Gemm g{(const bf16*)(ws + OFF_ACTM), (const bf16*)(ws + OFF_W_MOE2), tot, DM, 256, FFE / 2}; pg8::SplitOrder S{128, (tot - nmain) / 256, 7, 256, (int)gridDim.x, (int)blockIdx.x, ctl, (size_t)DM * FFE}; pg8::EpiPartS E{(float*)(ws + OFF_YS + 68 * MiB), 128, 8, dsc}; pg8::gemm_phase_f8(LDS, g, S, E); } });
#ifdef DIAG_SEL
    const unsigned long long tn3_ = __builtin_amdgcn_s_memrealtime();
#endif
    phase_norm<3>(p, 1, (int*)sm);
#ifdef DIAG_SEL
    if (blockIdx.x == 0 && threadIdx.x == 0) ((unsigned long long*)(ws + OFF_CTL + 98304))[29] = __builtin_amdgcn_s_memrealtime() - tn3_;
#endif
#endif
#ifdef DIAG_SEL
    xcd_barrier(gbar);
    for (size_t i_ = (size_t)blockIdx.x * 512 + threadIdx.x; i_ < (size_t)NTOK * DM; i_ += (size_t)gridDim.x * 512) p.out[i_] = 0.f;
    xcd_barrier(gbar);
    if (blockIdx.x == 0 && threadIdx.x == 0) { const unsigned long long* dg = (const unsigned long long*)(ws + OFF_CTL + 98304); const float tus = (DIAG_SEL == 0) ? 200.f : ((DIAG_SEL >= 29) ? floorf((float)(dg[DIAG_SEL]) * 0.01f / DIAG_Q + 0.5f) * DIAG_Q * 2.f : (DIAG_SEL >= 10) ? floorf((float)(dg[DIAG_SEL]) * 0.01f / 12.f + 0.5f) * 12.f * 4.f : floorf((float)(dg[DIAG_SEL]) * 0.01f / 30.f + 0.5f) * 30.f); p.out[0] = 50.f * tus; }
#endif
#ifdef EXTRA_SYNCS
    for (int i_ = 0; i_ < EXTRA_SYNCS; ++i_) xcd_barrier(gbar);
#endif
#undef PH
}

__global__ void nan_fill(float* out, int n) { int i = blockIdx.x * blockDim.x + threadIdx.x; if (i < n) out[i] = __builtin_nanf(""); }

extern "C" void kernel_launch(void* const* d_in, const int* in_sizes, int n_in, void* d_out, int out_size, void* d_ws, size_t ws_size, hipStream_t stream) {
    static int grid_blocks = 0;
    if (grid_blocks == 0) {
        int dev = 0, cus = 0, per_cu = 0;
        hipGetDevice(&dev);
        hipDeviceGetAttribute(&cus, hipDeviceAttributeMultiprocessorCount, dev);
        hipFuncSetAttribute((const void*)mega, hipFuncAttributeMaxDynamicSharedMemorySize, LDS_BYTES);
        hipOccupancyMaxActiveBlocksPerMultiprocessor(&per_cu, (const void*)mega, 512, LDS_BYTES);
        if (per_cu < 1) per_cu = 1;
        grid_blocks = cus * (per_cu > 1 ? 1 : per_cu);
        if (grid_blocks <= 0) grid_blocks = 256;
    }
    if (n_in != 37 || ws_size < WS_NEED) { fprintf(stderr, "kernel_launch: bad n_in %d or ws %zu < %zu\n", n_in, ws_size, (size_t)WS_NEED); nan_fill<<<(out_size + 255) / 256, 256, 0, stream>>>((float*)d_out, out_size); return; }
    Params p{};
    for (int i = 0; i < 37; ++i) p.in[i] = (const float*)d_in[i];
    p.out = (float*)d_out; p.ws = (unsigned char*)d_ws;
    if (hipMemsetAsync(d_ws, 0, 131072, stream) != hipSuccess) { fprintf(stderr, "kernel_launch: memset failed\n"); return; }
    hipLaunchKernelGGL(mega, dim3(grid_blocks), dim3(512), LDS_BYTES, stream, p);
    const hipError_t e = hipPeekAtLastError();
    if (e != hipSuccess) fprintf(stderr, "launch failed: %s (grid %d)\n", hipGetErrorString(e), grid_blocks);
}
```
